# Optimizing an MI355X kernel written in HIP

```python
import math
import jax
import jax.numpy as jnp
from jax import lax
import numpy as np

D_MODEL = 1024
BATCH = 8
SEQ = 4096
DEPTH = 2

HEAD_DIM = 64
ATTN_WIDTH = 3 * D_MODEL // 8
ATTN_HEADS = ATTN_WIDTH // HEAD_DIM
ATTN_GROUPS = ((128, 1), (512, 4), (2048, 16))
ATTN_HEADS_PER_GROUP = ATTN_HEADS // len(ATTN_GROUPS)
RWKV_WIDTH = 3 * D_MODEL // 8
RWKV_HEADS = RWKV_WIDTH // HEAD_DIM
DECAY_LORA = 64
AAA_LORA = 64
GATE_LORA = 128
RWKV_IN = 3 * RWKV_WIDTH + DECAY_LORA + AAA_LORA + GATE_LORA
RWKV_SPLITS = (RWKV_WIDTH, 2 * RWKV_WIDTH, 3 * RWKV_WIDTH,
               3 * RWKV_WIDTH + DECAY_LORA, 3 * RWKV_WIDTH + DECAY_LORA + AAA_LORA)
GN_EPS = 64e-5
SSM_WIDTH = D_MODEL // 4
SSM_GROUP_CH = 16
SSM_GROUPS = SSM_WIDTH // SSM_GROUP_CH
SSM_STATE = 64
STEP_MIN = 1e-3
STEP_MAX = 1e-1
N_BRANCH = 3
ATTN_IN = 3 * ATTN_WIDTH
RWKV_OFF = ATTN_IN
SSM_OFF = RWKV_OFF + RWKV_IN
GATE_OFF = SSM_OFF + SSM_WIDTH
N_IN = GATE_OFF + N_BRANCH * D_MODEL
FFN_HIDDEN = ((8 * D_MODEL + 3 * 256 - 1) // (3 * 256)) * 256
NORM_EPS = 1e-6

kernel_name = "hybrid_dilated_rwkv7_s5_block"


def rmsnorm(z, gain):
    zf = z.astype(jnp.float32)
    y = zf * lax.rsqrt(jnp.mean(zf * zf, axis=-1, keepdims=True) + NORM_EPS) * gain.astype(jnp.float32)
    return y.astype(z.dtype)


def token_shift(z):
    return jnp.pad(z, ((0, 0), (1, 0), (0, 0)))[:, :-1]


def dilated_window_attention(q, k, v, window, dilation):
    bsz, s, h, e = q.shape
    n_back = window // dilation
    span = n_back * dilation
    s_pad = -(-s // span) * span
    nb = s_pad // span

    def blocks(z):
        z = jnp.pad(z, ((0, 0), (0, s_pad - s), (0, 0), (0, 0)))
        return z.reshape(bsz, nb, n_back, dilation, h, e)

    def with_prev(z):
        prev = jnp.pad(z, ((0, 0), (1, 0), (0, 0), (0, 0), (0, 0), (0, 0)))[:, :-1]
        return jnp.concatenate([prev, z], axis=2)

    qb = blocks(q).astype(jnp.float32)
    kb = with_prev(blocks(k)).astype(jnp.float32)
    vb = with_prev(blocks(v)).astype(jnp.float32)
    scores = jnp.einsum('bnqrhe,bnkrhe->bnrhqk', qb, kb) * (e ** -0.5)
    qi = jnp.arange(n_back)[:, None]
    kj = jnp.arange(2 * n_back)[None, :]
    band = (kj >= qi) & (kj <= qi + n_back)
    has_prev = (jnp.arange(nb) > 0)[:, None, None] | (jnp.arange(2 * n_back) >= n_back)[None, None, :]
    mask = band[None] & has_prev
    scores = jnp.where(mask[None, :, None, None], scores, -jnp.inf)
    mx = jnp.max(scores, axis=-1, keepdims=True)
    p = jnp.exp(scores - mx)
    den = jnp.sum(p, axis=-1, keepdims=True)
    out = jnp.einsum('bnrhqk,bnkrhe->bnqrhe', p / den, vb)
    lse = (mx + jnp.log(den))[..., 0]
    out = out.reshape(bsz, s_pad, h, e)[:, :s]
    lse = jnp.transpose(lse, (0, 1, 4, 2, 3)).reshape(bsz, s_pad, h)[:, :s]
    return out, lse


def dilated_mixture_attention(p_attn):
    bsz, s, _ = p_attn.shape
    q, k, v = (t.reshape(bsz, s, ATTN_HEADS, HEAD_DIM) for t in jnp.split(p_attn, 3, axis=-1))
    outs, lses = [], []
    for g, (window, dilation) in enumerate(ATTN_GROUPS):
        hs = slice(g * ATTN_HEADS_PER_GROUP, (g + 1) * ATTN_HEADS_PER_GROUP)
        o, lse = dilated_window_attention(q[:, :, hs], k[:, :, hs], v[:, :, hs], window, dilation)
        outs.append(o)
        lses.append(lse)
    alpha = jax.nn.softmax(jnp.stack(lses, axis=0), axis=0)
    o = jnp.concatenate([o_g * alpha[g][..., None] for g, o_g in enumerate(outs)], axis=2)
    return o.reshape(bsz, s, ATTN_WIDTH)


def wkv7_scan(r, w, k, v, a, b):
    bsz, _, h, e = r.shape

    def step(state, inp):
        r_t, w_t, k_t, v_t, a_t, b_t = inp
        sa = jnp.einsum('bhij,bhj->bhi', state, a_t)
        state = (state * w_t[:, :, None, :] + sa[..., None] * b_t[:, :, None, :]
                 + v_t[..., None] * k_t[:, :, None, :])
        return state, jnp.einsum('bhij,bhj->bhi', state, r_t)

    xs = tuple(jnp.moveaxis(t, 1, 0) for t in (r, w, k, v, a, b))
    _, y = lax.scan(step, jnp.zeros((bsz, h, e, e), jnp.float32), xs)
    return jnp.moveaxis(y, 0, 1)


def rwkv7_time_mix(p_rwkv, shift_mix, w0, w2, a0, a2, g2, k_k, k_a, r_k, ln_w, ln_b):
    bsz, s, _ = p_rwkv.shape
    z = p_rwkv.astype(jnp.float32)
    z = z + (token_shift(z) - z) * shift_mix
    r, k, v, xw, xa, xg = jnp.split(z, RWKV_SPLITS, axis=-1)
    w = -jax.nn.softplus(-(w0 + jnp.tanh(xw) @ w2)) - 0.5
    decay = jnp.exp(-jnp.exp(w))
    a = jax.nn.sigmoid(a0 + xa @ a2)
    g = jax.nn.sigmoid(xg) @ g2

    def heads(t):
        return t.reshape(bsz, s, RWKV_HEADS, HEAD_DIM)

    kk = heads(k * k_k)
    kk = kk / jnp.maximum(jnp.linalg.norm(kk, axis=-1, keepdims=True), 1e-12)
    k = k * (1.0 + (a - 1.0) * k_a)
    r_h, k_h, v_h, a_h = heads(r), heads(k), heads(v), heads(a)
    y = wkv7_scan(r_h, heads(decay), k_h, v_h, -kk, kk * a_h)
    mu = jnp.mean(y, axis=-1, keepdims=True)
    var = jnp.mean(jnp.square(y - mu), axis=-1, keepdims=True)
    y = ((y - mu) * lax.rsqrt(var + GN_EPS)).reshape(bsz, s, RWKV_WIDTH) * ln_w + ln_b
    bonus = jnp.sum(r_h * k_h * r_k, axis=-1, keepdims=True) * v_h
    return (y + bonus.reshape(bsz, s, RWKV_WIDTH)) * g


def _complex_linear_combine(e1, e2):
    a1r, a1i, b1r, b1i = e1
    a2r, a2i, b2r, b2i = e2
    return (a2r * a1r - a2i * a1i, a2r * a1i + a2i * a1r,
            a2r * b1r - a2i * b1i + b2r, a2r * b1i + a2i * b1r + b2i)


def s5_glu(p_ssm, a_re, a_im, log_step, b_re, b_im, c_re, c_im, d_skip, w_val, w_gate):
    bsz, s, _ = p_ssm.shape
    u = p_ssm.astype(jnp.float32).reshape(bsz, s, SSM_GROUPS, SSM_GROUP_CH)
    lam_re = a_re.astype(jnp.float32)
    lam_im = a_im.astype(jnp.float32)
    step = jnp.exp(log_step.astype(jnp.float32))[:, None]
    mag = jnp.exp(lam_re * step)
    ang = lam_im * step
    abar_re, abar_im = mag * jnp.cos(ang), mag * jnp.sin(ang)
    inv = 1.0 / (lam_re * lam_re + lam_im * lam_im)
    f_re = ((abar_re - 1.0) * lam_re + abar_im * lam_im) * inv
    f_im = (abar_im * lam_re - (abar_re - 1.0) * lam_im) * inv
    bbar_re = f_re[..., None] * b_re - f_im[..., None] * b_im
    bbar_im = f_re[..., None] * b_im + f_im[..., None] * b_re
    bu_re = jnp.einsum('bsgc,gpc->bsgp', u, bbar_re)
    bu_im = jnp.einsum('bsgc,gpc->bsgp', u, bbar_im)
    shape = bu_re.shape
    _, _, x_re, x_im = lax.associative_scan(
        _complex_linear_combine,
        (jnp.broadcast_to(abar_re, shape), jnp.broadcast_to(abar_im, shape), bu_re, bu_im),
        axis=1)
    y = (jnp.einsum('bsgp,gcp->bsgc', x_re, c_re) - jnp.einsum('bsgp,gcp->bsgc', x_im, c_im)
         + d_skip.reshape(SSM_GROUPS, SSM_GROUP_CH) * u)
    zg = jax.nn.gelu(y.reshape(bsz, s, SSM_WIDTH))
    return (zg @ w_val) * jax.nn.sigmoid(zg @ w_gate)


def swiglu(u, w_gate_up, w_down):
    a, b = jnp.split(u @ w_gate_up, 2, axis=-1)
    return (jax.nn.silu(a) * b) @ w_down


def setup_inputs(seed: int = 0) -> dict:
    key = jax.random.key(seed)
    ks = iter(jax.random.split(key, 40))
    f32 = jnp.float32

    def nrm(shape, scale):
        return jax.random.normal(next(ks), shape, f32) * scale

    def uni(shape, lo, hi):
        return jax.random.uniform(next(ks), shape, f32, lo, hi)

    L, D = DEPTH, D_MODEL
    G, P, C = SSM_GROUPS, SSM_STATE, SSM_GROUP_CH
    return {
        "x": nrm((BATCH, SEQ, D), 1.0),
        "norm_mix": 1.0 + nrm((L, D), 0.02),
        "w_in": nrm((L, D, N_IN), D ** -0.5),
        "rwkv_shift_mix": uni((L, RWKV_IN), 0.0, 1.0),
        "rwkv_w0": uni((L, RWKV_WIDTH), -6.0, -1.0),
        "rwkv_w2": nrm((L, DECAY_LORA, RWKV_WIDTH), 0.1 * DECAY_LORA ** -0.5),
        "rwkv_a0": nrm((L, RWKV_WIDTH), 0.1),
        "rwkv_a2": nrm((L, AAA_LORA, RWKV_WIDTH), 0.5 * AAA_LORA ** -0.5),
        "rwkv_g2": nrm((L, GATE_LORA, RWKV_WIDTH), GATE_LORA ** -0.5),
        "rwkv_k_k": 0.85 + nrm((L, RWKV_WIDTH), 0.02),
        "rwkv_k_a": 1.0 + nrm((L, RWKV_WIDTH), 0.02),
        "rwkv_r_k": nrm((L, RWKV_HEADS, HEAD_DIM), 0.1),
        "rwkv_ln_w": 1.0 + nrm((L, RWKV_WIDTH), 0.02),
        "rwkv_ln_b": nrm((L, RWKV_WIDTH), 0.02),
        "ssm_a_re": -0.5 + nrm((L, G, P), 0.01),
        "ssm_a_im": jnp.pi * jnp.arange(P, dtype=f32) + nrm((L, G, P), 0.01),
        "ssm_log_step": uni((L, G), math.log(STEP_MIN), math.log(STEP_MAX)),
        "ssm_b_re": nrm((L, G, P, C), (2 * C) ** -0.5),
        "ssm_b_im": nrm((L, G, P, C), (2 * C) ** -0.5),
        "ssm_c_re": nrm((L, G, C, P), P ** -0.5),
        "ssm_c_im": nrm((L, G, C, P), P ** -0.5),
        "ssm_d": nrm((L, SSM_WIDTH), 1.0),
        "ssm_glu_val": nrm((L, SSM_WIDTH, SSM_WIDTH), SSM_WIDTH ** -0.5),
        "ssm_glu_gate": nrm((L, SSM_WIDTH, SSM_WIDTH), SSM_WIDTH ** -0.5),
        "w_branch_attn": nrm((L, ATTN_WIDTH, D), ATTN_WIDTH ** -0.5),
        "w_branch_rwkv": nrm((L, RWKV_WIDTH, D), RWKV_WIDTH ** -0.5),
        "w_branch_ssm": nrm((L, SSM_WIDTH, D), SSM_WIDTH ** -0.5),
        "w_out": nrm((L, D, D), D ** -0.5),
        "norm_ffn": 1.0 + nrm((L, D), 0.02),
        "ffn_w_gate_up": nrm((L, D, 2 * FFN_HIDDEN), D ** -0.5),
        "ffn_w_down": nrm((L, FFN_HIDDEN, D), FFN_HIDDEN ** -0.5),
        "norm_final": 1.0 + nrm((D,), 0.02),
    }


def reference(x, norm_mix, w_in, rwkv_shift_mix, rwkv_w0, rwkv_w2, rwkv_a0, rwkv_a2, rwkv_g2,
              rwkv_k_k, rwkv_k_a, rwkv_r_k, rwkv_ln_w, rwkv_ln_b, ssm_a_re, ssm_a_im, ssm_log_step,
              ssm_b_re, ssm_b_im, ssm_c_re, ssm_c_im, ssm_d, ssm_glu_val, ssm_glu_gate,
              w_branch_attn, w_branch_rwkv, w_branch_ssm, w_out, norm_ffn, ffn_w_gate_up,
              ffn_w_down, norm_final):
    h = x
    for l in range(DEPTH):
        u = rmsnorm(h, norm_mix[l])
        p = u @ w_in[l]
        bsz, s, _ = p.shape
        y_attn = dilated_mixture_attention(p[..., :ATTN_IN]) @ w_branch_attn[l]
        y_rwkv = rwkv7_time_mix(p[..., RWKV_OFF:SSM_OFF], rwkv_shift_mix[l], rwkv_w0[l], rwkv_w2[l],
                                rwkv_a0[l], rwkv_a2[l], rwkv_g2[l], rwkv_k_k[l], rwkv_k_a[l],
                                rwkv_r_k[l], rwkv_ln_w[l], rwkv_ln_b[l]) @ w_branch_rwkv[l]
        y_ssm = s5_glu(p[..., SSM_OFF:GATE_OFF], ssm_a_re[l], ssm_a_im[l], ssm_log_step[l],
                       ssm_b_re[l], ssm_b_im[l], ssm_c_re[l], ssm_c_im[l], ssm_d[l],
                       ssm_glu_val[l], ssm_glu_gate[l]) @ w_branch_ssm[l]
        gates = jax.nn.sigmoid(p[..., GATE_OFF:].astype(jnp.float32)).reshape(bsz, s, N_BRANCH, D_MODEL)
        merged = gates[:, :, 0] * y_attn + gates[:, :, 1] * y_rwkv + gates[:, :, 2] * y_ssm
        h = h + (merged @ w_out[l]).astype(h.dtype)
        u = rmsnorm(h, norm_ffn[l])
        h = h + swiglu(u, ffn_w_gate_up[l], ffn_w_down[l]).astype(h.dtype)
    return rmsnorm(h, norm_final)
```

```cpp
#include <hip/hip_runtime.h>
#include <hip/hip_cooperative_groups.h>
#include <cstdio>
#include <cstdint>
namespace cg = cooperative_groups;
#ifndef ONE_LAUNCH
#define ONE_LAUNCH 0
#endif
namespace pg8 {
#define PG8_LAS __attribute__((address_space(3)))
typedef unsigned short bf16_t;
typedef short bf16x8 __attribute__((ext_vector_type(8)));
typedef float f32x4 __attribute__((ext_vector_type(4)));
typedef float f32x2 __attribute__((ext_vector_type(2)));
typedef unsigned u32x4 __attribute__((ext_vector_type(4)));
typedef unsigned u32x2 __attribute__((ext_vector_type(2)));
constexpr int BM = 256, BK = 64, HALF = 128, HTB = HALF * BK * 2  , STAGE_BYTES = 8 * HTB, NXCD = 8, WGM = 8;

__host__ __device__ __forceinline__ int lds_byte(int r, int c) { const int st = (r >> 4) * 2 + (c >> 5), rr = r & 15, cc = c & 31, ob = rr * 64 + cc * 2; return st * 1024 + (ob ^ (((ob >> 9) & 1) << 5)); }
__host__ __device__ __forceinline__ void stage_rc(int b, int& R, int& C) { const int st = b / 1024, sb = b % 1024, swz = sb ^ (((sb >> 9) & 1) << 5); R = (st >> 1) * 16 + swz / 64; C = (st & 1) * 32 + (swz % 64) / 2; }
__host__ __device__ __forceinline__ int perm32(int rho) { const int n = rho >> 4, i = rho & 15; return 8 * (i >> 2) + 4 * n + (i & 3); }

struct Unit { int pm, pn; };
struct Gemm { const bf16_t* A; const bf16_t* Bt; int M, N, K, lda; };

struct StaticOrder {
    int nM, nN, nwg, G, c;
    __host__ __device__ void init(int M, int N, int G_, int c_) { nM = M / BM; nN = N / BM; nwg = nM * nN; G = G_; c = c_; }
    __host__ __device__ bool next(int i, Unit& u) const {
        const long L = (long)i * G + c; if (L >= nwg) return false;
        int wgid = (int)L; { const int q = nwg / NXCD, r = nwg % NXCD, xcd = wgid % NXCD, off = wgid / NXCD; wgid = (xcd < r ? xcd * (q + 1) : r * (q + 1) + (xcd - r) * q) + off; }
        const int nig = WGM * nN, gid = wgid / nig, fm = gid * WGM, gsz = (nM - fm) < WGM ? (nM - fm) : WGM;
        u.pm = fm + ((wgid % nig) % gsz); u.pn = (wgid % nig) / gsz; return true;
    }
    __device__ __forceinline__ void a_ready(const Unit&) const {}
    __device__ __forceinline__ void done(const Unit&) const {}
};

__device__ __forceinline__ unsigned cvt_pk_bf16(float lo, float hi) { unsigned r; asm volatile("v_cvt_pk_bf16_f32 %0, %1, %2" : "=v"(r) : "v"(lo), "v"(hi)); return r; }
__device__ __forceinline__ float bf_lo(unsigned w) { return __uint_as_float(w << 16); }
__device__ __forceinline__ float bf_hi(unsigned w) { return __uint_as_float(w & 0xffff0000u); }
__device__ __forceinline__ float sigmoidf_(float x) { return __builtin_amdgcn_rcpf(1.0f + __expf(-x)); }


struct EpiAny;
__device__ __forceinline__ void epi_win(bf16_t* PS, unsigned char* GT, const f32x4 (&acc)[2][2][4][2], const Unit& u, int wr, int wc, int fr, int fq) {
        const int row0 = u.pm * BM + wr * 64 + fr;
        if (u.pn < 11) {
            const int col0 = u.pn * BM + wc * 32 + 8 * fq;
#pragma unroll
            for (int ai = 0; ai < 2; ++ai)
#pragma unroll
                for (int m = 0; m < 4; ++m) { bf16_t* rowp = PS + (size_t)(row0 + ai * HALF + m * 16) * 2816 + col0;
#pragma unroll
                    for (int bj = 0; bj < 2; ++bj) { const f32x4 v0 = acc[ai][bj][m][0], v1 = acc[ai][bj][m][1];
                        u32x4 w; w.x = cvt_pk_bf16(v0[0], v0[1]); w.y = cvt_pk_bf16(v0[2], v0[3]); w.z = cvt_pk_bf16(v1[0], v1[1]); w.w = cvt_pk_bf16(v1[2], v1[3]);
                        *(u32x4*)(rowp + bj * HALF) = w; } }
        } else {
            const int col0 = (u.pn - 11) * BM + wc * 32 + 8 * fq;
#pragma unroll
            for (int ai = 0; ai < 2; ++ai)
#pragma unroll
                for (int m = 0; m < 4; ++m) { unsigned char* rowp = GT + (size_t)(row0 + ai * HALF + m * 16) * 3072 + col0;
#pragma unroll
                    for (int bj = 0; bj < 2; ++bj) { const f32x4 v0 = acc[ai][bj][m][0], v1 = acc[ai][bj][m][1];
                        unsigned q[8];
#pragma unroll
                        for (int k = 0; k < 4; ++k) { q[k] = (unsigned)(sigmoidf_(v0[k]) * 255.0f + 0.5f); q[4 + k] = (unsigned)(sigmoidf_(v1[k]) * 255.0f + 0.5f); }
                        u32x2 w; w.x = q[0] | (q[1] << 8) | (q[2] << 16) | (q[3] << 24); w.y = q[4] | (q[5] << 8) | (q[6] << 16) | (q[7] << 24);
                        *(u32x2*)(rowp + bj * HALF) = w; } }
        }
    }

__device__ __forceinline__ void epi_merge(bf16_t* MG, const unsigned char* GT, int gi, const f32x4 (&acc)[2][2][4][2], const Unit& u, int wr, int wc, int fr, int fq) {
        const int row0 = u.pm * BM + wr * 64 + fr, col0 = u.pn * BM + wc * 32 + 8 * fq;
#pragma unroll
        for (int ai = 0; ai < 2; ++ai)
#pragma unroll
            for (int m = 0; m < 4; ++m) { const size_t r = (size_t)(row0 + ai * HALF + m * 16);
#pragma unroll
                for (int bj = 0; bj < 2; ++bj) { const int c = col0 + bj * HALF;
                    const u32x2 gq = *(const u32x2*)(GT + r * 3072 + gi * 1024 + c);
                    float v[8];
#pragma unroll
                    for (int k = 0; k < 4; ++k) { v[k] = acc[ai][bj][m][0][k] * ((float)((gq.x >> (8 * k)) & 255u) * (1.0f / 255.0f)); v[4 + k] = acc[ai][bj][m][1][k] * ((float)((gq.y >> (8 * k)) & 255u) * (1.0f / 255.0f)); }
                    u32x4* dst = (u32x4*)(MG + r * 1024 + c);
                    if (gi > 0) { const u32x4 p = *dst;
                        v[0] += bf_lo(p.x); v[1] += bf_hi(p.x); v[2] += bf_lo(p.y); v[3] += bf_hi(p.y); v[4] += bf_lo(p.z); v[5] += bf_hi(p.z); v[6] += bf_lo(p.w); v[7] += bf_hi(p.w); }
                    u32x4 w; w.x = cvt_pk_bf16(v[0], v[1]); w.y = cvt_pk_bf16(v[2], v[3]); w.z = cvt_pk_bf16(v[4], v[5]); w.w = cvt_pk_bf16(v[6], v[7]);
                    *dst = w; } }
    }

__device__ __forceinline__ void epi_res(const float* base, float* out, const f32x4 (&acc)[2][2][4][2], const Unit& u, int wr, int wc, int fr, int fq) {
        const int row0 = u.pm * BM + wr * 64 + fr, col0 = u.pn * BM + wc * 32 + 4 * fq;
#pragma unroll
        for (int ai = 0; ai < 2; ++ai)
#pragma unroll
            for (int m = 0; m < 4; ++m) { const size_t off = (size_t)(row0 + ai * HALF + m * 16) * 1024 + col0;
#pragma unroll
                for (int bj = 0; bj < 2; ++bj)
#pragma unroll
                    for (int n = 0; n < 2; ++n) { const f32x4 b = *(const f32x4*)(base + off + bj * HALF + n * 16); *(f32x4*)(out + off + bj * HALF + n * 16) = b + acc[ai][bj][m][n]; } }
    }

template <int MODE> __device__ __forceinline__ void epi_pair(bf16_t* O, int ldo, const f32x4 (&acc)[2][2][4][2], const Unit& u, int wr, int wc, int fr, int fq) {
        const int row0 = u.pm * BM + wr * 64 + fr, col0 = u.pn * HALF + wc * 32 + 8 * fq;
#pragma unroll
        for (int ai = 0; ai < 2; ++ai)
#pragma unroll
            for (int m = 0; m < 4; ++m) { bf16_t* rowp = O + (size_t)(row0 + ai * HALF + m * 16) * ldo + col0;
                float v[8];
#pragma unroll
                for (int n = 0; n < 2; ++n)
#pragma unroll
                    for (int k = 0; k < 4; ++k) { const float a = acc[ai][0][m][n][k], b = acc[ai][1][m][n][k];
                        v[4 * n + k] = (MODE == 0) ? (a * sigmoidf_(a) * b) : (a * sigmoidf_(b)); }
                u32x4 w; w.x = cvt_pk_bf16(v[0], v[1]); w.y = cvt_pk_bf16(v[2], v[3]); w.z = cvt_pk_bf16(v[4], v[5]); w.w = cvt_pk_bf16(v[6], v[7]);
                *(u32x4*)rowp = w; }
    }


struct EpiAny {
    int kind;
    bf16_t* O; int ldo; unsigned char* GT; int gi; const float* base; float* out;
    __device__ __forceinline__ bool perm() const { return kind != 2; }
    __device__ __forceinline__ void operator()(const f32x4 (&acc)[2][2][4][2], const Unit& u, int wr, int wc, int fr, int fq) const {
        if (kind == 0) epi_win(O, GT, acc, u, wr, wc, fr, fq);
        else if (kind == 1) epi_merge(O, GT, gi, acc, u, wr, wc, fr, fq);
        else if (kind == 2) epi_res(base, out, acc, u, wr, wc, fr, fq);
        else if (kind == 3) epi_pair<0>(O, ldo, acc, u, wr, wc, fr, fq);
        else epi_pair<1>(O, ldo, acc, u, wr, wc, fr, fq);
    }
};

template <class Epi, class Sched, bool ALIGN_EPI = false>
__device__ __forceinline__ void gemm_phase(PG8_LAS unsigned char* lds, const Gemm g, const Sched& S, const Epi& E) {
    int tid_ = threadIdx.x; asm volatile("" : "+v"(tid_));
    const int tid = tid_, wid = __builtin_amdgcn_readfirstlane(tid >> 6), lane = tid & 63, wr = wid >> 2, wc = wid & 3, fr = lane & 15, fq = lane >> 4;
    const int K = g.K, lda = g.lda, nt = K / BK;
    unsigned voffA[2], voffB[2];
#pragma unroll
    for (int i = 0; i < 2; ++i) { int R, C; stage_rc(tid * 16 + i * 8192, R, C); const int Rb = E.perm() ? ((R & ~31) + perm32(R & 31)) : R;
        voffA[i] = (unsigned)(R * lda + C) * 2u; voffB[i] = (unsigned)(Rb * K + C) * 2u; }
    const size_t kstep = (size_t)(BK * 2);
    const size_t hstepA = (size_t)HALF * lda * 2, hstepB = (size_t)HALF * K * 2;
    const size_t tstepA = 2 * hstepA, tstepB = 2 * hstepB;
    const unsigned ldsw = (unsigned)wid * 1024u;
    const int aoff = lds_byte(wr * 64 + fr, fq * 8), boff = lds_byte(wc * 32 + fr, fq * 8);
#define PG8_SA(b, h) (((b) * 2 + (h)) * HTB)
#define PG8_SB(b, h) ((4 + (b) * 2 + (h)) * HTB)
#define PG8_STAGE(bufoff, gbase, voff) do { _Pragma("unroll") for (int _i = 0; _i < 2; ++_i) \
        __builtin_amdgcn_global_load_lds((const unsigned*)((const char*)(gbase) + (voff)[_i]), (PG8_LAS unsigned*)(lds + (bufoff) + ldsw + _i * 8192), 16, 0, 0); } while (0)
#define PG8_LDA(dst, b, h) do { _Pragma("unroll") for (int m = 0; m < 4; ++m) _Pragma("unroll") for (int k = 0; k < 2; ++k) dst[m][k] = *(const PG8_LAS bf16x8*)(lds + PG8_SA(b, h) + aoff + m * 2048 + k * 1024); } while (0)
#define PG8_LDB(dst, b, h) do { _Pragma("unroll") for (int n = 0; n < 2; ++n) _Pragma("unroll") for (int k = 0; k < 2; ++k) dst[n][k] = *(const PG8_LAS bf16x8*)(lds + PG8_SB(b, h) + boff + n * 2048 + k * 1024); } while (0)
#define PG8_MMA(ai, bj, At, Bt) do { __builtin_amdgcn_s_setprio(1); _Pragma("unroll") for (int m = 0; m < 4; ++m) _Pragma("unroll") for (int n = 0; n < 2; ++n) _Pragma("unroll") for (int k = 0; k < 2; ++k) \
        acc[ai][bj][m][n] = __builtin_amdgcn_mfma_f32_16x16x32_bf16(Bt[n][k], At[m][k], acc[ai][bj][m][n], 0, 0, 0); __builtin_amdgcn_s_setprio(0); } while (0)
#define PG8_WAIT_V(n) asm volatile("s_waitcnt vmcnt(" #n ")" ::: "memory")
#define PG8_WAIT_L(n) asm volatile("s_waitcnt lgkmcnt(" #n ")" ::: "memory")
#define PG8_BAR __builtin_amdgcn_s_barrier()
#define PG8_SCHED __builtin_amdgcn_sched_barrier(0)
    Unit cur, nxt; int ui = 0;
    if (!S.next(0, cur)) return;
    f32x4 acc[2][2][4][2];
#pragma unroll
    for (int a = 0; a < 2; ++a)
#pragma unroll
        for (int b = 0; b < 2; ++b)
#pragma unroll
            for (int m = 0; m < 4; ++m)
#pragma unroll
                for (int n = 0; n < 2; ++n) acc[a][b][m][n] = (f32x4){0.f, 0.f, 0.f, 0.f};
    bf16x8 At[4][2], B0[2][2], B1[2][2];
    const char* cA = (const char*)g.A + (size_t)cur.pm * tstepA; const char* cB = (const char*)g.Bt + (size_t)cur.pn * tstepB;
    S.a_ready(cur);
    PG8_STAGE(PG8_SB(0, 0), cB, voffB); PG8_STAGE(PG8_SB(0, 1), cB + hstepB, voffB); PG8_STAGE(PG8_SA(0, 0), cA, voffA); PG8_STAGE(PG8_SA(0, 1), cA + hstepA, voffA);
    if (wr == 1) PG8_BAR;
    PG8_WAIT_V(2); PG8_BAR;
    PG8_STAGE(PG8_SB(1, 0), cB + kstep, voffB); PG8_STAGE(PG8_SA(1, 0), cA + kstep, voffA); PG8_STAGE(PG8_SB(1, 1), cB + hstepB + kstep, voffB);
    PG8_WAIT_V(6); PG8_BAR;
    for (;;) {
        const bool has_next = S.next(ui + 1, nxt);
        const char* nA = has_next ? (const char*)g.A + (size_t)nxt.pm * tstepA : cA; const char* nB = has_next ? (const char*)g.Bt + (size_t)nxt.pn * tstepB : cB;
        for (int t = 0; t < nt; t += 2) {
            const bool last = (t == nt - 2);
            const char* a1 = cA + (size_t)(t + 1) * kstep;
            const char* a2 = last ? nA : cA + (size_t)(t + 2) * kstep; const char* b2 = last ? nB : cB + (size_t)(t + 2) * kstep;
            const char* a3 = a2 + kstep; const char* b3 = b2 + kstep;
            if (last && has_next) S.a_ready(nxt);
            PG8_LDB(B0, 0, 0); PG8_LDB(B1, 0, 1); PG8_SCHED; PG8_LDA(At, 0, 0); PG8_STAGE(PG8_SA(1, 1), a1 + hstepA, voffA);
            PG8_WAIT_V(8); PG8_WAIT_L(0); PG8_BAR; PG8_MMA(0, 0, At, B0); PG8_MMA(0, 1, At, B1); PG8_BAR; PG8_SCHED;
            PG8_LDA(At, 0, 1); PG8_STAGE(PG8_SB(0, 0), b2, voffB); PG8_STAGE(PG8_SB(0, 1), b2 + hstepB, voffB); PG8_STAGE(PG8_SA(0, 0), a2, voffA);
            PG8_WAIT_V(8); PG8_WAIT_L(0); PG8_BAR; PG8_MMA(1, 0, At, B0); PG8_MMA(1, 1, At, B1); PG8_BAR; PG8_SCHED;
            PG8_LDB(B0, 1, 0); PG8_LDB(B1, 1, 1); PG8_SCHED; PG8_LDA(At, 1, 0); PG8_STAGE(PG8_SA(0, 1), a2 + hstepA, voffA);
            PG8_WAIT_V(8); PG8_WAIT_L(0); PG8_BAR; PG8_MMA(0, 0, At, B0); PG8_MMA(0, 1, At, B1); PG8_BAR; PG8_SCHED;
            PG8_LDA(At, 1, 1); PG8_STAGE(PG8_SB(1, 0), b3, voffB); PG8_STAGE(PG8_SB(1, 1), b3 + hstepB, voffB); PG8_STAGE(PG8_SA(1, 0), a3, voffA);
            PG8_WAIT_V(8); PG8_WAIT_L(0); PG8_BAR; PG8_MMA(1, 0, At, B0); PG8_MMA(1, 1, At, B1); PG8_BAR; PG8_SCHED;
        }
        if constexpr (ALIGN_EPI) { if (wr == 0) PG8_BAR; }
        E(acc, cur, wr, wc, fr, fq); S.done(cur);
        if (!has_next) break;
#pragma unroll
        for (int a = 0; a < 2; ++a)
#pragma unroll
            for (int b = 0; b < 2; ++b)
#pragma unroll
                for (int m = 0; m < 4; ++m)
#pragma unroll
                    for (int n = 0; n < 2; ++n) acc[a][b][m][n] = (f32x4){0.f, 0.f, 0.f, 0.f};
        cur = nxt; cA = nA; cB = nB; ++ui;
        if constexpr (ALIGN_EPI) { if (wr == 1) PG8_BAR; }
    }
    PG8_WAIT_V(0);
    if constexpr (!ALIGN_EPI) { if (wr == 0) PG8_BAR; }
    PG8_BAR;
#undef PG8_SA
#undef PG8_SB
#undef PG8_STAGE
#undef PG8_LDA
#undef PG8_LDB
#undef PG8_MMA
#undef PG8_WAIT_V
#undef PG8_WAIT_L
#undef PG8_BAR
#undef PG8_SCHED
}
}
constexpr int NWAVES = 8, NTHREADS = 512;
constexpr int BATCH = 8, SEQ = 4096, T = BATCH * SEQ, D = 1024, DEPTH = 2;
constexpr int NIN = 5888, PSW = 2816, NGATE = 3072, FFH = 2816;
constexpr int C_Q = 0, C_K = 384, C_V = 768, C_RW = 1152, C_LORA = 2304, C_SSM = 2560;
constexpr float NORM_EPS = 1e-6f, GN_EPS = 64e-5f;

constexpr size_t MiB = 1u << 20;
constexpr size_t WS_CTL = 0, CTL_ZERO_BYTES = 1 * MiB;
constexpr size_t WS_W = 1 * MiB, W_LAYER = 33 * MiB;
constexpr size_t WO_IN = 0, WO_BA = 12 * MiB, WO_BR = WO_BA + 768 * 1024, WO_BS = WO_BR + 768 * 1024, WO_OUT = 14 * MiB, WO_GU = 16 * MiB, WO_DN = 27 * MiB, WO_GLU = 32 * MiB + 512 * 1024;
constexpr size_t WS_XN = 68 * MiB;
constexpr size_t WS_PS = 132 * MiB;
constexpr size_t WS_GT = 308 * MiB;
constexpr size_t WS_SO = 404 * MiB;
constexpr size_t WS_LSE = 420 * MiB;
constexpr size_t WS_SCR = 421 * MiB;
constexpr size_t WS_END = 512 * MiB;

constexpr int LDS_BYTES = 147456;

#define GAS __attribute__((address_space(1)))
#define LAS __attribute__((address_space(3)))
typedef unsigned short bf16;
typedef unsigned v4u __attribute__((ext_vector_type(4)));
typedef unsigned v2u __attribute__((ext_vector_type(2)));
typedef float f32x4 __attribute__((ext_vector_type(4)));
#define LDS_WAIT() asm volatile("s_waitcnt lgkmcnt(0)" ::: "memory")
#define VM_WAIT() asm volatile("s_waitcnt vmcnt(0)" ::: "memory")
__device__ __forceinline__ unsigned f2bf(float f) { unsigned u = __builtin_bit_cast(unsigned, f); return (u + 0x7fffu + ((u >> 16) & 1u)) >> 16; }
__device__ __forceinline__ unsigned pk2(float lo, float hi) { return f2bf(lo) | (f2bf(hi) << 16); }
__device__ __forceinline__ float bf2f(bf16 b) { return __uint_as_float((unsigned)b << 16); }
__device__ __forceinline__ float bflo(unsigned w) { return __uint_as_float(w << 16); }
__device__ __forceinline__ float bfhi(unsigned w) { return __uint_as_float(w & 0xffff0000u); }
__device__ __forceinline__ float wave_sum(float v) {
#pragma unroll
    for (int o = 1; o < 64; o <<= 1) v += __shfl_xor(v, o);
    return v;
}
__device__ __forceinline__ float sigm(float x) { return 1.0f / (1.0f + __expf(-x)); }

struct Args { const float* in[32]; float* out; unsigned char* ws; int ph_lo, ph_hi; };

typedef __attribute__((address_space(4))) const unsigned char* kptr_t;
struct KA {
    kptr_t p;
    typedef const float* cfptr_t; typedef float* fptr_t; typedef unsigned char* ucptr_t;
    __device__ __forceinline__ const float* in(int i) const { return *(const __attribute__((address_space(4))) cfptr_t*)(p + 8 * i); }
    __device__ __forceinline__ float* out() const { return *(const __attribute__((address_space(4))) fptr_t*)(p + 256); }
    __device__ __forceinline__ unsigned char* ws() const { return *(const __attribute__((address_space(4))) ucptr_t*)(p + 264); }
};
static_assert(sizeof(Args) == 280, "Args layout");

struct Ctx {
    unsigned char* lds; unsigned char* ws; float* out;
    int tid, lane, wave, G, bid;
};

__device__ __forceinline__ void tr_item(const float* W, int ldw, int K, int nblk, bf16* WT, int goff, float* scr, int item, int lane) {
    const int kb = item / nblk, nb = item % nblk, k0 = 64 * kb, n0 = 32 * nb;
#pragma unroll 8
    for (int i = 0; i < 32; ++i) { const int kk = 2 * i + (lane >> 5); scr[kk * 33 + (lane & 31)] = W[(size_t)(k0 + kk) * ldw + n0 + (lane & 31)]; }
    LDS_WAIT(); asm volatile("" ::: "memory");
    const int c = lane & 7;
#pragma unroll
    for (int j = 0; j < 4; ++j) { const int n = (lane >> 3) + 8 * j; const float* s = scr + (8 * c) * 33 + n;
        v4u o; o.x = pk2(s[0 * 33], s[1 * 33]); o.y = pk2(s[2 * 33], s[3 * 33]); o.z = pk2(s[4 * 33], s[5 * 33]); o.w = pk2(s[6 * 33], s[7 * 33]);
        const int nn = n0 + n; const int drow = goff < 0 ? nn : ((nn >> 7) * 256 + goff + (nn & 127));
        *(v4u*)(WT + (size_t)drow * K + k0 + 8 * c) = o; }
    LDS_WAIT(); asm volatile("" ::: "memory");
}

__device__ __forceinline__ void phase_prep(const KA& A, const Ctx& F) {
    float* scr = (float*)(F.lds + F.wave * 16384);
    const int gw = F.bid * NWAVES + F.wave, NGW = F.G * NWAVES;
    constexpr int NM = 10;
    constexpr int cnt[NM] = {16 * 184, 6 * 32, 6 * 32, 4 * 32, 16 * 32, 16 * 88, 16 * 88, 44 * 32, 4 * 8, 4 * 8};
    constexpr int per_layer = cnt[0] + cnt[1] + cnt[2] + cnt[3] + cnt[4] + cnt[5] + cnt[6] + cnt[7] + cnt[8] + cnt[9];
    for (int it = gw; it < DEPTH * per_layer; it += NGW) {
        const int l = it / per_layer; int r = it % per_layer;
        unsigned char* wl = F.ws + WS_W + (size_t)l * W_LAYER;
        if (r < cnt[0]) { tr_item(A.in(2) + (size_t)l * D * NIN, NIN, D, NIN / 32, (bf16*)(wl + WO_IN), -1, scr, r, F.lane); continue; } r -= cnt[0];
        if (r < cnt[1]) { tr_item(A.in(24) + (size_t)l * 384 * D, D, 384, D / 32, (bf16*)(wl + WO_BA), -1, scr, r, F.lane); continue; } r -= cnt[1];
        if (r < cnt[2]) { tr_item(A.in(25) + (size_t)l * 384 * D, D, 384, D / 32, (bf16*)(wl + WO_BR), -1, scr, r, F.lane); continue; } r -= cnt[2];
        if (r < cnt[3]) { tr_item(A.in(26) + (size_t)l * 256 * D, D, 256, D / 32, (bf16*)(wl + WO_BS), -1, scr, r, F.lane); continue; } r -= cnt[3];
        if (r < cnt[4]) { tr_item(A.in(27) + (size_t)l * D * D, D, D, D / 32, (bf16*)(wl + WO_OUT), -1, scr, r, F.lane); continue; } r -= cnt[4];
        if (r < cnt[5]) { tr_item(A.in(29) + (size_t)l * D * 2 * FFH, 2 * FFH, D, FFH / 32, (bf16*)(wl + WO_GU), 0, scr, r, F.lane); continue; } r -= cnt[5];
        if (r < cnt[6]) { tr_item(A.in(29) + (size_t)l * D * 2 * FFH + FFH, 2 * FFH, D, FFH / 32, (bf16*)(wl + WO_GU), 128, scr, r, F.lane); continue; } r -= cnt[6];
        if (r < cnt[7]) { tr_item(A.in(30) + (size_t)l * FFH * D, D, FFH, D / 32, (bf16*)(wl + WO_DN), -1, scr, r, F.lane); continue; } r -= cnt[7];
        if (r < cnt[8]) { tr_item(A.in(22) + (size_t)l * 256 * 256, 256, 256, 8, (bf16*)(wl + WO_GLU), 0, scr, r, F.lane); continue; } r -= cnt[8];
        tr_item(A.in(23) + (size_t)l * 256 * 256, 256, 256, 8, (bf16*)(wl + WO_GLU), 128, scr, r, F.lane);
    }
}

template <bool OUT_F32> __device__ __forceinline__ void phase_rmsnorm(const KA& A, const Ctx& F, const float* src, const float* gain, void* dst) {
    const int gw = F.bid * NWAVES + F.wave, NGW = F.G * NWAVES;
    f32x4 gv[4];
#pragma unroll
    for (int j = 0; j < 4; ++j) gv[j] = *((const f32x4*)gain + F.lane + 64 * j);
    for (int m = gw; m < T; m += NGW) {
        const f32x4* xr = (const f32x4*)(src + (size_t)m * D) + F.lane;
        f32x4 v[4]; float s = 0.f;
#pragma unroll
        for (int j = 0; j < 4; ++j) { v[j] = xr[64 * j]; s += (v[j].x * v[j].x + v[j].y * v[j].y) + (v[j].z * v[j].z + v[j].w * v[j].w); }
        const float rs = 1.0f / sqrtf(wave_sum(s) * (1.0f / D) + NORM_EPS);
        if (OUT_F32) {
            f32x4* o = (f32x4*)((float*)dst + (size_t)m * D) + F.lane;
#pragma unroll
            for (int j = 0; j < 4; ++j) o[64 * j] = v[j] * rs * gv[j];
        } else {
            v2u* o = (v2u*)((bf16*)dst + (size_t)m * D) + F.lane;
#pragma unroll
            for (int j = 0; j < 4; ++j) { const f32x4 y = v[j] * rs * gv[j]; v2u w; w.x = pk2(y.x, y.y); w.y = pk2(y.z, y.w); o[64 * j] = w; }
        }
    }
}
__device__ __forceinline__ void attn_v1(const KA& A, const Ctx& F, int blk, int nblk) {
    bf16* PS = (bf16*)(F.ws + WS_PS); float* LSE = (float*)(F.ws + WS_LSE);
#pragma unroll 1
    for (int item = blk * NTHREADS + F.tid; item < T * 12; item += nblk * NTHREADS) {
        const int hf = item & 1, it2 = item >> 1;
        const int h = it2 / T, bt = it2 % T, t = bt % SEQ;
        const int g = h >> 1, dil = (g == 0) ? 1 : (g == 1 ? 4 : 16);
        unsigned qp_[16]; float o[32];
        { const v4u* qp = (const v4u*)(PS + (size_t)bt * PSW + C_Q + h * 64 + hf * 32);
#pragma unroll
          for (int c = 0; c < 4; ++c) { const v4u w = qp[c]; qp_[4 * c + 0] = w.x; qp_[4 * c + 1] = w.y; qp_[4 * c + 2] = w.z; qp_[4 * c + 3] = w.w; } }
#pragma unroll
        for (int c = 0; c < 32; ++c) o[c] = 0.f;
        float mx = -1e30f, l = 0.f;
#pragma unroll 1
        for (int j = 0; j <= 128; ++j) {
            const int tk = t - j * dil; if (tk < 0) break;
            const size_t rowk = (size_t)(bt - j * dil) * PSW;
            const v4u* kp = (const v4u*)(PS + rowk + C_K + h * 64 + hf * 32); const v4u* vp = (const v4u*)(PS + rowk + C_V + h * 64 + hf * 32);
            float s = 0.f;
#pragma unroll
            for (int c = 0; c < 4; ++c) { const v4u w = kp[c];
                s += bflo(qp_[4 * c + 0]) * bflo(w.x) + bfhi(qp_[4 * c + 0]) * bfhi(w.x) + bflo(qp_[4 * c + 1]) * bflo(w.y) + bfhi(qp_[4 * c + 1]) * bfhi(w.y)
                   + bflo(qp_[4 * c + 2]) * bflo(w.z) + bfhi(qp_[4 * c + 2]) * bfhi(w.z) + bflo(qp_[4 * c + 3]) * bflo(w.w) + bfhi(qp_[4 * c + 3]) * bfhi(w.w); }
            s += __shfl_xor(s, 1);
            s *= 0.125f;
            const float mn = fmaxf(mx, s), cf = __expf(mx - mn), p = __expf(s - mn);
            l = l * cf + p; mx = mn;
#pragma unroll
            for (int c = 0; c < 4; ++c) { const v4u w = vp[c];
                o[8 * c + 0] = o[8 * c + 0] * cf + p * bflo(w.x); o[8 * c + 1] = o[8 * c + 1] * cf + p * bfhi(w.x); o[8 * c + 2] = o[8 * c + 2] * cf + p * bflo(w.y); o[8 * c + 3] = o[8 * c + 3] * cf + p * bfhi(w.y);
                o[8 * c + 4] = o[8 * c + 4] * cf + p * bflo(w.z); o[8 * c + 5] = o[8 * c + 5] * cf + p * bfhi(w.z); o[8 * c + 6] = o[8 * c + 6] * cf + p * bflo(w.w); o[8 * c + 7] = o[8 * c + 7] * cf + p * bfhi(w.w); }
        }
        const float il = 1.0f / l;
        v4u* op = (v4u*)(PS + (size_t)bt * PSW + C_Q + h * 64 + hf * 32);
#pragma unroll
        for (int c = 0; c < 4; ++c) { v4u w; w.x = pk2(o[8 * c + 0] * il, o[8 * c + 1] * il); w.y = pk2(o[8 * c + 2] * il, o[8 * c + 3] * il); w.z = pk2(o[8 * c + 4] * il, o[8 * c + 5] * il); w.w = pk2(o[8 * c + 6] * il, o[8 * c + 7] * il); op[c] = w; }
        if (hf == 0) LSE[(size_t)bt * 6 + h] = mx + __logf(l);
    }
}
__device__ __forceinline__ void attn_finalize(const KA& A, const Ctx& F) {
    bf16* PS = (bf16*)(F.ws + WS_PS); const float* LSE = (const float*)(F.ws + WS_LSE);
    for (int item = F.bid * NTHREADS + F.tid; item < T * 48; item += F.G * NTHREADS) {
        const int bt = item / 48, r = item % 48, h = r >> 3, c = r & 7, j = h & 1;
        const float l0 = LSE[(size_t)bt * 6 + j], l1 = LSE[(size_t)bt * 6 + 2 + j], l2 = LSE[(size_t)bt * 6 + 4 + j], lm = LSE[(size_t)bt * 6 + h];
        const float mx = fmaxf(l0, fmaxf(l1, l2));
        const float al = __expf(lm - mx) / (__expf(l0 - mx) + __expf(l1 - mx) + __expf(l2 - mx));
        v4u* p = (v4u*)(PS + (size_t)bt * PSW + C_Q + h * 64) + c; v4u w = *p;
        w.x = pk2(bflo(w.x) * al, bfhi(w.x) * al); w.y = pk2(bflo(w.y) * al, bfhi(w.y) * al); w.z = pk2(bflo(w.z) * al, bfhi(w.z) * al); w.w = pk2(bflo(w.w) * al, bfhi(w.w) * al);
        *p = w;
    }
}

__device__ __forceinline__ void rwkv_v1(const KA& A, const Ctx& F, int l, int b, int h) {
    constexpr int CH = 32;
    bf16* PS = (bf16*)(F.ws + WS_PS);
    float* L = (float*)F.lds;
    float* ZR = L, *ZK = L + CH * 64, *ZV = L + 2 * CH * 64, *ZX = L + 3 * CH * 64;
    float* WD = ZX + CH * 256, *KA = WD + CH * 64, *KB = KA + CH * 64, *GG = KB + CH * 64, *YB = GG + CH * 64, *BON = YB + CH * 64, *PREV = BON + 64;
    const float* mix = A.in(3) + (size_t)l * 1408;
    const float* w0 = A.in(4) + l * 384, *w2 = A.in(5) + (size_t)l * 64 * 384, *a0 = A.in(6) + l * 384, *a2 = A.in(7) + (size_t)l * 64 * 384, *g2 = A.in(8) + (size_t)l * 128 * 384;
    const float* k_k = A.in(9) + l * 384, *k_a = A.in(10) + l * 384, *r_k = A.in(11) + l * 384, *ln_w = A.in(12) + l * 384, *ln_b = A.in(13) + l * 384;
    const int tid = F.tid, lane = F.lane;
    const int hc = h * 64 + lane;
    float S[8];
#pragma unroll
    for (int j = 0; j < 8; ++j) S[j] = 0.f;
    const int si = tid >> 3, sj = (tid & 7) * 8;
#pragma unroll 1
    for (int ch = 0; ch < SEQ / CH; ++ch) {
        const int t0 = ch * CH; const size_t row0 = (size_t)b * SEQ + t0;
        float* PRc = PREV + (ch & 1) * 192, *PRn = PREV + ((ch + 1) & 1) * 192;
#pragma unroll 1
        for (int e = tid; e < CH * 192; e += NTHREADS) {
            const int t = e / 192, c3 = e % 192, which = c3 >> 6, c = c3 & 63;
            const int col = C_RW + which * 384 + h * 64 + c;
            const float cur = bf2f(PS[(row0 + t) * PSW + col]);
            float prev;
            if (t == 0) prev = (ch == 0) ? 0.f : PRc[c3]; else prev = bf2f(PS[(row0 + t - 1) * PSW + col]);
            if (t == CH - 1) PRn[c3] = cur;
            const float z = cur + (prev - cur) * mix[which * 384 + h * 64 + c];
            L[which * CH * 64 + t * 64 + c] = z;
        }
#pragma unroll 1
        for (int e = tid; e < CH * 256; e += NTHREADS) {
            const int t = e >> 8, j = e & 255; const int col = C_LORA + j;
            const float cur = bf2f(PS[(row0 + t) * PSW + col]);
            const float prev = (t0 + t == 0) ? 0.f : bf2f(PS[(row0 + t - 1) * PSW + col]);
            float z = cur + (prev - cur) * mix[1152 + j];
            if (j < 64) z = tanhf(z); else if (j >= 128) z = sigm(z);
            ZX[t * 256 + j] = z;
        }
        __syncthreads();
        {
            float accw[4], acca[4], accg[4];
#pragma unroll
            for (int i = 0; i < 4; ++i) { accw[i] = 0.f; acca[i] = 0.f; accg[i] = 0.f; }
#pragma unroll 2
            for (int j = 0; j < 64; ++j) { const float ww = w2[j * 384 + hc], aa = a2[j * 384 + hc];
#pragma unroll
                for (int i = 0; i < 4; ++i) { const int t = F.wave + 8 * i; accw[i] += ZX[t * 256 + j] * ww; acca[i] += ZX[t * 256 + 64 + j] * aa; } }
#pragma unroll 2
            for (int j = 0; j < 128; ++j) { const float gg = g2[j * 384 + hc];
#pragma unroll
                for (int i = 0; i < 4; ++i) { const int t = F.wave + 8 * i; accg[i] += ZX[t * 256 + 128 + j] * gg; } }
            const float w0c = w0[hc], a0c = a0[hc], kkc = k_k[hc], kac = k_a[hc], rkc = r_k[hc];
#pragma unroll
            for (int i = 0; i < 4; ++i) { const int t = F.wave + 8 * i; const int o = t * 64 + lane;
                const float x = -(w0c + accw[i]); const float sp = (x > 20.f) ? x : log1pf(__expf(x)); const float w = -sp - 0.5f;
                const float av = sigm(a0c + acca[i]);
                const float kraw = ZK[o]; float kk = kraw * kkc; const float nrm = sqrtf(wave_sum(kk * kk)); kk = kk / fmaxf(nrm, 1e-12f);
                const float knew = kraw * (1.0f + (av - 1.0f) * kac);
                const float bon = wave_sum(ZR[o] * knew * rkc);
                ZK[o] = knew; WD[o] = __expf(-__expf(w)); KA[o] = -kk; KB[o] = kk * av; GG[o] = accg[i]; if (lane == 0) BON[t] = bon; }
        }
        __syncthreads();
#pragma unroll 2
        for (int t = 0; t < CH; ++t) {
            const f32x4 a0v = *(const f32x4*)(KA + t * 64 + sj), a1v = *(const f32x4*)(KA + t * 64 + sj + 4);
            const f32x4 w0v = *(const f32x4*)(WD + t * 64 + sj), w1v = *(const f32x4*)(WD + t * 64 + sj + 4);
            const f32x4 b0v = *(const f32x4*)(KB + t * 64 + sj), b1v = *(const f32x4*)(KB + t * 64 + sj + 4);
            const f32x4 k0v = *(const f32x4*)(ZK + t * 64 + sj), k1v = *(const f32x4*)(ZK + t * 64 + sj + 4);
            const f32x4 r0v = *(const f32x4*)(ZR + t * 64 + sj), r1v = *(const f32x4*)(ZR + t * 64 + sj + 4);
            const float vi = ZV[t * 64 + si];
            float sa = 0.f;
#pragma unroll
            for (int j = 0; j < 4; ++j) sa += S[j] * a0v[j] + S[4 + j] * a1v[j];
            sa += __shfl_xor(sa, 1); sa += __shfl_xor(sa, 2); sa += __shfl_xor(sa, 4);
            float y = 0.f;
#pragma unroll
            for (int j = 0; j < 4; ++j) { S[j] = S[j] * w0v[j] + sa * b0v[j] + vi * k0v[j]; S[4 + j] = S[4 + j] * w1v[j] + sa * b1v[j] + vi * k1v[j]; y += S[j] * r0v[j] + S[4 + j] * r1v[j]; }
            y += __shfl_xor(y, 1); y += __shfl_xor(y, 2); y += __shfl_xor(y, 4);
            if ((tid & 7) == 0) YB[t * 64 + si] = y;
        }
        __syncthreads();
        const float lw = ln_w[hc], lb = ln_b[hc];
#pragma unroll
        for (int i = 0; i < 4; ++i) { const int t = F.wave + 8 * i; const int o = t * 64 + lane;
            const float y = YB[o]; const float mu = wave_sum(y) * (1.0f / 64.0f); const float dv = y - mu; const float var = wave_sum(dv * dv) * (1.0f / 64.0f);
            const float yn = dv * (1.0f / sqrtf(var + GN_EPS)) * lw + lb;
            const float out = (yn + BON[t] * ZV[o]) * GG[o];
            PS[(row0 + t) * PSW + C_RW + h * 64 + lane] = (bf16)f2bf(out); }
        __syncthreads();
    }
}

__device__ __forceinline__ float gelu_tanh(float x) { const float u = 0.7978845608028654f * (x + 0.044715f * x * x * x); return 0.5f * x * (1.0f + tanhf(u)); }
__device__ __forceinline__ void ssm_v1(const KA& A, const Ctx& F, int l, int b, int g) {
    bf16* PS = (bf16*)(F.ws + WS_PS);
    float* L = (float*)F.lds;
    float* U = L, *XR = L + 1024, *XI = L + 1024 + 64 * 65, *CR = L + 1024 + 2 * 64 * 65, *CI = CR + 1024;
    const int tid = F.tid, lane = F.lane, p = lane;
    float are, aim, bre[16], bim[16];
    {
        const float step = __expf(A.in(16)[l * 16 + g]);
        const float lr = A.in(14)[(size_t)l * 1024 + g * 64 + p], li = A.in(15)[(size_t)l * 1024 + g * 64 + p];
        const float mag = __expf(lr * step), ang = li * step; float sn, cs; sincosf(ang, &sn, &cs);
        are = mag * cs; aim = mag * sn;
        const float inv = 1.0f / (lr * lr + li * li);
        const float fre = ((are - 1.0f) * lr + aim * li) * inv, fim = (aim * lr - (are - 1.0f) * li) * inv;
        const float* br = A.in(17) + (size_t)l * 16384 + (size_t)(g * 64 + p) * 16, *bi = A.in(18) + (size_t)l * 16384 + (size_t)(g * 64 + p) * 16;
#pragma unroll
        for (int c = 0; c < 16; ++c) { bre[c] = fre * br[c] - fim * bi[c]; bim[c] = fre * bi[c] + fim * br[c]; }
    }
    for (int e = tid; e < 1024; e += NTHREADS) { CR[e] = A.in(19)[(size_t)l * 16384 + g * 1024 + e]; CI[e] = A.in(20)[(size_t)l * 16384 + g * 1024 + e]; }
    const float* dsk = A.in(21) + l * 256 + g * 16;
    float xr = 0.f, xi = 0.f;
#pragma unroll 1
    for (int ch = 0; ch < SEQ / 64; ++ch) {
        const size_t row0 = (size_t)b * SEQ + ch * 64;
        for (int e = tid; e < 1024; e += NTHREADS) { const int t = e >> 4, c = e & 15; U[e] = bf2f(PS[(row0 + t) * PSW + C_SSM + g * 16 + c]); }
        __syncthreads();
#pragma unroll
        for (int i = 0; i < 8; ++i) { const int t = F.wave + 8 * i; float sr = 0.f, sii = 0.f;
#pragma unroll
            for (int c = 0; c < 16; ++c) { const float u = U[t * 16 + c]; sr += bre[c] * u; sii += bim[c] * u; }
            XR[t * 65 + p] = sr; XI[t * 65 + p] = sii; }
        __syncthreads();
        if (F.wave == 0) {
#pragma unroll 4
            for (int t = 0; t < 64; ++t) { const float nr = are * xr - aim * xi + XR[t * 65 + p], ni = are * xi + aim * xr + XI[t * 65 + p]; xr = nr; xi = ni; XR[t * 65 + p] = xr; XI[t * 65 + p] = xi; }
        }
        __syncthreads();
        { const int t = tid >> 3, c2 = (tid & 7) * 2;
#pragma unroll
          for (int q = 0; q < 2; ++q) { const int c = c2 + q; float y = 0.f;
#pragma unroll 4
              for (int pp = 0; pp < 64; ++pp) y += CR[c * 64 + pp] * XR[t * 65 + pp] - CI[c * 64 + pp] * XI[t * 65 + pp];
              y += dsk[c] * U[t * 16 + c];
              PS[(row0 + t) * PSW + C_SSM + g * 16 + c] = (bf16)f2bf(gelu_tanh(y)); } }
        __syncthreads();
    }
}
constexpr int NPH = 20;

__device__ __forceinline__ void run_phase(const KA& A, const Ctx& F, int ph) {
    PG8_LAS unsigned char* lds3 = (PG8_LAS unsigned char*)F.lds;
    bf16* XN = (bf16*)(F.ws + WS_XN); bf16* PS = (bf16*)(F.ws + WS_PS); unsigned char* GT = F.ws + WS_GT; bf16* SO = (bf16*)(F.ws + WS_SO);
    const int l = (ph - 1) / 9, k = (ph == 0) ? 10 : (ph == NPH - 1 ? 11 : (ph - 1) % 9);
    unsigned char* wl = F.ws + WS_W + (size_t)l * W_LAYER;
    const float* hin = (l == 0) ? A.in(0) : F.out;
    int ngemm = 0;
    if (k == 10) phase_prep(A, F);
    else if (k == 11) phase_rmsnorm<true>(A, F, F.out, A.in(31), F.out);
    else if (k == 0) phase_rmsnorm<false>(A, F, hin, A.in(1) + l * D, XN);
    else if (k == 6) phase_rmsnorm<false>(A, F, F.out, A.in(28) + l * D, XN);
    else if (k == 2) {
        if (F.bid < 48) rwkv_v1(A, F, l, F.bid / 6, F.bid % 6);
        else if (F.bid < 176) { const int it = F.bid - 48; ssm_v1(A, F, l, it / 16, it % 16); }
        else attn_v1(A, F, F.bid - 176, F.G - 176);
    }
    else if (k == 3) { attn_finalize(A, F); ngemm = 1; }
    else if (k == 4) ngemm = 3;
    else ngemm = 1;
#pragma unroll 1
    for (int gi = 0; gi < ngemm; ++gi) {
        pg8::Gemm g; pg8::EpiAny E; E.kind = 0; E.O = PS; E.ldo = FFH; E.GT = GT; E.gi = gi; E.base = hin; E.out = F.out;
        if (k == 1) { g = pg8::Gemm{XN, (const bf16*)(wl + WO_IN), T, NIN, D, D}; E.kind = 0; }
        else if (k == 3) { g = pg8::Gemm{PS + C_SSM, (const bf16*)(wl + WO_GLU), T, 512, 256, PSW}; E.kind = 4; E.O = SO; E.ldo = 256; }
        else if (k == 4) { E.kind = 1; E.O = XN;
            if (gi == 0) g = pg8::Gemm{PS + C_Q, (const bf16*)(wl + WO_BA), T, D, 384, PSW};
            else if (gi == 1) g = pg8::Gemm{PS + C_RW, (const bf16*)(wl + WO_BR), T, D, 384, PSW};
            else g = pg8::Gemm{SO, (const bf16*)(wl + WO_BS), T, D, 256, 256}; }
        else if (k == 5) { g = pg8::Gemm{XN, (const bf16*)(wl + WO_OUT), T, D, D, D}; E.kind = 2; }
        else if (k == 7) { g = pg8::Gemm{XN, (const bf16*)(wl + WO_GU), T, 2 * FFH, D, D}; E.kind = 3; }
        else { g = pg8::Gemm{PS, (const bf16*)(wl + WO_DN), T, D, FFH, FFH}; E.kind = 2; E.base = F.out; }
        pg8::StaticOrder S; S.init(T, g.N, F.G, F.bid);
        pg8::gemm_phase<pg8::EpiAny, pg8::StaticOrder, true>(lds3, g, S, E);
    }
}

__global__ void __launch_bounds__(NTHREADS, 2) mega_fwd(Args args) {
    extern __shared__ __attribute__((aligned(16))) unsigned char lds[];
#pragma unroll 1
    for (int ph = args.ph_lo; ph < args.ph_hi; ++ph) {
        KA A; A.p = (kptr_t)__builtin_amdgcn_kernarg_segment_ptr(); asm volatile("" : "+s"(A.p));
        int tid = threadIdx.x, bid = blockIdx.x, G = gridDim.x; asm volatile("" : "+v"(tid), "+s"(bid), "+s"(G));
        Ctx F;
        F.lds = lds; F.ws = A.ws(); F.out = A.out();
        F.tid = tid; F.lane = tid & 63; F.wave = __builtin_amdgcn_readfirstlane(tid >> 6); F.G = G; F.bid = bid;
        run_phase(A, F, ph);
#if ONE_LAUNCH
        if (ph + 1 < args.ph_hi) { __threadfence(); cg::this_grid().sync(); }
#endif
    }
}

extern "C" void kernel_launch(void* const* d_in, const int* in_sizes, int n_in, void* d_out, int out_size, void* d_ws, size_t ws_size, hipStream_t stream) {
    static int grid = 0;
    if (grid == 0) {
        if (n_in != 32 || in_sizes[0] != T * D || out_size != T * D || ws_size < WS_END) { fprintf(stderr, "kernel_launch: unexpected shapes (n_in %d, in0 %d, out %d, ws %zu); nothing launched\n", n_in, n_in > 0 ? in_sizes[0] : -1, out_size, ws_size); grid = -1; return; }
        int dev = 0, cus = 0, per_cu = 0;
        if (hipGetDevice(&dev) != hipSuccess || hipDeviceGetAttribute(&cus, hipDeviceAttributeMultiprocessorCount, dev) != hipSuccess) { grid = -1; return; }
        if (hipFuncSetAttribute((const void*)mega_fwd, hipFuncAttributeMaxDynamicSharedMemorySize, LDS_BYTES) != hipSuccess) { fprintf(stderr, "kernel_launch: hipFuncSetAttribute failed\n"); grid = -1; return; }
        if (hipOccupancyMaxActiveBlocksPerMultiprocessor(&per_cu, (const void*)mega_fwd, NTHREADS, LDS_BYTES) != hipSuccess || per_cu < 1) { fprintf(stderr, "kernel_launch: occupancy query says %d\n", per_cu); per_cu = 1; }
        (void)hipGetLastError();
        grid = cus;
        if (grid < 200) { fprintf(stderr, "kernel_launch: needs >= 200 CUs, got %d\n", grid); grid = -1; return; }
    }
    if (grid < 0) return;
    Args a{};
    for (int i = 0; i < 32; ++i) a.in[i] = (const float*)d_in[i];
    a.out = (float*)d_out; a.ws = (unsigned char*)d_ws;
#if ONE_LAUNCH
    a.ph_lo = 0; a.ph_hi = NPH;
    void* kargs[] = {&a};
    hipError_t e = hipLaunchCooperativeKernel((const void*)mega_fwd, dim3(grid), dim3(NTHREADS), kargs, LDS_BYTES, stream);
    if (e != hipSuccess) fprintf(stderr, "kernel_launch: cooperative launch failed: %s (grid %d)\n", hipGetErrorString(e), grid);
#else
    for (int ph = 0; ph < NPH; ++ph) {
        a.ph_lo = ph; a.ph_hi = ph + 1;
        hipLaunchKernelGGL(mega_fwd, dim3(grid), dim3(NTHREADS), LDS_BYTES, stream, a);
    }
#endif
}
```

```cpp
#include <hip/hip_runtime.h>
#include <hip/hip_cooperative_groups.h>
#include <cstdio>
#include <cstdint>
namespace cg = cooperative_groups;
#ifndef ONE_LAUNCH
#define ONE_LAUNCH 1
#endif
namespace pg8 {
#define PG8_LAS __attribute__((address_space(3)))
typedef unsigned short bf16_t;
typedef short bf16x8 __attribute__((ext_vector_type(8)));
typedef float f32x4 __attribute__((ext_vector_type(4)));
typedef float f32x2 __attribute__((ext_vector_type(2)));
typedef unsigned u32x4 __attribute__((ext_vector_type(4)));
typedef unsigned u32x2 __attribute__((ext_vector_type(2)));
constexpr int BM = 256, BK = 64, HALF = 128, HTB = HALF * BK * 2  , STAGE_BYTES = 8 * HTB, NXCD = 8, WGM = 8;

__host__ __device__ __forceinline__ int lds_byte(int r, int c) { const int st = (r >> 4) * 2 + (c >> 5), rr = r & 15, cc = c & 31, ob = rr * 64 + cc * 2; return st * 1024 + (ob ^ (((ob >> 9) & 1) << 5)); }
__host__ __device__ __forceinline__ void stage_rc(int b, int& R, int& C) { const int st = b / 1024, sb = b % 1024, swz = sb ^ (((sb >> 9) & 1) << 5); R = (st >> 1) * 16 + swz / 64; C = (st & 1) * 32 + (swz % 64) / 2; }
__host__ __device__ __forceinline__ int perm32(int rho) { const int n = rho >> 4, i = rho & 15; return 8 * (i >> 2) + 4 * n + (i & 3); }

struct Unit { int pm, pn; };
struct Gemm { const bf16_t* A; const bf16_t* Bt; int M, N, K, lda; };

struct StaticOrder {
    int nM, nN, nwg, G, c;
    __host__ __device__ void init(int M, int N, int G_, int c_) { nM = M / BM; nN = N / BM; nwg = nM * nN; G = G_; c = c_; }
    __host__ __device__ bool next(int i, Unit& u) const {
        const long L = (long)i * G + c; if (L >= nwg) return false;
        int wgid = (int)L; { const int q = nwg / NXCD, r = nwg % NXCD, xcd = wgid % NXCD, off = wgid / NXCD; wgid = (xcd < r ? xcd * (q + 1) : r * (q + 1) + (xcd - r) * q) + off; }
        const int nig = WGM * nN, gid = wgid / nig, fm = gid * WGM, gsz = (nM - fm) < WGM ? (nM - fm) : WGM;
        u.pm = fm + ((wgid % nig) % gsz); u.pn = (wgid % nig) / gsz; return true;
    }
    __device__ __forceinline__ void a_ready(const Unit&) const {}
    __device__ __forceinline__ void done(const Unit&) const {}
};

__device__ __forceinline__ unsigned cvt_pk_bf16(float lo, float hi) { unsigned r; asm volatile("v_cvt_pk_bf16_f32 %0, %1, %2" : "=v"(r) : "v"(lo), "v"(hi)); return r; }
__device__ __forceinline__ float bf_lo(unsigned w) { return __uint_as_float(w << 16); }
__device__ __forceinline__ float bf_hi(unsigned w) { return __uint_as_float(w & 0xffff0000u); }
__device__ __forceinline__ float sigmoidf_(float x) { return __builtin_amdgcn_rcpf(1.0f + __expf(-x)); }


struct EpiAny;
__device__ __forceinline__ void epi_win(bf16_t* PS, unsigned char* GT, const f32x4 (&acc)[2][2][4][2], const Unit& u, int wr, int wc, int fr, int fq) {
        const int row0 = u.pm * BM + wr * 64 + fr;
        if (u.pn < 11) {
            const int col0 = u.pn * BM + wc * 32 + 8 * fq;
#pragma unroll
            for (int ai = 0; ai < 2; ++ai)
#pragma unroll
                for (int m = 0; m < 4; ++m) { bf16_t* rowp = PS + (size_t)(row0 + ai * HALF + m * 16) * 2816 + col0;
#pragma unroll
                    for (int bj = 0; bj < 2; ++bj) { const f32x4 v0 = acc[ai][bj][m][0], v1 = acc[ai][bj][m][1];
                        u32x4 w; w.x = cvt_pk_bf16(v0[0], v0[1]); w.y = cvt_pk_bf16(v0[2], v0[3]); w.z = cvt_pk_bf16(v1[0], v1[1]); w.w = cvt_pk_bf16(v1[2], v1[3]);
                        *(u32x4*)(rowp + bj * HALF) = w; } }
        } else {
            const int col0 = (u.pn - 11) * BM + wc * 32 + 8 * fq;
#pragma unroll
            for (int ai = 0; ai < 2; ++ai)
#pragma unroll
                for (int m = 0; m < 4; ++m) { unsigned char* rowp = GT + (size_t)(row0 + ai * HALF + m * 16) * 3072 + col0;
#pragma unroll
                    for (int bj = 0; bj < 2; ++bj) { const f32x4 v0 = acc[ai][bj][m][0], v1 = acc[ai][bj][m][1];
                        unsigned q[8];
#pragma unroll
                        for (int k = 0; k < 4; ++k) { q[k] = (unsigned)(sigmoidf_(v0[k]) * 255.0f + 0.5f); q[4 + k] = (unsigned)(sigmoidf_(v1[k]) * 255.0f + 0.5f); }
                        u32x2 w; w.x = q[0] | (q[1] << 8) | (q[2] << 16) | (q[3] << 24); w.y = q[4] | (q[5] << 8) | (q[6] << 16) | (q[7] << 24);
                        *(u32x2*)(rowp + bj * HALF) = w; } }
        }
    }

__device__ __forceinline__ void epi_merge(bf16_t* MG, const unsigned char* GT, int gi, const f32x4 (&acc)[2][2][4][2], const Unit& u, int wr, int wc, int fr, int fq) {
        const int row0 = u.pm * BM + wr * 64 + fr, col0 = u.pn * BM + wc * 32 + 8 * fq;
#pragma unroll
        for (int ai = 0; ai < 2; ++ai)
#pragma unroll
            for (int m = 0; m < 4; ++m) { const size_t r = (size_t)(row0 + ai * HALF + m * 16);
#pragma unroll
                for (int bj = 0; bj < 2; ++bj) { const int c = col0 + bj * HALF;
                    const u32x2 gq = *(const u32x2*)(GT + r * 3072 + gi * 1024 + c);
                    float v[8];
#pragma unroll
                    for (int k = 0; k < 4; ++k) { v[k] = acc[ai][bj][m][0][k] * ((float)((gq.x >> (8 * k)) & 255u) * (1.0f / 255.0f)); v[4 + k] = acc[ai][bj][m][1][k] * ((float)((gq.y >> (8 * k)) & 255u) * (1.0f / 255.0f)); }
                    u32x4* dst = (u32x4*)(MG + r * 1024 + c);
                    if (gi > 0) { const u32x4 p = *dst;
                        v[0] += bf_lo(p.x); v[1] += bf_hi(p.x); v[2] += bf_lo(p.y); v[3] += bf_hi(p.y); v[4] += bf_lo(p.z); v[5] += bf_hi(p.z); v[6] += bf_lo(p.w); v[7] += bf_hi(p.w); }
                    u32x4 w; w.x = cvt_pk_bf16(v[0], v[1]); w.y = cvt_pk_bf16(v[2], v[3]); w.z = cvt_pk_bf16(v[4], v[5]); w.w = cvt_pk_bf16(v[6], v[7]);
                    *dst = w; } }
    }

__device__ __forceinline__ void epi_res(const float* base, float* out, const f32x4 (&acc)[2][2][4][2], const Unit& u, int wr, int wc, int fr, int fq) {
        const int row0 = u.pm * BM + wr * 64 + fr, col0 = u.pn * BM + wc * 32 + 4 * fq;
#pragma unroll
        for (int ai = 0; ai < 2; ++ai)
#pragma unroll
            for (int m = 0; m < 4; ++m) { const size_t off = (size_t)(row0 + ai * HALF + m * 16) * 1024 + col0;
#pragma unroll
                for (int bj = 0; bj < 2; ++bj)
#pragma unroll
                    for (int n = 0; n < 2; ++n) { const f32x4 b = *(const f32x4*)(base + off + bj * HALF + n * 16); *(f32x4*)(out + off + bj * HALF + n * 16) = b + acc[ai][bj][m][n]; } }
    }

template <int MODE> __device__ __forceinline__ void epi_pair(bf16_t* O, int ldo, const f32x4 (&acc)[2][2][4][2], const Unit& u, int wr, int wc, int fr, int fq) {
        const int row0 = u.pm * BM + wr * 64 + fr, col0 = u.pn * HALF + wc * 32 + 8 * fq;
#pragma unroll
        for (int ai = 0; ai < 2; ++ai)
#pragma unroll
            for (int m = 0; m < 4; ++m) { bf16_t* rowp = O + (size_t)(row0 + ai * HALF + m * 16) * ldo + col0;
                float v[8];
#pragma unroll
                for (int n = 0; n < 2; ++n)
#pragma unroll
                    for (int k = 0; k < 4; ++k) { const float a = acc[ai][0][m][n][k], b = acc[ai][1][m][n][k];
                        v[4 * n + k] = (MODE == 0) ? (a * sigmoidf_(a) * b) : (a * sigmoidf_(b)); }
                u32x4 w; w.x = cvt_pk_bf16(v[0], v[1]); w.y = cvt_pk_bf16(v[2], v[3]); w.z = cvt_pk_bf16(v[4], v[5]); w.w = cvt_pk_bf16(v[6], v[7]);
                *(u32x4*)rowp = w; }
    }


struct EpiAny {
    int kind;
    bf16_t* O; int ldo; unsigned char* GT; int gi; const float* base; float* out;
    __device__ __forceinline__ bool perm() const { return kind != 2; }
    __device__ __forceinline__ void operator()(const f32x4 (&acc)[2][2][4][2], const Unit& u, int wr, int wc, int fr, int fq) const {
        if (kind == 0) epi_win(O, GT, acc, u, wr, wc, fr, fq);
        else if (kind == 1) epi_merge(O, GT, gi, acc, u, wr, wc, fr, fq);
        else if (kind == 2) epi_res(base, out, acc, u, wr, wc, fr, fq);
        else if (kind == 3) epi_pair<0>(O, ldo, acc, u, wr, wc, fr, fq);
        else epi_pair<1>(O, ldo, acc, u, wr, wc, fr, fq);
    }
};

template <class Epi, class Sched, bool ALIGN_EPI = false>
__device__ __forceinline__ void gemm_phase(PG8_LAS unsigned char* lds, const Gemm g, const Sched& S, const Epi& E) {
    int tid_ = threadIdx.x; asm volatile("" : "+v"(tid_));
    const int tid = tid_, wid = __builtin_amdgcn_readfirstlane(tid >> 6), lane = tid & 63, wr = wid >> 2, wc = wid & 3, fr = lane & 15, fq = lane >> 4;
    const int K = g.K, lda = g.lda, nt = K / BK;
    unsigned voffA[2], voffB[2];
#pragma unroll
    for (int i = 0; i < 2; ++i) { int R, C; stage_rc(tid * 16 + i * 8192, R, C); const int Rb = E.perm() ? ((R & ~31) + perm32(R & 31)) : R;
        voffA[i] = (unsigned)(R * lda + C) * 2u; voffB[i] = (unsigned)(Rb * K + C) * 2u; }
    const size_t kstep = (size_t)(BK * 2);
    const size_t hstepA = (size_t)HALF * lda * 2, hstepB = (size_t)HALF * K * 2;
    const size_t tstepA = 2 * hstepA, tstepB = 2 * hstepB;
    const unsigned ldsw = (unsigned)wid * 1024u;
    const int aoff = lds_byte(wr * 64 + fr, fq * 8), boff = lds_byte(wc * 32 + fr, fq * 8);
#define PG8_SA(b, h) (((b) * 2 + (h)) * HTB)
#define PG8_SB(b, h) ((4 + (b) * 2 + (h)) * HTB)
#define PG8_STAGE(bufoff, gbase, voff) do { _Pragma("unroll") for (int _i = 0; _i < 2; ++_i) \
        __builtin_amdgcn_global_load_lds((const unsigned*)((const char*)(gbase) + (voff)[_i]), (PG8_LAS unsigned*)(lds + (bufoff) + ldsw + _i * 8192), 16, 0, 0); } while (0)
#define PG8_LDA(dst, b, h) do { _Pragma("unroll") for (int m = 0; m < 4; ++m) _Pragma("unroll") for (int k = 0; k < 2; ++k) dst[m][k] = *(const PG8_LAS bf16x8*)(lds + PG8_SA(b, h) + aoff + m * 2048 + k * 1024); } while (0)
#define PG8_LDB(dst, b, h) do { _Pragma("unroll") for (int n = 0; n < 2; ++n) _Pragma("unroll") for (int k = 0; k < 2; ++k) dst[n][k] = *(const PG8_LAS bf16x8*)(lds + PG8_SB(b, h) + boff + n * 2048 + k * 1024); } while (0)
#define PG8_MMA(ai, bj, At, Bt) do { __builtin_amdgcn_s_setprio(1); _Pragma("unroll") for (int m = 0; m < 4; ++m) _Pragma("unroll") for (int n = 0; n < 2; ++n) _Pragma("unroll") for (int k = 0; k < 2; ++k) \
        acc[ai][bj][m][n] = __builtin_amdgcn_mfma_f32_16x16x32_bf16(Bt[n][k], At[m][k], acc[ai][bj][m][n], 0, 0, 0); __builtin_amdgcn_s_setprio(0); } while (0)
#define PG8_WAIT_V(n) asm volatile("s_waitcnt vmcnt(" #n ")" ::: "memory")
#define PG8_WAIT_L(n) asm volatile("s_waitcnt lgkmcnt(" #n ")" ::: "memory")
#define PG8_BAR __builtin_amdgcn_s_barrier()
#define PG8_SCHED __builtin_amdgcn_sched_barrier(0)
    Unit cur, nxt; int ui = 0;
    if (!S.next(0, cur)) return;
    f32x4 acc[2][2][4][2];
#pragma unroll
    for (int a = 0; a < 2; ++a)
#pragma unroll
        for (int b = 0; b < 2; ++b)
#pragma unroll
            for (int m = 0; m < 4; ++m)
#pragma unroll
                for (int n = 0; n < 2; ++n) acc[a][b][m][n] = (f32x4){0.f, 0.f, 0.f, 0.f};
    bf16x8 At[4][2], B0[2][2], B1[2][2];
    const char* cA = (const char*)g.A + (size_t)cur.pm * tstepA; const char* cB = (const char*)g.Bt + (size_t)cur.pn * tstepB;
    S.a_ready(cur);
    PG8_STAGE(PG8_SB(0, 0), cB, voffB); PG8_STAGE(PG8_SB(0, 1), cB + hstepB, voffB); PG8_STAGE(PG8_SA(0, 0), cA, voffA); PG8_STAGE(PG8_SA(0, 1), cA + hstepA, voffA);
    if (wr == 1) PG8_BAR;
    PG8_WAIT_V(2); PG8_BAR;
    PG8_STAGE(PG8_SB(1, 0), cB + kstep, voffB); PG8_STAGE(PG8_SA(1, 0), cA + kstep, voffA); PG8_STAGE(PG8_SB(1, 1), cB + hstepB + kstep, voffB);
    PG8_WAIT_V(6); PG8_BAR;
    for (;;) {
        const bool has_next = S.next(ui + 1, nxt);
        const char* nA = has_next ? (const char*)g.A + (size_t)nxt.pm * tstepA : cA; const char* nB = has_next ? (const char*)g.Bt + (size_t)nxt.pn * tstepB : cB;
        for (int t = 0; t < nt; t += 2) {
            const bool last = (t == nt - 2);
            const char* a1 = cA + (size_t)(t + 1) * kstep;
            const char* a2 = last ? nA : cA + (size_t)(t + 2) * kstep; const char* b2 = last ? nB : cB + (size_t)(t + 2) * kstep;
            const char* a3 = a2 + kstep; const char* b3 = b2 + kstep;
            if (last && has_next) S.a_ready(nxt);
            PG8_LDB(B0, 0, 0); PG8_LDB(B1, 0, 1); PG8_SCHED; PG8_LDA(At, 0, 0); PG8_STAGE(PG8_SA(1, 1), a1 + hstepA, voffA);
            PG8_WAIT_V(8); PG8_WAIT_L(0); PG8_BAR; PG8_MMA(0, 0, At, B0); PG8_MMA(0, 1, At, B1); PG8_BAR; PG8_SCHED;
            PG8_LDA(At, 0, 1); PG8_STAGE(PG8_SB(0, 0), b2, voffB); PG8_STAGE(PG8_SB(0, 1), b2 + hstepB, voffB); PG8_STAGE(PG8_SA(0, 0), a2, voffA);
            PG8_WAIT_V(8); PG8_WAIT_L(0); PG8_BAR; PG8_MMA(1, 0, At, B0); PG8_MMA(1, 1, At, B1); PG8_BAR; PG8_SCHED;
            PG8_LDB(B0, 1, 0); PG8_LDB(B1, 1, 1); PG8_SCHED; PG8_LDA(At, 1, 0); PG8_STAGE(PG8_SA(0, 1), a2 + hstepA, voffA);
            PG8_WAIT_V(8); PG8_WAIT_L(0); PG8_BAR; PG8_MMA(0, 0, At, B0); PG8_MMA(0, 1, At, B1); PG8_BAR; PG8_SCHED;
            PG8_LDA(At, 1, 1); PG8_STAGE(PG8_SB(1, 0), b3, voffB); PG8_STAGE(PG8_SB(1, 1), b3 + hstepB, voffB); PG8_STAGE(PG8_SA(1, 0), a3, voffA);
            PG8_WAIT_V(8); PG8_WAIT_L(0); PG8_BAR; PG8_MMA(1, 0, At, B0); PG8_MMA(1, 1, At, B1); PG8_BAR; PG8_SCHED;
        }
        if constexpr (ALIGN_EPI) { if (wr == 0) PG8_BAR; }
        E(acc, cur, wr, wc, fr, fq); S.done(cur);
        if (!has_next) break;
#pragma unroll
        for (int a = 0; a < 2; ++a)
#pragma unroll
            for (int b = 0; b < 2; ++b)
#pragma unroll
                for (int m = 0; m < 4; ++m)
#pragma unroll
                    for (int n = 0; n < 2; ++n) acc[a][b][m][n] = (f32x4){0.f, 0.f, 0.f, 0.f};
        cur = nxt; cA = nA; cB = nB; ++ui;
        if constexpr (ALIGN_EPI) { if (wr == 1) PG8_BAR; }
    }
    PG8_WAIT_V(0);
    if constexpr (!ALIGN_EPI) { if (wr == 0) PG8_BAR; }
    PG8_BAR;
#undef PG8_SA
#undef PG8_SB
#undef PG8_STAGE
#undef PG8_LDA
#undef PG8_LDB
#undef PG8_MMA
#undef PG8_WAIT_V
#undef PG8_WAIT_L
#undef PG8_BAR
#undef PG8_SCHED
}
}
constexpr int NWAVES = 8, NTHREADS = 512;
constexpr int BATCH = 8, SEQ = 4096, T = BATCH * SEQ, D = 1024, DEPTH = 2;
constexpr int NIN = 5888, PSW = 2816, NGATE = 3072, FFH = 2816;
constexpr int C_Q = 0, C_K = 384, C_V = 768, C_RW = 1152, C_LORA = 2304, C_SSM = 2560;
constexpr float NORM_EPS = 1e-6f, GN_EPS = 64e-5f;

constexpr size_t MiB = 1u << 20;
constexpr size_t WS_CTL = 0, CTL_ZERO_BYTES = 1 * MiB;
constexpr size_t WS_W = 1 * MiB, W_LAYER = 33 * MiB;
constexpr size_t WO_IN = 0, WO_BA = 12 * MiB, WO_BR = WO_BA + 768 * 1024, WO_BS = WO_BR + 768 * 1024, WO_OUT = 14 * MiB, WO_GU = 16 * MiB, WO_DN = 27 * MiB, WO_GLU = 32 * MiB + 512 * 1024;
constexpr size_t WS_XN = 68 * MiB;
constexpr size_t WS_PS = 132 * MiB;
constexpr size_t WS_GT = 308 * MiB;
constexpr size_t WS_SO = 404 * MiB;
constexpr size_t WS_LSE = 420 * MiB;
constexpr size_t WS_SCR = 421 * MiB;
constexpr size_t WS_END = 512 * MiB;

constexpr int LDS_BYTES = 147456;

#define GAS __attribute__((address_space(1)))
#define LAS __attribute__((address_space(3)))
typedef unsigned short bf16;
typedef unsigned v4u __attribute__((ext_vector_type(4)));
typedef unsigned v2u __attribute__((ext_vector_type(2)));
typedef float f32x4 __attribute__((ext_vector_type(4)));
#define LDS_WAIT() asm volatile("s_waitcnt lgkmcnt(0)" ::: "memory")
#define VM_WAIT() asm volatile("s_waitcnt vmcnt(0)" ::: "memory")
__device__ __forceinline__ unsigned f2bf(float f) { unsigned u = __builtin_bit_cast(unsigned, f); return (u + 0x7fffu + ((u >> 16) & 1u)) >> 16; }
__device__ __forceinline__ unsigned pk2(float lo, float hi) { return f2bf(lo) | (f2bf(hi) << 16); }
__device__ __forceinline__ float bf2f(bf16 b) { return __uint_as_float((unsigned)b << 16); }
__device__ __forceinline__ float bflo(unsigned w) { return __uint_as_float(w << 16); }
__device__ __forceinline__ float bfhi(unsigned w) { return __uint_as_float(w & 0xffff0000u); }
__device__ __forceinline__ float wave_sum(float v) {
#pragma unroll
    for (int o = 1; o < 64; o <<= 1) v += __shfl_xor(v, o);
    return v;
}
__device__ __forceinline__ float sigm(float x) { return 1.0f / (1.0f + __expf(-x)); }

struct Args { const float* in[32]; float* out; unsigned char* ws; int ph_lo, ph_hi; };

typedef __attribute__((address_space(4))) const unsigned char* kptr_t;
struct KA {
    kptr_t p;
    typedef const float* cfptr_t; typedef float* fptr_t; typedef unsigned char* ucptr_t;
    __device__ __forceinline__ const float* in(int i) const { return *(const __attribute__((address_space(4))) cfptr_t*)(p + 8 * i); }
    __device__ __forceinline__ float* out() const { return *(const __attribute__((address_space(4))) fptr_t*)(p + 256); }
    __device__ __forceinline__ unsigned char* ws() const { return *(const __attribute__((address_space(4))) ucptr_t*)(p + 264); }
};
static_assert(sizeof(Args) == 280, "Args layout");

struct Ctx {
    unsigned char* lds; unsigned char* ws; float* out;
    int tid, lane, wave, G, bid;
};

__device__ __forceinline__ void tr_item(const float* W, int ldw, int K, int nblk, bf16* WT, int goff, float* scr, int item, int lane) {
    const int kb = item / nblk, nb = item % nblk, k0 = 64 * kb, n0 = 32 * nb;
#pragma unroll 8
    for (int i = 0; i < 32; ++i) { const int kk = 2 * i + (lane >> 5); scr[kk * 33 + (lane & 31)] = W[(size_t)(k0 + kk) * ldw + n0 + (lane & 31)]; }
    LDS_WAIT(); asm volatile("" ::: "memory");
    const int c = lane & 7;
#pragma unroll
    for (int j = 0; j < 4; ++j) { const int n = (lane >> 3) + 8 * j; const float* s = scr + (8 * c) * 33 + n;
        v4u o; o.x = pk2(s[0 * 33], s[1 * 33]); o.y = pk2(s[2 * 33], s[3 * 33]); o.z = pk2(s[4 * 33], s[5 * 33]); o.w = pk2(s[6 * 33], s[7 * 33]);
        const int nn = n0 + n; const int drow = goff < 0 ? nn : ((nn >> 7) * 256 + goff + (nn & 127));
        *(v4u*)(WT + (size_t)drow * K + k0 + 8 * c) = o; }
    LDS_WAIT(); asm volatile("" ::: "memory");
}

__device__ __forceinline__ void phase_prep(const KA& A, const Ctx& F) {
    float* scr = (float*)(F.lds + F.wave * 16384);
    const int gw = F.bid * NWAVES + F.wave, NGW = F.G * NWAVES;
    constexpr int NM = 10;
    constexpr int cnt[NM] = {16 * 184, 6 * 32, 6 * 32, 4 * 32, 16 * 32, 16 * 88, 16 * 88, 44 * 32, 4 * 8, 4 * 8};
    constexpr int per_layer = cnt[0] + cnt[1] + cnt[2] + cnt[3] + cnt[4] + cnt[5] + cnt[6] + cnt[7] + cnt[8] + cnt[9];
    for (int it = gw; it < DEPTH * per_layer; it += NGW) {
        const int l = it / per_layer; int r = it % per_layer;
        unsigned char* wl = F.ws + WS_W + (size_t)l * W_LAYER;
        if (r < cnt[0]) { tr_item(A.in(2) + (size_t)l * D * NIN, NIN, D, NIN / 32, (bf16*)(wl + WO_IN), -1, scr, r, F.lane); continue; } r -= cnt[0];
        if (r < cnt[1]) { tr_item(A.in(24) + (size_t)l * 384 * D, D, 384, D / 32, (bf16*)(wl + WO_BA), -1, scr, r, F.lane); continue; } r -= cnt[1];
        if (r < cnt[2]) { tr_item(A.in(25) + (size_t)l * 384 * D, D, 384, D / 32, (bf16*)(wl + WO_BR), -1, scr, r, F.lane); continue; } r -= cnt[2];
        if (r < cnt[3]) { tr_item(A.in(26) + (size_t)l * 256 * D, D, 256, D / 32, (bf16*)(wl + WO_BS), -1, scr, r, F.lane); continue; } r -= cnt[3];
        if (r < cnt[4]) { tr_item(A.in(27) + (size_t)l * D * D, D, D, D / 32, (bf16*)(wl + WO_OUT), -1, scr, r, F.lane); continue; } r -= cnt[4];
        if (r < cnt[5]) { tr_item(A.in(29) + (size_t)l * D * 2 * FFH, 2 * FFH, D, FFH / 32, (bf16*)(wl + WO_GU), 0, scr, r, F.lane); continue; } r -= cnt[5];
        if (r < cnt[6]) { tr_item(A.in(29) + (size_t)l * D * 2 * FFH + FFH, 2 * FFH, D, FFH / 32, (bf16*)(wl + WO_GU), 128, scr, r, F.lane); continue; } r -= cnt[6];
        if (r < cnt[7]) { tr_item(A.in(30) + (size_t)l * FFH * D, D, FFH, D / 32, (bf16*)(wl + WO_DN), -1, scr, r, F.lane); continue; } r -= cnt[7];
        if (r < cnt[8]) { tr_item(A.in(22) + (size_t)l * 256 * 256, 256, 256, 8, (bf16*)(wl + WO_GLU), 0, scr, r, F.lane); continue; } r -= cnt[8];
        tr_item(A.in(23) + (size_t)l * 256 * 256, 256, 256, 8, (bf16*)(wl + WO_GLU), 128, scr, r, F.lane);
    }
}

template <bool OUT_F32> __device__ __forceinline__ void phase_rmsnorm(const KA& A, const Ctx& F, const float* src, const float* gain, void* dst) {
    const int gw = F.bid * NWAVES + F.wave, NGW = F.G * NWAVES;
    f32x4 gv[4];
#pragma unroll
    for (int j = 0; j < 4; ++j) gv[j] = *((const f32x4*)gain + F.lane + 64 * j);
    for (int m = gw; m < T; m += NGW) {
        const f32x4* xr = (const f32x4*)(src + (size_t)m * D) + F.lane;
        f32x4 v[4]; float s = 0.f;
#pragma unroll
        for (int j = 0; j < 4; ++j) { v[j] = xr[64 * j]; s += (v[j].x * v[j].x + v[j].y * v[j].y) + (v[j].z * v[j].z + v[j].w * v[j].w); }
        const float rs = 1.0f / sqrtf(wave_sum(s) * (1.0f / D) + NORM_EPS);
        if (OUT_F32) {
            f32x4* o = (f32x4*)((float*)dst + (size_t)m * D) + F.lane;
#pragma unroll
            for (int j = 0; j < 4; ++j) o[64 * j] = v[j] * rs * gv[j];
        } else {
            v2u* o = (v2u*)((bf16*)dst + (size_t)m * D) + F.lane;
#pragma unroll
            for (int j = 0; j < 4; ++j) { const f32x4 y = v[j] * rs * gv[j]; v2u w; w.x = pk2(y.x, y.y); w.y = pk2(y.z, y.w); o[64 * j] = w; }
        }
    }
}
__device__ __forceinline__ void attn_v1(const KA& A, const Ctx& F, int blk, int nblk) {
    bf16* PS = (bf16*)(F.ws + WS_PS); float* LSE = (float*)(F.ws + WS_LSE);
#pragma unroll 1
    for (int item = blk * NTHREADS + F.tid; item < T * 12; item += nblk * NTHREADS) {
        const int hf = item & 1, it2 = item >> 1;
        const int h = it2 / T, bt = it2 % T, t = bt % SEQ;
        const int g = h >> 1, dil = (g == 0) ? 1 : (g == 1 ? 4 : 16);
        unsigned qp_[16]; float o[32];
        { const v4u* qp = (const v4u*)(PS + (size_t)bt * PSW + C_Q + h * 64 + hf * 32);
#pragma unroll
          for (int c = 0; c < 4; ++c) { const v4u w = qp[c]; qp_[4 * c + 0] = w.x; qp_[4 * c + 1] = w.y; qp_[4 * c + 2] = w.z; qp_[4 * c + 3] = w.w; } }
#pragma unroll
        for (int c = 0; c < 32; ++c) o[c] = 0.f;
        float mx = -1e30f, l = 0.f;
#pragma unroll 1
        for (int j = 0; j <= 128; ++j) {
            const int tk = t - j * dil; if (tk < 0) break;
            const size_t rowk = (size_t)(bt - j * dil) * PSW;
            const v4u* kp = (const v4u*)(PS + rowk + C_K + h * 64 + hf * 32); const v4u* vp = (const v4u*)(PS + rowk + C_V + h * 64 + hf * 32);
            float s = 0.f;
#pragma unroll
            for (int c = 0; c < 4; ++c) { const v4u w = kp[c];
                s += bflo(qp_[4 * c + 0]) * bflo(w.x) + bfhi(qp_[4 * c + 0]) * bfhi(w.x) + bflo(qp_[4 * c + 1]) * bflo(w.y) + bfhi(qp_[4 * c + 1]) * bfhi(w.y)
                   + bflo(qp_[4 * c + 2]) * bflo(w.z) + bfhi(qp_[4 * c + 2]) * bfhi(w.z) + bflo(qp_[4 * c + 3]) * bflo(w.w) + bfhi(qp_[4 * c + 3]) * bfhi(w.w); }
            s += __shfl_xor(s, 1);
            s *= 0.125f;
            const float mn = fmaxf(mx, s), cf = __expf(mx - mn), p = __expf(s - mn);
            l = l * cf + p; mx = mn;
#pragma unroll
            for (int c = 0; c < 4; ++c) { const v4u w = vp[c];
                o[8 * c + 0] = o[8 * c + 0] * cf + p * bflo(w.x); o[8 * c + 1] = o[8 * c + 1] * cf + p * bfhi(w.x); o[8 * c + 2] = o[8 * c + 2] * cf + p * bflo(w.y); o[8 * c + 3] = o[8 * c + 3] * cf + p * bfhi(w.y);
                o[8 * c + 4] = o[8 * c + 4] * cf + p * bflo(w.z); o[8 * c + 5] = o[8 * c + 5] * cf + p * bfhi(w.z); o[8 * c + 6] = o[8 * c + 6] * cf + p * bflo(w.w); o[8 * c + 7] = o[8 * c + 7] * cf + p * bfhi(w.w); }
        }
        const float il = 1.0f / l;
        v4u* op = (v4u*)(PS + (size_t)bt * PSW + C_Q + h * 64 + hf * 32);
#pragma unroll
        for (int c = 0; c < 4; ++c) { v4u w; w.x = pk2(o[8 * c + 0] * il, o[8 * c + 1] * il); w.y = pk2(o[8 * c + 2] * il, o[8 * c + 3] * il); w.z = pk2(o[8 * c + 4] * il, o[8 * c + 5] * il); w.w = pk2(o[8 * c + 6] * il, o[8 * c + 7] * il); op[c] = w; }
        if (hf == 0) LSE[(size_t)bt * 6 + h] = mx + __logf(l);
    }
}
__device__ __forceinline__ void attn_finalize(const KA& A, const Ctx& F) {
    bf16* PS = (bf16*)(F.ws + WS_PS); const float* LSE = (const float*)(F.ws + WS_LSE);
    for (int item = F.bid * NTHREADS + F.tid; item < T * 48; item += F.G * NTHREADS) {
        const int bt = item / 48, r = item % 48, h = r >> 3, c = r & 7, j = h & 1;
        const float l0 = LSE[(size_t)bt * 6 + j], l1 = LSE[(size_t)bt * 6 + 2 + j], l2 = LSE[(size_t)bt * 6 + 4 + j], lm = LSE[(size_t)bt * 6 + h];
        const float mx = fmaxf(l0, fmaxf(l1, l2));
        const float al = __expf(lm - mx) / (__expf(l0 - mx) + __expf(l1 - mx) + __expf(l2 - mx));
        v4u* p = (v4u*)(PS + (size_t)bt * PSW + C_Q + h * 64) + c; v4u w = *p;
        w.x = pk2(bflo(w.x) * al, bfhi(w.x) * al); w.y = pk2(bflo(w.y) * al, bfhi(w.y) * al); w.z = pk2(bflo(w.z) * al, bfhi(w.z) * al); w.w = pk2(bflo(w.w) * al, bfhi(w.w) * al);
        *p = w;
    }
}

__device__ __forceinline__ void rwkv_v1(const KA& A, const Ctx& F, int l, int b, int h) {
    constexpr int CH = 32;
    bf16* PS = (bf16*)(F.ws + WS_PS);
    float* L = (float*)F.lds;
    float* ZR = L, *ZK = L + CH * 64, *ZV = L + 2 * CH * 64, *ZX = L + 3 * CH * 64;
    float* WD = ZX + CH * 256, *KA = WD + CH * 64, *KB = KA + CH * 64, *GG = KB + CH * 64, *YB = GG + CH * 64, *BON = YB + CH * 64, *PREV = BON + 64;
    const float* mix = A.in(3) + (size_t)l * 1408;
    const float* w0 = A.in(4) + l * 384, *w2 = A.in(5) + (size_t)l * 64 * 384, *a0 = A.in(6) + l * 384, *a2 = A.in(7) + (size_t)l * 64 * 384, *g2 = A.in(8) + (size_t)l * 128 * 384;
    const float* k_k = A.in(9) + l * 384, *k_a = A.in(10) + l * 384, *r_k = A.in(11) + l * 384, *ln_w = A.in(12) + l * 384, *ln_b = A.in(13) + l * 384;
    const int tid = F.tid, lane = F.lane;
    const int hc = h * 64 + lane;
    float S[8];
#pragma unroll
    for (int j = 0; j < 8; ++j) S[j] = 0.f;
    const int si = tid >> 3, sj = (tid & 7) * 8;
#pragma unroll 1
    for (int ch = 0; ch < SEQ / CH; ++ch) {
        const int t0 = ch * CH; const size_t row0 = (size_t)b * SEQ + t0;
        float* PRc = PREV + (ch & 1) * 192, *PRn = PREV + ((ch + 1) & 1) * 192;
#pragma unroll 1
        for (int e = tid; e < CH * 192; e += NTHREADS) {
            const int t = e / 192, c3 = e % 192, which = c3 >> 6, c = c3 & 63;
            const int col = C_RW + which * 384 + h * 64 + c;
            const float cur = bf2f(PS[(row0 + t) * PSW + col]);
            float prev;
            if (t == 0) prev = (ch == 0) ? 0.f : PRc[c3]; else prev = bf2f(PS[(row0 + t - 1) * PSW + col]);
            if (t == CH - 1) PRn[c3] = cur;
            const float z = cur + (prev - cur) * mix[which * 384 + h * 64 + c];
            L[which * CH * 64 + t * 64 + c] = z;
        }
#pragma unroll 1
        for (int e = tid; e < CH * 256; e += NTHREADS) {
            const int t = e >> 8, j = e & 255; const int col = C_LORA + j;
            const float cur = bf2f(PS[(row0 + t) * PSW + col]);
            const float prev = (t0 + t == 0) ? 0.f : bf2f(PS[(row0 + t - 1) * PSW + col]);
            float z = cur + (prev - cur) * mix[1152 + j];
            if (j < 64) z = tanhf(z); else if (j >= 128) z = sigm(z);
            ZX[t * 256 + j] = z;
        }
        __syncthreads();
        {
            float accw[4], acca[4], accg[4];
#pragma unroll
            for (int i = 0; i < 4; ++i) { accw[i] = 0.f; acca[i] = 0.f; accg[i] = 0.f; }
#pragma unroll 2
            for (int j = 0; j < 64; ++j) { const float ww = w2[j * 384 + hc], aa = a2[j * 384 + hc];
#pragma unroll
                for (int i = 0; i < 4; ++i) { const int t = F.wave + 8 * i; accw[i] += ZX[t * 256 + j] * ww; acca[i] += ZX[t * 256 + 64 + j] * aa; } }
#pragma unroll 2
            for (int j = 0; j < 128; ++j) { const float gg = g2[j * 384 + hc];
#pragma unroll
                for (int i = 0; i < 4; ++i) { const int t = F.wave + 8 * i; accg[i] += ZX[t * 256 + 128 + j] * gg; } }
            const float w0c = w0[hc], a0c = a0[hc], kkc = k_k[hc], kac = k_a[hc], rkc = r_k[hc];
#pragma unroll
            for (int i = 0; i < 4; ++i) { const int t = F.wave + 8 * i; const int o = t * 64 + lane;
                const float x = -(w0c + accw[i]); const float sp = (x > 20.f) ? x : log1pf(__expf(x)); const float w = -sp - 0.5f;
                const float av = sigm(a0c + acca[i]);
                const float kraw = ZK[o]; float kk = kraw * kkc; const float nrm = sqrtf(wave_sum(kk * kk)); kk = kk / fmaxf(nrm, 1e-12f);
                const float knew = kraw * (1.0f + (av - 1.0f) * kac);
                const float bon = wave_sum(ZR[o] * knew * rkc);
                ZK[o] = knew; WD[o] = __expf(-__expf(w)); KA[o] = -kk; KB[o] = kk * av; GG[o] = accg[i]; if (lane == 0) BON[t] = bon; }
        }
        __syncthreads();
#pragma unroll 2
        for (int t = 0; t < CH; ++t) {
            const f32x4 a0v = *(const f32x4*)(KA + t * 64 + sj), a1v = *(const f32x4*)(KA + t * 64 + sj + 4);
            const f32x4 w0v = *(const f32x4*)(WD + t * 64 + sj), w1v = *(const f32x4*)(WD + t * 64 + sj + 4);
            const f32x4 b0v = *(const f32x4*)(KB + t * 64 + sj), b1v = *(const f32x4*)(KB + t * 64 + sj + 4);
            const f32x4 k0v = *(const f32x4*)(ZK + t * 64 + sj), k1v = *(const f32x4*)(ZK + t * 64 + sj + 4);
            const f32x4 r0v = *(const f32x4*)(ZR + t * 64 + sj), r1v = *(const f32x4*)(ZR + t * 64 + sj + 4);
            const float vi = ZV[t * 64 + si];
            float sa = 0.f;
#pragma unroll
            for (int j = 0; j < 4; ++j) sa += S[j] * a0v[j] + S[4 + j] * a1v[j];
            sa += __shfl_xor(sa, 1); sa += __shfl_xor(sa, 2); sa += __shfl_xor(sa, 4);
            float y = 0.f;
#pragma unroll
            for (int j = 0; j < 4; ++j) { S[j] = S[j] * w0v[j] + sa * b0v[j] + vi * k0v[j]; S[4 + j] = S[4 + j] * w1v[j] + sa * b1v[j] + vi * k1v[j]; y += S[j] * r0v[j] + S[4 + j] * r1v[j]; }
            y += __shfl_xor(y, 1); y += __shfl_xor(y, 2); y += __shfl_xor(y, 4);
            if ((tid & 7) == 0) YB[t * 64 + si] = y;
        }
        __syncthreads();
        const float lw = ln_w[hc], lb = ln_b[hc];
#pragma unroll
        for (int i = 0; i < 4; ++i) { const int t = F.wave + 8 * i; const int o = t * 64 + lane;
            const float y = YB[o]; const float mu = wave_sum(y) * (1.0f / 64.0f); const float dv = y - mu; const float var = wave_sum(dv * dv) * (1.0f / 64.0f);
            const float yn = dv * (1.0f / sqrtf(var + GN_EPS)) * lw + lb;
            const float out = (yn + BON[t] * ZV[o]) * GG[o];
            PS[(row0 + t) * PSW + C_RW + h * 64 + lane] = (bf16)f2bf(out); }
        __syncthreads();
    }
}

__device__ __forceinline__ float gelu_tanh(float x) { const float u = 0.7978845608028654f * (x + 0.044715f * x * x * x); return 0.5f * x * (1.0f + tanhf(u)); }
__device__ __forceinline__ void ssm_v1(const KA& A, const Ctx& F, int l, int b, int g) {
    bf16* PS = (bf16*)(F.ws + WS_PS);
    float* L = (float*)F.lds;
    float* U = L, *XR = L + 1024, *XI = L + 1024 + 64 * 65, *CR = L + 1024 + 2 * 64 * 65, *CI = CR + 1024;
    const int tid = F.tid, lane = F.lane, p = lane;
    float are, aim, bre[16], bim[16];
    {
        const float step = __expf(A.in(16)[l * 16 + g]);
        const float lr = A.in(14)[(size_t)l * 1024 + g * 64 + p], li = A.in(15)[(size_t)l * 1024 + g * 64 + p];
        const float mag = __expf(lr * step), ang = li * step; float sn, cs; sincosf(ang, &sn, &cs);
        are = mag * cs; aim = mag * sn;
        const float inv = 1.0f / (lr * lr + li * li);
        const float fre = ((are - 1.0f) * lr + aim * li) * inv, fim = (aim * lr - (are - 1.0f) * li) * inv;
        const float* br = A.in(17) + (size_t)l * 16384 + (size_t)(g * 64 + p) * 16, *bi = A.in(18) + (size_t)l * 16384 + (size_t)(g * 64 + p) * 16;
#pragma unroll
        for (int c = 0; c < 16; ++c) { bre[c] = fre * br[c] - fim * bi[c]; bim[c] = fre * bi[c] + fim * br[c]; }
    }
    for (int e = tid; e < 1024; e += NTHREADS) { CR[e] = A.in(19)[(size_t)l * 16384 + g * 1024 + e]; CI[e] = A.in(20)[(size_t)l * 16384 + g * 1024 + e]; }
    const float* dsk = A.in(21) + l * 256 + g * 16;
    float xr = 0.f, xi = 0.f;
#pragma unroll 1
    for (int ch = 0; ch < SEQ / 64; ++ch) {
        const size_t row0 = (size_t)b * SEQ + ch * 64;
        for (int e = tid; e < 1024; e += NTHREADS) { const int t = e >> 4, c = e & 15; U[e] = bf2f(PS[(row0 + t) * PSW + C_SSM + g * 16 + c]); }
        __syncthreads();
#pragma unroll
        for (int i = 0; i < 8; ++i) { const int t = F.wave + 8 * i; float sr = 0.f, sii = 0.f;
#pragma unroll
            for (int c = 0; c < 16; ++c) { const float u = U[t * 16 + c]; sr += bre[c] * u; sii += bim[c] * u; }
            XR[t * 65 + p] = sr; XI[t * 65 + p] = sii; }
        __syncthreads();
        if (F.wave == 0) {
#pragma unroll 4
            for (int t = 0; t < 64; ++t) { const float nr = are * xr - aim * xi + XR[t * 65 + p], ni = are * xi + aim * xr + XI[t * 65 + p]; xr = nr; xi = ni; XR[t * 65 + p] = xr; XI[t * 65 + p] = xi; }
        }
        __syncthreads();
        { const int t = tid >> 3, c2 = (tid & 7) * 2;
#pragma unroll
          for (int q = 0; q < 2; ++q) { const int c = c2 + q; float y = 0.f;
#pragma unroll 4
              for (int pp = 0; pp < 64; ++pp) y += CR[c * 64 + pp] * XR[t * 65 + pp] - CI[c * 64 + pp] * XI[t * 65 + pp];
              y += dsk[c] * U[t * 16 + c];
              PS[(row0 + t) * PSW + C_SSM + g * 16 + c] = (bf16)f2bf(gelu_tanh(y)); } }
        __syncthreads();
    }
}
constexpr int NPH = 20;

__device__ __forceinline__ void run_phase(const KA& A, const Ctx& F, int ph) {
    PG8_LAS unsigned char* lds3 = (PG8_LAS unsigned char*)F.lds;
    bf16* XN = (bf16*)(F.ws + WS_XN); bf16* PS = (bf16*)(F.ws + WS_PS); unsigned char* GT = F.ws + WS_GT; bf16* SO = (bf16*)(F.ws + WS_SO);
    const int l = (ph - 1) / 9, k = (ph == 0) ? 10 : (ph == NPH - 1 ? 11 : (ph - 1) % 9);
    unsigned char* wl = F.ws + WS_W + (size_t)l * W_LAYER;
    const float* hin = (l == 0) ? A.in(0) : F.out;
    int ngemm = 0;
    if (k == 10) phase_prep(A, F);
    else if (k == 11) phase_rmsnorm<true>(A, F, F.out, A.in(31), F.out);
    else if (k == 0) phase_rmsnorm<false>(A, F, hin, A.in(1) + l * D, XN);
    else if (k == 6) phase_rmsnorm<false>(A, F, F.out, A.in(28) + l * D, XN);
    else if (k == 2) {
        if (F.bid < 48) rwkv_v1(A, F, l, F.bid / 6, F.bid % 6);
        else if (F.bid < 176) { const int it = F.bid - 48; ssm_v1(A, F, l, it / 16, it % 16); }
        else attn_v1(A, F, F.bid - 176, F.G - 176);
    }
    else if (k == 3) { attn_finalize(A, F); ngemm = 1; }
    else if (k == 4) ngemm = 3;
    else ngemm = 1;
#pragma unroll 1
    for (int gi = 0; gi < ngemm; ++gi) {
        pg8::Gemm g; pg8::EpiAny E; E.kind = 0; E.O = PS; E.ldo = FFH; E.GT = GT; E.gi = gi; E.base = hin; E.out = F.out;
        if (k == 1) { g = pg8::Gemm{XN, (const bf16*)(wl + WO_IN), T, NIN, D, D}; E.kind = 0; }
        else if (k == 3) { g = pg8::Gemm{PS + C_SSM, (const bf16*)(wl + WO_GLU), T, 512, 256, PSW}; E.kind = 4; E.O = SO; E.ldo = 256; }
        else if (k == 4) { E.kind = 1; E.O = XN;
            if (gi == 0) g = pg8::Gemm{PS + C_Q, (const bf16*)(wl + WO_BA), T, D, 384, PSW};
            else if (gi == 1) g = pg8::Gemm{PS + C_RW, (const bf16*)(wl + WO_BR), T, D, 384, PSW};
            else g = pg8::Gemm{SO, (const bf16*)(wl + WO_BS), T, D, 256, 256}; }
        else if (k == 5) { g = pg8::Gemm{XN, (const bf16*)(wl + WO_OUT), T, D, D, D}; E.kind = 2; }
        else if (k == 7) { g = pg8::Gemm{XN, (const bf16*)(wl + WO_GU), T, 2 * FFH, D, D}; E.kind = 3; }
        else { g = pg8::Gemm{PS, (const bf16*)(wl + WO_DN), T, D, FFH, FFH}; E.kind = 2; E.base = F.out; }
        pg8::StaticOrder S; S.init(T, g.N, F.G, F.bid);
        pg8::gemm_phase<pg8::EpiAny, pg8::StaticOrder, true>(lds3, g, S, E);
    }
}

__global__ void __launch_bounds__(NTHREADS, 2) mega_fwd(Args args) {
    extern __shared__ __attribute__((aligned(16))) unsigned char lds[];
#pragma unroll 1
    for (int ph = args.ph_lo; ph < args.ph_hi; ++ph) {
        KA A; A.p = (kptr_t)__builtin_amdgcn_kernarg_segment_ptr(); asm volatile("" : "+s"(A.p));
        int tid = threadIdx.x, bid = blockIdx.x, G = gridDim.x; asm volatile("" : "+v"(tid), "+s"(bid), "+s"(G));
        Ctx F;
        F.lds = lds; F.ws = A.ws(); F.out = A.out();
        F.tid = tid; F.lane = tid & 63; F.wave = __builtin_amdgcn_readfirstlane(tid >> 6); F.G = G; F.bid = bid;
        run_phase(A, F, ph);
#if ONE_LAUNCH
        if (ph + 1 < args.ph_hi) { __threadfence(); cg::this_grid().sync(); }
#endif
    }
}

extern "C" void kernel_launch(void* const* d_in, const int* in_sizes, int n_in, void* d_out, int out_size, void* d_ws, size_t ws_size, hipStream_t stream) {
    static int grid = 0;
    if (grid == 0) {
        if (n_in != 32 || in_sizes[0] != T * D || out_size != T * D || ws_size < WS_END) { fprintf(stderr, "kernel_launch: unexpected shapes (n_in %d, in0 %d, out %d, ws %zu); nothing launched\n", n_in, n_in > 0 ? in_sizes[0] : -1, out_size, ws_size); grid = -1; return; }
        int dev = 0, cus = 0, per_cu = 0;
        if (hipGetDevice(&dev) != hipSuccess || hipDeviceGetAttribute(&cus, hipDeviceAttributeMultiprocessorCount, dev) != hipSuccess) { grid = -1; return; }
        if (hipFuncSetAttribute((const void*)mega_fwd, hipFuncAttributeMaxDynamicSharedMemorySize, LDS_BYTES) != hipSuccess) { fprintf(stderr, "kernel_launch: hipFuncSetAttribute failed\n"); grid = -1; return; }
        if (hipOccupancyMaxActiveBlocksPerMultiprocessor(&per_cu, (const void*)mega_fwd, NTHREADS, LDS_BYTES) != hipSuccess || per_cu < 1) { fprintf(stderr, "kernel_launch: occupancy query says %d\n", per_cu); per_cu = 1; }
        (void)hipGetLastError();
        grid = cus;
        if (grid < 200) { fprintf(stderr, "kernel_launch: needs >= 200 CUs, got %d\n", grid); grid = -1; return; }
    }
    if (grid < 0) return;
    Args a{};
    for (int i = 0; i < 32; ++i) a.in[i] = (const float*)d_in[i];
    a.out = (float*)d_out; a.ws = (unsigned char*)d_ws;
#if ONE_LAUNCH
    a.ph_lo = 0; a.ph_hi = NPH;
    void* kargs[] = {&a};
    hipError_t e = hipLaunchCooperativeKernel((const void*)mega_fwd, dim3(grid), dim3(NTHREADS), kargs, LDS_BYTES, stream);
    if (e != hipSuccess) fprintf(stderr, "kernel_launch: cooperative launch failed: %s (grid %d)\n", hipGetErrorString(e), grid);
#else
    for (int ph = 0; ph < NPH; ++ph) {
        a.ph_lo = ph; a.ph_hi = ph + 1;
        hipLaunchKernelGGL(mega_fwd, dim3(grid), dim3(NTHREADS), LDS_BYTES, stream, a);
    }
#endif
}
```

```cpp
#include <hip/hip_runtime.h>
#include <hip/hip_cooperative_groups.h>
#include <cstdio>
#include <cstdint>
namespace cg = cooperative_groups;
#ifndef ONE_LAUNCH
#define ONE_LAUNCH 1
#endif
namespace pg8 {
#define PG8_LAS __attribute__((address_space(3)))
typedef unsigned short bf16_t;
typedef short bf16x8 __attribute__((ext_vector_type(8)));
typedef float f32x4 __attribute__((ext_vector_type(4)));
typedef float f32x2 __attribute__((ext_vector_type(2)));
typedef unsigned u32x4 __attribute__((ext_vector_type(4)));
typedef unsigned u32x2 __attribute__((ext_vector_type(2)));
constexpr int BM = 256, BK = 64, HALF = 128, HTB = HALF * BK * 2  , STAGE_BYTES = 8 * HTB, NXCD = 8, WGM = 8;

__host__ __device__ __forceinline__ int lds_byte(int r, int c) { const int st = (r >> 4) * 2 + (c >> 5), rr = r & 15, cc = c & 31, ob = rr * 64 + cc * 2; return st * 1024 + (ob ^ (((ob >> 9) & 1) << 5)); }
__host__ __device__ __forceinline__ void stage_rc(int b, int& R, int& C) { const int st = b / 1024, sb = b % 1024, swz = sb ^ (((sb >> 9) & 1) << 5); R = (st >> 1) * 16 + swz / 64; C = (st & 1) * 32 + (swz % 64) / 2; }
__host__ __device__ __forceinline__ int perm32(int rho) { const int n = rho >> 4, i = rho & 15; return 8 * (i >> 2) + 4 * n + (i & 3); }

struct Unit { int pm, pn; };
struct Gemm { const bf16_t* A; const bf16_t* Bt; int M, N, K, lda; };

struct StaticOrder {
    int nM, nN, nwg, G, c;
    __host__ __device__ void init(int M, int N, int G_, int c_) { nM = M / BM; nN = N / BM; nwg = nM * nN; G = G_; c = c_; }
    __host__ __device__ bool next(int i, Unit& u) const {
        const long L = (long)i * G + c; if (L >= nwg) return false;
        int wgid = (int)L; { const int q = nwg / NXCD, r = nwg % NXCD, xcd = wgid % NXCD, off = wgid / NXCD; wgid = (xcd < r ? xcd * (q + 1) : r * (q + 1) + (xcd - r) * q) + off; }
        const int nig = WGM * nN, gid = wgid / nig, fm = gid * WGM, gsz = (nM - fm) < WGM ? (nM - fm) : WGM;
        u.pm = fm + ((wgid % nig) % gsz); u.pn = (wgid % nig) / gsz; return true;
    }
    __device__ __forceinline__ void a_ready(const Unit&) const {}
    __device__ __forceinline__ void done(const Unit&) const {}
};

__device__ __forceinline__ unsigned cvt_pk_bf16(float lo, float hi) { unsigned r; asm volatile("v_cvt_pk_bf16_f32 %0, %1, %2" : "=v"(r) : "v"(lo), "v"(hi)); return r; }
__device__ __forceinline__ float bf_lo(unsigned w) { return __uint_as_float(w << 16); }
__device__ __forceinline__ float bf_hi(unsigned w) { return __uint_as_float(w & 0xffff0000u); }
__device__ __forceinline__ float sigmoidf_(float x) { return __builtin_amdgcn_rcpf(1.0f + __expf(-x)); }


struct EpiAny;
__device__ __forceinline__ void epi_win(bf16_t* PS, unsigned char* GT, bf16_t* BRW, const f32x4 (&acc)[2][2][4][2], const Unit& u, int wr, int wc, int fr, int fq) {
        const int row0 = u.pm * BM + wr * 64 + fr;
        if (u.pn < 11) {
            const int col0 = u.pn * BM + wc * 32 + 8 * fq;
#pragma unroll
            for (int ai = 0; ai < 2; ++ai)
#pragma unroll
                for (int m = 0; m < 4; ++m) { bf16_t* rowp = PS + (size_t)(row0 + ai * HALF + m * 16) * 2816 + col0;
#pragma unroll
                    for (int bj = 0; bj < 2; ++bj) { const f32x4 v0 = acc[ai][bj][m][0], v1 = acc[ai][bj][m][1];
                        u32x4 w; w.x = cvt_pk_bf16(v0[0], v0[1]); w.y = cvt_pk_bf16(v0[2], v0[3]); w.z = cvt_pk_bf16(v1[0], v1[1]); w.w = cvt_pk_bf16(v1[2], v1[3]);
                        *(u32x4*)(rowp + bj * HALF) = w;
                        if (m == 3 && fr == 15) *(u32x4*)(BRW + (size_t)((row0 + ai * HALF + m * 16) >> 6) * 2816 + col0 + bj * HALF) = w; } }
        } else {
            const int col0 = (u.pn - 11) * BM + wc * 32 + 8 * fq;
#pragma unroll
            for (int ai = 0; ai < 2; ++ai)
#pragma unroll
                for (int m = 0; m < 4; ++m) { unsigned char* rowp = GT + (size_t)(row0 + ai * HALF + m * 16) * 3072 + col0;
#pragma unroll
                    for (int bj = 0; bj < 2; ++bj) { const f32x4 v0 = acc[ai][bj][m][0], v1 = acc[ai][bj][m][1];
                        unsigned q[8];
#pragma unroll
                        for (int k = 0; k < 4; ++k) { q[k] = (unsigned)(sigmoidf_(v0[k]) * 255.0f + 0.5f); q[4 + k] = (unsigned)(sigmoidf_(v1[k]) * 255.0f + 0.5f); }
                        u32x2 w; w.x = q[0] | (q[1] << 8) | (q[2] << 16) | (q[3] << 24); w.y = q[4] | (q[5] << 8) | (q[6] << 16) | (q[7] << 24);
                        *(u32x2*)(rowp + bj * HALF) = w; } }
        }
    }

__device__ __forceinline__ void epi_merge(bf16_t* MG, const unsigned char* GT, int gi, const f32x4 (&acc)[2][2][4][2], const Unit& u, int wr, int wc, int fr, int fq) {
        const int row0 = u.pm * BM + wr * 64 + fr, col0 = u.pn * BM + wc * 32 + 8 * fq;
#pragma unroll
        for (int ai = 0; ai < 2; ++ai)
#pragma unroll
            for (int m = 0; m < 4; ++m) { const size_t r = (size_t)(row0 + ai * HALF + m * 16);
#pragma unroll
                for (int bj = 0; bj < 2; ++bj) { const int c = col0 + bj * HALF;
                    const u32x2 gq = *(const u32x2*)(GT + r * 3072 + gi * 1024 + c);
                    float v[8];
#pragma unroll
                    for (int k = 0; k < 4; ++k) { v[k] = acc[ai][bj][m][0][k] * ((float)((gq.x >> (8 * k)) & 255u) * (1.0f / 255.0f)); v[4 + k] = acc[ai][bj][m][1][k] * ((float)((gq.y >> (8 * k)) & 255u) * (1.0f / 255.0f)); }
                    u32x4* dst = (u32x4*)(MG + r * 1024 + c);
                    if (gi > 0) { const u32x4 p = *dst;
                        v[0] += bf_lo(p.x); v[1] += bf_hi(p.x); v[2] += bf_lo(p.y); v[3] += bf_hi(p.y); v[4] += bf_lo(p.z); v[5] += bf_hi(p.z); v[6] += bf_lo(p.w); v[7] += bf_hi(p.w); }
                    u32x4 w; w.x = cvt_pk_bf16(v[0], v[1]); w.y = cvt_pk_bf16(v[2], v[3]); w.z = cvt_pk_bf16(v[4], v[5]); w.w = cvt_pk_bf16(v[6], v[7]);
                    *dst = w; } }
    }

__device__ __forceinline__ void epi_res(const float* base, float* out, const f32x4 (&acc)[2][2][4][2], const Unit& u, int wr, int wc, int fr, int fq) {
        const int row0 = u.pm * BM + wr * 64 + fr, col0 = u.pn * BM + wc * 32 + 4 * fq;
#pragma unroll
        for (int ai = 0; ai < 2; ++ai)
#pragma unroll
            for (int m = 0; m < 4; ++m) { const size_t off = (size_t)(row0 + ai * HALF + m * 16) * 1024 + col0;
#pragma unroll
                for (int bj = 0; bj < 2; ++bj)
#pragma unroll
                    for (int n = 0; n < 2; ++n) { const f32x4 b = *(const f32x4*)(base + off + bj * HALF + n * 16); *(f32x4*)(out + off + bj * HALF + n * 16) = b + acc[ai][bj][m][n]; } }
    }

template <int MODE> __device__ __forceinline__ void epi_pair(bf16_t* O, int ldo, const f32x4 (&acc)[2][2][4][2], const Unit& u, int wr, int wc, int fr, int fq) {
        const int row0 = u.pm * BM + wr * 64 + fr, col0 = u.pn * HALF + wc * 32 + 8 * fq;
#pragma unroll
        for (int ai = 0; ai < 2; ++ai)
#pragma unroll
            for (int m = 0; m < 4; ++m) { bf16_t* rowp = O + (size_t)(row0 + ai * HALF + m * 16) * ldo + col0;
                float v[8];
#pragma unroll
                for (int n = 0; n < 2; ++n)
#pragma unroll
                    for (int k = 0; k < 4; ++k) { const float a = acc[ai][0][m][n][k], b = acc[ai][1][m][n][k];
                        v[4 * n + k] = (MODE == 0) ? (a * sigmoidf_(a) * b) : (a * sigmoidf_(b)); }
                u32x4 w; w.x = cvt_pk_bf16(v[0], v[1]); w.y = cvt_pk_bf16(v[2], v[3]); w.z = cvt_pk_bf16(v[4], v[5]); w.w = cvt_pk_bf16(v[6], v[7]);
                *(u32x4*)rowp = w; }
    }


struct EpiAny {
    int kind;
    bf16_t* O; int ldo; unsigned char* GT; int gi; const float* base; float* out; bf16_t* BRW;
    __device__ __forceinline__ bool perm() const { return kind != 2; }
    __device__ __forceinline__ void operator()(const f32x4 (&acc)[2][2][4][2], const Unit& u, int wr, int wc, int fr, int fq) const {
        if (kind == 0) epi_win(O, GT, BRW, acc, u, wr, wc, fr, fq);
        else if (kind == 1) epi_merge(O, GT, gi, acc, u, wr, wc, fr, fq);
        else if (kind == 2) epi_res(base, out, acc, u, wr, wc, fr, fq);
        else if (kind == 3) epi_pair<0>(O, ldo, acc, u, wr, wc, fr, fq);
        else epi_pair<1>(O, ldo, acc, u, wr, wc, fr, fq);
    }
};

template <class Epi, class Sched, bool ALIGN_EPI = false>
__device__ __forceinline__ void gemm_phase(PG8_LAS unsigned char* lds, const Gemm g, const Sched& S, const Epi& E) {
    int tid_ = threadIdx.x; asm volatile("" : "+v"(tid_));
    const int tid = tid_, wid = __builtin_amdgcn_readfirstlane(tid >> 6), lane = tid & 63, wr = wid >> 2, wc = wid & 3, fr = lane & 15, fq = lane >> 4;
    const int K = g.K, lda = g.lda, nt = K / BK;
    unsigned voffA[2], voffB[2];
#pragma unroll
    for (int i = 0; i < 2; ++i) { int R, C; stage_rc(tid * 16 + i * 8192, R, C); const int Rb = E.perm() ? ((R & ~31) + perm32(R & 31)) : R;
        voffA[i] = (unsigned)(R * lda + C) * 2u; voffB[i] = (unsigned)(Rb * K + C) * 2u; }
    const size_t kstep = (size_t)(BK * 2);
    const size_t hstepA = (size_t)HALF * lda * 2, hstepB = (size_t)HALF * K * 2;
    const size_t tstepA = 2 * hstepA, tstepB = 2 * hstepB;
    const unsigned ldsw = (unsigned)wid * 1024u;
    const int aoff = lds_byte(wr * 64 + fr, fq * 8), boff = lds_byte(wc * 32 + fr, fq * 8);
#define PG8_SA(b, h) (((b) * 2 + (h)) * HTB)
#define PG8_SB(b, h) ((4 + (b) * 2 + (h)) * HTB)
#define PG8_STAGE(bufoff, gbase, voff) do { _Pragma("unroll") for (int _i = 0; _i < 2; ++_i) \
        __builtin_amdgcn_global_load_lds((const unsigned*)((const char*)(gbase) + (voff)[_i]), (PG8_LAS unsigned*)(lds + (bufoff) + ldsw + _i * 8192), 16, 0, 0); } while (0)
#define PG8_LDA(dst, b, h) do { _Pragma("unroll") for (int m = 0; m < 4; ++m) _Pragma("unroll") for (int k = 0; k < 2; ++k) dst[m][k] = *(const PG8_LAS bf16x8*)(lds + PG8_SA(b, h) + aoff + m * 2048 + k * 1024); } while (0)
#define PG8_LDB(dst, b, h) do { _Pragma("unroll") for (int n = 0; n < 2; ++n) _Pragma("unroll") for (int k = 0; k < 2; ++k) dst[n][k] = *(const PG8_LAS bf16x8*)(lds + PG8_SB(b, h) + boff + n * 2048 + k * 1024); } while (0)
#define PG8_MMA(ai, bj, At, Bt) do { __builtin_amdgcn_s_setprio(1); _Pragma("unroll") for (int m = 0; m < 4; ++m) _Pragma("unroll") for (int n = 0; n < 2; ++n) _Pragma("unroll") for (int k = 0; k < 2; ++k) \
        acc[ai][bj][m][n] = __builtin_amdgcn_mfma_f32_16x16x32_bf16(Bt[n][k], At[m][k], acc[ai][bj][m][n], 0, 0, 0); __builtin_amdgcn_s_setprio(0); } while (0)
#define PG8_WAIT_V(n) asm volatile("s_waitcnt vmcnt(" #n ")" ::: "memory")
#define PG8_WAIT_L(n) asm volatile("s_waitcnt lgkmcnt(" #n ")" ::: "memory")
#define PG8_BAR __builtin_amdgcn_s_barrier()
#define PG8_SCHED __builtin_amdgcn_sched_barrier(0)
    Unit cur, nxt; int ui = 0;
    if (!S.next(0, cur)) return;
    f32x4 acc[2][2][4][2];
#pragma unroll
    for (int a = 0; a < 2; ++a)
#pragma unroll
        for (int b = 0; b < 2; ++b)
#pragma unroll
            for (int m = 0; m < 4; ++m)
#pragma unroll
                for (int n = 0; n < 2; ++n) acc[a][b][m][n] = (f32x4){0.f, 0.f, 0.f, 0.f};
    bf16x8 At[4][2], B0[2][2], B1[2][2];
    const char* cA = (const char*)g.A + (size_t)cur.pm * tstepA; const char* cB = (const char*)g.Bt + (size_t)cur.pn * tstepB;
    S.a_ready(cur);
    PG8_STAGE(PG8_SB(0, 0), cB, voffB); PG8_STAGE(PG8_SB(0, 1), cB + hstepB, voffB); PG8_STAGE(PG8_SA(0, 0), cA, voffA); PG8_STAGE(PG8_SA(0, 1), cA + hstepA, voffA);
    if (wr == 1) PG8_BAR;
    PG8_WAIT_V(2); PG8_BAR;
    PG8_STAGE(PG8_SB(1, 0), cB + kstep, voffB); PG8_STAGE(PG8_SA(1, 0), cA + kstep, voffA); PG8_STAGE(PG8_SB(1, 1), cB + hstepB + kstep, voffB);
    PG8_WAIT_V(6); PG8_BAR;
    for (;;) {
        const bool has_next = S.next(ui + 1, nxt);
        const char* nA = has_next ? (const char*)g.A + (size_t)nxt.pm * tstepA : cA; const char* nB = has_next ? (const char*)g.Bt + (size_t)nxt.pn * tstepB : cB;
        for (int t = 0; t < nt; t += 2) {
            const bool last = (t == nt - 2);
            const char* a1 = cA + (size_t)(t + 1) * kstep;
            const char* a2 = last ? nA : cA + (size_t)(t + 2) * kstep; const char* b2 = last ? nB : cB + (size_t)(t + 2) * kstep;
            const char* a3 = a2 + kstep; const char* b3 = b2 + kstep;
            if (last && has_next) S.a_ready(nxt);
            PG8_LDB(B0, 0, 0); PG8_LDB(B1, 0, 1); PG8_SCHED; PG8_LDA(At, 0, 0); PG8_STAGE(PG8_SA(1, 1), a1 + hstepA, voffA);
            PG8_WAIT_V(8); PG8_WAIT_L(0); PG8_BAR; PG8_MMA(0, 0, At, B0); PG8_MMA(0, 1, At, B1); PG8_BAR; PG8_SCHED;
            PG8_LDA(At, 0, 1); PG8_STAGE(PG8_SB(0, 0), b2, voffB); PG8_STAGE(PG8_SB(0, 1), b2 + hstepB, voffB); PG8_STAGE(PG8_SA(0, 0), a2, voffA);
            PG8_WAIT_V(8); PG8_WAIT_L(0); PG8_BAR; PG8_MMA(1, 0, At, B0); PG8_MMA(1, 1, At, B1); PG8_BAR; PG8_SCHED;
            PG8_LDB(B0, 1, 0); PG8_LDB(B1, 1, 1); PG8_SCHED; PG8_LDA(At, 1, 0); PG8_STAGE(PG8_SA(0, 1), a2 + hstepA, voffA);
            PG8_WAIT_V(8); PG8_WAIT_L(0); PG8_BAR; PG8_MMA(0, 0, At, B0); PG8_MMA(0, 1, At, B1); PG8_BAR; PG8_SCHED;
            PG8_LDA(At, 1, 1); PG8_STAGE(PG8_SB(1, 0), b3, voffB); PG8_STAGE(PG8_SB(1, 1), b3 + hstepB, voffB); PG8_STAGE(PG8_SA(1, 0), a3, voffA);
            PG8_WAIT_V(8); PG8_WAIT_L(0); PG8_BAR; PG8_MMA(1, 0, At, B0); PG8_MMA(1, 1, At, B1); PG8_BAR; PG8_SCHED;
        }
        if constexpr (ALIGN_EPI) { if (wr == 0) PG8_BAR; }
        E(acc, cur, wr, wc, fr, fq); S.done(cur);
        if (!has_next) break;
#pragma unroll
        for (int a = 0; a < 2; ++a)
#pragma unroll
            for (int b = 0; b < 2; ++b)
#pragma unroll
                for (int m = 0; m < 4; ++m)
#pragma unroll
                    for (int n = 0; n < 2; ++n) acc[a][b][m][n] = (f32x4){0.f, 0.f, 0.f, 0.f};
        cur = nxt; cA = nA; cB = nB; ++ui;
        if constexpr (ALIGN_EPI) { if (wr == 1) PG8_BAR; }
    }
    PG8_WAIT_V(0);
    if constexpr (!ALIGN_EPI) { if (wr == 0) PG8_BAR; }
    PG8_BAR;
#undef PG8_SA
#undef PG8_SB
#undef PG8_STAGE
#undef PG8_LDA
#undef PG8_LDB
#undef PG8_MMA
#undef PG8_WAIT_V
#undef PG8_WAIT_L
#undef PG8_BAR
#undef PG8_SCHED
}
}
constexpr int NWAVES = 8, NTHREADS = 512;
constexpr int BATCH = 8, SEQ = 4096, T = BATCH * SEQ, D = 1024, DEPTH = 2;
constexpr int NIN = 5888, PSW = 2816, NGATE = 3072, FFH = 2816;
constexpr int C_Q = 0, C_K = 384, C_V = 768, C_RW = 1152, C_LORA = 2304, C_SSM = 2560;
constexpr float NORM_EPS = 1e-6f, GN_EPS = 64e-5f;

constexpr size_t MiB = 1u << 20;
constexpr size_t WS_CTL = 0, CTL_ZERO_BYTES = 1 * MiB;
constexpr size_t WS_W = 1 * MiB, W_LAYER = 33 * MiB;
constexpr size_t WO_IN = 0, WO_BA = 12 * MiB, WO_BR = WO_BA + 768 * 1024, WO_BS = WO_BR + 768 * 1024, WO_OUT = 14 * MiB, WO_GU = 16 * MiB, WO_DN = 27 * MiB, WO_GLU = 32 * MiB + 512 * 1024,
                 WO_W2 = WO_GLU + 256 * 1024, WO_A2 = WO_W2 + 48 * 1024, WO_G2 = WO_A2 + 48 * 1024;
constexpr size_t WS_XN = 68 * MiB;
constexpr size_t WS_PS = 132 * MiB;
constexpr size_t WS_GT = 308 * MiB;
constexpr size_t WS_SO = 404 * MiB;
constexpr size_t WS_LSE = 420 * MiB;
constexpr size_t WS_SCR = 421 * MiB;
constexpr size_t WS_BR = WS_SCR;
constexpr size_t WS_RMC = WS_SCR + 3 * MiB;
constexpr size_t WS_RNT = WS_RMC + 24 * MiB;
constexpr size_t WS_REM = WS_RNT + 24 * MiB;
constexpr size_t WS_RGL = WS_REM + 24 * MiB;
static_assert(WS_RGL + 1 * MiB <= 512 * MiB, "scratch map");
constexpr size_t WS_END = 512 * MiB;

constexpr int LDS_BYTES = 147456;

#define GAS __attribute__((address_space(1)))
#define LAS __attribute__((address_space(3)))
typedef unsigned short bf16;
typedef unsigned v4u __attribute__((ext_vector_type(4)));
typedef unsigned v2u __attribute__((ext_vector_type(2)));
typedef float f32x4 __attribute__((ext_vector_type(4)));
#define LDS_WAIT() asm volatile("s_waitcnt lgkmcnt(0)" ::: "memory")
#define VM_WAIT() asm volatile("s_waitcnt vmcnt(0)" ::: "memory")
__device__ __forceinline__ unsigned f2bf(float f) { unsigned u = __builtin_bit_cast(unsigned, f); return (u + 0x7fffu + ((u >> 16) & 1u)) >> 16; }
__device__ __forceinline__ unsigned pk2(float lo, float hi) { return f2bf(lo) | (f2bf(hi) << 16); }
__device__ __forceinline__ float bf2f(bf16 b) { return __uint_as_float((unsigned)b << 16); }
__device__ __forceinline__ float bflo(unsigned w) { return __uint_as_float(w << 16); }
__device__ __forceinline__ float bfhi(unsigned w) { return __uint_as_float(w & 0xffff0000u); }
__device__ __forceinline__ float wave_sum(float v) {
#pragma unroll
    for (int o = 1; o < 64; o <<= 1) v += __shfl_xor(v, o);
    return v;
}
__device__ __forceinline__ float sigm(float x) { return 1.0f / (1.0f + __expf(-x)); }

struct Args { const float* in[32]; float* out; unsigned char* ws; int ph_lo, ph_hi; };

typedef __attribute__((address_space(4))) const unsigned char* kptr_t;
struct KA {
    kptr_t p;
    typedef const float* cfptr_t; typedef float* fptr_t; typedef unsigned char* ucptr_t;
    __device__ __forceinline__ const float* in(int i) const { return *(const __attribute__((address_space(4))) cfptr_t*)(p + 8 * i); }
    __device__ __forceinline__ float* out() const { return *(const __attribute__((address_space(4))) fptr_t*)(p + 256); }
    __device__ __forceinline__ unsigned char* ws() const { return *(const __attribute__((address_space(4))) ucptr_t*)(p + 264); }
};
static_assert(sizeof(Args) == 280, "Args layout");

struct Ctx {
    unsigned char* lds; unsigned char* ws; float* out;
    int tid, lane, wave, G, bid;
};

__device__ __forceinline__ void tr_item(const float* W, int ldw, int K, int nblk, bf16* WT, int goff, float* scr, int item, int lane) {
    const int kb = item / nblk, nb = item % nblk, k0 = 64 * kb, n0 = 32 * nb;
#pragma unroll 8
    for (int i = 0; i < 32; ++i) { const int kk = 2 * i + (lane >> 5); scr[kk * 33 + (lane & 31)] = W[(size_t)(k0 + kk) * ldw + n0 + (lane & 31)]; }
    LDS_WAIT(); asm volatile("" ::: "memory");
    const int c = lane & 7;
#pragma unroll
    for (int j = 0; j < 4; ++j) { const int n = (lane >> 3) + 8 * j; const float* s = scr + (8 * c) * 33 + n;
        v4u o; o.x = pk2(s[0 * 33], s[1 * 33]); o.y = pk2(s[2 * 33], s[3 * 33]); o.z = pk2(s[4 * 33], s[5 * 33]); o.w = pk2(s[6 * 33], s[7 * 33]);
        const int nn = n0 + n; const int drow = goff < 0 ? nn : ((nn >> 7) * 256 + goff + (nn & 127));
        *(v4u*)(WT + (size_t)drow * K + k0 + 8 * c) = o; }
    LDS_WAIT(); asm volatile("" ::: "memory");
}

__device__ __forceinline__ void phase_prep(const KA& A, const Ctx& F) {
    float* scr = (float*)(F.lds + F.wave * 16384);
    const int gw = F.bid * NWAVES + F.wave, NGW = F.G * NWAVES;
    constexpr int NM = 13;
    constexpr int cnt[NM] = {16 * 184, 6 * 32, 6 * 32, 4 * 32, 16 * 32, 16 * 88, 16 * 88, 44 * 32, 4 * 8, 4 * 8, 12, 12, 24};
    constexpr int per_layer = cnt[0] + cnt[1] + cnt[2] + cnt[3] + cnt[4] + cnt[5] + cnt[6] + cnt[7] + cnt[8] + cnt[9] + cnt[10] + cnt[11] + cnt[12];
    for (int it = gw; it < DEPTH * per_layer; it += NGW) {
        const int l = it / per_layer; int r = it % per_layer;
        unsigned char* wl = F.ws + WS_W + (size_t)l * W_LAYER;
        if (r < cnt[0]) { tr_item(A.in(2) + (size_t)l * D * NIN, NIN, D, NIN / 32, (bf16*)(wl + WO_IN), -1, scr, r, F.lane); continue; } r -= cnt[0];
        if (r < cnt[1]) { tr_item(A.in(24) + (size_t)l * 384 * D, D, 384, D / 32, (bf16*)(wl + WO_BA), -1, scr, r, F.lane); continue; } r -= cnt[1];
        if (r < cnt[2]) { tr_item(A.in(25) + (size_t)l * 384 * D, D, 384, D / 32, (bf16*)(wl + WO_BR), -1, scr, r, F.lane); continue; } r -= cnt[2];
        if (r < cnt[3]) { tr_item(A.in(26) + (size_t)l * 256 * D, D, 256, D / 32, (bf16*)(wl + WO_BS), -1, scr, r, F.lane); continue; } r -= cnt[3];
        if (r < cnt[4]) { tr_item(A.in(27) + (size_t)l * D * D, D, D, D / 32, (bf16*)(wl + WO_OUT), -1, scr, r, F.lane); continue; } r -= cnt[4];
        if (r < cnt[5]) { tr_item(A.in(29) + (size_t)l * D * 2 * FFH, 2 * FFH, D, FFH / 32, (bf16*)(wl + WO_GU), 0, scr, r, F.lane); continue; } r -= cnt[5];
        if (r < cnt[6]) { tr_item(A.in(29) + (size_t)l * D * 2 * FFH + FFH, 2 * FFH, D, FFH / 32, (bf16*)(wl + WO_GU), 128, scr, r, F.lane); continue; } r -= cnt[6];
        if (r < cnt[7]) { tr_item(A.in(30) + (size_t)l * FFH * D, D, FFH, D / 32, (bf16*)(wl + WO_DN), -1, scr, r, F.lane); continue; } r -= cnt[7];
        if (r < cnt[8]) { tr_item(A.in(22) + (size_t)l * 256 * 256, 256, 256, 8, (bf16*)(wl + WO_GLU), 0, scr, r, F.lane); continue; } r -= cnt[8];
        if (r < cnt[9]) { tr_item(A.in(23) + (size_t)l * 256 * 256, 256, 256, 8, (bf16*)(wl + WO_GLU), 128, scr, r, F.lane); continue; } r -= cnt[9];
        if (r < cnt[10]) { tr_item(A.in(5) + (size_t)l * 64 * 384, 384, 64, 12, (bf16*)(wl + WO_W2), -1, scr, r, F.lane); continue; } r -= cnt[10];
        if (r < cnt[11]) { tr_item(A.in(7) + (size_t)l * 64 * 384, 384, 64, 12, (bf16*)(wl + WO_A2), -1, scr, r, F.lane); continue; } r -= cnt[11];
        tr_item(A.in(8) + (size_t)l * 128 * 384, 384, 128, 12, (bf16*)(wl + WO_G2), -1, scr, r, F.lane);
    }
}

template <bool OUT_F32> __device__ __forceinline__ void phase_rmsnorm(const KA& A, const Ctx& F, const float* src, const float* gain, void* dst) {
    const int gw = F.bid * NWAVES + F.wave, NGW = F.G * NWAVES;
    f32x4 gv[4];
#pragma unroll
    for (int j = 0; j < 4; ++j) gv[j] = *((const f32x4*)gain + F.lane + 64 * j);
    for (int m = gw; m < T; m += NGW) {
        const f32x4* xr = (const f32x4*)(src + (size_t)m * D) + F.lane;
        f32x4 v[4]; float s = 0.f;
#pragma unroll
        for (int j = 0; j < 4; ++j) { v[j] = xr[64 * j]; s += (v[j].x * v[j].x + v[j].y * v[j].y) + (v[j].z * v[j].z + v[j].w * v[j].w); }
        const float rs = 1.0f / sqrtf(wave_sum(s) * (1.0f / D) + NORM_EPS);
        if (OUT_F32) {
            f32x4* o = (f32x4*)((float*)dst + (size_t)m * D) + F.lane;
#pragma unroll
            for (int j = 0; j < 4; ++j) o[64 * j] = v[j] * rs * gv[j];
        } else {
            v2u* o = (v2u*)((bf16*)dst + (size_t)m * D) + F.lane;
#pragma unroll
            for (int j = 0; j < 4; ++j) { const f32x4 y = v[j] * rs * gv[j]; v2u w; w.x = pk2(y.x, y.y); w.y = pk2(y.z, y.w); o[64 * j] = w; }
        }
    }
}
__device__ __forceinline__ void attn_v1(const KA& A, const Ctx& F, int blk, int nblk) {
    bf16* PS = (bf16*)(F.ws + WS_PS); float* LSE = (float*)(F.ws + WS_LSE);
#pragma unroll 1
    for (int item = blk * NTHREADS + F.tid; item < T * 12; item += nblk * NTHREADS) {
        const int hf = item & 1, it2 = item >> 1;
        const int h = it2 / T, bt = it2 % T, t = bt % SEQ;
        const int g = h >> 1, dil = (g == 0) ? 1 : (g == 1 ? 4 : 16);
        unsigned qp_[16]; float o[32];
        { const v4u* qp = (const v4u*)(PS + (size_t)bt * PSW + C_Q + h * 64 + hf * 32);
#pragma unroll
          for (int c = 0; c < 4; ++c) { const v4u w = qp[c]; qp_[4 * c + 0] = w.x; qp_[4 * c + 1] = w.y; qp_[4 * c + 2] = w.z; qp_[4 * c + 3] = w.w; } }
#pragma unroll
        for (int c = 0; c < 32; ++c) o[c] = 0.f;
        float mx = -1e30f, l = 0.f;
#pragma unroll 1
        for (int j = 0; j <= 128; ++j) {
            const int tk = t - j * dil; if (tk < 0) break;
            const size_t rowk = (size_t)(bt - j * dil) * PSW;
            const v4u* kp = (const v4u*)(PS + rowk + C_K + h * 64 + hf * 32); const v4u* vp = (const v4u*)(PS + rowk + C_V + h * 64 + hf * 32);
            float s = 0.f;
#pragma unroll
            for (int c = 0; c < 4; ++c) { const v4u w = kp[c];
                s += bflo(qp_[4 * c + 0]) * bflo(w.x) + bfhi(qp_[4 * c + 0]) * bfhi(w.x) + bflo(qp_[4 * c + 1]) * bflo(w.y) + bfhi(qp_[4 * c + 1]) * bfhi(w.y)
                   + bflo(qp_[4 * c + 2]) * bflo(w.z) + bfhi(qp_[4 * c + 2]) * bfhi(w.z) + bflo(qp_[4 * c + 3]) * bflo(w.w) + bfhi(qp_[4 * c + 3]) * bfhi(w.w); }
            s += __shfl_xor(s, 1);
            s *= 0.125f;
            const float mn = fmaxf(mx, s), cf = __expf(mx - mn), p = __expf(s - mn);
            l = l * cf + p; mx = mn;
#pragma unroll
            for (int c = 0; c < 4; ++c) { const v4u w = vp[c];
                o[8 * c + 0] = o[8 * c + 0] * cf + p * bflo(w.x); o[8 * c + 1] = o[8 * c + 1] * cf + p * bfhi(w.x); o[8 * c + 2] = o[8 * c + 2] * cf + p * bflo(w.y); o[8 * c + 3] = o[8 * c + 3] * cf + p * bfhi(w.y);
                o[8 * c + 4] = o[8 * c + 4] * cf + p * bflo(w.z); o[8 * c + 5] = o[8 * c + 5] * cf + p * bfhi(w.z); o[8 * c + 6] = o[8 * c + 6] * cf + p * bflo(w.w); o[8 * c + 7] = o[8 * c + 7] * cf + p * bfhi(w.w); }
        }
        const float il = 1.0f / l;
        v4u* op = (v4u*)(PS + (size_t)bt * PSW + C_Q + h * 64 + hf * 32);
#pragma unroll
        for (int c = 0; c < 4; ++c) { v4u w; w.x = pk2(o[8 * c + 0] * il, o[8 * c + 1] * il); w.y = pk2(o[8 * c + 2] * il, o[8 * c + 3] * il); w.z = pk2(o[8 * c + 4] * il, o[8 * c + 5] * il); w.w = pk2(o[8 * c + 6] * il, o[8 * c + 7] * il); op[c] = w; }
        if (hf == 0) LSE[(size_t)bt * 6 + h] = mx + __logf(l);
    }
}
__device__ __forceinline__ void attn_finalize(const KA& A, const Ctx& F) {
    bf16* PS = (bf16*)(F.ws + WS_PS); const float* LSE = (const float*)(F.ws + WS_LSE);
    for (int item = F.bid * NTHREADS + F.tid; item < T * 48; item += F.G * NTHREADS) {
        const int bt = item / 48, r = item % 48, h = r >> 3, c = r & 7, j = h & 1;
        const float l0 = LSE[(size_t)bt * 6 + j], l1 = LSE[(size_t)bt * 6 + 2 + j], l2 = LSE[(size_t)bt * 6 + 4 + j], lm = LSE[(size_t)bt * 6 + h];
        const float mx = fmaxf(l0, fmaxf(l1, l2));
        const float al = __expf(lm - mx) / (__expf(l0 - mx) + __expf(l1 - mx) + __expf(l2 - mx));
        v4u* p = (v4u*)(PS + (size_t)bt * PSW + C_Q + h * 64) + c; v4u w = *p;
        w.x = pk2(bflo(w.x) * al, bfhi(w.x) * al); w.y = pk2(bflo(w.y) * al, bfhi(w.y) * al); w.z = pk2(bflo(w.z) * al, bfhi(w.z) * al); w.w = pk2(bflo(w.w) * al, bfhi(w.w) * al);
        *p = w;
    }
}

__device__ __forceinline__ void rwkv_v1(const KA& A, const Ctx& F, int l, int b, int h) {
    constexpr int CH = 32;
    bf16* PS = (bf16*)(F.ws + WS_PS);
    float* L = (float*)F.lds;
    float* ZR = L, *ZK = L + CH * 64, *ZV = L + 2 * CH * 64, *ZX = L + 3 * CH * 64;
    float* WD = ZX + CH * 256, *KA = WD + CH * 64, *KB = KA + CH * 64, *GG = KB + CH * 64, *YB = GG + CH * 64, *BON = YB + CH * 64, *PREV = BON + 64;
    const float* mix = A.in(3) + (size_t)l * 1408;
    const float* w0 = A.in(4) + l * 384, *w2 = A.in(5) + (size_t)l * 64 * 384, *a0 = A.in(6) + l * 384, *a2 = A.in(7) + (size_t)l * 64 * 384, *g2 = A.in(8) + (size_t)l * 128 * 384;
    const float* k_k = A.in(9) + l * 384, *k_a = A.in(10) + l * 384, *r_k = A.in(11) + l * 384, *ln_w = A.in(12) + l * 384, *ln_b = A.in(13) + l * 384;
    const int tid = F.tid, lane = F.lane;
    const int hc = h * 64 + lane;
    float S[8];
#pragma unroll
    for (int j = 0; j < 8; ++j) S[j] = 0.f;
    const int si = tid >> 3, sj = (tid & 7) * 8;
#pragma unroll 1
    for (int ch = 0; ch < SEQ / CH; ++ch) {
        const int t0 = ch * CH; const size_t row0 = (size_t)b * SEQ + t0;
        float* PRc = PREV + (ch & 1) * 192, *PRn = PREV + ((ch + 1) & 1) * 192;
#pragma unroll 1
        for (int e = tid; e < CH * 192; e += NTHREADS) {
            const int t = e / 192, c3 = e % 192, which = c3 >> 6, c = c3 & 63;
            const int col = C_RW + which * 384 + h * 64 + c;
            const float cur = bf2f(PS[(row0 + t) * PSW + col]);
            float prev;
            if (t == 0) prev = (ch == 0) ? 0.f : PRc[c3]; else prev = bf2f(PS[(row0 + t - 1) * PSW + col]);
            if (t == CH - 1) PRn[c3] = cur;
            const float z = cur + (prev - cur) * mix[which * 384 + h * 64 + c];
            L[which * CH * 64 + t * 64 + c] = z;
        }
#pragma unroll 1
        for (int e = tid; e < CH * 256; e += NTHREADS) {
            const int t = e >> 8, j = e & 255; const int col = C_LORA + j;
            const float cur = bf2f(PS[(row0 + t) * PSW + col]);
            const float prev = (t0 + t == 0) ? 0.f : bf2f(PS[(row0 + t - 1) * PSW + col]);
            float z = cur + (prev - cur) * mix[1152 + j];
            if (j < 64) z = tanhf(z); else if (j >= 128) z = sigm(z);
            ZX[t * 256 + j] = z;
        }
        __syncthreads();
        {
            float accw[4], acca[4], accg[4];
#pragma unroll
            for (int i = 0; i < 4; ++i) { accw[i] = 0.f; acca[i] = 0.f; accg[i] = 0.f; }
#pragma unroll 2
            for (int j = 0; j < 64; ++j) { const float ww = w2[j * 384 + hc], aa = a2[j * 384 + hc];
#pragma unroll
                for (int i = 0; i < 4; ++i) { const int t = F.wave + 8 * i; accw[i] += ZX[t * 256 + j] * ww; acca[i] += ZX[t * 256 + 64 + j] * aa; } }
#pragma unroll 2
            for (int j = 0; j < 128; ++j) { const float gg = g2[j * 384 + hc];
#pragma unroll
                for (int i = 0; i < 4; ++i) { const int t = F.wave + 8 * i; accg[i] += ZX[t * 256 + 128 + j] * gg; } }
            const float w0c = w0[hc], a0c = a0[hc], kkc = k_k[hc], kac = k_a[hc], rkc = r_k[hc];
#pragma unroll
            for (int i = 0; i < 4; ++i) { const int t = F.wave + 8 * i; const int o = t * 64 + lane;
                const float x = -(w0c + accw[i]); const float sp = (x > 20.f) ? x : log1pf(__expf(x)); const float w = -sp - 0.5f;
                const float av = sigm(a0c + acca[i]);
                const float kraw = ZK[o]; float kk = kraw * kkc; const float nrm = sqrtf(wave_sum(kk * kk)); kk = kk / fmaxf(nrm, 1e-12f);
                const float knew = kraw * (1.0f + (av - 1.0f) * kac);
                const float bon = wave_sum(ZR[o] * knew * rkc);
                ZK[o] = knew; WD[o] = __expf(-__expf(w)); KA[o] = -kk; KB[o] = kk * av; GG[o] = accg[i]; if (lane == 0) BON[t] = bon; }
        }
        __syncthreads();
#pragma unroll 2
        for (int t = 0; t < CH; ++t) {
            const f32x4 a0v = *(const f32x4*)(KA + t * 64 + sj), a1v = *(const f32x4*)(KA + t * 64 + sj + 4);
            const f32x4 w0v = *(const f32x4*)(WD + t * 64 + sj), w1v = *(const f32x4*)(WD + t * 64 + sj + 4);
            const f32x4 b0v = *(const f32x4*)(KB + t * 64 + sj), b1v = *(const f32x4*)(KB + t * 64 + sj + 4);
            const f32x4 k0v = *(const f32x4*)(ZK + t * 64 + sj), k1v = *(const f32x4*)(ZK + t * 64 + sj + 4);
            const f32x4 r0v = *(const f32x4*)(ZR + t * 64 + sj), r1v = *(const f32x4*)(ZR + t * 64 + sj + 4);
            const float vi = ZV[t * 64 + si];
            float sa = 0.f;
#pragma unroll
            for (int j = 0; j < 4; ++j) sa += S[j] * a0v[j] + S[4 + j] * a1v[j];
            sa += __shfl_xor(sa, 1); sa += __shfl_xor(sa, 2); sa += __shfl_xor(sa, 4);
            float y = 0.f;
#pragma unroll
            for (int j = 0; j < 4; ++j) { S[j] = S[j] * w0v[j] + sa * b0v[j] + vi * k0v[j]; S[4 + j] = S[4 + j] * w1v[j] + sa * b1v[j] + vi * k1v[j]; y += S[j] * r0v[j] + S[4 + j] * r1v[j]; }
            y += __shfl_xor(y, 1); y += __shfl_xor(y, 2); y += __shfl_xor(y, 4);
            if ((tid & 7) == 0) YB[t * 64 + si] = y;
        }
        __syncthreads();
        const float lw = ln_w[hc], lb = ln_b[hc];
#pragma unroll
        for (int i = 0; i < 4; ++i) { const int t = F.wave + 8 * i; const int o = t * 64 + lane;
            const float y = YB[o]; const float mu = wave_sum(y) * (1.0f / 64.0f); const float dv = y - mu; const float var = wave_sum(dv * dv) * (1.0f / 64.0f);
            const float yn = dv * (1.0f / sqrtf(var + GN_EPS)) * lw + lb;
            const float out = (yn + BON[t] * ZV[o]) * GG[o];
            PS[(row0 + t) * PSW + C_RW + h * 64 + lane] = (bf16)f2bf(out); }
        __syncthreads();
    }
}

__device__ __forceinline__ float gelu_tanh(float x) { const float u = 0.7978845608028654f * (x + 0.044715f * x * x * x); return 0.5f * x * (1.0f + tanhf(u)); }
__device__ __forceinline__ void ssm_v1(const KA& A, const Ctx& F, int l, int b, int g) {
    bf16* PS = (bf16*)(F.ws + WS_PS);
    float* L = (float*)F.lds;
    float* U = L, *XR = L + 1024, *XI = L + 1024 + 64 * 65, *CR = L + 1024 + 2 * 64 * 65, *CI = CR + 1024;
    const int tid = F.tid, lane = F.lane, p = lane;
    float are, aim, bre[16], bim[16];
    {
        const float step = __expf(A.in(16)[l * 16 + g]);
        const float lr = A.in(14)[(size_t)l * 1024 + g * 64 + p], li = A.in(15)[(size_t)l * 1024 + g * 64 + p];
        const float mag = __expf(lr * step), ang = li * step; float sn, cs; sincosf(ang, &sn, &cs);
        are = mag * cs; aim = mag * sn;
        const float inv = 1.0f / (lr * lr + li * li);
        const float fre = ((are - 1.0f) * lr + aim * li) * inv, fim = (aim * lr - (are - 1.0f) * li) * inv;
        const float* br = A.in(17) + (size_t)l * 16384 + (size_t)(g * 64 + p) * 16, *bi = A.in(18) + (size_t)l * 16384 + (size_t)(g * 64 + p) * 16;
#pragma unroll
        for (int c = 0; c < 16; ++c) { bre[c] = fre * br[c] - fim * bi[c]; bim[c] = fre * bi[c] + fim * br[c]; }
    }
    for (int e = tid; e < 1024; e += NTHREADS) { CR[e] = A.in(19)[(size_t)l * 16384 + g * 1024 + e]; CI[e] = A.in(20)[(size_t)l * 16384 + g * 1024 + e]; }
    const float* dsk = A.in(21) + l * 256 + g * 16;
    float xr = 0.f, xi = 0.f;
#pragma unroll 1
    for (int ch = 0; ch < SEQ / 64; ++ch) {
        const size_t row0 = (size_t)b * SEQ + ch * 64;
        for (int e = tid; e < 1024; e += NTHREADS) { const int t = e >> 4, c = e & 15; U[e] = bf2f(PS[(row0 + t) * PSW + C_SSM + g * 16 + c]); }
        __syncthreads();
#pragma unroll
        for (int i = 0; i < 8; ++i) { const int t = F.wave + 8 * i; float sr = 0.f, sii = 0.f;
#pragma unroll
            for (int c = 0; c < 16; ++c) { const float u = U[t * 16 + c]; sr += bre[c] * u; sii += bim[c] * u; }
            XR[t * 65 + p] = sr; XI[t * 65 + p] = sii; }
        __syncthreads();
        if (F.wave == 0) {
#pragma unroll 4
            for (int t = 0; t < 64; ++t) { const float nr = are * xr - aim * xi + XR[t * 65 + p], ni = are * xi + aim * xr + XI[t * 65 + p]; xr = nr; xi = ni; XR[t * 65 + p] = xr; XI[t * 65 + p] = xi; }
        }
        __syncthreads();
        { const int t = tid >> 3, c2 = (tid & 7) * 2;
#pragma unroll
          for (int q = 0; q < 2; ++q) { const int c = c2 + q; float y = 0.f;
#pragma unroll 4
              for (int pp = 0; pp < 64; ++pp) y += CR[c * 64 + pp] * XR[t * 65 + pp] - CI[c * 64 + pp] * XI[t * 65 + pp];
              y += dsk[c] * U[t * 16 + c];
              PS[(row0 + t) * PSW + C_SSM + g * 16 + c] = (bf16)f2bf(gelu_tanh(y)); } }
        __syncthreads();
    }
}
typedef short bf16x8_t __attribute__((ext_vector_type(8)));
typedef float f32x16 __attribute__((ext_vector_type(16)));
typedef short v4i16_t __attribute__((ext_vector_type(4)));
typedef __bf16 bf16x2_t __attribute__((ext_vector_type(2)));
typedef float f32x2_t __attribute__((ext_vector_type(2)));
__device__ __forceinline__ unsigned cvtpk(float lo, float hi) { f32x2_t v = {lo, hi}; bf16x2_t b = __builtin_convertvector(v, bf16x2_t); return __builtin_bit_cast(unsigned, b); }
__device__ __forceinline__ v4i16_t ds_tr16(const unsigned char* p) { return __builtin_amdgcn_ds_read_tr16_b64_v4i16((LAS v4i16_t*)p); }
__device__ __forceinline__ int crow16(int g, int hh) { return (g & 3) + 8 * (g >> 2) + 4 * hh; }

constexpr int ATT_VS = 96;
constexpr int ATT_ITEMS = BATCH * 6 * 16;

__device__ __forceinline__ void attn_v2(const KA& A, const Ctx& F, int blk, int nblk) {
    bf16* PS = (bf16*)(F.ws + WS_PS); float* LSE = (float*)(F.ws + WS_LSE);
    unsigned char* VI = F.lds;
    const int lane = F.lane, q = lane & 31, hh = lane >> 5, w = F.wave;
#pragma unroll 1
    for (int item = blk; item < ATT_ITEMS; item += nblk) {
        const int idx16 = item & 15, h = (item >> 4) % 6, b = item / 96;
        const int g = h >> 1, dsh = 2 * g, dil = 1 << dsh;
        const int bpr = 16 >> dsh, r = idx16 / bpr, i0 = (idx16 % bpr) * 256;
        const size_t tb = (size_t)b * SEQ + r;
#pragma unroll
        for (int ps = 0; ps < 6; ++ps) { const int row = (F.tid >> 3) + 64 * ps, ch = F.tid & 7; int ki = i0 - 128 + row; ki = ki < 0 ? 0 : ki;
            const v4u v = *(const v4u*)(PS + (tb + (size_t)ki * dil) * PSW + C_V + h * 64 + ch * 8);
            *(v4u*)(VI + (row * ATT_VS + ch * 8) * 2) = v; }
        bf16x8_t qf[4];
        { const bf16* qp = PS + (tb + (size_t)(i0 + 32 * w + q) * dil) * PSW + C_Q + h * 64 + 8 * hh;
#pragma unroll
          for (int s = 0; s < 4; ++s) qf[s] = *(const bf16x8_t*)(qp + 16 * s); }
        f32x16 p[5];
#pragma unroll
        for (int kt = 0; kt < 5; ++kt) {
            int ki = i0 + 32 * w - 128 + 32 * kt + q; ki = ki < 0 ? 0 : ki;
            const bf16* kp = PS + (tb + (size_t)ki * dil) * PSW + C_K + h * 64 + 8 * hh;
            bf16x8_t kf[4];
#pragma unroll
            for (int s = 0; s < 4; ++s) kf[s] = *(const bf16x8_t*)(kp + 16 * s);
            f32x16 acc = {};
#pragma unroll
            for (int s = 0; s < 4; ++s) acc = __builtin_amdgcn_mfma_f32_32x32x16_bf16(kf[s], qf[s], acc, 0, 0, 0);
            p[kt] = acc;
        }
        const int kbase = i0 + 32 * w - 128;
        float mx = -3.0e38f;
#pragma unroll
        for (int kt = 0; kt < 5; ++kt)
#pragma unroll
            for (int gq = 0; gq < 16; ++gq) { const int kl = crow16(gq, hh); const int dist = q + 128 - 32 * kt - kl;
                const bool ok = (dist >= 0) && (dist <= 128) && (kbase + 32 * kt + kl >= 0);
                const float s = ok ? p[kt][gq] : -3.0e38f; p[kt][gq] = s; mx = fmaxf(mx, s); }
        mx = fmaxf(mx, __shfl_xor(mx, 32));
        const float sc = 0.125f * 1.4426950408889634f;
        float l = 0.f;
#pragma unroll
        for (int kt = 0; kt < 5; ++kt)
#pragma unroll
            for (int gq = 0; gq < 16; ++gq) { const float e = __builtin_amdgcn_exp2f((p[kt][gq] - mx) * sc); p[kt][gq] = e; l += e; }
        l += __shfl_xor(l, 32);
        __syncthreads();
        f32x16 o[2]; o[0] = f32x16{}; o[1] = f32x16{};
        const unsigned char* vb = VI + ((32 * w + 4 * hh + ((lane & 15) >> 2)) * ATT_VS + 16 * ((lane >> 4) & 1) + 4 * (lane & 3)) * 2;
#pragma unroll
        for (int kt = 0; kt < 5; ++kt)
#pragma unroll
            for (int s = 0; s < 2; ++s) {
                v4u pw; pw.x = cvtpk(p[kt][8 * s + 0], p[kt][8 * s + 1]); pw.y = cvtpk(p[kt][8 * s + 2], p[kt][8 * s + 3]); pw.z = cvtpk(p[kt][8 * s + 4], p[kt][8 * s + 5]); pw.w = cvtpk(p[kt][8 * s + 6], p[kt][8 * s + 7]);
                const bf16x8_t pb = __builtin_bit_cast(bf16x8_t, pw);
#pragma unroll
                for (int dt = 0; dt < 2; ++dt) {
                    const unsigned char* vp = vb + ((32 * kt + 16 * s) * ATT_VS + 32 * dt) * 2;
                    const v4i16_t lo = ds_tr16(vp), hi = ds_tr16(vp + 8 * ATT_VS * 2);
                    const bf16x8_t va = (bf16x8_t){lo[0], lo[1], lo[2], lo[3], hi[0], hi[1], hi[2], hi[3]};
                    o[dt] = __builtin_amdgcn_mfma_f32_32x32x16_bf16(va, pb, o[dt], 0, 0, 0);
                }
            }
        const float il = 1.0f / l;
        bf16* op = PS + (tb + (size_t)(i0 + 32 * w + q) * dil) * PSW + C_Q + h * 64 + 4 * hh;
#pragma unroll
        for (int dt = 0; dt < 2; ++dt)
#pragma unroll
            for (int g4 = 0; g4 < 4; ++g4) { v2u wv; wv.x = cvtpk(o[dt][4 * g4 + 0] * il, o[dt][4 * g4 + 1] * il); wv.y = cvtpk(o[dt][4 * g4 + 2] * il, o[dt][4 * g4 + 3] * il);
                *(v2u*)(op + 32 * dt + 8 * g4) = wv; }
        if (hh == 0) LSE[(tb + (size_t)(i0 + 32 * w + q) * dil) * 6 + h] = mx * 0.125f + __logf(l);
        __syncthreads();
    }
}
constexpr int TS = 72;
constexpr int RL_A = 0, RL_B = 9216, RL_K = 18432, RL_R = 27648, RL_AT = 36864, RL_VT = 46080, RL_BHT = 55296, RL_KHT = 64512,
              RL_AAK = 73728, RL_ARB = 82944, RL_ARK = 92160, RL_AABF = 101376, RL_TF = 117760, RL_PB = 134144;
constexpr int RL_TB = RL_A, RL_XT = RL_B, RL_WT = RL_K, RL_UT = RL_AAK;
constexpr int RL_WLF = 73728, RL_ALF = 90112, RL_GF = 106496, RL_LW = 122880;
static_assert(RL_LW + 16384 <= LDS_BYTES && RL_PB + 3072 <= LDS_BYTES, "rwkv LDS map");
constexpr int RW_ITEMS = BATCH * 6 * 64;
#ifndef SEC
#define SEC 0xFFFF
#endif

__device__ __forceinline__ bf16x8_t ldfrag(const unsigned char* tile, int row, int s, int hh) { return *(const bf16x8_t*)(tile + (row * TS + 16 * s + 8 * hh) * 2); }
__device__ __forceinline__ f32x16 mm64(f32x16 acc, const unsigned char* At, int arow0, const unsigned char* Bt, int brow0, int ks, int lane) {
    const int r = lane & 31, hh = lane >> 5;
#pragma unroll
    for (int s = 0; s < 4; ++s) if (s < ks) acc = __builtin_amdgcn_mfma_f32_32x32x16_bf16(ldfrag(At, arow0 + r, s, hh), ldfrag(Bt, brow0 + r, s, hh), acc, 0, 0, 0);
    return acc;
}
__device__ __forceinline__ void st_tileT(unsigned char* tile, int ncol, int m0, const f32x16& acc, int hh) {
#pragma unroll
    for (int g4 = 0; g4 < 4; ++g4) { v2u wv; wv.x = cvtpk(acc[4 * g4 + 0], acc[4 * g4 + 1]); wv.y = cvtpk(acc[4 * g4 + 2], acc[4 * g4 + 3]);
        *(v2u*)(tile + (ncol * TS + m0 + 8 * g4 + 4 * hh) * 2) = wv; }
}
__device__ __forceinline__ bf16x8_t pack8(const float (&z)[8]) { v4u pw; pw.x = cvtpk(z[0], z[1]); pw.y = cvtpk(z[2], z[3]); pw.z = cvtpk(z[4], z[5]); pw.w = cvtpk(z[6], z[7]); return __builtin_bit_cast(bf16x8_t, pw); }
__device__ __forceinline__ void unpack8(const v4u w, float (&z)[8]) { z[0] = bflo(w.x); z[1] = bfhi(w.x); z[2] = bflo(w.y); z[3] = bfhi(w.y); z[4] = bflo(w.z); z[5] = bfhi(w.z); z[6] = bflo(w.w); z[7] = bfhi(w.w); }

template <int ACT> __device__ __forceinline__ bf16x8_t lora_frag(const bf16* PS, size_t grow, bool first, int jcol, const float* mix) {
    float c[8], p[8];
    unpack8(*(const v4u*)(PS + grow * PSW + C_LORA + jcol), c);
    if (first) {
#pragma unroll
        for (int e = 0; e < 8; ++e) p[e] = 0.f;
    } else unpack8(*(const v4u*)(PS + (grow - 1) * PSW + C_LORA + jcol), p);
    const f32x4 m0 = *(const f32x4*)(mix + 1152 + jcol), m1 = *(const f32x4*)(mix + 1152 + jcol + 4);
    float z[8];
#pragma unroll
    for (int e = 0; e < 8; ++e) { const float mm = e < 4 ? m0[e] : m1[e - 4]; float v = c[e] + (p[e] - c[e]) * mm;
        if (ACT == 1) v = 1.0f - 2.0f / (__expf(2.0f * v) + 1.0f); else if (ACT == 2) v = sigm(v);
        z[e] = v; }
    return pack8(z);
}

__device__ __forceinline__ void rwkv_p1(const KA& A, const Ctx& F, int l) {
    bf16* PS = (bf16*)(F.ws + WS_PS); const bf16* BRB = (const bf16*)(F.ws + WS_BR);
    unsigned char* L = F.lds;
    unsigned char* wl = F.ws + WS_W + (size_t)l * W_LAYER;
    const bf16* W2T = (const bf16*)(wl + WO_W2); const bf16* A2T = (const bf16*)(wl + WO_A2); const bf16* G2T = (const bf16*)(wl + WO_G2);
    const float* mix = A.in(3) + (size_t)l * 1408;
    int tid = F.tid, lane = F.lane, r32 = lane & 31, hh = lane >> 5; const int w = F.wave;
#define RW_FENCE() do { __syncthreads(); asm volatile("" : "+v"(tid)); lane = tid & 63; r32 = lane & 31; hh = lane >> 5; hc = h * 64 + lane; } while (0)
#pragma unroll 1
    for (int item = F.bid; item < RW_ITEMS; item += F.G) {
        const int j = item & 63, h = (item >> 6) % 6, b = item / 384;
        const size_t row0 = (size_t)b * SEQ + 64 * j;
        int hc = h * 64 + lane;
        if (SEC & 1) {
            const int tl = (w & 3), ct = tl >> 1, tt = tl & 1;
            const size_t grow = row0 + 32 * tt + r32; const bool first = (j == 0) && (tt == 0) && (r32 == 0);
            if (w < 4) {
                f32x16 acc = {};
#pragma unroll
                for (int s = 0; s < 8; ++s) { const bf16x8_t af = *(const bf16x8_t*)(G2T + (size_t)(h * 64 + 32 * ct + r32) * 128 + 16 * s + 8 * hh);
                    acc = __builtin_amdgcn_mfma_f32_32x32x16_bf16(af, lora_frag<2>(PS, grow, first, 128 + 16 * s + 8 * hh, mix), acc, 0, 0, 0); }
                float* G = (float*)(L + RL_GF);
#pragma unroll
                for (int g4 = 0; g4 < 4; ++g4) *(f32x4*)(G + (32 * tt + r32) * 64 + 32 * ct + 8 * g4 + 4 * hh) = (f32x4){acc[4 * g4], acc[4 * g4 + 1], acc[4 * g4 + 2], acc[4 * g4 + 3]};
            } else {
                f32x16 accw = {}, acca = {};
#pragma unroll
                for (int s = 0; s < 4; ++s) {
                    const bf16x8_t wf = *(const bf16x8_t*)(W2T + (size_t)(h * 64 + 32 * ct + r32) * 64 + 16 * s + 8 * hh);
                    const bf16x8_t af = *(const bf16x8_t*)(A2T + (size_t)(h * 64 + 32 * ct + r32) * 64 + 16 * s + 8 * hh);
                    accw = __builtin_amdgcn_mfma_f32_32x32x16_bf16(wf, lora_frag<1>(PS, grow, first, 16 * s + 8 * hh, mix), accw, 0, 0, 0);
                    acca = __builtin_amdgcn_mfma_f32_32x32x16_bf16(af, lora_frag<0>(PS, grow, first, 64 + 16 * s + 8 * hh, mix), acca, 0, 0, 0); }
                float* WLp = (float*)(L + RL_WLF); float* ALp = (float*)(L + RL_ALF);
#pragma unroll
                for (int g4 = 0; g4 < 4; ++g4) { const int o = (32 * tt + r32) * 64 + 32 * ct + 8 * g4 + 4 * hh;
                    *(f32x4*)(WLp + o) = (f32x4){accw[4 * g4], accw[4 * g4 + 1], accw[4 * g4 + 2], accw[4 * g4 + 3]};
                    *(f32x4*)(ALp + o) = (f32x4){acca[4 * g4], acca[4 * g4 + 1], acca[4 * g4 + 2], acca[4 * g4 + 3]}; }
            }
        }
        float rr[8], kn[8], vv[8], kk[8], bb[8], eadd[8];
        {
            const float mr = mix[hc], mk = mix[384 + hc], mv = mix[768 + hc];
#pragma unroll
            for (int i = 0; i < 8; ++i) { const int t = w + 8 * i; const size_t g = row0 + t;
                const bf16* cp = PS + g * PSW + C_RW + hc;
                const float cr = bf2f(cp[0]), ck = bf2f(cp[384]), cv = bf2f(cp[768]);
                float pr, pk, pv;
                if (t == 0) { if (j == 0) { pr = 0.f; pk = 0.f; pv = 0.f; } else { const bf16* bp = BRB + (size_t)(b * 64 + j - 1) * PSW + C_RW + hc; pr = bf2f(bp[0]); pk = bf2f(bp[384]); pv = bf2f(bp[768]); } }
                else { const bf16* pp = cp - PSW; pr = bf2f(pp[0]); pk = bf2f(pp[384]); pv = bf2f(pp[768]); }
                rr[i] = cr + (pr - cr) * mr; kn[i] = ck + (pk - ck) * mk; vv[i] = cv + (pv - cv) * mv; }
        }
        RW_FENCE();
        if (SEC & 2) {
            const float* WLp = (const float*)(L + RL_WLF); const float* ALp = (const float*)(L + RL_ALF); const float* G = (const float*)(L + RL_GF); float* LW = (float*)(L + RL_LW);
            const float w0c = A.in(4)[l * 384 + hc], a0c = A.in(6)[l * 384 + hc], kkc = A.in(9)[l * 384 + hc], kac = A.in(10)[l * 384 + hc], rkc = A.in(11)[l * 384 + hc];
            const float lnw = A.in(12)[l * 384 + hc], lnb = A.in(13)[l * 384 + hc];
            bf16* EM = (bf16*)(F.ws + WS_REM) + (size_t)item * 4096;
#pragma unroll
            for (int i = 0; i < 8; ++i) { const int t = w + 8 * i; const int o = t * 64 + lane;
                const float x = -(w0c + WLp[o]); const float sp = (x > 20.f) ? x : log1pf(__expf(x)); const float wv = -sp - 0.5f;
                LW[o] = -__expf(wv);
                const float av = sigm(a0c + ALp[o]); const float gv = G[o];
                float kq = kn[i] * kkc; const float nrm = sqrtf(wave_sum(kq * kq)); kq = kq / fmaxf(nrm, 1e-12f);
                const float knew = kn[i] * (1.0f + (av - 1.0f) * kac);
                const float bon = wave_sum(rr[i] * knew * rkc);
                kk[i] = kq; bb[i] = kq * av; kn[i] = knew;
                EM[o] = (bf16)f2bf(lnw * gv); eadd[i] = (lnb + bon * vv[i]) * gv; }
        }
        RW_FENCE();
        if ((SEC & 4) && w == 0) { float* LW = (float*)(L + RL_LW); float c[64];
#pragma unroll
            for (int t = 0; t < 64; ++t) c[t] = LW[t * 64 + lane];
#pragma unroll
            for (int t = 1; t < 64; ++t) c[t] += c[t - 1];
#pragma unroll
            for (int t = 0; t < 64; ++t) LW[t * 64 + lane] = c[t];
            ((float*)(F.ws + WS_RGL))[(size_t)item * 64 + lane] = __expf(c[63]); }
        RW_FENCE();
        if (SEC & 8) {
            const float* CU = (const float*)(L + RL_LW); const float cl = CU[63 * 64 + lane];
            bf16* At = (bf16*)(L + RL_A), *Bt = (bf16*)(L + RL_B), *Kt = (bf16*)(L + RL_K), *Rt = (bf16*)(L + RL_R);
            bf16* ATt = (bf16*)(L + RL_AT), *VTt = (bf16*)(L + RL_VT), *BHt = (bf16*)(L + RL_BHT), *KHt = (bf16*)(L + RL_KHT);
#pragma unroll
            for (int i = 0; i < 8; ++i) { const int t = w + 8 * i;
                const float ct = CU[t * 64 + lane], cp = (t == 0) ? 0.f : CU[(t - 1) * 64 + lane];
                const float ep = __expf(cp), et = __expf(ct), ei = __expf(-ct), eh = __expf(cl - ct);
                const bf16 av = (bf16)f2bf(-kk[i] * ep);
                At[t * TS + lane] = av; ATt[lane * TS + t] = av;
                Rt[t * TS + lane] = (bf16)f2bf(rr[i] * et);
                Bt[t * TS + lane] = (bf16)f2bf(bb[i] * ei); Kt[t * TS + lane] = (bf16)f2bf(kn[i] * ei);
                VTt[lane * TS + t] = (bf16)f2bf(vv[i]); BHt[lane * TS + t] = (bf16)f2bf(bb[i] * eh); KHt[lane * TS + t] = (bf16)f2bf(kn[i] * eh); }
        }
        RW_FENCE();
#pragma unroll
        for (int rep = 0; rep < ((SEC & 16) ? 2 : 0); ++rep) { const int job = w + 8 * rep, prod = job >> 2, tt = (job >> 1) & 1, st = job & 1;
            f32x16 acc = {};
            acc = mm64(acc, L + ((prod & 1) ? RL_K : RL_B), 32 * st, L + ((prod & 2) ? RL_R : RL_A), 32 * tt, 4, lane);
            const int t = 32 * tt + r32; const int incl = prod >> 1;
#pragma unroll
            for (int g = 0; g < 16; ++g) { const int s = 32 * st + crow16(g, hh); if (!(s < t + incl)) acc[g] = 0.f; }
            if (prod == 0) { float* AF = (float*)(L + RL_AABF);
#pragma unroll
                for (int g4 = 0; g4 < 4; ++g4) *(f32x4*)(AF + t * 64 + 32 * st + 8 * g4 + 4 * hh) = (f32x4){acc[4 * g4], acc[4 * g4 + 1], acc[4 * g4 + 2], acc[4 * g4 + 3]};
            } else st_tileT(L + (prod == 1 ? RL_AAK : (prod == 2 ? RL_ARB : RL_ARK)), t, 32 * st, acc, hh);
        }
        RW_FENCE();
        if (SEC & 32) {
            const float* AF = (const float*)(L + RL_AABF); float* TF = (float*)(L + RL_TF); float* PB = (float*)(L + RL_PB);
            if (w == 0) {
                const int I = lane >> 4, jc = lane & 15; float x[16];
#pragma unroll
                for (int r = 0; r < 16; ++r) { float s = (r == jc) ? 1.f : 0.f;
#pragma unroll
                    for (int q = 0; q < 16; ++q) if (q < r) s += AF[(16 * I + r) * 64 + 16 * I + q] * x[q];
                    x[r] = s; TF[(16 * I + r) * 64 + 16 * I + jc] = s; }
            } else if (w >= 4) { const int tl = w - 4, tt = tl >> 1, it = tl & 1;
                f32x16 acc = {};
                acc = mm64(acc, L + RL_AAK, 32 * tt, L + RL_VT, 32 * it, tt ? 4 : 2, lane);
                st_tileT(L + RL_XT, 32 * it + r32, 32 * tt, acc, hh); }
            RW_FENCE();
#pragma unroll 1
            for (int dist = 1; dist < 4; ++dist) { const int nb = 4 - dist;
                for (int o = tid; o < nb * 256; o += NTHREADS) { const int J = o >> 8, I = J + dist, rw = (o >> 4) & 15, cc = o & 15; float s = 0.f;
                    for (int Kb = J; Kb < I; ++Kb)
#pragma unroll
                        for (int m = 0; m < 16; ++m) s += AF[(16 * I + rw) * 64 + 16 * Kb + m] * TF[(16 * Kb + m) * 64 + 16 * J + cc];
                    PB[o] = s; }
                __syncthreads();
                for (int o = tid; o < nb * 256; o += NTHREADS) { const int J = o >> 8, I = J + dist, rw = (o >> 4) & 15, cc = o & 15; float s = 0.f;
#pragma unroll
                    for (int m = 0; m < 16; ++m) s += TF[(16 * I + rw) * 64 + 16 * I + m] * PB[(J << 8) + m * 16 + cc];
                    TF[(16 * I + rw) * 64 + 16 * J + cc] = s; }
                __syncthreads();
            }
            bf16* TB = (bf16*)(L + RL_TB);
#pragma unroll
            for (int e = 0; e < 8; ++e) { const int o = tid + NTHREADS * e, t = o >> 6, s = o & 63; TB[t * TS + s] = ((s >> 4) > (t >> 4)) ? (bf16)0 : (bf16)f2bf(TF[o]); }
        }
        RW_FENCE();
        if (SEC & 64) { const int mat = w >> 2, tl = w & 3, tt = tl >> 1, nt = tl & 1;
          f32x16 acc = {};
          acc = mm64(acc, L + RL_TB, 32 * tt, L + (mat ? RL_XT : RL_AT), 32 * nt, tt ? 4 : 2, lane);
          st_tileT(L + (mat ? RL_UT : RL_WT), 32 * nt + r32, 32 * tt, acc, hh); }
        RW_FENCE();
        if (SEC & 128) { const int tl = w & 3, ta = tl >> 1, tb2 = tl & 1;
          if (w < 4) {
              f32x16 acc = {};
              acc = mm64(acc, L + RL_WT, 32 * ta, L + RL_BHT, 32 * tb2, 4, lane);
              bf16* MC = (bf16*)(F.ws + WS_RMC) + (size_t)item * 4096;
#pragma unroll
              for (int g4 = 0; g4 < 4; ++g4) { v2u wv; wv.x = cvtpk(acc[4 * g4], acc[4 * g4 + 1]); wv.y = cvtpk(acc[4 * g4 + 2], acc[4 * g4 + 3]); *(v2u*)(MC + (32 * tb2 + r32) * 64 + 32 * ta + 8 * g4 + 4 * hh) = wv; }
              f32x16 an = {};
              an = mm64(an, L + RL_BHT, 32 * ta, L + RL_UT, 32 * tb2, 4, lane);
              an = mm64(an, L + RL_KHT, 32 * ta, L + RL_VT, 32 * tb2, 4, lane);
              bf16* NT = (bf16*)(F.ws + WS_RNT) + (size_t)item * 4096;
#pragma unroll
              for (int g4 = 0; g4 < 4; ++g4) { v2u wv; wv.x = cvtpk(an[4 * g4], an[4 * g4 + 1]); wv.y = cvtpk(an[4 * g4 + 2], an[4 * g4 + 3]); *(v2u*)(NT + (32 * tb2 + r32) * 64 + 32 * ta + 8 * g4 + 4 * hh) = wv; }
          } else {
              f32x16 acc = {};
              acc = mm64(acc, L + RL_WT, 32 * ta, L + RL_ARB, 32 * tb2, tb2 ? 4 : 2, lane);
              const int t = 32 * tb2 + r32; const bf16* Rt = (const bf16*)(L + RL_R);
              bf16* qd = PS + (row0 + t) * PSW + C_RW + h * 64;
#pragma unroll
              for (int g4 = 0; g4 < 4; ++g4) { const int c0 = 32 * ta + 8 * g4 + 4 * hh; const v2u rv = *(const v2u*)(Rt + t * TS + c0);
                  v2u wv; wv.x = cvtpk(acc[4 * g4] + bflo(rv.x), acc[4 * g4 + 1] + bfhi(rv.x)); wv.y = cvtpk(acc[4 * g4 + 2] + bflo(rv.y), acc[4 * g4 + 3] + bfhi(rv.y)); *(v2u*)(qd + c0) = wv; }
              f32x16 ay = {};
              ay = mm64(ay, L + RL_UT, 32 * ta, L + RL_ARB, 32 * tb2, tb2 ? 4 : 2, lane);
              ay = mm64(ay, L + RL_VT, 32 * ta, L + RL_ARK, 32 * tb2, tb2 ? 4 : 2, lane);
              bf16* yd = PS + (row0 + t) * PSW + C_RW + 384 + h * 64;
#pragma unroll
              for (int g4 = 0; g4 < 4; ++g4) { v2u wv; wv.x = cvtpk(ay[4 * g4], ay[4 * g4 + 1]); wv.y = cvtpk(ay[4 * g4 + 2], ay[4 * g4 + 3]); *(v2u*)(yd + 32 * ta + 8 * g4 + 4 * hh) = wv; }
          }
#pragma unroll
          for (int i = 0; i < 8; ++i) { const int t = w + 8 * i; PS[(row0 + t) * PSW + C_RW + 768 + hc] = (bf16)f2bf(eadd[i]); }
        }
        RW_FENCE();
    }
}
#undef RW_FENCE

__device__ __forceinline__ void rwkv_scan(const KA& A, const Ctx& F, int l, int b, int h) {
    bf16* PS = (bf16*)(F.ws + WS_PS);
    unsigned char* L = F.lds;
    const int tid = F.tid, lane = F.lane, w = F.wave, r32 = lane & 31, hh = lane >> 5;
    for (int o = tid; o < 2 * 9216 / 4; o += NTHREADS) ((unsigned*)L)[o] = 0u;
    __syncthreads();
    const int ta = (w >> 1) & 1, tb2 = w & 1;
    f32x16 Hacc = {};
#pragma unroll 1
    for (int j = 0; j < 64; ++j) {
        const int item = (b * 6 + h) * 64 + j; const size_t row0 = (size_t)b * SEQ + 64 * j;
        const unsigned char* HBc = L + (j & 1) * 9216; unsigned char* HBn = L + ((j + 1) & 1) * 9216;
        if (w < 4) {
            const bf16* MC = (const bf16*)(F.ws + WS_RMC) + (size_t)item * 4096; const bf16* NT = (const bf16*)(F.ws + WS_RNT) + (size_t)item * 4096; const float* GL = (const float*)(F.ws + WS_RGL) + (size_t)item * 64;
            bf16x8_t mf[4];
#pragma unroll
            for (int s = 0; s < 4; ++s) mf[s] = *(const bf16x8_t*)(MC + (32 * ta + r32) * 64 + 16 * s + 8 * hh);
#pragma unroll
            for (int g4 = 0; g4 < 4; ++g4) { const int c0 = 32 * ta + 8 * g4 + 4 * hh; const f32x4 gl = *(const f32x4*)(GL + c0); const v2u nv = *(const v2u*)(NT + (32 * tb2 + r32) * 64 + c0);
                Hacc[4 * g4 + 0] = Hacc[4 * g4 + 0] * gl[0] + bflo(nv.x); Hacc[4 * g4 + 1] = Hacc[4 * g4 + 1] * gl[1] + bfhi(nv.x); Hacc[4 * g4 + 2] = Hacc[4 * g4 + 2] * gl[2] + bflo(nv.y); Hacc[4 * g4 + 3] = Hacc[4 * g4 + 3] * gl[3] + bfhi(nv.y); }
#pragma unroll
            for (int s = 0; s < 4; ++s) Hacc = __builtin_amdgcn_mfma_f32_32x32x16_bf16(mf[s], ldfrag(HBc, 32 * tb2 + r32, s, hh), Hacc, 0, 0, 0);
            st_tileT(HBn, 32 * tb2 + r32, 32 * ta, Hacc, hh);
        } else if (w < 6) {
            const int t = 32 * tb2 + r32;
            const bf16* qd = PS + (row0 + t) * PSW + C_RW + h * 64; const bf16* yd = qd + 384; const bf16* ed = qd + 768; const bf16* EM = (const bf16*)(F.ws + WS_REM) + (size_t)item * 4096 + t * 64;
            bf16x8_t qf[4];
#pragma unroll
            for (int s = 0; s < 4; ++s) qf[s] = *(const bf16x8_t*)(qd + 16 * s + 8 * hh);
            f32x16 y[2];
#pragma unroll
            for (int it = 0; it < 2; ++it) {
#pragma unroll
                for (int g4 = 0; g4 < 4; ++g4) { const v2u yv = *(const v2u*)(yd + 32 * it + 8 * g4 + 4 * hh); y[it][4 * g4] = bflo(yv.x); y[it][4 * g4 + 1] = bfhi(yv.x); y[it][4 * g4 + 2] = bflo(yv.y); y[it][4 * g4 + 3] = bfhi(yv.y); }
#pragma unroll
                for (int s = 0; s < 4; ++s) y[it] = __builtin_amdgcn_mfma_f32_32x32x16_bf16(ldfrag(HBc, 32 * it + r32, s, hh), qf[s], y[it], 0, 0, 0);
            }
            float s1 = 0.f, s2 = 0.f;
#pragma unroll
            for (int it = 0; it < 2; ++it)
#pragma unroll
                for (int g = 0; g < 16; ++g) { s1 += y[it][g]; s2 += y[it][g] * y[it][g]; }
            s1 += __shfl_xor(s1, 32); s2 += __shfl_xor(s2, 32);
            const float mu = s1 * (1.0f / 64.0f); const float var = fmaxf(s2 * (1.0f / 64.0f) - mu * mu, 0.f); const float rs = 1.0f / sqrtf(var + GN_EPS);
            bf16* od = PS + (row0 + t) * PSW + C_RW + h * 64;
#pragma unroll
            for (int it = 0; it < 2; ++it)
#pragma unroll
                for (int g4 = 0; g4 < 4; ++g4) { const int i0 = 32 * it + 8 * g4 + 4 * hh; const v2u em = *(const v2u*)(EM + i0); const v2u ea = *(const v2u*)(ed + i0);
                    v2u wv; wv.x = cvtpk((y[it][4 * g4] - mu) * rs * bflo(em.x) + bflo(ea.x), (y[it][4 * g4 + 1] - mu) * rs * bfhi(em.x) + bfhi(ea.x));
                    wv.y = cvtpk((y[it][4 * g4 + 2] - mu) * rs * bflo(em.y) + bflo(ea.y), (y[it][4 * g4 + 3] - mu) * rs * bfhi(em.y) + bfhi(ea.y));
                    *(v2u*)(od + i0) = wv; }
        }
        __syncthreads();
    }
}
constexpr int PPL = 10, NPH = 2 + DEPTH * PPL;

__device__ __forceinline__ void run_phase(const KA& A, const Ctx& F, int ph) {
    PG8_LAS unsigned char* lds3 = (PG8_LAS unsigned char*)F.lds;
    bf16* XN = (bf16*)(F.ws + WS_XN); bf16* PS = (bf16*)(F.ws + WS_PS); unsigned char* GT = F.ws + WS_GT; bf16* SO = (bf16*)(F.ws + WS_SO);
    const int l = (ph - 1) / PPL, k = (ph == 0) ? 20 : (ph == NPH - 1 ? 21 : (ph - 1) % PPL);
    unsigned char* wl = F.ws + WS_W + (size_t)l * W_LAYER;
    const float* hin = (l == 0) ? A.in(0) : F.out;
    int ngemm = 0;
    if (k == 20) phase_prep(A, F);
    else if (k == 21) phase_rmsnorm<true>(A, F, F.out, A.in(31), F.out);
    else if (k == 0) phase_rmsnorm<false>(A, F, hin, A.in(1) + l * D, XN);
    else if (k == 7) phase_rmsnorm<false>(A, F, F.out, A.in(28) + l * D, XN);
    else if (k == 2) rwkv_p1(A, F, l);
    else if (k == 3) {
        if (F.bid < 48) rwkv_scan(A, F, l, F.bid / 6, F.bid % 6);
        else if (F.bid < 176) { const int it = F.bid - 48; ssm_v1(A, F, l, it / 16, it % 16); }
        else attn_v2(A, F, F.bid - 176, F.G - 176);
    }
    else if (k == 4) { attn_finalize(A, F); ngemm = 1; }
    else if (k == 5) ngemm = 3;
    else ngemm = 1;
#pragma unroll 1
    for (int gi = 0; gi < ngemm; ++gi) {
        pg8::Gemm g; pg8::EpiAny E; E.kind = 0; E.O = PS; E.ldo = FFH; E.GT = GT; E.gi = gi; E.base = hin; E.out = F.out; E.BRW = (bf16*)(F.ws + WS_BR);
        if (k == 1) { g = pg8::Gemm{XN, (const bf16*)(wl + WO_IN), T, NIN, D, D}; E.kind = 0; }
        else if (k == 4) { g = pg8::Gemm{PS + C_SSM, (const bf16*)(wl + WO_GLU), T, 512, 256, PSW}; E.kind = 4; E.O = SO; E.ldo = 256; }
        else if (k == 5) { E.kind = 1; E.O = XN;
            if (gi == 0) g = pg8::Gemm{PS + C_Q, (const bf16*)(wl + WO_BA), T, D, 384, PSW};
            else if (gi == 1) g = pg8::Gemm{PS + C_RW, (const bf16*)(wl + WO_BR), T, D, 384, PSW};
            else g = pg8::Gemm{SO, (const bf16*)(wl + WO_BS), T, D, 256, 256}; }
        else if (k == 6) { g = pg8::Gemm{XN, (const bf16*)(wl + WO_OUT), T, D, D, D}; E.kind = 2; }
        else if (k == 8) { g = pg8::Gemm{XN, (const bf16*)(wl + WO_GU), T, 2 * FFH, D, D}; E.kind = 3; }
        else { g = pg8::Gemm{PS, (const bf16*)(wl + WO_DN), T, D, FFH, FFH}; E.kind = 2; E.base = F.out; }
        pg8::StaticOrder S; S.init(T, g.N, F.G, F.bid);
        pg8::gemm_phase<pg8::EpiAny, pg8::StaticOrder, true>(lds3, g, S, E);
    }
}

__global__ void __launch_bounds__(NTHREADS, 2) mega_fwd(Args args) {
    extern __shared__ __attribute__((aligned(16))) unsigned char lds[];
#pragma unroll 1
    for (int ph = args.ph_lo; ph < args.ph_hi; ++ph) {
        KA A; A.p = (kptr_t)__builtin_amdgcn_kernarg_segment_ptr(); asm volatile("" : "+s"(A.p));
        int tid = threadIdx.x, bid = blockIdx.x, G = gridDim.x; asm volatile("" : "+v"(tid), "+s"(bid), "+s"(G));
        Ctx F;
        F.lds = lds; F.ws = A.ws(); F.out = A.out();
        F.tid = tid; F.lane = tid & 63; F.wave = __builtin_amdgcn_readfirstlane(tid >> 6); F.G = G; F.bid = bid;
        run_phase(A, F, ph);
#if ONE_LAUNCH
        if (ph + 1 < args.ph_hi) { __threadfence(); cg::this_grid().sync(); }
#endif
    }
}

extern "C" void kernel_launch(void* const* d_in, const int* in_sizes, int n_in, void* d_out, int out_size, void* d_ws, size_t ws_size, hipStream_t stream) {
    static int grid = 0;
    if (grid == 0) {
        if (n_in != 32 || in_sizes[0] != T * D || out_size != T * D || ws_size < WS_END) { fprintf(stderr, "kernel_launch: unexpected shapes (n_in %d, in0 %d, out %d, ws %zu); nothing launched\n", n_in, n_in > 0 ? in_sizes[0] : -1, out_size, ws_size); grid = -1; return; }
        int dev = 0, cus = 0, per_cu = 0;
        if (hipGetDevice(&dev) != hipSuccess || hipDeviceGetAttribute(&cus, hipDeviceAttributeMultiprocessorCount, dev) != hipSuccess) { grid = -1; return; }
        if (hipFuncSetAttribute((const void*)mega_fwd, hipFuncAttributeMaxDynamicSharedMemorySize, LDS_BYTES) != hipSuccess) { fprintf(stderr, "kernel_launch: hipFuncSetAttribute failed\n"); grid = -1; return; }
        if (hipOccupancyMaxActiveBlocksPerMultiprocessor(&per_cu, (const void*)mega_fwd, NTHREADS, LDS_BYTES) != hipSuccess || per_cu < 1) { fprintf(stderr, "kernel_launch: occupancy query says %d\n", per_cu); per_cu = 1; }
        (void)hipGetLastError();
        grid = cus;
        if (grid < 200) { fprintf(stderr, "kernel_launch: needs >= 200 CUs, got %d\n", grid); grid = -1; return; }
    }
    if (grid < 0) return;
    Args a{};
    for (int i = 0; i < 32; ++i) a.in[i] = (const float*)d_in[i];
    a.out = (float*)d_out; a.ws = (unsigned char*)d_ws;
#if ONE_LAUNCH
    a.ph_lo = 0; a.ph_hi = NPH;
    void* kargs[] = {&a};
    hipError_t e = hipLaunchCooperativeKernel((const void*)mega_fwd, dim3(grid), dim3(NTHREADS), kargs, LDS_BYTES, stream);
    if (e != hipSuccess) fprintf(stderr, "kernel_launch: cooperative launch failed: %s (grid %d)\n", hipGetErrorString(e), grid);
#else
    for (int ph = 0; ph < NPH; ++ph) {
        a.ph_lo = ph; a.ph_hi = ph + 1;
        hipLaunchKernelGGL(mega_fwd, dim3(grid), dim3(NTHREADS), LDS_BYTES, stream, a);
    }
#endif
}
```

```cpp
#include <hip/hip_runtime.h>
#include <hip/hip_cooperative_groups.h>
#include <cstdio>
#include <cstdint>
namespace cg = cooperative_groups;
#ifndef ONE_LAUNCH
#define ONE_LAUNCH 1
#endif
namespace pg8 {
#define PG8_LAS __attribute__((address_space(3)))
typedef unsigned short bf16_t;
typedef short bf16x8 __attribute__((ext_vector_type(8)));
typedef float f32x4 __attribute__((ext_vector_type(4)));
typedef float f32x2 __attribute__((ext_vector_type(2)));
typedef unsigned u32x4 __attribute__((ext_vector_type(4)));
typedef unsigned u32x2 __attribute__((ext_vector_type(2)));
constexpr int BM = 256, BK = 64, HALF = 128, HTB = HALF * BK * 2  , STAGE_BYTES = 8 * HTB, NXCD = 8, WGM = 8;

__host__ __device__ __forceinline__ int lds_byte(int r, int c) { const int st = (r >> 4) * 2 + (c >> 5), rr = r & 15, cc = c & 31, ob = rr * 64 + cc * 2; return st * 1024 + (ob ^ (((ob >> 9) & 1) << 5)); }
__host__ __device__ __forceinline__ void stage_rc(int b, int& R, int& C) { const int st = b / 1024, sb = b % 1024, swz = sb ^ (((sb >> 9) & 1) << 5); R = (st >> 1) * 16 + swz / 64; C = (st & 1) * 32 + (swz % 64) / 2; }
__host__ __device__ __forceinline__ int perm32(int rho) { const int n = rho >> 4, i = rho & 15; return 8 * (i >> 2) + 4 * n + (i & 3); }

struct Unit { int pm, pn; };
constexpr size_t EP_XN = 68ull << 20, EP_PS = 132ull << 20, EP_GT = 308ull << 20, EP_SO = 404ull << 20, EP_BR = 421ull << 20;
struct Gemm { const bf16_t* A; const bf16_t* Bt; int N, K, lda; };

struct StaticOrder {
    static constexpr int nM = 128;
    int nN, G, c;
    __host__ __device__ void init(int N, int G_, int c_) { nN = N / BM; G = G_; c = c_; }
    __host__ __device__ bool next(int i, Unit& u) const {
        const int nwg = nM * nN;
        const long L = (long)i * G + c; if (L >= nwg) return false;
        int wgid = (int)L; { const int q = nwg / NXCD, r = nwg % NXCD, xcd = wgid % NXCD, off = wgid / NXCD; wgid = (xcd < r ? xcd * (q + 1) : r * (q + 1) + (xcd - r) * q) + off; }
        const int nig = WGM * nN, gid = wgid / nig, fm = gid * WGM, gsz = (nM - fm) < WGM ? (nM - fm) : WGM;
        u.pm = fm + ((wgid % nig) % gsz); u.pn = (wgid % nig) / gsz; return true;
    }
    __device__ __forceinline__ void a_ready(const Unit&) const {}
    __device__ __forceinline__ void done(const Unit&) const {}
};

__device__ __forceinline__ unsigned cvt_pk_bf16(float lo, float hi) { unsigned r; asm volatile("v_cvt_pk_bf16_f32 %0, %1, %2" : "=v"(r) : "v"(lo), "v"(hi)); return r; }
__device__ __forceinline__ float bf_lo(unsigned w) { return __uint_as_float(w << 16); }
__device__ __forceinline__ float bf_hi(unsigned w) { return __uint_as_float(w & 0xffff0000u); }
__device__ __forceinline__ float sigmoidf_(float x) { return __builtin_amdgcn_rcpf(1.0f + __expf(-x)); }


struct EpiAny;
__device__ __forceinline__ void epi_win(bf16_t* PS, unsigned char* GT, bf16_t* BRW, const f32x4 (&acc)[2][2][4][2], const Unit& u, int wr, int wc, int fr, int fq) {
        const int row0 = u.pm * BM + wr * 64 + fr;
        if (u.pn < 11) {
            const int col0 = u.pn * BM + wc * 32 + 8 * fq;
#pragma unroll
            for (int ai = 0; ai < 2; ++ai)
#pragma unroll
                for (int m = 0; m < 4; ++m) { bf16_t* rowp = PS + (size_t)(row0 + ai * HALF + m * 16) * 2816 + col0;
#pragma unroll
                    for (int bj = 0; bj < 2; ++bj) { const f32x4 v0 = acc[ai][bj][m][0], v1 = acc[ai][bj][m][1];
                        u32x4 w; w.x = cvt_pk_bf16(v0[0], v0[1]); w.y = cvt_pk_bf16(v0[2], v0[3]); w.z = cvt_pk_bf16(v1[0], v1[1]); w.w = cvt_pk_bf16(v1[2], v1[3]);
                        *(u32x4*)(rowp + bj * HALF) = w;
                        if (m == 3 && fr == 15) *(u32x4*)(BRW + (size_t)((row0 + ai * HALF + m * 16) >> 6) * 2816 + col0 + bj * HALF) = w; } }
        } else {
            const int col0 = (u.pn - 11) * BM + wc * 32 + 8 * fq;
#pragma unroll
            for (int ai = 0; ai < 2; ++ai)
#pragma unroll
                for (int m = 0; m < 4; ++m) { unsigned char* rowp = GT + (size_t)(row0 + ai * HALF + m * 16) * 3072 + col0;
#pragma unroll
                    for (int bj = 0; bj < 2; ++bj) { const f32x4 v0 = acc[ai][bj][m][0], v1 = acc[ai][bj][m][1];
                        unsigned q[8];
#pragma unroll
                        for (int k = 0; k < 4; ++k) { q[k] = (unsigned)(sigmoidf_(v0[k]) * 255.0f + 0.5f); q[4 + k] = (unsigned)(sigmoidf_(v1[k]) * 255.0f + 0.5f); }
                        u32x2 w; w.x = q[0] | (q[1] << 8) | (q[2] << 16) | (q[3] << 24); w.y = q[4] | (q[5] << 8) | (q[6] << 16) | (q[7] << 24);
                        *(u32x2*)(rowp + bj * HALF) = w; } }
        }
    }

__device__ __forceinline__ void epi_merge(bf16_t* MG, const unsigned char* GT, int gi, const f32x4 (&acc)[2][2][4][2], const Unit& u, int wr, int wc, int fr, int fq) {
        const int row0 = u.pm * BM + wr * 64 + fr, col0 = u.pn * BM + wc * 32 + 8 * fq;
#pragma unroll
        for (int ai = 0; ai < 2; ++ai)
#pragma unroll
            for (int m = 0; m < 4; ++m) { const size_t r = (size_t)(row0 + ai * HALF + m * 16);
#pragma unroll
                for (int bj = 0; bj < 2; ++bj) { const int c = col0 + bj * HALF;
                    const u32x2 gq = *(const u32x2*)(GT + r * 3072 + gi * 1024 + c);
                    float v[8];
#pragma unroll
                    for (int k = 0; k < 4; ++k) { v[k] = acc[ai][bj][m][0][k] * ((float)((gq.x >> (8 * k)) & 255u) * (1.0f / 255.0f)); v[4 + k] = acc[ai][bj][m][1][k] * ((float)((gq.y >> (8 * k)) & 255u) * (1.0f / 255.0f)); }
                    u32x4* dst = (u32x4*)(MG + r * 1024 + c);
                    if (gi > 0) { const u32x4 p = *dst;
                        v[0] += bf_lo(p.x); v[1] += bf_hi(p.x); v[2] += bf_lo(p.y); v[3] += bf_hi(p.y); v[4] += bf_lo(p.z); v[5] += bf_hi(p.z); v[6] += bf_lo(p.w); v[7] += bf_hi(p.w); }
                    u32x4 w; w.x = cvt_pk_bf16(v[0], v[1]); w.y = cvt_pk_bf16(v[2], v[3]); w.z = cvt_pk_bf16(v[4], v[5]); w.w = cvt_pk_bf16(v[6], v[7]);
                    *dst = w; } }
    }

__device__ __forceinline__ void epi_res(const float* base, float* out, const f32x4 (&acc)[2][2][4][2], const Unit& u, int wr, int wc, int fr, int fq) {
        const int row0 = u.pm * BM + wr * 64 + fr, col0 = u.pn * BM + wc * 32 + 4 * fq;
#pragma unroll
        for (int ai = 0; ai < 2; ++ai)
#pragma unroll
            for (int m = 0; m < 4; ++m) { const size_t off = (size_t)(row0 + ai * HALF + m * 16) * 1024 + col0;
#pragma unroll
                for (int bj = 0; bj < 2; ++bj)
#pragma unroll
                    for (int n = 0; n < 2; ++n) { const f32x4 b = *(const f32x4*)(base + off + bj * HALF + n * 16); *(f32x4*)(out + off + bj * HALF + n * 16) = b + acc[ai][bj][m][n]; } }
    }

template <int MODE> __device__ __forceinline__ void epi_pair(bf16_t* O, int ldo, const f32x4 (&acc)[2][2][4][2], const Unit& u, int wr, int wc, int fr, int fq) {
        const int row0 = u.pm * BM + wr * 64 + fr, col0 = u.pn * HALF + wc * 32 + 8 * fq;
#pragma unroll
        for (int ai = 0; ai < 2; ++ai)
#pragma unroll
            for (int m = 0; m < 4; ++m) { bf16_t* rowp = O + (size_t)(row0 + ai * HALF + m * 16) * ldo + col0;
                float v[8];
#pragma unroll
                for (int n = 0; n < 2; ++n)
#pragma unroll
                    for (int k = 0; k < 4; ++k) { const float a = acc[ai][0][m][n][k], b = acc[ai][1][m][n][k];
                        v[4 * n + k] = (MODE == 0) ? (a * sigmoidf_(a) * b) : (a * sigmoidf_(b)); }
                u32x4 w; w.x = cvt_pk_bf16(v[0], v[1]); w.y = cvt_pk_bf16(v[2], v[3]); w.z = cvt_pk_bf16(v[4], v[5]); w.w = cvt_pk_bf16(v[6], v[7]);
                *(u32x4*)rowp = w; }
    }


struct EpiAny {
    int kind;
    int gi; unsigned char* ws; const float* base; float* out;
    __device__ __forceinline__ bool perm() const { return kind != 2; }
    __device__ __forceinline__ void operator()(const f32x4 (&acc)[2][2][4][2], const Unit& u, int wr, int wc, int fr, int fq) const {
        if (kind == 0) epi_win((bf16_t*)(ws + EP_PS), ws + EP_GT, (bf16_t*)(ws + EP_BR), acc, u, wr, wc, fr, fq);
        else if (kind == 1) epi_merge((bf16_t*)(ws + EP_XN), ws + EP_GT, gi, acc, u, wr, wc, fr, fq);
        else if (kind == 2) epi_res(base, out, acc, u, wr, wc, fr, fq);
        else if (kind == 3) epi_pair<0>((bf16_t*)(ws + EP_PS), 2816, acc, u, wr, wc, fr, fq);
        else epi_pair<1>((bf16_t*)(ws + EP_SO), 256, acc, u, wr, wc, fr, fq);
    }
};

template <class Epi, class Sched, bool ALIGN_EPI = false>
__device__ __forceinline__ void gemm_phase(PG8_LAS unsigned char* lds, const Gemm g, const Sched& S, const Epi& E) {
    int tid_ = threadIdx.x; asm volatile("" : "+v"(tid_));
    const int tid = tid_, wid = __builtin_amdgcn_readfirstlane(tid >> 6), lane = tid & 63, wr = wid >> 2, wc = wid & 3, fr = lane & 15, fq = lane >> 4;
    const int K = g.K, lda = g.lda, nt = K / BK;
    unsigned voffA[2], voffB[2];
#pragma unroll
    for (int i = 0; i < 2; ++i) { int R, C; stage_rc(tid * 16 + i * 8192, R, C); const int Rb = E.perm() ? ((R & ~31) + perm32(R & 31)) : R;
        voffA[i] = (unsigned)(R * lda + C) * 2u; voffB[i] = (unsigned)(Rb * K + C) * 2u; }
    const size_t kstep = (size_t)(BK * 2);
    const size_t hstepA = (size_t)HALF * lda * 2, hstepB = (size_t)HALF * K * 2;
    const size_t tstepA = 2 * hstepA, tstepB = 2 * hstepB;
    const unsigned ldsw = (unsigned)wid * 1024u;
    const int aoff = lds_byte(wr * 64 + fr, fq * 8), boff = lds_byte(wc * 32 + fr, fq * 8);
#define PG8_SA(b, h) (((b) * 2 + (h)) * HTB)
#define PG8_SB(b, h) ((4 + (b) * 2 + (h)) * HTB)
#define PG8_STAGE(bufoff, gbase, voff) do { _Pragma("unroll") for (int _i = 0; _i < 2; ++_i) \
        __builtin_amdgcn_global_load_lds((const unsigned*)((const char*)(gbase) + (voff)[_i]), (PG8_LAS unsigned*)(lds + (bufoff) + ldsw + _i * 8192), 16, 0, 0); } while (0)
#define PG8_LDA(dst, b, h) do { _Pragma("unroll") for (int m = 0; m < 4; ++m) _Pragma("unroll") for (int k = 0; k < 2; ++k) dst[m][k] = *(const PG8_LAS bf16x8*)(lds + PG8_SA(b, h) + aoff + m * 2048 + k * 1024); } while (0)
#define PG8_LDB(dst, b, h) do { _Pragma("unroll") for (int n = 0; n < 2; ++n) _Pragma("unroll") for (int k = 0; k < 2; ++k) dst[n][k] = *(const PG8_LAS bf16x8*)(lds + PG8_SB(b, h) + boff + n * 2048 + k * 1024); } while (0)
#define PG8_MMA(ai, bj, At, Bt) do { __builtin_amdgcn_s_setprio(1); _Pragma("unroll") for (int m = 0; m < 4; ++m) _Pragma("unroll") for (int n = 0; n < 2; ++n) _Pragma("unroll") for (int k = 0; k < 2; ++k) \
        acc[ai][bj][m][n] = __builtin_amdgcn_mfma_f32_16x16x32_bf16(Bt[n][k], At[m][k], acc[ai][bj][m][n], 0, 0, 0); __builtin_amdgcn_s_setprio(0); } while (0)
#define PG8_WAIT_V(n) asm volatile("s_waitcnt vmcnt(" #n ")" ::: "memory")
#define PG8_WAIT_L(n) asm volatile("s_waitcnt lgkmcnt(" #n ")" ::: "memory")
#define PG8_BAR __builtin_amdgcn_s_barrier()
#define PG8_SCHED __builtin_amdgcn_sched_barrier(0)
    Unit cur, nxt; int ui = 0;
    if (!S.next(0, cur)) return;
    f32x4 acc[2][2][4][2];
#pragma unroll
    for (int a = 0; a < 2; ++a)
#pragma unroll
        for (int b = 0; b < 2; ++b)
#pragma unroll
            for (int m = 0; m < 4; ++m)
#pragma unroll
                for (int n = 0; n < 2; ++n) acc[a][b][m][n] = (f32x4){0.f, 0.f, 0.f, 0.f};
    bf16x8 At[4][2], B0[2][2], B1[2][2];
    const char* cA = (const char*)g.A + (size_t)cur.pm * tstepA; const char* cB = (const char*)g.Bt + (size_t)cur.pn * tstepB;
    S.a_ready(cur);
    PG8_STAGE(PG8_SB(0, 0), cB, voffB); PG8_STAGE(PG8_SB(0, 1), cB + hstepB, voffB); PG8_STAGE(PG8_SA(0, 0), cA, voffA); PG8_STAGE(PG8_SA(0, 1), cA + hstepA, voffA);
    if (wr == 1) PG8_BAR;
    PG8_WAIT_V(2); PG8_BAR;
    PG8_STAGE(PG8_SB(1, 0), cB + kstep, voffB); PG8_STAGE(PG8_SA(1, 0), cA + kstep, voffA); PG8_STAGE(PG8_SB(1, 1), cB + hstepB + kstep, voffB);
    PG8_WAIT_V(6); PG8_BAR;
    for (;;) {
        const bool has_next = S.next(ui + 1, nxt);
        const char* nA = has_next ? (const char*)g.A + (size_t)nxt.pm * tstepA : cA; const char* nB = has_next ? (const char*)g.Bt + (size_t)nxt.pn * tstepB : cB;
        for (int t = 0; t < nt; t += 2) {
            const bool last = (t == nt - 2);
            const char* a1 = cA + (size_t)(t + 1) * kstep;
            const char* a2 = last ? nA : cA + (size_t)(t + 2) * kstep; const char* b2 = last ? nB : cB + (size_t)(t + 2) * kstep;
            const char* a3 = a2 + kstep; const char* b3 = b2 + kstep;
            if (last && has_next) S.a_ready(nxt);
            PG8_LDB(B0, 0, 0); PG8_LDB(B1, 0, 1); PG8_SCHED; PG8_LDA(At, 0, 0); PG8_STAGE(PG8_SA(1, 1), a1 + hstepA, voffA);
            PG8_WAIT_V(8); PG8_WAIT_L(0); PG8_BAR; PG8_MMA(0, 0, At, B0); PG8_MMA(0, 1, At, B1); PG8_BAR; PG8_SCHED;
            PG8_LDA(At, 0, 1); PG8_STAGE(PG8_SB(0, 0), b2, voffB); PG8_STAGE(PG8_SB(0, 1), b2 + hstepB, voffB); PG8_STAGE(PG8_SA(0, 0), a2, voffA);
            PG8_WAIT_V(8); PG8_WAIT_L(0); PG8_BAR; PG8_MMA(1, 0, At, B0); PG8_MMA(1, 1, At, B1); PG8_BAR; PG8_SCHED;
            PG8_LDB(B0, 1, 0); PG8_LDB(B1, 1, 1); PG8_SCHED; PG8_LDA(At, 1, 0); PG8_STAGE(PG8_SA(0, 1), a2 + hstepA, voffA);
            PG8_WAIT_V(8); PG8_WAIT_L(0); PG8_BAR; PG8_MMA(0, 0, At, B0); PG8_MMA(0, 1, At, B1); PG8_BAR; PG8_SCHED;
            PG8_LDA(At, 1, 1); PG8_STAGE(PG8_SB(1, 0), b3, voffB); PG8_STAGE(PG8_SB(1, 1), b3 + hstepB, voffB); PG8_STAGE(PG8_SA(1, 0), a3, voffA);
            PG8_WAIT_V(8); PG8_WAIT_L(0); PG8_BAR; PG8_MMA(1, 0, At, B0); PG8_MMA(1, 1, At, B1); PG8_BAR; PG8_SCHED;
        }
        if constexpr (ALIGN_EPI) { if (wr == 0) PG8_BAR; }
        E(acc, cur, wr, wc, fr, fq); S.done(cur);
        if (!has_next) break;
#pragma unroll
        for (int a = 0; a < 2; ++a)
#pragma unroll
            for (int b = 0; b < 2; ++b)
#pragma unroll
                for (int m = 0; m < 4; ++m)
#pragma unroll
                    for (int n = 0; n < 2; ++n) acc[a][b][m][n] = (f32x4){0.f, 0.f, 0.f, 0.f};
        cur = nxt; cA = nA; cB = nB; ++ui;
        if constexpr (ALIGN_EPI) { if (wr == 1) PG8_BAR; }
    }
    PG8_WAIT_V(0);
    if constexpr (!ALIGN_EPI) { if (wr == 0) PG8_BAR; }
    PG8_BAR;
#undef PG8_SA
#undef PG8_SB
#undef PG8_STAGE
#undef PG8_LDA
#undef PG8_LDB
#undef PG8_MMA
#undef PG8_WAIT_V
#undef PG8_WAIT_L
#undef PG8_BAR
#undef PG8_SCHED
}
}
constexpr int NWAVES = 8, NTHREADS = 512;
constexpr int BATCH = 8, SEQ = 4096, T = BATCH * SEQ, D = 1024, DEPTH = 2;
constexpr int NIN = 5888, PSW = 2816, NGATE = 3072, FFH = 2816;
constexpr int C_Q = 0, C_K = 384, C_V = 768, C_RW = 1152, C_LORA = 2304, C_SSM = 2560;
constexpr float NORM_EPS = 1e-6f, GN_EPS = 64e-5f;

constexpr size_t MiB = 1u << 20;
constexpr size_t WS_CTL = 0, CTL_ZERO_BYTES = 1 * MiB;
constexpr size_t WS_W = 1 * MiB, W_LAYER = 33 * MiB;
constexpr size_t WO_IN = 0, WO_BA = 12 * MiB, WO_BR = WO_BA + 768 * 1024, WO_BS = WO_BR + 768 * 1024, WO_OUT = 14 * MiB, WO_GU = 16 * MiB, WO_DN = 27 * MiB, WO_GLU = 32 * MiB + 512 * 1024,
                 WO_W2 = WO_GLU + 256 * 1024, WO_A2 = WO_W2 + 48 * 1024, WO_G2 = WO_A2 + 48 * 1024;
constexpr size_t WS_XN = 68 * MiB;
constexpr size_t WS_PS = 132 * MiB;
constexpr size_t WS_GT = 308 * MiB;
constexpr size_t WS_SO = 404 * MiB;
constexpr size_t WS_LSE = 420 * MiB;
constexpr size_t WS_SCR = 421 * MiB;
constexpr size_t WS_BR = WS_SCR;
constexpr size_t WS_RMC = WS_SCR + 3 * MiB;
constexpr size_t WS_RNT = WS_RMC + 24 * MiB;
constexpr size_t WS_REM = WS_RNT + 24 * MiB;
constexpr size_t WS_RGL = WS_REM + 24 * MiB;
static_assert(WS_RGL + 1 * MiB <= 512 * MiB, "scratch map");
constexpr size_t WS_END = 512 * MiB;

constexpr int LDS_BYTES = 147456;

#define GAS __attribute__((address_space(1)))
#define LAS __attribute__((address_space(3)))
typedef unsigned short bf16;
typedef unsigned v4u __attribute__((ext_vector_type(4)));
typedef unsigned v2u __attribute__((ext_vector_type(2)));
typedef float f32x4 __attribute__((ext_vector_type(4)));
#define LDS_WAIT() asm volatile("s_waitcnt lgkmcnt(0)" ::: "memory")
#define VM_WAIT() asm volatile("s_waitcnt vmcnt(0)" ::: "memory")
__device__ __forceinline__ unsigned f2bf(float f) { unsigned u = __builtin_bit_cast(unsigned, f); return (u + 0x7fffu + ((u >> 16) & 1u)) >> 16; }
__device__ __forceinline__ unsigned pk2(float lo, float hi) { return f2bf(lo) | (f2bf(hi) << 16); }
__device__ __forceinline__ float bf2f(bf16 b) { return __uint_as_float((unsigned)b << 16); }
__device__ __forceinline__ float bflo(unsigned w) { return __uint_as_float(w << 16); }
__device__ __forceinline__ float bfhi(unsigned w) { return __uint_as_float(w & 0xffff0000u); }
template <int M> __device__ __forceinline__ float shx(float v) { static_assert(M < 32, "shx: xor mask inside a 32-lane half"); return __int_as_float(__builtin_amdgcn_ds_swizzle(__float_as_int(v), (M << 10) | 0x1f)); }
__device__ __forceinline__ float xsum32(float v) { auto r = __builtin_amdgcn_permlane32_swap(__float_as_uint(v), __float_as_uint(v), false, false); return __uint_as_float(r[0]) + __uint_as_float(r[1]); }
__device__ __forceinline__ float xmax32(float v) { auto r = __builtin_amdgcn_permlane32_swap(__float_as_uint(v), __float_as_uint(v), false, false); return fmaxf(__uint_as_float(r[0]), __uint_as_float(r[1])); }
__device__ __forceinline__ float wave_sum(float v) { v += shx<1>(v); v += shx<2>(v); v += shx<4>(v); v += shx<8>(v); v += shx<16>(v); return xsum32(v); }
__device__ __forceinline__ float sigm(float x) { return 1.0f / (1.0f + __expf(-x)); }

struct Args { const float* in[32]; float* out; unsigned char* ws; int ph_lo, ph_hi; };

typedef __attribute__((address_space(4))) const unsigned char* kptr_t;
struct KA {
    kptr_t p;
    typedef const float* cfptr_t; typedef float* fptr_t; typedef unsigned char* ucptr_t;
    __device__ __forceinline__ const float* in(int i) const { return *(const __attribute__((address_space(4))) cfptr_t*)(p + 8 * i); }
    __device__ __forceinline__ float* out() const { return *(const __attribute__((address_space(4))) fptr_t*)(p + 256); }
    __device__ __forceinline__ unsigned char* ws() const { return *(const __attribute__((address_space(4))) ucptr_t*)(p + 264); }
};
static_assert(sizeof(Args) == 280, "Args layout");

struct Ctx {
    unsigned char* lds; unsigned char* ws; float* out;
    int tid, lane, wave, G, bid;
};

__device__ __forceinline__ void tr_item(const float* W, int ldw, int K, int nblk, bf16* WT, int goff, float* scr, int item, int lane) {
    const int kb = item / nblk, nb = item % nblk, k0 = 64 * kb, n0 = 32 * nb;
#pragma unroll 8
    for (int i = 0; i < 32; ++i) { const int kk = 2 * i + (lane >> 5); scr[kk * 33 + (lane & 31)] = W[(size_t)(k0 + kk) * ldw + n0 + (lane & 31)]; }
    LDS_WAIT(); asm volatile("" ::: "memory");
    const int c = lane & 7;
#pragma unroll
    for (int j = 0; j < 4; ++j) { const int n = (lane >> 3) + 8 * j; const float* s = scr + (8 * c) * 33 + n;
        v4u o; o.x = pk2(s[0 * 33], s[1 * 33]); o.y = pk2(s[2 * 33], s[3 * 33]); o.z = pk2(s[4 * 33], s[5 * 33]); o.w = pk2(s[6 * 33], s[7 * 33]);
        const int nn = n0 + n; const int drow = goff < 0 ? nn : ((nn >> 7) * 256 + goff + (nn & 127));
        *(v4u*)(WT + (size_t)drow * K + k0 + 8 * c) = o; }
    LDS_WAIT(); asm volatile("" ::: "memory");
}

__device__ __forceinline__ void phase_prep(const KA& A, const Ctx& F) {
    float* scr = (float*)(F.lds + F.wave * 16384);
    const int gw = F.bid * NWAVES + F.wave, NGW = F.G * NWAVES;
    constexpr int NM = 13;
    constexpr int cnt[NM] = {16 * 184, 6 * 32, 6 * 32, 4 * 32, 16 * 32, 16 * 88, 16 * 88, 44 * 32, 4 * 8, 4 * 8, 12, 12, 24};
    constexpr int per_layer = cnt[0] + cnt[1] + cnt[2] + cnt[3] + cnt[4] + cnt[5] + cnt[6] + cnt[7] + cnt[8] + cnt[9] + cnt[10] + cnt[11] + cnt[12];
    for (int it = gw; it < DEPTH * per_layer; it += NGW) {
        const int l = it / per_layer; int r = it % per_layer;
        unsigned char* wl = F.ws + WS_W + (size_t)l * W_LAYER;
        if (r < cnt[0]) { tr_item(A.in(2) + (size_t)l * D * NIN, NIN, D, NIN / 32, (bf16*)(wl + WO_IN), -1, scr, r, F.lane); continue; } r -= cnt[0];
        if (r < cnt[1]) { tr_item(A.in(24) + (size_t)l * 384 * D, D, 384, D / 32, (bf16*)(wl + WO_BA), -1, scr, r, F.lane); continue; } r -= cnt[1];
        if (r < cnt[2]) { tr_item(A.in(25) + (size_t)l * 384 * D, D, 384, D / 32, (bf16*)(wl + WO_BR), -1, scr, r, F.lane); continue; } r -= cnt[2];
        if (r < cnt[3]) { tr_item(A.in(26) + (size_t)l * 256 * D, D, 256, D / 32, (bf16*)(wl + WO_BS), -1, scr, r, F.lane); continue; } r -= cnt[3];
        if (r < cnt[4]) { tr_item(A.in(27) + (size_t)l * D * D, D, D, D / 32, (bf16*)(wl + WO_OUT), -1, scr, r, F.lane); continue; } r -= cnt[4];
        if (r < cnt[5]) { tr_item(A.in(29) + (size_t)l * D * 2 * FFH, 2 * FFH, D, FFH / 32, (bf16*)(wl + WO_GU), 0, scr, r, F.lane); continue; } r -= cnt[5];
        if (r < cnt[6]) { tr_item(A.in(29) + (size_t)l * D * 2 * FFH + FFH, 2 * FFH, D, FFH / 32, (bf16*)(wl + WO_GU), 128, scr, r, F.lane); continue; } r -= cnt[6];
        if (r < cnt[7]) { tr_item(A.in(30) + (size_t)l * FFH * D, D, FFH, D / 32, (bf16*)(wl + WO_DN), -1, scr, r, F.lane); continue; } r -= cnt[7];
        if (r < cnt[8]) { tr_item(A.in(22) + (size_t)l * 256 * 256, 256, 256, 8, (bf16*)(wl + WO_GLU), 0, scr, r, F.lane); continue; } r -= cnt[8];
        if (r < cnt[9]) { tr_item(A.in(23) + (size_t)l * 256 * 256, 256, 256, 8, (bf16*)(wl + WO_GLU), 128, scr, r, F.lane); continue; } r -= cnt[9];
        if (r < cnt[10]) { tr_item(A.in(5) + (size_t)l * 64 * 384, 384, 64, 12, (bf16*)(wl + WO_W2), -1, scr, r, F.lane); continue; } r -= cnt[10];
        if (r < cnt[11]) { tr_item(A.in(7) + (size_t)l * 64 * 384, 384, 64, 12, (bf16*)(wl + WO_A2), -1, scr, r, F.lane); continue; } r -= cnt[11];
        tr_item(A.in(8) + (size_t)l * 128 * 384, 384, 128, 12, (bf16*)(wl + WO_G2), -1, scr, r, F.lane);
    }
}

template <bool OUT_F32> __device__ __forceinline__ void phase_rmsnorm(const KA& A, const Ctx& F, const float* src, const float* gain, void* dst) {
    const int gw = F.bid * NWAVES + F.wave, NGW = F.G * NWAVES;
    f32x4 gv[4];
#pragma unroll
    for (int j = 0; j < 4; ++j) gv[j] = *((const f32x4*)gain + F.lane + 64 * j);
    for (int m = gw; m < T; m += NGW) {
        const f32x4* xr = (const f32x4*)(src + (size_t)m * D) + F.lane;
        f32x4 v[4]; float s = 0.f;
#pragma unroll
        for (int j = 0; j < 4; ++j) { v[j] = xr[64 * j]; s += (v[j].x * v[j].x + v[j].y * v[j].y) + (v[j].z * v[j].z + v[j].w * v[j].w); }
        const float rs = 1.0f / sqrtf(wave_sum(s) * (1.0f / D) + NORM_EPS);
        if (OUT_F32) {
            f32x4* o = (f32x4*)((float*)dst + (size_t)m * D) + F.lane;
#pragma unroll
            for (int j = 0; j < 4; ++j) o[64 * j] = v[j] * rs * gv[j];
        } else {
            v2u* o = (v2u*)((bf16*)dst + (size_t)m * D) + F.lane;
#pragma unroll
            for (int j = 0; j < 4; ++j) { const f32x4 y = v[j] * rs * gv[j]; v2u w; w.x = pk2(y.x, y.y); w.y = pk2(y.z, y.w); o[64 * j] = w; }
        }
    }
}
__device__ __forceinline__ void attn_v1(const KA& A, const Ctx& F, int blk, int nblk) {
    bf16* PS = (bf16*)(F.ws + WS_PS); float* LSE = (float*)(F.ws + WS_LSE);
#pragma unroll 1
    for (int item = blk * NTHREADS + F.tid; item < T * 12; item += nblk * NTHREADS) {
        const int hf = item & 1, it2 = item >> 1;
        const int h = it2 / T, bt = it2 % T, t = bt % SEQ;
        const int g = h >> 1, dil = (g == 0) ? 1 : (g == 1 ? 4 : 16);
        unsigned qp_[16]; float o[32];
        { const v4u* qp = (const v4u*)(PS + (size_t)bt * PSW + C_Q + h * 64 + hf * 32);
#pragma unroll
          for (int c = 0; c < 4; ++c) { const v4u w = qp[c]; qp_[4 * c + 0] = w.x; qp_[4 * c + 1] = w.y; qp_[4 * c + 2] = w.z; qp_[4 * c + 3] = w.w; } }
#pragma unroll
        for (int c = 0; c < 32; ++c) o[c] = 0.f;
        float mx = -1e30f, l = 0.f;
#pragma unroll 1
        for (int j = 0; j <= 128; ++j) {
            const int tk = t - j * dil; if (tk < 0) break;
            const size_t rowk = (size_t)(bt - j * dil) * PSW;
            const v4u* kp = (const v4u*)(PS + rowk + C_K + h * 64 + hf * 32); const v4u* vp = (const v4u*)(PS + rowk + C_V + h * 64 + hf * 32);
            float s = 0.f;
#pragma unroll
            for (int c = 0; c < 4; ++c) { const v4u w = kp[c];
                s += bflo(qp_[4 * c + 0]) * bflo(w.x) + bfhi(qp_[4 * c + 0]) * bfhi(w.x) + bflo(qp_[4 * c + 1]) * bflo(w.y) + bfhi(qp_[4 * c + 1]) * bfhi(w.y)
                   + bflo(qp_[4 * c + 2]) * bflo(w.z) + bfhi(qp_[4 * c + 2]) * bfhi(w.z) + bflo(qp_[4 * c + 3]) * bflo(w.w) + bfhi(qp_[4 * c + 3]) * bfhi(w.w); }
            s += shx<1>(s);
            s *= 0.125f;
            const float mn = fmaxf(mx, s), cf = __expf(mx - mn), p = __expf(s - mn);
            l = l * cf + p; mx = mn;
#pragma unroll
            for (int c = 0; c < 4; ++c) { const v4u w = vp[c];
                o[8 * c + 0] = o[8 * c + 0] * cf + p * bflo(w.x); o[8 * c + 1] = o[8 * c + 1] * cf + p * bfhi(w.x); o[8 * c + 2] = o[8 * c + 2] * cf + p * bflo(w.y); o[8 * c + 3] = o[8 * c + 3] * cf + p * bfhi(w.y);
                o[8 * c + 4] = o[8 * c + 4] * cf + p * bflo(w.z); o[8 * c + 5] = o[8 * c + 5] * cf + p * bfhi(w.z); o[8 * c + 6] = o[8 * c + 6] * cf + p * bflo(w.w); o[8 * c + 7] = o[8 * c + 7] * cf + p * bfhi(w.w); }
        }
        const float il = 1.0f / l;
        v4u* op = (v4u*)(PS + (size_t)bt * PSW + C_Q + h * 64 + hf * 32);
#pragma unroll
        for (int c = 0; c < 4; ++c) { v4u w; w.x = pk2(o[8 * c + 0] * il, o[8 * c + 1] * il); w.y = pk2(o[8 * c + 2] * il, o[8 * c + 3] * il); w.z = pk2(o[8 * c + 4] * il, o[8 * c + 5] * il); w.w = pk2(o[8 * c + 6] * il, o[8 * c + 7] * il); op[c] = w; }
        if (hf == 0) LSE[(size_t)bt * 6 + h] = mx + __logf(l);
    }
}
__device__ __forceinline__ void attn_finalize(const KA& A, const Ctx& F) {
    bf16* PS = (bf16*)(F.ws + WS_PS); const float* LSE = (const float*)(F.ws + WS_LSE);
    for (int item = F.bid * NTHREADS + F.tid; item < T * 48; item += F.G * NTHREADS) {
        const int bt = item / 48, r = item % 48, h = r >> 3, c = r & 7, j = h & 1;
        const float l0 = LSE[(size_t)bt * 6 + j], l1 = LSE[(size_t)bt * 6 + 2 + j], l2 = LSE[(size_t)bt * 6 + 4 + j], lm = LSE[(size_t)bt * 6 + h];
        const float mx = fmaxf(l0, fmaxf(l1, l2));
        const float al = __expf(lm - mx) / (__expf(l0 - mx) + __expf(l1 - mx) + __expf(l2 - mx));
        v4u* p = (v4u*)(PS + (size_t)bt * PSW + C_Q + h * 64) + c; v4u w = *p;
        w.x = pk2(bflo(w.x) * al, bfhi(w.x) * al); w.y = pk2(bflo(w.y) * al, bfhi(w.y) * al); w.z = pk2(bflo(w.z) * al, bfhi(w.z) * al); w.w = pk2(bflo(w.w) * al, bfhi(w.w) * al);
        *p = w;
    }
}

__device__ __forceinline__ void rwkv_v1(const KA& A, const Ctx& F, int l, int b, int h) {
    constexpr int CH = 32;
    bf16* PS = (bf16*)(F.ws + WS_PS);
    float* L = (float*)F.lds;
    float* ZR = L, *ZK = L + CH * 64, *ZV = L + 2 * CH * 64, *ZX = L + 3 * CH * 64;
    float* WD = ZX + CH * 256, *KA = WD + CH * 64, *KB = KA + CH * 64, *GG = KB + CH * 64, *YB = GG + CH * 64, *BON = YB + CH * 64, *PREV = BON + 64;
    const float* mix = A.in(3) + (size_t)l * 1408;
    const float* w0 = A.in(4) + l * 384, *w2 = A.in(5) + (size_t)l * 64 * 384, *a0 = A.in(6) + l * 384, *a2 = A.in(7) + (size_t)l * 64 * 384, *g2 = A.in(8) + (size_t)l * 128 * 384;
    const float* k_k = A.in(9) + l * 384, *k_a = A.in(10) + l * 384, *r_k = A.in(11) + l * 384, *ln_w = A.in(12) + l * 384, *ln_b = A.in(13) + l * 384;
    const int tid = F.tid, lane = F.lane;
    const int hc = h * 64 + lane;
    float S[8];
#pragma unroll
    for (int j = 0; j < 8; ++j) S[j] = 0.f;
    const int si = tid >> 3, sj = (tid & 7) * 8;
#pragma unroll 1
    for (int ch = 0; ch < SEQ / CH; ++ch) {
        const int t0 = ch * CH; const size_t row0 = (size_t)b * SEQ + t0;
        float* PRc = PREV + (ch & 1) * 192, *PRn = PREV + ((ch + 1) & 1) * 192;
#pragma unroll 1
        for (int e = tid; e < CH * 192; e += NTHREADS) {
            const int t = e / 192, c3 = e % 192, which = c3 >> 6, c = c3 & 63;
            const int col = C_RW + which * 384 + h * 64 + c;
            const float cur = bf2f(PS[(row0 + t) * PSW + col]);
            float prev;
            if (t == 0) prev = (ch == 0) ? 0.f : PRc[c3]; else prev = bf2f(PS[(row0 + t - 1) * PSW + col]);
            if (t == CH - 1) PRn[c3] = cur;
            const float z = cur + (prev - cur) * mix[which * 384 + h * 64 + c];
            L[which * CH * 64 + t * 64 + c] = z;
        }
#pragma unroll 1
        for (int e = tid; e < CH * 256; e += NTHREADS) {
            const int t = e >> 8, j = e & 255; const int col = C_LORA + j;
            const float cur = bf2f(PS[(row0 + t) * PSW + col]);
            const float prev = (t0 + t == 0) ? 0.f : bf2f(PS[(row0 + t - 1) * PSW + col]);
            float z = cur + (prev - cur) * mix[1152 + j];
            if (j < 64) z = tanhf(z); else if (j >= 128) z = sigm(z);
            ZX[t * 256 + j] = z;
        }
        __syncthreads();
        {
            float accw[4], acca[4], accg[4];
#pragma unroll
            for (int i = 0; i < 4; ++i) { accw[i] = 0.f; acca[i] = 0.f; accg[i] = 0.f; }
#pragma unroll 2
            for (int j = 0; j < 64; ++j) { const float ww = w2[j * 384 + hc], aa = a2[j * 384 + hc];
#pragma unroll
                for (int i = 0; i < 4; ++i) { const int t = F.wave + 8 * i; accw[i] += ZX[t * 256 + j] * ww; acca[i] += ZX[t * 256 + 64 + j] * aa; } }
#pragma unroll 2
            for (int j = 0; j < 128; ++j) { const float gg = g2[j * 384 + hc];
#pragma unroll
                for (int i = 0; i < 4; ++i) { const int t = F.wave + 8 * i; accg[i] += ZX[t * 256 + 128 + j] * gg; } }
            const float w0c = w0[hc], a0c = a0[hc], kkc = k_k[hc], kac = k_a[hc], rkc = r_k[hc];
#pragma unroll
            for (int i = 0; i < 4; ++i) { const int t = F.wave + 8 * i; const int o = t * 64 + lane;
                const float x = -(w0c + accw[i]); const float sp = (x > 20.f) ? x : log1pf(__expf(x)); const float w = -sp - 0.5f;
                const float av = sigm(a0c + acca[i]);
                const float kraw = ZK[o]; float kk = kraw * kkc; const float nrm = sqrtf(wave_sum(kk * kk)); kk = kk / fmaxf(nrm, 1e-12f);
                const float knew = kraw * (1.0f + (av - 1.0f) * kac);
                const float bon = wave_sum(ZR[o] * knew * rkc);
                ZK[o] = knew; WD[o] = __expf(-__expf(w)); KA[o] = -kk; KB[o] = kk * av; GG[o] = accg[i]; if (lane == 0) BON[t] = bon; }
        }
        __syncthreads();
#pragma unroll 2
        for (int t = 0; t < CH; ++t) {
            const f32x4 a0v = *(const f32x4*)(KA + t * 64 + sj), a1v = *(const f32x4*)(KA + t * 64 + sj + 4);
            const f32x4 w0v = *(const f32x4*)(WD + t * 64 + sj), w1v = *(const f32x4*)(WD + t * 64 + sj + 4);
            const f32x4 b0v = *(const f32x4*)(KB + t * 64 + sj), b1v = *(const f32x4*)(KB + t * 64 + sj + 4);
            const f32x4 k0v = *(const f32x4*)(ZK + t * 64 + sj), k1v = *(const f32x4*)(ZK + t * 64 + sj + 4);
            const f32x4 r0v = *(const f32x4*)(ZR + t * 64 + sj), r1v = *(const f32x4*)(ZR + t * 64 + sj + 4);
            const float vi = ZV[t * 64 + si];
            float sa = 0.f;
#pragma unroll
            for (int j = 0; j < 4; ++j) sa += S[j] * a0v[j] + S[4 + j] * a1v[j];
            sa += shx<1>(sa); sa += shx<2>(sa); sa += shx<4>(sa);
            float y = 0.f;
#pragma unroll
            for (int j = 0; j < 4; ++j) { S[j] = S[j] * w0v[j] + sa * b0v[j] + vi * k0v[j]; S[4 + j] = S[4 + j] * w1v[j] + sa * b1v[j] + vi * k1v[j]; y += S[j] * r0v[j] + S[4 + j] * r1v[j]; }
            y += shx<1>(y); y += shx<2>(y); y += shx<4>(y);
            if ((tid & 7) == 0) YB[t * 64 + si] = y;
        }
        __syncthreads();
        const float lw = ln_w[hc], lb = ln_b[hc];
#pragma unroll
        for (int i = 0; i < 4; ++i) { const int t = F.wave + 8 * i; const int o = t * 64 + lane;
            const float y = YB[o]; const float mu = wave_sum(y) * (1.0f / 64.0f); const float dv = y - mu; const float var = wave_sum(dv * dv) * (1.0f / 64.0f);
            const float yn = dv * (1.0f / sqrtf(var + GN_EPS)) * lw + lb;
            const float out = (yn + BON[t] * ZV[o]) * GG[o];
            PS[(row0 + t) * PSW + C_RW + h * 64 + lane] = (bf16)f2bf(out); }
        __syncthreads();
    }
}

__device__ __forceinline__ float gelu_tanh(float x) { const float u = 0.7978845608028654f * (x + 0.044715f * x * x * x); return 0.5f * x * (1.0f + tanhf(u)); }
__device__ __forceinline__ void ssm_v1(const KA& A, const Ctx& F, int l, int b, int g) {
    bf16* PS = (bf16*)(F.ws + WS_PS);
    float* L = (float*)F.lds;
    float* U = L, *XR = L + 1024, *XI = L + 1024 + 64 * 65, *CR = L + 1024 + 2 * 64 * 65, *CI = CR + 1024;
    const int tid = F.tid, lane = F.lane, p = lane;
    float are, aim, bre[16], bim[16];
    {
        const float step = __expf(A.in(16)[l * 16 + g]);
        const float lr = A.in(14)[(size_t)l * 1024 + g * 64 + p], li = A.in(15)[(size_t)l * 1024 + g * 64 + p];
        const float mag = __expf(lr * step), ang = li * step; float sn, cs; sincosf(ang, &sn, &cs);
        are = mag * cs; aim = mag * sn;
        const float inv = 1.0f / (lr * lr + li * li);
        const float fre = ((are - 1.0f) * lr + aim * li) * inv, fim = (aim * lr - (are - 1.0f) * li) * inv;
        const float* br = A.in(17) + (size_t)l * 16384 + (size_t)(g * 64 + p) * 16, *bi = A.in(18) + (size_t)l * 16384 + (size_t)(g * 64 + p) * 16;
#pragma unroll
        for (int c = 0; c < 16; ++c) { bre[c] = fre * br[c] - fim * bi[c]; bim[c] = fre * bi[c] + fim * br[c]; }
    }
    for (int e = tid; e < 1024; e += NTHREADS) { CR[e] = A.in(19)[(size_t)l * 16384 + g * 1024 + e]; CI[e] = A.in(20)[(size_t)l * 16384 + g * 1024 + e]; }
    const float* dsk = A.in(21) + l * 256 + g * 16;
    float xr = 0.f, xi = 0.f;
#pragma unroll 1
    for (int ch = 0; ch < SEQ / 64; ++ch) {
        const size_t row0 = (size_t)b * SEQ + ch * 64;
        for (int e = tid; e < 1024; e += NTHREADS) { const int t = e >> 4, c = e & 15; U[e] = bf2f(PS[(row0 + t) * PSW + C_SSM + g * 16 + c]); }
        __syncthreads();
#pragma unroll
        for (int i = 0; i < 8; ++i) { const int t = F.wave + 8 * i; float sr = 0.f, sii = 0.f;
#pragma unroll
            for (int c = 0; c < 16; ++c) { const float u = U[t * 16 + c]; sr += bre[c] * u; sii += bim[c] * u; }
            XR[t * 65 + p] = sr; XI[t * 65 + p] = sii; }
        __syncthreads();
        if (F.wave == 0) {
#pragma unroll 4
            for (int t = 0; t < 64; ++t) { const float nr = are * xr - aim * xi + XR[t * 65 + p], ni = are * xi + aim * xr + XI[t * 65 + p]; xr = nr; xi = ni; XR[t * 65 + p] = xr; XI[t * 65 + p] = xi; }
        }
        __syncthreads();
        { const int t = tid >> 3, c2 = (tid & 7) * 2;
#pragma unroll
          for (int q = 0; q < 2; ++q) { const int c = c2 + q; float y = 0.f;
#pragma unroll 4
              for (int pp = 0; pp < 64; ++pp) y += CR[c * 64 + pp] * XR[t * 65 + pp] - CI[c * 64 + pp] * XI[t * 65 + pp];
              y += dsk[c] * U[t * 16 + c];
              PS[(row0 + t) * PSW + C_SSM + g * 16 + c] = (bf16)f2bf(gelu_tanh(y)); } }
        __syncthreads();
    }
}
typedef short bf16x8_t __attribute__((ext_vector_type(8)));
typedef float f32x16 __attribute__((ext_vector_type(16)));
typedef short v4i16_t __attribute__((ext_vector_type(4)));
typedef __bf16 bf16x2_t __attribute__((ext_vector_type(2)));
typedef float f32x2_t __attribute__((ext_vector_type(2)));
__device__ __forceinline__ unsigned cvtpk(float lo, float hi) { f32x2_t v = {lo, hi}; bf16x2_t b = __builtin_convertvector(v, bf16x2_t); return __builtin_bit_cast(unsigned, b); }
__device__ __forceinline__ v4i16_t ds_tr16(const unsigned char* p) { return __builtin_amdgcn_ds_read_tr16_b64_v4i16((LAS v4i16_t*)p); }
__device__ __forceinline__ int crow16(int g, int hh) { return (g & 3) + 8 * (g >> 2) + 4 * hh; }

constexpr int ATT_VS = 96;
constexpr int ATT_ITEMS = BATCH * 6 * 16;

__device__ __forceinline__ void attn_v2(const KA& A, const Ctx& F, int blk, int nblk) {
    bf16* PS = (bf16*)(F.ws + WS_PS); float* LSE = (float*)(F.ws + WS_LSE);
    unsigned char* VI = F.lds;
    const int lane = F.lane, q = lane & 31, hh = lane >> 5, w = F.wave;
#pragma unroll 1
    for (int item = blk; item < ATT_ITEMS; item += nblk) {
        const int idx16 = item & 15, h = (item >> 4) % 6, b = item / 96;
        const int g = h >> 1, dsh = 2 * g, dil = 1 << dsh;
        const int bpr = 16 >> dsh, r = idx16 / bpr, i0 = (idx16 % bpr) * 256;
        const size_t tb = (size_t)b * SEQ + r;
#pragma unroll
        for (int ps = 0; ps < 6; ++ps) { const int row = (F.tid >> 3) + 64 * ps, ch = F.tid & 7; int ki = i0 - 128 + row; ki = ki < 0 ? 0 : ki;
            const v4u v = *(const v4u*)(PS + (tb + (size_t)ki * dil) * PSW + C_V + h * 64 + ch * 8);
            *(v4u*)(VI + (row * ATT_VS + ch * 8) * 2) = v; }
        bf16x8_t qf[4];
        { const bf16* qp = PS + (tb + (size_t)(i0 + 32 * w + q) * dil) * PSW + C_Q + h * 64 + 8 * hh;
#pragma unroll
          for (int s = 0; s < 4; ++s) qf[s] = *(const bf16x8_t*)(qp + 16 * s); }
        f32x16 p[5];
#pragma unroll
        for (int kt = 0; kt < 5; ++kt) {
            int ki = i0 + 32 * w - 128 + 32 * kt + q; ki = ki < 0 ? 0 : ki;
            const bf16* kp = PS + (tb + (size_t)ki * dil) * PSW + C_K + h * 64 + 8 * hh;
            bf16x8_t kf[4];
#pragma unroll
            for (int s = 0; s < 4; ++s) kf[s] = *(const bf16x8_t*)(kp + 16 * s);
            f32x16 acc = {};
#pragma unroll
            for (int s = 0; s < 4; ++s) acc = __builtin_amdgcn_mfma_f32_32x32x16_bf16(kf[s], qf[s], acc, 0, 0, 0);
            p[kt] = acc;
        }
        const int kbase = i0 + 32 * w - 128;
        float mx = -3.0e38f;
#pragma unroll
        for (int kt = 0; kt < 5; ++kt)
#pragma unroll
            for (int gq = 0; gq < 16; ++gq) { const int kl = crow16(gq, hh); const int dist = q + 128 - 32 * kt - kl;
                const bool ok = (dist >= 0) && (dist <= 128) && (kbase + 32 * kt + kl >= 0);
                const float s = ok ? p[kt][gq] : -3.0e38f; p[kt][gq] = s; mx = fmaxf(mx, s); }
        mx = xmax32(mx);
        const float sc = 0.125f * 1.4426950408889634f;
        float l = 0.f;
#pragma unroll
        for (int kt = 0; kt < 5; ++kt)
#pragma unroll
            for (int gq = 0; gq < 16; ++gq) { const float e = __builtin_amdgcn_exp2f((p[kt][gq] - mx) * sc); p[kt][gq] = e; l += e; }
        l = xsum32(l);
        __syncthreads();
        f32x16 o[2]; o[0] = f32x16{}; o[1] = f32x16{};
        const unsigned char* vb = VI + ((32 * w + 4 * hh + ((lane & 15) >> 2)) * ATT_VS + 16 * ((lane >> 4) & 1) + 4 * (lane & 3)) * 2;
#pragma unroll
        for (int kt = 0; kt < 5; ++kt)
#pragma unroll
            for (int s = 0; s < 2; ++s) {
                v4u pw; pw.x = cvtpk(p[kt][8 * s + 0], p[kt][8 * s + 1]); pw.y = cvtpk(p[kt][8 * s + 2], p[kt][8 * s + 3]); pw.z = cvtpk(p[kt][8 * s + 4], p[kt][8 * s + 5]); pw.w = cvtpk(p[kt][8 * s + 6], p[kt][8 * s + 7]);
                const bf16x8_t pb = __builtin_bit_cast(bf16x8_t, pw);
#pragma unroll
                for (int dt = 0; dt < 2; ++dt) {
                    const unsigned char* vp = vb + ((32 * kt + 16 * s) * ATT_VS + 32 * dt) * 2;
                    const v4i16_t lo = ds_tr16(vp), hi = ds_tr16(vp + 8 * ATT_VS * 2);
                    const bf16x8_t va = (bf16x8_t){lo[0], lo[1], lo[2], lo[3], hi[0], hi[1], hi[2], hi[3]};
                    o[dt] = __builtin_amdgcn_mfma_f32_32x32x16_bf16(va, pb, o[dt], 0, 0, 0);
                }
            }
        const float il = 1.0f / l;
        bf16* op = PS + (tb + (size_t)(i0 + 32 * w + q) * dil) * PSW + C_Q + h * 64 + 4 * hh;
#pragma unroll
        for (int dt = 0; dt < 2; ++dt)
#pragma unroll
            for (int g4 = 0; g4 < 4; ++g4) { v2u wv; wv.x = cvtpk(o[dt][4 * g4 + 0] * il, o[dt][4 * g4 + 1] * il); wv.y = cvtpk(o[dt][4 * g4 + 2] * il, o[dt][4 * g4 + 3] * il);
                *(v2u*)(op + 32 * dt + 8 * g4) = wv; }
        if (hh == 0) LSE[(tb + (size_t)(i0 + 32 * w + q) * dil) * 6 + h] = mx * 0.125f + __logf(l);
        __syncthreads();
    }
}
constexpr int TS = 72;
constexpr int RL_A = 0, RL_B = 9216, RL_K = 18432, RL_R = 27648, RL_AT = 36864, RL_VT = 46080, RL_BHT = 55296, RL_KHT = 64512,
              RL_AAK = 73728, RL_ARB = 82944, RL_ARK = 92160, RL_AABF = 101376, RL_TF = 117760, RL_PB = 134144;
constexpr int RL_TB = RL_A, RL_XT = RL_B, RL_WT = RL_K, RL_UT = RL_AAK;
constexpr int RL_WLF = 73728, RL_ALF = 90112, RL_GF = 106496, RL_LW = 122880;
static_assert(RL_LW + 16384 <= LDS_BYTES && RL_PB + 3072 <= LDS_BYTES, "rwkv LDS map");
constexpr int RW_ITEMS = BATCH * 6 * 64;
#ifndef SEC
#define SEC 0xFFFF
#endif

__device__ __forceinline__ bf16x8_t ldfrag(const unsigned char* tile, int row, int s, int hh) { return *(const bf16x8_t*)(tile + (row * TS + 16 * s + 8 * hh) * 2); }
__device__ __forceinline__ f32x16 mm64(f32x16 acc, const unsigned char* At, int arow0, const unsigned char* Bt, int brow0, int ks, int lane) {
    const int r = lane & 31, hh = lane >> 5;
#pragma unroll
    for (int s = 0; s < 4; ++s) if (s < ks) acc = __builtin_amdgcn_mfma_f32_32x32x16_bf16(ldfrag(At, arow0 + r, s, hh), ldfrag(Bt, brow0 + r, s, hh), acc, 0, 0, 0);
    return acc;
}
__device__ __forceinline__ void st_tileT(unsigned char* tile, int ncol, int m0, const f32x16& acc, int hh) {
#pragma unroll
    for (int g4 = 0; g4 < 4; ++g4) { v2u wv; wv.x = cvtpk(acc[4 * g4 + 0], acc[4 * g4 + 1]); wv.y = cvtpk(acc[4 * g4 + 2], acc[4 * g4 + 3]);
        *(v2u*)(tile + (ncol * TS + m0 + 8 * g4 + 4 * hh) * 2) = wv; }
}
__device__ __forceinline__ bf16x8_t pack8(const float (&z)[8]) { v4u pw; pw.x = cvtpk(z[0], z[1]); pw.y = cvtpk(z[2], z[3]); pw.z = cvtpk(z[4], z[5]); pw.w = cvtpk(z[6], z[7]); return __builtin_bit_cast(bf16x8_t, pw); }
__device__ __forceinline__ void unpack8(const v4u w, float (&z)[8]) { z[0] = bflo(w.x); z[1] = bfhi(w.x); z[2] = bflo(w.y); z[3] = bfhi(w.y); z[4] = bflo(w.z); z[5] = bfhi(w.z); z[6] = bflo(w.w); z[7] = bfhi(w.w); }

template <int ACT> __device__ __forceinline__ bf16x8_t lora_frag(const bf16* PS, size_t grow, bool first, int jcol, const float* mix) {
    float c[8], p[8];
    unpack8(*(const v4u*)(PS + grow * PSW + C_LORA + jcol), c);
    if (first) {
#pragma unroll
        for (int e = 0; e < 8; ++e) p[e] = 0.f;
    } else unpack8(*(const v4u*)(PS + (grow - 1) * PSW + C_LORA + jcol), p);
    const f32x4 m0 = *(const f32x4*)(mix + 1152 + jcol), m1 = *(const f32x4*)(mix + 1152 + jcol + 4);
    float z[8];
#pragma unroll
    for (int e = 0; e < 8; ++e) { const float mm = e < 4 ? m0[e] : m1[e - 4]; float v = c[e] + (p[e] - c[e]) * mm;
        if (ACT == 1) v = 1.0f - 2.0f / (__expf(2.0f * v) + 1.0f); else if (ACT == 2) v = sigm(v);
        z[e] = v; }
    return pack8(z);
}

__device__ __forceinline__ void rwkv_p1(const KA& A, const Ctx& F, int l) {
    bf16* PS = (bf16*)(F.ws + WS_PS); const bf16* BRB = (const bf16*)(F.ws + WS_BR);
    unsigned char* L = F.lds;
    unsigned char* wl = F.ws + WS_W + (size_t)l * W_LAYER;
    const bf16* W2T = (const bf16*)(wl + WO_W2); const bf16* A2T = (const bf16*)(wl + WO_A2); const bf16* G2T = (const bf16*)(wl + WO_G2);
    const float* mix = A.in(3) + (size_t)l * 1408;
    int tid = F.tid, lane = F.lane, r32 = lane & 31, hh = lane >> 5; const int w = F.wave;
#define RW_FENCE() do { __syncthreads(); asm volatile("" : "+v"(tid)); lane = tid & 63; r32 = lane & 31; hh = lane >> 5; hc = h * 64 + lane; } while (0)
#pragma unroll 1
    for (int item = F.bid; item < RW_ITEMS; item += F.G) {
        const int j = item & 63, h = (item >> 6) % 6, b = item / 384;
        const size_t row0 = (size_t)b * SEQ + 64 * j;
        int hc = h * 64 + lane;
        if (SEC & 1) {
            const int tl = (w & 3), ct = tl >> 1, tt = tl & 1;
            const size_t grow = row0 + 32 * tt + r32; const bool first = (j == 0) && (tt == 0) && (r32 == 0);
            if (w < 4) {
                f32x16 acc = {};
#pragma unroll
                for (int s = 0; s < 8; ++s) { const bf16x8_t af = *(const bf16x8_t*)(G2T + (size_t)(h * 64 + 32 * ct + r32) * 128 + 16 * s + 8 * hh);
                    acc = __builtin_amdgcn_mfma_f32_32x32x16_bf16(af, lora_frag<2>(PS, grow, first, 128 + 16 * s + 8 * hh, mix), acc, 0, 0, 0); }
                float* G = (float*)(L + RL_GF);
#pragma unroll
                for (int g4 = 0; g4 < 4; ++g4) *(f32x4*)(G + (32 * tt + r32) * 64 + 32 * ct + 8 * g4 + 4 * hh) = (f32x4){acc[4 * g4], acc[4 * g4 + 1], acc[4 * g4 + 2], acc[4 * g4 + 3]};
            } else {
                f32x16 accw = {}, acca = {};
#pragma unroll
                for (int s = 0; s < 4; ++s) {
                    const bf16x8_t wf = *(const bf16x8_t*)(W2T + (size_t)(h * 64 + 32 * ct + r32) * 64 + 16 * s + 8 * hh);
                    const bf16x8_t af = *(const bf16x8_t*)(A2T + (size_t)(h * 64 + 32 * ct + r32) * 64 + 16 * s + 8 * hh);
                    accw = __builtin_amdgcn_mfma_f32_32x32x16_bf16(wf, lora_frag<1>(PS, grow, first, 16 * s + 8 * hh, mix), accw, 0, 0, 0);
                    acca = __builtin_amdgcn_mfma_f32_32x32x16_bf16(af, lora_frag<0>(PS, grow, first, 64 + 16 * s + 8 * hh, mix), acca, 0, 0, 0); }
                float* WLp = (float*)(L + RL_WLF); float* ALp = (float*)(L + RL_ALF);
#pragma unroll
                for (int g4 = 0; g4 < 4; ++g4) { const int o = (32 * tt + r32) * 64 + 32 * ct + 8 * g4 + 4 * hh;
                    *(f32x4*)(WLp + o) = (f32x4){accw[4 * g4], accw[4 * g4 + 1], accw[4 * g4 + 2], accw[4 * g4 + 3]};
                    *(f32x4*)(ALp + o) = (f32x4){acca[4 * g4], acca[4 * g4 + 1], acca[4 * g4 + 2], acca[4 * g4 + 3]}; }
            }
        }
        float rr[8], kn[8], vv[8], kk[8], bb[8], eadd[8];
        {
            const float mr = mix[hc], mk = mix[384 + hc], mv = mix[768 + hc];
#pragma unroll
            for (int i = 0; i < 8; ++i) { const int t = w + 8 * i; const size_t g = row0 + t;
                const bf16* cp = PS + g * PSW + C_RW + hc;
                const float cr = bf2f(cp[0]), ck = bf2f(cp[384]), cv = bf2f(cp[768]);
                float pr, pk, pv;
                if (t == 0) { if (j == 0) { pr = 0.f; pk = 0.f; pv = 0.f; } else { const bf16* bp = BRB + (size_t)(b * 64 + j - 1) * PSW + C_RW + hc; pr = bf2f(bp[0]); pk = bf2f(bp[384]); pv = bf2f(bp[768]); } }
                else { const bf16* pp = cp - PSW; pr = bf2f(pp[0]); pk = bf2f(pp[384]); pv = bf2f(pp[768]); }
                rr[i] = cr + (pr - cr) * mr; kn[i] = ck + (pk - ck) * mk; vv[i] = cv + (pv - cv) * mv; }
        }
        RW_FENCE();
        if (SEC & 2) {
            const float* WLp = (const float*)(L + RL_WLF); const float* ALp = (const float*)(L + RL_ALF); const float* G = (const float*)(L + RL_GF); float* LW = (float*)(L + RL_LW);
            const float w0c = A.in(4)[l * 384 + hc], a0c = A.in(6)[l * 384 + hc], kkc = A.in(9)[l * 384 + hc], kac = A.in(10)[l * 384 + hc], rkc = A.in(11)[l * 384 + hc];
            const float lnw = A.in(12)[l * 384 + hc], lnb = A.in(13)[l * 384 + hc];
            bf16* EM = (bf16*)(F.ws + WS_REM) + (size_t)item * 4096;
#pragma unroll
            for (int i = 0; i < 8; ++i) { const int t = w + 8 * i; const int o = t * 64 + lane;
                const float x = -(w0c + WLp[o]); const float sp = (x > 20.f) ? x : log1pf(__expf(x)); const float wv = -sp - 0.5f;
                LW[o] = -__expf(wv);
                const float av = sigm(a0c + ALp[o]); const float gv = G[o];
                float kq = kn[i] * kkc; const float nrm = sqrtf(wave_sum(kq * kq)); kq = kq / fmaxf(nrm, 1e-12f);
                const float knew = kn[i] * (1.0f + (av - 1.0f) * kac);
                const float bon = wave_sum(rr[i] * knew * rkc);
                kk[i] = kq; bb[i] = kq * av; kn[i] = knew;
                EM[o] = (bf16)f2bf(lnw * gv); eadd[i] = (lnb + bon * vv[i]) * gv; }
        }
        RW_FENCE();
        if ((SEC & 4) && w == 0) { float* LW = (float*)(L + RL_LW); float c[64];
#pragma unroll
            for (int t = 0; t < 64; ++t) c[t] = LW[t * 64 + lane];
#pragma unroll
            for (int t = 1; t < 64; ++t) c[t] += c[t - 1];
#pragma unroll
            for (int t = 0; t < 64; ++t) LW[t * 64 + lane] = c[t];
            ((float*)(F.ws + WS_RGL))[(size_t)item * 64 + lane] = __expf(c[63]); }
        RW_FENCE();
        if (SEC & 8) {
            const float* CU = (const float*)(L + RL_LW); const float cl = CU[63 * 64 + lane];
            bf16* At = (bf16*)(L + RL_A), *Bt = (bf16*)(L + RL_B), *Kt = (bf16*)(L + RL_K), *Rt = (bf16*)(L + RL_R);
            bf16* ATt = (bf16*)(L + RL_AT), *VTt = (bf16*)(L + RL_VT), *BHt = (bf16*)(L + RL_BHT), *KHt = (bf16*)(L + RL_KHT);
#pragma unroll
            for (int i = 0; i < 8; ++i) { const int t = w + 8 * i;
                const float ct = CU[t * 64 + lane], cp = (t == 0) ? 0.f : CU[(t - 1) * 64 + lane];
                const float ep = __expf(cp), et = __expf(ct), ei = __expf(-ct), eh = __expf(cl - ct);
                const bf16 av = (bf16)f2bf(-kk[i] * ep);
                At[t * TS + lane] = av; ATt[lane * TS + t] = av;
                Rt[t * TS + lane] = (bf16)f2bf(rr[i] * et);
                Bt[t * TS + lane] = (bf16)f2bf(bb[i] * ei); Kt[t * TS + lane] = (bf16)f2bf(kn[i] * ei);
                VTt[lane * TS + t] = (bf16)f2bf(vv[i]); BHt[lane * TS + t] = (bf16)f2bf(bb[i] * eh); KHt[lane * TS + t] = (bf16)f2bf(kn[i] * eh); }
        }
        RW_FENCE();
#pragma unroll
        for (int rep = 0; rep < ((SEC & 16) ? 2 : 0); ++rep) { const int job = w + 8 * rep, prod = job >> 2, tt = (job >> 1) & 1, st = job & 1;
            f32x16 acc = {};
            acc = mm64(acc, L + ((prod & 1) ? RL_K : RL_B), 32 * st, L + ((prod & 2) ? RL_R : RL_A), 32 * tt, 4, lane);
            const int t = 32 * tt + r32; const int incl = prod >> 1;
#pragma unroll
            for (int g = 0; g < 16; ++g) { const int s = 32 * st + crow16(g, hh); if (!(s < t + incl)) acc[g] = 0.f; }
            if (prod == 0) { float* AF = (float*)(L + RL_AABF);
#pragma unroll
                for (int g4 = 0; g4 < 4; ++g4) *(f32x4*)(AF + t * 64 + 32 * st + 8 * g4 + 4 * hh) = (f32x4){acc[4 * g4], acc[4 * g4 + 1], acc[4 * g4 + 2], acc[4 * g4 + 3]};
            } else st_tileT(L + (prod == 1 ? RL_AAK : (prod == 2 ? RL_ARB : RL_ARK)), t, 32 * st, acc, hh);
        }
        RW_FENCE();
        if (SEC & 32) {
            const float* AF = (const float*)(L + RL_AABF); float* TF = (float*)(L + RL_TF); float* PB = (float*)(L + RL_PB);
            if (w == 0) {
                const int I = lane >> 4, jc = lane & 15; float x[16];
#pragma unroll
                for (int r = 0; r < 16; ++r) { float s = (r == jc) ? 1.f : 0.f;
#pragma unroll
                    for (int q = 0; q < 16; ++q) if (q < r) s += AF[(16 * I + r) * 64 + 16 * I + q] * x[q];
                    x[r] = s; TF[(16 * I + r) * 64 + 16 * I + jc] = s; }
            } else if (w >= 4) { const int tl = w - 4, tt = tl >> 1, it = tl & 1;
                f32x16 acc = {};
                acc = mm64(acc, L + RL_AAK, 32 * tt, L + RL_VT, 32 * it, tt ? 4 : 2, lane);
                st_tileT(L + RL_XT, 32 * it + r32, 32 * tt, acc, hh); }
            RW_FENCE();
#pragma unroll 1
            for (int dist = 1; dist < 4; ++dist) { const int nb = 4 - dist;
                for (int o = tid; o < nb * 256; o += NTHREADS) { const int J = o >> 8, I = J + dist, rw = (o >> 4) & 15, cc = o & 15; float s = 0.f;
                    for (int Kb = J; Kb < I; ++Kb)
#pragma unroll
                        for (int m = 0; m < 16; ++m) s += AF[(16 * I + rw) * 64 + 16 * Kb + m] * TF[(16 * Kb + m) * 64 + 16 * J + cc];
                    PB[o] = s; }
                __syncthreads();
                for (int o = tid; o < nb * 256; o += NTHREADS) { const int J = o >> 8, I = J + dist, rw = (o >> 4) & 15, cc = o & 15; float s = 0.f;
#pragma unroll
                    for (int m = 0; m < 16; ++m) s += TF[(16 * I + rw) * 64 + 16 * I + m] * PB[(J << 8) + m * 16 + cc];
                    TF[(16 * I + rw) * 64 + 16 * J + cc] = s; }
                __syncthreads();
            }
            bf16* TB = (bf16*)(L + RL_TB);
#pragma unroll
            for (int e = 0; e < 8; ++e) { const int o = tid + NTHREADS * e, t = o >> 6, s = o & 63; TB[t * TS + s] = ((s >> 4) > (t >> 4)) ? (bf16)0 : (bf16)f2bf(TF[o]); }
        }
        RW_FENCE();
        if (SEC & 64) { const int mat = w >> 2, tl = w & 3, tt = tl >> 1, nt = tl & 1;
          f32x16 acc = {};
          acc = mm64(acc, L + RL_TB, 32 * tt, L + (mat ? RL_XT : RL_AT), 32 * nt, tt ? 4 : 2, lane);
          st_tileT(L + (mat ? RL_UT : RL_WT), 32 * nt + r32, 32 * tt, acc, hh); }
        RW_FENCE();
        if (SEC & 128) { const int tl = w & 3, ta = tl >> 1, tb2 = tl & 1;
          if (w < 4) {
              f32x16 acc = {};
              acc = mm64(acc, L + RL_WT, 32 * ta, L + RL_BHT, 32 * tb2, 4, lane);
              bf16* MC = (bf16*)(F.ws + WS_RMC) + (size_t)item * 4096;
#pragma unroll
              for (int g4 = 0; g4 < 4; ++g4) { v2u wv; wv.x = cvtpk(acc[4 * g4], acc[4 * g4 + 1]); wv.y = cvtpk(acc[4 * g4 + 2], acc[4 * g4 + 3]); *(v2u*)(MC + (32 * tb2 + r32) * 64 + 32 * ta + 8 * g4 + 4 * hh) = wv; }
              f32x16 an = {};
              an = mm64(an, L + RL_BHT, 32 * ta, L + RL_UT, 32 * tb2, 4, lane);
              an = mm64(an, L + RL_KHT, 32 * ta, L + RL_VT, 32 * tb2, 4, lane);
              bf16* NT = (bf16*)(F.ws + WS_RNT) + (size_t)item * 4096;
#pragma unroll
              for (int g4 = 0; g4 < 4; ++g4) { v2u wv; wv.x = cvtpk(an[4 * g4], an[4 * g4 + 1]); wv.y = cvtpk(an[4 * g4 + 2], an[4 * g4 + 3]); *(v2u*)(NT + (32 * tb2 + r32) * 64 + 32 * ta + 8 * g4 + 4 * hh) = wv; }
          } else {
              f32x16 acc = {};
              acc = mm64(acc, L + RL_WT, 32 * ta, L + RL_ARB, 32 * tb2, tb2 ? 4 : 2, lane);
              const int t = 32 * tb2 + r32; const bf16* Rt = (const bf16*)(L + RL_R);
              bf16* qd = PS + (row0 + t) * PSW + C_RW + h * 64;
#pragma unroll
              for (int g4 = 0; g4 < 4; ++g4) { const int c0 = 32 * ta + 8 * g4 + 4 * hh; const v2u rv = *(const v2u*)(Rt + t * TS + c0);
                  v2u wv; wv.x = cvtpk(acc[4 * g4] + bflo(rv.x), acc[4 * g4 + 1] + bfhi(rv.x)); wv.y = cvtpk(acc[4 * g4 + 2] + bflo(rv.y), acc[4 * g4 + 3] + bfhi(rv.y)); *(v2u*)(qd + c0) = wv; }
              f32x16 ay = {};
              ay = mm64(ay, L + RL_UT, 32 * ta, L + RL_ARB, 32 * tb2, tb2 ? 4 : 2, lane);
              ay = mm64(ay, L + RL_VT, 32 * ta, L + RL_ARK, 32 * tb2, tb2 ? 4 : 2, lane);
              bf16* yd = PS + (row0 + t) * PSW + C_RW + 384 + h * 64;
#pragma unroll
              for (int g4 = 0; g4 < 4; ++g4) { v2u wv; wv.x = cvtpk(ay[4 * g4], ay[4 * g4 + 1]); wv.y = cvtpk(ay[4 * g4 + 2], ay[4 * g4 + 3]); *(v2u*)(yd + 32 * ta + 8 * g4 + 4 * hh) = wv; }
          }
#pragma unroll
          for (int i = 0; i < 8; ++i) { const int t = w + 8 * i; PS[(row0 + t) * PSW + C_RW + 768 + hc] = (bf16)f2bf(eadd[i]); }
        }
        RW_FENCE();
    }
}
#undef RW_FENCE

__device__ __forceinline__ void rwkv_scan(const KA& A, const Ctx& F, int l, int b, int h) {
    bf16* PS = (bf16*)(F.ws + WS_PS);
    unsigned char* L = F.lds;
    const int tid = F.tid, lane = F.lane, w = F.wave, r32 = lane & 31, hh = lane >> 5;
    for (int o = tid; o < 2 * 9216 / 4; o += NTHREADS) ((unsigned*)L)[o] = 0u;
    __syncthreads();
    const int ta = (w >> 1) & 1, tb2 = w & 1;
    f32x16 Hacc = {};
#pragma unroll 1
    for (int j = 0; j < 64; ++j) {
        const int item = (b * 6 + h) * 64 + j; const size_t row0 = (size_t)b * SEQ + 64 * j;
        const unsigned char* HBc = L + (j & 1) * 9216; unsigned char* HBn = L + ((j + 1) & 1) * 9216;
        if (w < 4) {
            const bf16* MC = (const bf16*)(F.ws + WS_RMC) + (size_t)item * 4096; const bf16* NT = (const bf16*)(F.ws + WS_RNT) + (size_t)item * 4096; const float* GL = (const float*)(F.ws + WS_RGL) + (size_t)item * 64;
            bf16x8_t mf[4];
#pragma unroll
            for (int s = 0; s < 4; ++s) mf[s] = *(const bf16x8_t*)(MC + (32 * ta + r32) * 64 + 16 * s + 8 * hh);
#pragma unroll
            for (int g4 = 0; g4 < 4; ++g4) { const int c0 = 32 * ta + 8 * g4 + 4 * hh; const f32x4 gl = *(const f32x4*)(GL + c0); const v2u nv = *(const v2u*)(NT + (32 * tb2 + r32) * 64 + c0);
                Hacc[4 * g4 + 0] = Hacc[4 * g4 + 0] * gl[0] + bflo(nv.x); Hacc[4 * g4 + 1] = Hacc[4 * g4 + 1] * gl[1] + bfhi(nv.x); Hacc[4 * g4 + 2] = Hacc[4 * g4 + 2] * gl[2] + bflo(nv.y); Hacc[4 * g4 + 3] = Hacc[4 * g4 + 3] * gl[3] + bfhi(nv.y); }
#pragma unroll
            for (int s = 0; s < 4; ++s) Hacc = __builtin_amdgcn_mfma_f32_32x32x16_bf16(mf[s], ldfrag(HBc, 32 * tb2 + r32, s, hh), Hacc, 0, 0, 0);
            st_tileT(HBn, 32 * tb2 + r32, 32 * ta, Hacc, hh);
        } else if (w < 6) {
            const int t = 32 * tb2 + r32;
            const bf16* qd = PS + (row0 + t) * PSW + C_RW + h * 64; const bf16* yd = qd + 384; const bf16* ed = qd + 768; const bf16* EM = (const bf16*)(F.ws + WS_REM) + (size_t)item * 4096 + t * 64;
            bf16x8_t qf[4];
#pragma unroll
            for (int s = 0; s < 4; ++s) qf[s] = *(const bf16x8_t*)(qd + 16 * s + 8 * hh);
            f32x16 y[2];
#pragma unroll
            for (int it = 0; it < 2; ++it) {
#pragma unroll
                for (int g4 = 0; g4 < 4; ++g4) { const v2u yv = *(const v2u*)(yd + 32 * it + 8 * g4 + 4 * hh); y[it][4 * g4] = bflo(yv.x); y[it][4 * g4 + 1] = bfhi(yv.x); y[it][4 * g4 + 2] = bflo(yv.y); y[it][4 * g4 + 3] = bfhi(yv.y); }
#pragma unroll
                for (int s = 0; s < 4; ++s) y[it] = __builtin_amdgcn_mfma_f32_32x32x16_bf16(ldfrag(HBc, 32 * it + r32, s, hh), qf[s], y[it], 0, 0, 0);
            }
            float s1 = 0.f, s2 = 0.f;
#pragma unroll
            for (int it = 0; it < 2; ++it)
#pragma unroll
                for (int g = 0; g < 16; ++g) { s1 += y[it][g]; s2 += y[it][g] * y[it][g]; }
            s1 = xsum32(s1); s2 = xsum32(s2);
            const float mu = s1 * (1.0f / 64.0f); const float var = fmaxf(s2 * (1.0f / 64.0f) - mu * mu, 0.f); const float rs = 1.0f / sqrtf(var + GN_EPS);
            bf16* od = PS + (row0 + t) * PSW + C_RW + h * 64;
#pragma unroll
            for (int it = 0; it < 2; ++it)
#pragma unroll
                for (int g4 = 0; g4 < 4; ++g4) { const int i0 = 32 * it + 8 * g4 + 4 * hh; const v2u em = *(const v2u*)(EM + i0); const v2u ea = *(const v2u*)(ed + i0);
                    v2u wv; wv.x = cvtpk((y[it][4 * g4] - mu) * rs * bflo(em.x) + bflo(ea.x), (y[it][4 * g4 + 1] - mu) * rs * bfhi(em.x) + bfhi(ea.x));
                    wv.y = cvtpk((y[it][4 * g4 + 2] - mu) * rs * bflo(em.y) + bflo(ea.y), (y[it][4 * g4 + 3] - mu) * rs * bfhi(em.y) + bfhi(ea.y));
                    *(v2u*)(od + i0) = wv; }
        }
        __syncthreads();
    }
}
constexpr size_t SSG_TM = 0, SSG_GM = 131072, SSG_HM = 196608, SSG_LAM = 262144, SSG_BYTES = 263168;
constexpr size_t WS_SSM = WS_RGL + 1 * MiB;
static_assert(WS_SSM + 32 * SSG_BYTES <= 512 * MiB, "ssm matrices fit the workspace");
constexpr int ZS = 132;

__device__ __forceinline__ void ssm_prep(const KA& A, const Ctx& F, int l, int g) {
    float* L = (float*)F.lds;
    float* PWr = L, *PWi = L + 17 * 64, *BBr = L + 2 * 17 * 64, *BBi = BBr + 1024, *CCr = BBi + 1024, *CCi = CCr + 1024, *KE = CCi + 1024;
    unsigned char* base = F.ws + WS_SSM + (size_t)(l * 16 + g) * SSG_BYTES;
    const int tid = F.tid;
    __syncthreads();
    if (tid < 64) { const int p = tid;
        const float step = __expf(A.in(16)[l * 16 + g]);
        const float lr = A.in(14)[(size_t)l * 1024 + g * 64 + p], li = A.in(15)[(size_t)l * 1024 + g * 64 + p];
        const float ang = li * step;
        for (int m = 0; m <= 16; ++m) { float sn, cs; sincosf(ang * (float)m, &sn, &cs); const float mg = __expf(lr * step * (float)m); PWr[m * 64 + p] = mg * cs; PWi[m * 64 + p] = mg * sn; }
        const float are = PWr[64 + p], aim = PWi[64 + p];
        const float inv = 1.0f / (lr * lr + li * li);
        const float fre = ((are - 1.0f) * lr + aim * li) * inv, fim = (aim * lr - (are - 1.0f) * li) * inv;
        const float* br = A.in(17) + (size_t)l * 16384 + (size_t)(g * 64 + p) * 16, *bi = A.in(18) + (size_t)l * 16384 + (size_t)(g * 64 + p) * 16;
        for (int c = 0; c < 16; ++c) { BBr[p * 16 + c] = fre * br[c] - fim * bi[c]; BBi[p * 16 + c] = fre * bi[c] + fim * br[c]; }
        float* lam = (float*)(base + SSG_LAM); lam[p] = PWr[16 * 64 + p]; lam[64 + p] = PWi[16 * 64 + p];
    }
    for (int e = tid; e < 1024; e += NTHREADS) { CCr[e] = A.in(19)[(size_t)l * 16384 + g * 1024 + e]; CCi[e] = A.in(20)[(size_t)l * 16384 + g * 1024 + e]; }
    __syncthreads();
    for (int e = tid; e < 4096; e += NTHREADS) { const int tau = e >> 8, c = (e >> 4) & 15, cp = e & 15; float s = 0.f;
        for (int p = 0; p < 64; ++p) { const float wr = CCr[c * 64 + p] * PWr[tau * 64 + p] - CCi[c * 64 + p] * PWi[tau * 64 + p], wi = CCr[c * 64 + p] * PWi[tau * 64 + p] + CCi[c * 64 + p] * PWr[tau * 64 + p];
            s += wr * BBr[p * 16 + cp] - wi * BBi[p * 16 + cp]; }
        KE[e] = s; }
    __syncthreads();
    const float* dsk = A.in(21) + l * 256 + g * 16;
    bf16* TM = (bf16*)(base + SSG_TM); bf16* GM = (bf16*)(base + SSG_GM); bf16* HM = (bf16*)(base + SSG_HM);
    for (int e = tid; e < 65536; e += NTHREADS) { const int n = e >> 8, k = e & 255, tp = n >> 4, c = n & 15, sp = k >> 4, cp = k & 15;
        float v = (sp <= tp) ? KE[((tp - sp) << 8) + (c << 4) + cp] : 0.f; if (sp == tp && c == cp) v += dsk[c];
        TM[e] = (bf16)f2bf(v); }
    for (int e = tid; e < 32768; e += NTHREADS) { const int n = e >> 8, k = e & 255, p = n & 63, im = n >> 6, sp = k >> 4, cp = k & 15, m = 15 - sp;
        const float wr = PWr[m * 64 + p] * BBr[p * 16 + cp] - PWi[m * 64 + p] * BBi[p * 16 + cp], wi = PWr[m * 64 + p] * BBi[p * 16 + cp] + PWi[m * 64 + p] * BBr[p * 16 + cp];
        GM[e] = (bf16)f2bf(im ? wi : wr); }
    for (int e = tid; e < 32768; e += NTHREADS) { const int n = e >> 7, k = e & 127, tp = n >> 4, c = n & 15, p = k & 63, im = k >> 6, m = tp + 1;
        const float wr = CCr[c * 64 + p] * PWr[m * 64 + p] - CCi[c * 64 + p] * PWi[m * 64 + p], wi = CCr[c * 64 + p] * PWi[m * 64 + p] + CCi[c * 64 + p] * PWr[m * 64 + p];
        HM[e] = (bf16)f2bf(im ? -wi : wr); }
    __syncthreads();
}

__device__ __forceinline__ void ssm_v2(const KA& A, const Ctx& F, int l, int b, int g) {
    bf16* PS = (bf16*)(F.ws + WS_PS);
    float* ZF = (float*)F.lds;
    const unsigned char* base = F.ws + WS_SSM + (size_t)(l * 16 + g) * SSG_BYTES;
    const bf16* TM = (const bf16*)(base + SSG_TM); const bf16* GM = (const bf16*)(base + SSG_GM); const bf16* HM = (const bf16*)(base + SSG_HM); const float* lam = (const float*)(base + SSG_LAM);
    const int lane = F.lane, w = F.wave, r32 = lane & 31, hh = lane >> 5;
    const size_t tok0 = (size_t)b * SEQ + 512 * w;
    bf16x8_t uf[16];
    { const bf16* up = PS + (tok0 + 16 * r32) * PSW + C_SSM + 16 * g + 8 * hh;
#pragma unroll
      for (int s = 0; s < 16; ++s) uf[s] = *(const bf16x8_t*)(up + (size_t)s * PSW); }
#pragma unroll 1
    for (int nt = 0; nt < 4; ++nt) {
        f32x16 acc = {};
        const bf16* gp = GM + (size_t)(32 * nt + r32) * 256 + 8 * hh;
#pragma unroll
        for (int s = 0; s < 16; ++s) acc = __builtin_amdgcn_mfma_f32_32x32x16_bf16(uf[s], *(const bf16x8_t*)(gp + 16 * s), acc, 0, 0, 0);
#pragma unroll
        for (int q = 0; q < 16; ++q) ZF[(32 * w + crow16(q, hh)) * ZS + 32 * nt + r32] = acc[q];
    }
    __syncthreads();
    if (w == 0) { const float lr = lam[lane], li = lam[64 + lane]; float xr = 0.f, xi = 0.f;
#pragma unroll 8
        for (int j = 0; j < 256; ++j) { const float zr = ZF[j * ZS + lane], zi = ZF[j * ZS + 64 + lane];
            ZF[j * ZS + lane] = xr; ZF[j * ZS + 64 + lane] = xi;
            const float nr = lr * xr - li * xi + zr, ni = lr * xi + li * xr + zi; xr = nr; xi = ni; } }
    __syncthreads();
    bf16x8_t xf[8];
    { const float* zp = ZF + (32 * w + r32) * ZS + 8 * hh;
#pragma unroll
      for (int s = 0; s < 8; ++s) { const f32x4 a0 = *(const f32x4*)(zp + 16 * s), a1 = *(const f32x4*)(zp + 16 * s + 4);
          v4u pw; pw.x = cvtpk(a0[0], a0[1]); pw.y = cvtpk(a0[2], a0[3]); pw.z = cvtpk(a1[0], a1[1]); pw.w = cvtpk(a1[2], a1[3]); xf[s] = __builtin_bit_cast(bf16x8_t, pw); } }
#pragma unroll
    for (int nt = 0; nt < 8; ++nt) {
        f32x16 acc = {};
        const bf16* tp = TM + (size_t)(32 * nt + r32) * 256 + 8 * hh; const bf16* hp = HM + (size_t)(32 * nt + r32) * 128 + 8 * hh;
#pragma unroll
        for (int s = 0; s < 16; ++s) if (s <= 2 * nt + 1) acc = __builtin_amdgcn_mfma_f32_32x32x16_bf16(uf[s], *(const bf16x8_t*)(tp + 16 * s), acc, 0, 0, 0);
#pragma unroll
        for (int s = 0; s < 8; ++s) acc = __builtin_amdgcn_mfma_f32_32x32x16_bf16(xf[s], *(const bf16x8_t*)(hp + 16 * s), acc, 0, 0, 0);
        bf16* op = PS + (tok0 + 2 * nt + (r32 >> 4)) * PSW + C_SSM + 16 * g + (r32 & 15);
#pragma unroll
        for (int q = 0; q < 16; ++q) op[(size_t)(16 * crow16(q, hh)) * PSW] = (bf16)f2bf(gelu_tanh(acc[q]));
    }
    __syncthreads();
}
constexpr int PPL = 10, NPH = 2 + DEPTH * PPL;

__device__ __forceinline__ void run_phase(const KA& A, const Ctx& F, int ph) {
    PG8_LAS unsigned char* lds3 = (PG8_LAS unsigned char*)F.lds;
    bf16* XN = (bf16*)(F.ws + WS_XN); bf16* PS = (bf16*)(F.ws + WS_PS); bf16* SO = (bf16*)(F.ws + WS_SO);
    const int l = (ph - 1) / PPL, k = (ph == 0) ? 20 : (ph == NPH - 1 ? 21 : (ph - 1) % PPL);
    unsigned char* wl = F.ws + WS_W + (size_t)l * W_LAYER;
    const float* hin = (l == 0) ? A.in(0) : F.out;
    int ngemm = 0;
    if (k == 20) { phase_prep(A, F); for (int it = F.bid; it < 32; it += F.G) ssm_prep(A, F, it >> 4, it & 15); }
    else if (k == 21) phase_rmsnorm<true>(A, F, F.out, A.in(31), F.out);
    else if (k == 0) phase_rmsnorm<false>(A, F, hin, A.in(1) + l * D, XN);
    else if (k == 7) phase_rmsnorm<false>(A, F, F.out, A.in(28) + l * D, XN);
    else if (k == 2) rwkv_p1(A, F, l);
    else if (k == 3) {
        if (F.bid < 48) rwkv_scan(A, F, l, F.bid / 6, F.bid % 6);
        else if (F.bid < 176) { const int it = F.bid - 48; ssm_v2(A, F, l, it / 16, it % 16); }
        else attn_v2(A, F, F.bid - 176, F.G - 176);
    }
    else if (k == 4) { attn_finalize(A, F); ngemm = 1; }
    else if (k == 5) ngemm = 3;
    else ngemm = 1;
#pragma unroll 1
    for (int gi = 0; gi < ngemm; ++gi) {
        pg8::Gemm g; pg8::EpiAny E; E.kind = 0; E.gi = gi; E.ws = F.ws; E.base = hin; E.out = F.out;
        if (k == 1) { g = pg8::Gemm{XN, (const bf16*)(wl + WO_IN), NIN, D, D}; E.kind = 0; }
        else if (k == 4) { g = pg8::Gemm{PS + C_SSM, (const bf16*)(wl + WO_GLU), 512, 256, PSW}; E.kind = 4; }
        else if (k == 5) { E.kind = 1;
            if (gi == 0) g = pg8::Gemm{PS + C_Q, (const bf16*)(wl + WO_BA), D, 384, PSW};
            else if (gi == 1) g = pg8::Gemm{PS + C_RW, (const bf16*)(wl + WO_BR), D, 384, PSW};
            else g = pg8::Gemm{SO, (const bf16*)(wl + WO_BS), D, 256, 256}; }
        else if (k == 6) { g = pg8::Gemm{XN, (const bf16*)(wl + WO_OUT), D, D, D}; E.kind = 2; }
        else if (k == 8) { g = pg8::Gemm{XN, (const bf16*)(wl + WO_GU), 2 * FFH, D, D}; E.kind = 3; }
        else { g = pg8::Gemm{PS, (const bf16*)(wl + WO_DN), D, FFH, FFH}; E.kind = 2; E.base = F.out; }
        pg8::StaticOrder S; S.init(g.N, F.G, F.bid);
        pg8::gemm_phase<pg8::EpiAny, pg8::StaticOrder, true>(lds3, g, S, E);
    }
}

static_assert(pg8::EP_XN == WS_XN && pg8::EP_PS == WS_PS && pg8::EP_GT == WS_GT && pg8::EP_SO == WS_SO && pg8::EP_BR == WS_BR, "epilogue workspace offsets");

__global__ void __launch_bounds__(NTHREADS, 2) mega_fwd(Args args) {
    extern __shared__ __attribute__((aligned(16))) unsigned char lds[];
#pragma unroll 1
    for (int ph = args.ph_lo; ph < args.ph_hi; ++ph) {
        KA A; A.p = (kptr_t)__builtin_amdgcn_kernarg_segment_ptr(); asm volatile("" : "+s"(A.p));
        int tid = threadIdx.x, bid = blockIdx.x, G = gridDim.x; asm volatile("" : "+v"(tid), "+s"(bid), "+s"(G));
        Ctx F;
        F.lds = lds; F.ws = A.ws(); F.out = A.out();
        F.tid = tid; F.lane = tid & 63; F.wave = __builtin_amdgcn_readfirstlane(tid >> 6); F.G = G; F.bid = bid;
        run_phase(A, F, ph);
#if ONE_LAUNCH
        if (ph + 1 < args.ph_hi) { __threadfence(); cg::this_grid().sync(); }
#endif
    }
}

extern "C" void kernel_launch(void* const* d_in, const int* in_sizes, int n_in, void* d_out, int out_size, void* d_ws, size_t ws_size, hipStream_t stream) {
    static int grid = 0;
    if (grid == 0) {
        if (n_in != 32 || in_sizes[0] != T * D || out_size != T * D || ws_size < WS_END) { fprintf(stderr, "kernel_launch: unexpected shapes (n_in %d, in0 %d, out %d, ws %zu); nothing launched\n", n_in, n_in > 0 ? in_sizes[0] : -1, out_size, ws_size); grid = -1; return; }
        int dev = 0, cus = 0, per_cu = 0;
        if (hipGetDevice(&dev) != hipSuccess || hipDeviceGetAttribute(&cus, hipDeviceAttributeMultiprocessorCount, dev) != hipSuccess) { grid = -1; return; }
        if (hipFuncSetAttribute((const void*)mega_fwd, hipFuncAttributeMaxDynamicSharedMemorySize, LDS_BYTES) != hipSuccess) { fprintf(stderr, "kernel_launch: hipFuncSetAttribute failed\n"); grid = -1; return; }
        if (hipOccupancyMaxActiveBlocksPerMultiprocessor(&per_cu, (const void*)mega_fwd, NTHREADS, LDS_BYTES) != hipSuccess || per_cu < 1) { fprintf(stderr, "kernel_launch: occupancy query says %d\n", per_cu); per_cu = 1; }
        (void)hipGetLastError();
        grid = cus;
        if (grid < 200) { fprintf(stderr, "kernel_launch: needs >= 200 CUs, got %d\n", grid); grid = -1; return; }
    }
    if (grid < 0) return;
    Args a{};
    for (int i = 0; i < 32; ++i) a.in[i] = (const float*)d_in[i];
    a.out = (float*)d_out; a.ws = (unsigned char*)d_ws;
#if ONE_LAUNCH
    a.ph_lo = 0; a.ph_hi = NPH;
    void* kargs[] = {&a};
    hipError_t e = hipLaunchCooperativeKernel((const void*)mega_fwd, dim3(grid), dim3(NTHREADS), kargs, LDS_BYTES, stream);
    if (e != hipSuccess) fprintf(stderr, "kernel_launch: cooperative launch failed: %s (grid %d)\n", hipGetErrorString(e), grid);
#else
    for (int ph = 0; ph < NPH; ++ph) {
        a.ph_lo = ph; a.ph_hi = ph + 1;
        hipLaunchKernelGGL(mega_fwd, dim3(grid), dim3(NTHREADS), LDS_BYTES, stream, a);
    }
#endif
}
```

```cpp
#include <hip/hip_runtime.h>
#include <hip/hip_cooperative_groups.h>
#include <cstdio>
#include <cstdint>
namespace cg = cooperative_groups;
#ifndef ONE_LAUNCH
#define ONE_LAUNCH 1
#endif
namespace pg8 {
#define PG8_LAS __attribute__((address_space(3)))
typedef unsigned short bf16_t;
typedef short bf16x8 __attribute__((ext_vector_type(8)));
typedef float f32x4 __attribute__((ext_vector_type(4)));
typedef float f32x2 __attribute__((ext_vector_type(2)));
typedef unsigned u32x4 __attribute__((ext_vector_type(4)));
typedef unsigned u32x2 __attribute__((ext_vector_type(2)));
constexpr int BM = 256, BK = 64, HALF = 128, HTB = HALF * BK * 2  , STAGE_BYTES = 8 * HTB, NXCD = 8, WGM = 8;

__host__ __device__ __forceinline__ int lds_byte(int r, int c) { const int st = (r >> 4) * 2 + (c >> 5), rr = r & 15, cc = c & 31, ob = rr * 64 + cc * 2; return st * 1024 + (ob ^ (((ob >> 9) & 1) << 5)); }
__host__ __device__ __forceinline__ void stage_rc(int b, int& R, int& C) { const int st = b / 1024, sb = b % 1024, swz = sb ^ (((sb >> 9) & 1) << 5); R = (st >> 1) * 16 + swz / 64; C = (st & 1) * 32 + (swz % 64) / 2; }
__host__ __device__ __forceinline__ int perm32(int rho) { const int n = rho >> 4, i = rho & 15; return 8 * (i >> 2) + 4 * n + (i & 3); }

struct Unit { int pm, pn; };
constexpr size_t EP_XN = 68ull << 20, EP_PS = 132ull << 20, EP_GT = 308ull << 20, EP_SO = 404ull << 20, EP_BR = 421ull << 20;
struct Gemm { const bf16_t* A; const bf16_t* Bt; int N, K, lda; };

struct StaticOrder {
    static constexpr int nM = 128;
    int nN, G, c;
    __host__ __device__ void init(int N, int G_, int c_) { nN = N / BM; G = G_; c = c_; }
    __host__ __device__ bool next(int i, Unit& u) const {
        const int nwg = nM * nN;
        const long L = (long)i * G + c; if (L >= nwg) return false;
        int wgid = (int)L; { const int q = nwg / NXCD, r = nwg % NXCD, xcd = wgid % NXCD, off = wgid / NXCD; wgid = (xcd < r ? xcd * (q + 1) : r * (q + 1) + (xcd - r) * q) + off; }
        const int nig = WGM * nN, gid = wgid / nig, fm = gid * WGM, gsz = (nM - fm) < WGM ? (nM - fm) : WGM;
        u.pm = fm + ((wgid % nig) % gsz); u.pn = (wgid % nig) / gsz; return true;
    }
    __device__ __forceinline__ void a_ready(const Unit&) const {}
    __device__ __forceinline__ void done(const Unit&) const {}
};

__device__ __forceinline__ unsigned cvt_pk_bf16(float lo, float hi) { unsigned r; asm volatile("v_cvt_pk_bf16_f32 %0, %1, %2" : "=v"(r) : "v"(lo), "v"(hi)); return r; }
__device__ __forceinline__ float bf_lo(unsigned w) { return __uint_as_float(w << 16); }
__device__ __forceinline__ float bf_hi(unsigned w) { return __uint_as_float(w & 0xffff0000u); }
__device__ __forceinline__ float sigmoidf_(float x) { return __builtin_amdgcn_rcpf(1.0f + __expf(-x)); }


struct EpiAny;
__device__ __forceinline__ void epi_win(bf16_t* PS, unsigned char* GT, bf16_t* BRW, const f32x4 (&acc)[2][2][4][2], const Unit& u, int wr, int wc, int fr, int fq) {
        const int row0 = u.pm * BM + wr * 64 + fr;
        if (u.pn < 11) {
            const int col0 = u.pn * BM + wc * 32 + 8 * fq;
#pragma unroll
            for (int ai = 0; ai < 2; ++ai)
#pragma unroll
                for (int m = 0; m < 4; ++m) { bf16_t* rowp = PS + (size_t)(row0 + ai * HALF + m * 16) * 2816 + col0;
#pragma unroll
                    for (int bj = 0; bj < 2; ++bj) { const f32x4 v0 = acc[ai][bj][m][0], v1 = acc[ai][bj][m][1];
                        u32x4 w; w.x = cvt_pk_bf16(v0[0], v0[1]); w.y = cvt_pk_bf16(v0[2], v0[3]); w.z = cvt_pk_bf16(v1[0], v1[1]); w.w = cvt_pk_bf16(v1[2], v1[3]);
                        *(u32x4*)(rowp + bj * HALF) = w;
                        if (m == 3 && fr == 15) *(u32x4*)(BRW + (size_t)((row0 + ai * HALF + m * 16) >> 6) * 2816 + col0 + bj * HALF) = w; } }
        } else {
            const int col0 = (u.pn - 11) * BM + wc * 32 + 8 * fq;
#pragma unroll
            for (int ai = 0; ai < 2; ++ai)
#pragma unroll
                for (int m = 0; m < 4; ++m) { unsigned char* rowp = GT + (size_t)(row0 + ai * HALF + m * 16) * 3072 + col0;
#pragma unroll
                    for (int bj = 0; bj < 2; ++bj) { const f32x4 v0 = acc[ai][bj][m][0], v1 = acc[ai][bj][m][1];
                        unsigned q[8];
#pragma unroll
                        for (int k = 0; k < 4; ++k) { q[k] = (unsigned)(sigmoidf_(v0[k]) * 255.0f + 0.5f); q[4 + k] = (unsigned)(sigmoidf_(v1[k]) * 255.0f + 0.5f); }
                        u32x2 w; w.x = q[0] | (q[1] << 8) | (q[2] << 16) | (q[3] << 24); w.y = q[4] | (q[5] << 8) | (q[6] << 16) | (q[7] << 24);
                        *(u32x2*)(rowp + bj * HALF) = w; } }
        }
    }

__device__ __forceinline__ void epi_merge(bf16_t* MG, const unsigned char* GT, int gi, const f32x4 (&acc)[2][2][4][2], const Unit& u, int wr, int wc, int fr, int fq) {
        const int row0 = u.pm * BM + wr * 64 + fr, col0 = u.pn * BM + wc * 32 + 8 * fq;
#pragma unroll
        for (int ai = 0; ai < 2; ++ai)
#pragma unroll
            for (int m = 0; m < 4; ++m) { const size_t r = (size_t)(row0 + ai * HALF + m * 16);
#pragma unroll
                for (int bj = 0; bj < 2; ++bj) { const int c = col0 + bj * HALF;
                    const u32x2 gq = *(const u32x2*)(GT + r * 3072 + gi * 1024 + c);
                    float v[8];
#pragma unroll
                    for (int k = 0; k < 4; ++k) { v[k] = acc[ai][bj][m][0][k] * ((float)((gq.x >> (8 * k)) & 255u) * (1.0f / 255.0f)); v[4 + k] = acc[ai][bj][m][1][k] * ((float)((gq.y >> (8 * k)) & 255u) * (1.0f / 255.0f)); }
                    u32x4* dst = (u32x4*)(MG + r * 1024 + c);
                    if (gi > 0) { const u32x4 p = *dst;
                        v[0] += bf_lo(p.x); v[1] += bf_hi(p.x); v[2] += bf_lo(p.y); v[3] += bf_hi(p.y); v[4] += bf_lo(p.z); v[5] += bf_hi(p.z); v[6] += bf_lo(p.w); v[7] += bf_hi(p.w); }
                    u32x4 w; w.x = cvt_pk_bf16(v[0], v[1]); w.y = cvt_pk_bf16(v[2], v[3]); w.z = cvt_pk_bf16(v[4], v[5]); w.w = cvt_pk_bf16(v[6], v[7]);
                    *dst = w; } }
    }

__device__ __forceinline__ void epi_res(const float* base, float* out, const f32x4 (&acc)[2][2][4][2], const Unit& u, int wr, int wc, int fr, int fq) {
        const int row0 = u.pm * BM + wr * 64 + fr, col0 = u.pn * BM + wc * 32 + 4 * fq;
#pragma unroll
        for (int ai = 0; ai < 2; ++ai)
#pragma unroll
            for (int m = 0; m < 4; ++m) { const size_t off = (size_t)(row0 + ai * HALF + m * 16) * 1024 + col0;
#pragma unroll
                for (int bj = 0; bj < 2; ++bj)
#pragma unroll
                    for (int n = 0; n < 2; ++n) { const f32x4 b = *(const f32x4*)(base + off + bj * HALF + n * 16); *(f32x4*)(out + off + bj * HALF + n * 16) = b + acc[ai][bj][m][n]; } }
    }

template <int MODE> __device__ __forceinline__ void epi_pair(bf16_t* O, int ldo, const f32x4 (&acc)[2][2][4][2], const Unit& u, int wr, int wc, int fr, int fq) {
        const int row0 = u.pm * BM + wr * 64 + fr, col0 = u.pn * HALF + wc * 32 + 8 * fq;
#pragma unroll
        for (int ai = 0; ai < 2; ++ai)
#pragma unroll
            for (int m = 0; m < 4; ++m) { bf16_t* rowp = O + (size_t)(row0 + ai * HALF + m * 16) * ldo + col0;
                float v[8];
#pragma unroll
                for (int n = 0; n < 2; ++n)
#pragma unroll
                    for (int k = 0; k < 4; ++k) { const float a = acc[ai][0][m][n][k], b = acc[ai][1][m][n][k];
                        v[4 * n + k] = (MODE == 0) ? (a * sigmoidf_(a) * b) : (a * sigmoidf_(b)); }
                u32x4 w; w.x = cvt_pk_bf16(v[0], v[1]); w.y = cvt_pk_bf16(v[2], v[3]); w.z = cvt_pk_bf16(v[4], v[5]); w.w = cvt_pk_bf16(v[6], v[7]);
                *(u32x4*)rowp = w; }
    }


struct EpiAny {
    int kind;
    int gi; unsigned char* ws; const float* base; float* out;
    __device__ __forceinline__ bool perm() const { return kind != 2; }
    __device__ __forceinline__ void operator()(const f32x4 (&acc)[2][2][4][2], const Unit& u, int wr, int wc, int fr, int fq) const {
        if (kind == 0) epi_win((bf16_t*)(ws + EP_PS), ws + EP_GT, (bf16_t*)(ws + EP_BR), acc, u, wr, wc, fr, fq);
        else if (kind == 1) epi_merge((bf16_t*)(ws + EP_XN), ws + EP_GT, gi, acc, u, wr, wc, fr, fq);
        else if (kind == 2) epi_res(base, out, acc, u, wr, wc, fr, fq);
        else if (kind == 3) epi_pair<0>((bf16_t*)(ws + EP_PS), 2816, acc, u, wr, wc, fr, fq);
        else epi_pair<1>((bf16_t*)(ws + EP_SO), 256, acc, u, wr, wc, fr, fq);
    }
};

template <class Epi, class Sched, bool ALIGN_EPI = false>
__device__ __forceinline__ void gemm_phase(PG8_LAS unsigned char* lds, const Gemm g, const Sched& S, const Epi& E) {
    int tid_ = threadIdx.x; asm volatile("" : "+v"(tid_));
    const int tid = tid_, wid = __builtin_amdgcn_readfirstlane(tid >> 6), lane = tid & 63, wr = wid >> 2, wc = wid & 3, fr = lane & 15, fq = lane >> 4;
    const int K = g.K, lda = g.lda, nt = K / BK;
    unsigned voffA[2], voffB[2];
#pragma unroll
    for (int i = 0; i < 2; ++i) { int R, C; stage_rc(tid * 16 + i * 8192, R, C); const int Rb = E.perm() ? ((R & ~31) + perm32(R & 31)) : R;
        voffA[i] = (unsigned)(R * lda + C) * 2u; voffB[i] = (unsigned)(Rb * K + C) * 2u; }
    const size_t kstep = (size_t)(BK * 2);
    const size_t hstepA = (size_t)HALF * lda * 2, hstepB = (size_t)HALF * K * 2;
    const size_t tstepA = 2 * hstepA, tstepB = 2 * hstepB;
    const unsigned ldsw = (unsigned)wid * 1024u;
    const int aoff = lds_byte(wr * 64 + fr, fq * 8), boff = lds_byte(wc * 32 + fr, fq * 8);
#define PG8_SA(b, h) (((b) * 2 + (h)) * HTB)
#define PG8_SB(b, h) ((4 + (b) * 2 + (h)) * HTB)
#define PG8_STAGE(bufoff, gbase, voff) do { _Pragma("unroll") for (int _i = 0; _i < 2; ++_i) \
        __builtin_amdgcn_global_load_lds((const unsigned*)((const char*)(gbase) + (voff)[_i]), (PG8_LAS unsigned*)(lds + (bufoff) + ldsw + _i * 8192), 16, 0, 0); } while (0)
#define PG8_LDA(dst, b, h) do { _Pragma("unroll") for (int m = 0; m < 4; ++m) _Pragma("unroll") for (int k = 0; k < 2; ++k) dst[m][k] = *(const PG8_LAS bf16x8*)(lds + PG8_SA(b, h) + aoff + m * 2048 + k * 1024); } while (0)
#define PG8_LDB(dst, b, h) do { _Pragma("unroll") for (int n = 0; n < 2; ++n) _Pragma("unroll") for (int k = 0; k < 2; ++k) dst[n][k] = *(const PG8_LAS bf16x8*)(lds + PG8_SB(b, h) + boff + n * 2048 + k * 1024); } while (0)
#define PG8_MMA(ai, bj, At, Bt) do { __builtin_amdgcn_s_setprio(1); _Pragma("unroll") for (int m = 0; m < 4; ++m) _Pragma("unroll") for (int n = 0; n < 2; ++n) _Pragma("unroll") for (int k = 0; k < 2; ++k) \
        acc[ai][bj][m][n] = __builtin_amdgcn_mfma_f32_16x16x32_bf16(Bt[n][k], At[m][k], acc[ai][bj][m][n], 0, 0, 0); __builtin_amdgcn_s_setprio(0); } while (0)
#define PG8_WAIT_V(n) asm volatile("s_waitcnt vmcnt(" #n ")" ::: "memory")
#define PG8_WAIT_L(n) asm volatile("s_waitcnt lgkmcnt(" #n ")" ::: "memory")
#define PG8_BAR __builtin_amdgcn_s_barrier()
#define PG8_SCHED __builtin_amdgcn_sched_barrier(0)
    Unit cur, nxt; int ui = 0;
    if (!S.next(0, cur)) return;
    f32x4 acc[2][2][4][2];
#pragma unroll
    for (int a = 0; a < 2; ++a)
#pragma unroll
        for (int b = 0; b < 2; ++b)
#pragma unroll
            for (int m = 0; m < 4; ++m)
#pragma unroll
                for (int n = 0; n < 2; ++n) acc[a][b][m][n] = (f32x4){0.f, 0.f, 0.f, 0.f};
    bf16x8 At[4][2], B0[2][2], B1[2][2];
    const char* cA = (const char*)g.A + (size_t)cur.pm * tstepA; const char* cB = (const char*)g.Bt + (size_t)cur.pn * tstepB;
    S.a_ready(cur);
    PG8_STAGE(PG8_SB(0, 0), cB, voffB); PG8_STAGE(PG8_SB(0, 1), cB + hstepB, voffB); PG8_STAGE(PG8_SA(0, 0), cA, voffA); PG8_STAGE(PG8_SA(0, 1), cA + hstepA, voffA);
    if (wr == 1) PG8_BAR;
    PG8_WAIT_V(2); PG8_BAR;
    PG8_STAGE(PG8_SB(1, 0), cB + kstep, voffB); PG8_STAGE(PG8_SA(1, 0), cA + kstep, voffA); PG8_STAGE(PG8_SB(1, 1), cB + hstepB + kstep, voffB);
    PG8_WAIT_V(6); PG8_BAR;
    for (;;) {
        const bool has_next = S.next(ui + 1, nxt);
        const char* nA = has_next ? (const char*)g.A + (size_t)nxt.pm * tstepA : cA; const char* nB = has_next ? (const char*)g.Bt + (size_t)nxt.pn * tstepB : cB;
        for (int t = 0; t < nt; t += 2) {
            const bool last = (t == nt - 2);
            const char* a1 = cA + (size_t)(t + 1) * kstep;
            const char* a2 = last ? nA : cA + (size_t)(t + 2) * kstep; const char* b2 = last ? nB : cB + (size_t)(t + 2) * kstep;
            const char* a3 = a2 + kstep; const char* b3 = b2 + kstep;
            if (last && has_next) S.a_ready(nxt);
            PG8_LDB(B0, 0, 0); PG8_LDB(B1, 0, 1); PG8_SCHED; PG8_LDA(At, 0, 0); PG8_STAGE(PG8_SA(1, 1), a1 + hstepA, voffA);
            PG8_WAIT_V(8); PG8_WAIT_L(0); PG8_BAR; PG8_MMA(0, 0, At, B0); PG8_MMA(0, 1, At, B1); PG8_BAR; PG8_SCHED;
            PG8_LDA(At, 0, 1); PG8_STAGE(PG8_SB(0, 0), b2, voffB); PG8_STAGE(PG8_SB(0, 1), b2 + hstepB, voffB); PG8_STAGE(PG8_SA(0, 0), a2, voffA);
            PG8_WAIT_V(8); PG8_WAIT_L(0); PG8_BAR; PG8_MMA(1, 0, At, B0); PG8_MMA(1, 1, At, B1); PG8_BAR; PG8_SCHED;
            PG8_LDB(B0, 1, 0); PG8_LDB(B1, 1, 1); PG8_SCHED; PG8_LDA(At, 1, 0); PG8_STAGE(PG8_SA(0, 1), a2 + hstepA, voffA);
            PG8_WAIT_V(8); PG8_WAIT_L(0); PG8_BAR; PG8_MMA(0, 0, At, B0); PG8_MMA(0, 1, At, B1); PG8_BAR; PG8_SCHED;
            PG8_LDA(At, 1, 1); PG8_STAGE(PG8_SB(1, 0), b3, voffB); PG8_STAGE(PG8_SB(1, 1), b3 + hstepB, voffB); PG8_STAGE(PG8_SA(1, 0), a3, voffA);
            PG8_WAIT_V(8); PG8_WAIT_L(0); PG8_BAR; PG8_MMA(1, 0, At, B0); PG8_MMA(1, 1, At, B1); PG8_BAR; PG8_SCHED;
        }
        if constexpr (ALIGN_EPI) { if (wr == 0) PG8_BAR; }
        E(acc, cur, wr, wc, fr, fq); S.done(cur);
        if (!has_next) break;
#pragma unroll
        for (int a = 0; a < 2; ++a)
#pragma unroll
            for (int b = 0; b < 2; ++b)
#pragma unroll
                for (int m = 0; m < 4; ++m)
#pragma unroll
                    for (int n = 0; n < 2; ++n) acc[a][b][m][n] = (f32x4){0.f, 0.f, 0.f, 0.f};
        cur = nxt; cA = nA; cB = nB; ++ui;
        if constexpr (ALIGN_EPI) { if (wr == 1) PG8_BAR; }
    }
    PG8_WAIT_V(0);
    if constexpr (!ALIGN_EPI) { if (wr == 0) PG8_BAR; }
    PG8_BAR;
#undef PG8_SA
#undef PG8_SB
#undef PG8_STAGE
#undef PG8_LDA
#undef PG8_LDB
#undef PG8_MMA
#undef PG8_WAIT_V
#undef PG8_WAIT_L
#undef PG8_BAR
#undef PG8_SCHED
}
}
constexpr int NWAVES = 8, NTHREADS = 512;
constexpr int BATCH = 8, SEQ = 4096, T = BATCH * SEQ, D = 1024, DEPTH = 2;
constexpr int NIN = 5888, PSW = 2816, NGATE = 3072, FFH = 2816;
constexpr int C_Q = 0, C_K = 384, C_V = 768, C_RW = 1152, C_LORA = 2304, C_SSM = 2560;
constexpr float NORM_EPS = 1e-6f, GN_EPS = 64e-5f;

constexpr size_t MiB = 1u << 20;
constexpr size_t WS_CTL = 0, CTL_ZERO_BYTES = 1 * MiB;
constexpr size_t WS_W = 1 * MiB, W_LAYER = 33 * MiB;
constexpr size_t WO_IN = 0, WO_BA = 12 * MiB, WO_BR = WO_BA + 768 * 1024, WO_BS = WO_BR + 768 * 1024, WO_OUT = 14 * MiB, WO_GU = 16 * MiB, WO_DN = 27 * MiB, WO_GLU = 32 * MiB + 512 * 1024,
                 WO_W2 = WO_GLU + 256 * 1024, WO_A2 = WO_W2 + 48 * 1024, WO_G2 = WO_A2 + 48 * 1024;
constexpr size_t WS_XN = 68 * MiB;
constexpr size_t WS_PS = 132 * MiB;
constexpr size_t WS_GT = 308 * MiB;
constexpr size_t WS_SO = 404 * MiB;
constexpr size_t WS_LSE = 420 * MiB;
constexpr size_t WS_SCR = 421 * MiB;
constexpr size_t WS_BR = WS_SCR;
constexpr size_t WS_RMC = WS_SCR + 3 * MiB;
constexpr size_t WS_RNT = WS_RMC + 24 * MiB;
constexpr size_t WS_REM = WS_RNT + 24 * MiB;
constexpr size_t WS_RGL = WS_REM + 24 * MiB;
static_assert(WS_RGL + 1 * MiB <= 512 * MiB, "scratch map");
constexpr size_t WS_END = 512 * MiB;

constexpr int LDS_BYTES = 147456;
constexpr int MISC_OFF = LDS_BYTES - 128;
constexpr int CW_BAR = 4096;

#define GAS __attribute__((address_space(1)))
#define LAS __attribute__((address_space(3)))
typedef unsigned short bf16;
typedef unsigned v4u __attribute__((ext_vector_type(4)));
typedef unsigned v2u __attribute__((ext_vector_type(2)));
typedef float f32x4 __attribute__((ext_vector_type(4)));
#define LDS_WAIT() asm volatile("s_waitcnt lgkmcnt(0)" ::: "memory")
#define VM_WAIT() asm volatile("s_waitcnt vmcnt(0)" ::: "memory")
__device__ __forceinline__ unsigned f2bf(float f) { unsigned u = __builtin_bit_cast(unsigned, f); return (u + 0x7fffu + ((u >> 16) & 1u)) >> 16; }
__device__ __forceinline__ unsigned pk2(float lo, float hi) { return f2bf(lo) | (f2bf(hi) << 16); }
__device__ __forceinline__ float bf2f(bf16 b) { return __uint_as_float((unsigned)b << 16); }
__device__ __forceinline__ float bflo(unsigned w) { return __uint_as_float(w << 16); }
__device__ __forceinline__ float bfhi(unsigned w) { return __uint_as_float(w & 0xffff0000u); }
template <int M> __device__ __forceinline__ float shx(float v) { static_assert(M < 32, "shx: xor mask inside a 32-lane half"); return __int_as_float(__builtin_amdgcn_ds_swizzle(__float_as_int(v), (M << 10) | 0x1f)); }
__device__ __forceinline__ float xsum32(float v) { auto r = __builtin_amdgcn_permlane32_swap(__float_as_uint(v), __float_as_uint(v), false, false); return __uint_as_float(r[0]) + __uint_as_float(r[1]); }
__device__ __forceinline__ float xmax32(float v) { auto r = __builtin_amdgcn_permlane32_swap(__float_as_uint(v), __float_as_uint(v), false, false); return fmaxf(__uint_as_float(r[0]), __uint_as_float(r[1])); }
__device__ __forceinline__ float wave_sum(float v) { v += shx<1>(v); v += shx<2>(v); v += shx<4>(v); v += shx<8>(v); v += shx<16>(v); return xsum32(v); }
__device__ __forceinline__ float sigm(float x) { return 1.0f / (1.0f + __expf(-x)); }

struct Args { const float* in[32]; float* out; unsigned char* ws; int ph_lo, ph_hi; };

typedef __attribute__((address_space(4))) const unsigned char* kptr_t;
struct KA {
    kptr_t p;
    typedef const float* cfptr_t; typedef float* fptr_t; typedef unsigned char* ucptr_t;
    __device__ __forceinline__ const float* in(int i) const { return *(const __attribute__((address_space(4))) cfptr_t*)(p + 8 * i); }
    __device__ __forceinline__ float* out() const { return *(const __attribute__((address_space(4))) fptr_t*)(p + 256); }
    __device__ __forceinline__ unsigned char* ws() const { return *(const __attribute__((address_space(4))) ucptr_t*)(p + 264); }
};
static_assert(sizeof(Args) == 280, "Args layout");

struct Ctx {
    unsigned char* lds; unsigned char* ws; float* out;
    int tid, lane, wave, G, bid;
};

__device__ __forceinline__ void tr_item(const float* W, int ldw, int K, int nblk, bf16* WT, int goff, float* scr, int item, int lane) {
    const int kb = item / nblk, nb = item % nblk, k0 = 64 * kb, n0 = 32 * nb;
#pragma unroll 8
    for (int i = 0; i < 32; ++i) { const int kk = 2 * i + (lane >> 5); scr[kk * 33 + (lane & 31)] = W[(size_t)(k0 + kk) * ldw + n0 + (lane & 31)]; }
    LDS_WAIT(); asm volatile("" ::: "memory");
    const int c = lane & 7;
#pragma unroll
    for (int j = 0; j < 4; ++j) { const int n = (lane >> 3) + 8 * j; const float* s = scr + (8 * c) * 33 + n;
        v4u o; o.x = pk2(s[0 * 33], s[1 * 33]); o.y = pk2(s[2 * 33], s[3 * 33]); o.z = pk2(s[4 * 33], s[5 * 33]); o.w = pk2(s[6 * 33], s[7 * 33]);
        const int nn = n0 + n; const int drow = goff < 0 ? nn : ((nn >> 7) * 256 + goff + (nn & 127));
        *(v4u*)(WT + (size_t)drow * K + k0 + 8 * c) = o; }
    LDS_WAIT(); asm volatile("" ::: "memory");
}

__device__ __forceinline__ void phase_prep(const KA& A, const Ctx& F) {
    float* scr = (float*)(F.lds + F.wave * 16384);
    const int gw = F.bid * NWAVES + F.wave, NGW = F.G * NWAVES;
    constexpr int NM = 13;
    constexpr int cnt[NM] = {16 * 184, 6 * 32, 6 * 32, 4 * 32, 16 * 32, 16 * 88, 16 * 88, 44 * 32, 4 * 8, 4 * 8, 12, 12, 24};
    constexpr int per_layer = cnt[0] + cnt[1] + cnt[2] + cnt[3] + cnt[4] + cnt[5] + cnt[6] + cnt[7] + cnt[8] + cnt[9] + cnt[10] + cnt[11] + cnt[12];
    for (int it = gw; it < DEPTH * per_layer; it += NGW) {
        const int l = it / per_layer; int r = it % per_layer;
        unsigned char* wl = F.ws + WS_W + (size_t)l * W_LAYER;
        if (r < cnt[0]) { tr_item(A.in(2) + (size_t)l * D * NIN, NIN, D, NIN / 32, (bf16*)(wl + WO_IN), -1, scr, r, F.lane); continue; } r -= cnt[0];
        if (r < cnt[1]) { tr_item(A.in(24) + (size_t)l * 384 * D, D, 384, D / 32, (bf16*)(wl + WO_BA), -1, scr, r, F.lane); continue; } r -= cnt[1];
        if (r < cnt[2]) { tr_item(A.in(25) + (size_t)l * 384 * D, D, 384, D / 32, (bf16*)(wl + WO_BR), -1, scr, r, F.lane); continue; } r -= cnt[2];
        if (r < cnt[3]) { tr_item(A.in(26) + (size_t)l * 256 * D, D, 256, D / 32, (bf16*)(wl + WO_BS), -1, scr, r, F.lane); continue; } r -= cnt[3];
        if (r < cnt[4]) { tr_item(A.in(27) + (size_t)l * D * D, D, D, D / 32, (bf16*)(wl + WO_OUT), -1, scr, r, F.lane); continue; } r -= cnt[4];
        if (r < cnt[5]) { tr_item(A.in(29) + (size_t)l * D * 2 * FFH, 2 * FFH, D, FFH / 32, (bf16*)(wl + WO_GU), 0, scr, r, F.lane); continue; } r -= cnt[5];
        if (r < cnt[6]) { tr_item(A.in(29) + (size_t)l * D * 2 * FFH + FFH, 2 * FFH, D, FFH / 32, (bf16*)(wl + WO_GU), 128, scr, r, F.lane); continue; } r -= cnt[6];
        if (r < cnt[7]) { tr_item(A.in(30) + (size_t)l * FFH * D, D, FFH, D / 32, (bf16*)(wl + WO_DN), -1, scr, r, F.lane); continue; } r -= cnt[7];
        if (r < cnt[8]) { tr_item(A.in(22) + (size_t)l * 256 * 256, 256, 256, 8, (bf16*)(wl + WO_GLU), 0, scr, r, F.lane); continue; } r -= cnt[8];
        if (r < cnt[9]) { tr_item(A.in(23) + (size_t)l * 256 * 256, 256, 256, 8, (bf16*)(wl + WO_GLU), 128, scr, r, F.lane); continue; } r -= cnt[9];
        if (r < cnt[10]) { tr_item(A.in(5) + (size_t)l * 64 * 384, 384, 64, 12, (bf16*)(wl + WO_W2), -1, scr, r, F.lane); continue; } r -= cnt[10];
        if (r < cnt[11]) { tr_item(A.in(7) + (size_t)l * 64 * 384, 384, 64, 12, (bf16*)(wl + WO_A2), -1, scr, r, F.lane); continue; } r -= cnt[11];
        tr_item(A.in(8) + (size_t)l * 128 * 384, 384, 128, 12, (bf16*)(wl + WO_G2), -1, scr, r, F.lane);
    }
}

template <bool OUT_F32> __device__ __forceinline__ void phase_rmsnorm(const KA& A, const Ctx& F, const float* src, const float* gain, void* dst) {
    const int gw = F.bid * NWAVES + F.wave, NGW = F.G * NWAVES;
    f32x4 gv[4];
#pragma unroll
    for (int j = 0; j < 4; ++j) gv[j] = *((const f32x4*)gain + F.lane + 64 * j);
    for (int m = gw; m < T; m += NGW) {
        const f32x4* xr = (const f32x4*)(src + (size_t)m * D) + F.lane;
        f32x4 v[4]; float s = 0.f;
#pragma unroll
        for (int j = 0; j < 4; ++j) { v[j] = xr[64 * j]; s += (v[j].x * v[j].x + v[j].y * v[j].y) + (v[j].z * v[j].z + v[j].w * v[j].w); }
        const float rs = 1.0f / sqrtf(wave_sum(s) * (1.0f / D) + NORM_EPS);
        if (OUT_F32) {
            f32x4* o = (f32x4*)((float*)dst + (size_t)m * D) + F.lane;
#pragma unroll
            for (int j = 0; j < 4; ++j) o[64 * j] = v[j] * rs * gv[j];
        } else {
            v2u* o = (v2u*)((bf16*)dst + (size_t)m * D) + F.lane;
#pragma unroll
            for (int j = 0; j < 4; ++j) { const f32x4 y = v[j] * rs * gv[j]; v2u w; w.x = pk2(y.x, y.y); w.y = pk2(y.z, y.w); o[64 * j] = w; }
        }
    }
}
__device__ __forceinline__ void attn_v1(const KA& A, const Ctx& F, int blk, int nblk) {
    bf16* PS = (bf16*)(F.ws + WS_PS); float* LSE = (float*)(F.ws + WS_LSE);
#pragma unroll 1
    for (int item = blk * NTHREADS + F.tid; item < T * 12; item += nblk * NTHREADS) {
        const int hf = item & 1, it2 = item >> 1;
        const int h = it2 / T, bt = it2 % T, t = bt % SEQ;
        const int g = h >> 1, dil = (g == 0) ? 1 : (g == 1 ? 4 : 16);
        unsigned qp_[16]; float o[32];
        { const v4u* qp = (const v4u*)(PS + (size_t)bt * PSW + C_Q + h * 64 + hf * 32);
#pragma unroll
          for (int c = 0; c < 4; ++c) { const v4u w = qp[c]; qp_[4 * c + 0] = w.x; qp_[4 * c + 1] = w.y; qp_[4 * c + 2] = w.z; qp_[4 * c + 3] = w.w; } }
#pragma unroll
        for (int c = 0; c < 32; ++c) o[c] = 0.f;
        float mx = -1e30f, l = 0.f;
#pragma unroll 1
        for (int j = 0; j <= 128; ++j) {
            const int tk = t - j * dil; if (tk < 0) break;
            const size_t rowk = (size_t)(bt - j * dil) * PSW;
            const v4u* kp = (const v4u*)(PS + rowk + C_K + h * 64 + hf * 32); const v4u* vp = (const v4u*)(PS + rowk + C_V + h * 64 + hf * 32);
            float s = 0.f;
#pragma unroll
            for (int c = 0; c < 4; ++c) { const v4u w = kp[c];
                s += bflo(qp_[4 * c + 0]) * bflo(w.x) + bfhi(qp_[4 * c + 0]) * bfhi(w.x) + bflo(qp_[4 * c + 1]) * bflo(w.y) + bfhi(qp_[4 * c + 1]) * bfhi(w.y)
                   + bflo(qp_[4 * c + 2]) * bflo(w.z) + bfhi(qp_[4 * c + 2]) * bfhi(w.z) + bflo(qp_[4 * c + 3]) * bflo(w.w) + bfhi(qp_[4 * c + 3]) * bfhi(w.w); }
            s += shx<1>(s);
            s *= 0.125f;
            const float mn = fmaxf(mx, s), cf = __expf(mx - mn), p = __expf(s - mn);
            l = l * cf + p; mx = mn;
#pragma unroll
            for (int c = 0; c < 4; ++c) { const v4u w = vp[c];
                o[8 * c + 0] = o[8 * c + 0] * cf + p * bflo(w.x); o[8 * c + 1] = o[8 * c + 1] * cf + p * bfhi(w.x); o[8 * c + 2] = o[8 * c + 2] * cf + p * bflo(w.y); o[8 * c + 3] = o[8 * c + 3] * cf + p * bfhi(w.y);
                o[8 * c + 4] = o[8 * c + 4] * cf + p * bflo(w.z); o[8 * c + 5] = o[8 * c + 5] * cf + p * bfhi(w.z); o[8 * c + 6] = o[8 * c + 6] * cf + p * bflo(w.w); o[8 * c + 7] = o[8 * c + 7] * cf + p * bfhi(w.w); }
        }
        const float il = 1.0f / l;
        v4u* op = (v4u*)(PS + (size_t)bt * PSW + C_Q + h * 64 + hf * 32);
#pragma unroll
        for (int c = 0; c < 4; ++c) { v4u w; w.x = pk2(o[8 * c + 0] * il, o[8 * c + 1] * il); w.y = pk2(o[8 * c + 2] * il, o[8 * c + 3] * il); w.z = pk2(o[8 * c + 4] * il, o[8 * c + 5] * il); w.w = pk2(o[8 * c + 6] * il, o[8 * c + 7] * il); op[c] = w; }
        if (hf == 0) LSE[(size_t)bt * 6 + h] = mx + __logf(l);
    }
}
__device__ __forceinline__ void attn_finalize(const KA& A, const Ctx& F) {
    bf16* PS = (bf16*)(F.ws + WS_PS); const float* LSE = (const float*)(F.ws + WS_LSE);
    for (int item = F.bid * NTHREADS + F.tid; item < T * 48; item += F.G * NTHREADS) {
        const int bt = item / 48, r = item % 48, h = r >> 3, c = r & 7, j = h & 1;
        const float l0 = LSE[(size_t)bt * 6 + j], l1 = LSE[(size_t)bt * 6 + 2 + j], l2 = LSE[(size_t)bt * 6 + 4 + j], lm = LSE[(size_t)bt * 6 + h];
        const float mx = fmaxf(l0, fmaxf(l1, l2));
        const float al = __expf(lm - mx) / (__expf(l0 - mx) + __expf(l1 - mx) + __expf(l2 - mx));
        v4u* p = (v4u*)(PS + (size_t)bt * PSW + C_Q + h * 64) + c; v4u w = *p;
        w.x = pk2(bflo(w.x) * al, bfhi(w.x) * al); w.y = pk2(bflo(w.y) * al, bfhi(w.y) * al); w.z = pk2(bflo(w.z) * al, bfhi(w.z) * al); w.w = pk2(bflo(w.w) * al, bfhi(w.w) * al);
        *p = w;
    }
}

__device__ __forceinline__ void rwkv_v1(const KA& A, const Ctx& F, int l, int b, int h) {
    constexpr int CH = 32;
    bf16* PS = (bf16*)(F.ws + WS_PS);
    float* L = (float*)F.lds;
    float* ZR = L, *ZK = L + CH * 64, *ZV = L + 2 * CH * 64, *ZX = L + 3 * CH * 64;
    float* WD = ZX + CH * 256, *KA = WD + CH * 64, *KB = KA + CH * 64, *GG = KB + CH * 64, *YB = GG + CH * 64, *BON = YB + CH * 64, *PREV = BON + 64;
    const float* mix = A.in(3) + (size_t)l * 1408;
    const float* w0 = A.in(4) + l * 384, *w2 = A.in(5) + (size_t)l * 64 * 384, *a0 = A.in(6) + l * 384, *a2 = A.in(7) + (size_t)l * 64 * 384, *g2 = A.in(8) + (size_t)l * 128 * 384;
    const float* k_k = A.in(9) + l * 384, *k_a = A.in(10) + l * 384, *r_k = A.in(11) + l * 384, *ln_w = A.in(12) + l * 384, *ln_b = A.in(13) + l * 384;
    const int tid = F.tid, lane = F.lane;
    const int hc = h * 64 + lane;
    float S[8];
#pragma unroll
    for (int j = 0; j < 8; ++j) S[j] = 0.f;
    const int si = tid >> 3, sj = (tid & 7) * 8;
#pragma unroll 1
    for (int ch = 0; ch < SEQ / CH; ++ch) {
        const int t0 = ch * CH; const size_t row0 = (size_t)b * SEQ + t0;
        float* PRc = PREV + (ch & 1) * 192, *PRn = PREV + ((ch + 1) & 1) * 192;
#pragma unroll 1
        for (int e = tid; e < CH * 192; e += NTHREADS) {
            const int t = e / 192, c3 = e % 192, which = c3 >> 6, c = c3 & 63;
            const int col = C_RW + which * 384 + h * 64 + c;
            const float cur = bf2f(PS[(row0 + t) * PSW + col]);
            float prev;
            if (t == 0) prev = (ch == 0) ? 0.f : PRc[c3]; else prev = bf2f(PS[(row0 + t - 1) * PSW + col]);
            if (t == CH - 1) PRn[c3] = cur;
            const float z = cur + (prev - cur) * mix[which * 384 + h * 64 + c];
            L[which * CH * 64 + t * 64 + c] = z;
        }
#pragma unroll 1
        for (int e = tid; e < CH * 256; e += NTHREADS) {
            const int t = e >> 8, j = e & 255; const int col = C_LORA + j;
            const float cur = bf2f(PS[(row0 + t) * PSW + col]);
            const float prev = (t0 + t == 0) ? 0.f : bf2f(PS[(row0 + t - 1) * PSW + col]);
            float z = cur + (prev - cur) * mix[1152 + j];
            if (j < 64) z = tanhf(z); else if (j >= 128) z = sigm(z);
            ZX[t * 256 + j] = z;
        }
        __syncthreads();
        {
            float accw[4], acca[4], accg[4];
#pragma unroll
            for (int i = 0; i < 4; ++i) { accw[i] = 0.f; acca[i] = 0.f; accg[i] = 0.f; }
#pragma unroll 2
            for (int j = 0; j < 64; ++j) { const float ww = w2[j * 384 + hc], aa = a2[j * 384 + hc];
#pragma unroll
                for (int i = 0; i < 4; ++i) { const int t = F.wave + 8 * i; accw[i] += ZX[t * 256 + j] * ww; acca[i] += ZX[t * 256 + 64 + j] * aa; } }
#pragma unroll 2
            for (int j = 0; j < 128; ++j) { const float gg = g2[j * 384 + hc];
#pragma unroll
                for (int i = 0; i < 4; ++i) { const int t = F.wave + 8 * i; accg[i] += ZX[t * 256 + 128 + j] * gg; } }
            const float w0c = w0[hc], a0c = a0[hc], kkc = k_k[hc], kac = k_a[hc], rkc = r_k[hc];
#pragma unroll
            for (int i = 0; i < 4; ++i) { const int t = F.wave + 8 * i; const int o = t * 64 + lane;
                const float x = -(w0c + accw[i]); const float sp = (x > 20.f) ? x : log1pf(__expf(x)); const float w = -sp - 0.5f;
                const float av = sigm(a0c + acca[i]);
                const float kraw = ZK[o]; float kk = kraw * kkc; const float nrm = sqrtf(wave_sum(kk * kk)); kk = kk / fmaxf(nrm, 1e-12f);
                const float knew = kraw * (1.0f + (av - 1.0f) * kac);
                const float bon = wave_sum(ZR[o] * knew * rkc);
                ZK[o] = knew; WD[o] = __expf(-__expf(w)); KA[o] = -kk; KB[o] = kk * av; GG[o] = accg[i]; if (lane == 0) BON[t] = bon; }
        }
        __syncthreads();
#pragma unroll 2
        for (int t = 0; t < CH; ++t) {
            const f32x4 a0v = *(const f32x4*)(KA + t * 64 + sj), a1v = *(const f32x4*)(KA + t * 64 + sj + 4);
            const f32x4 w0v = *(const f32x4*)(WD + t * 64 + sj), w1v = *(const f32x4*)(WD + t * 64 + sj + 4);
            const f32x4 b0v = *(const f32x4*)(KB + t * 64 + sj), b1v = *(const f32x4*)(KB + t * 64 + sj + 4);
            const f32x4 k0v = *(const f32x4*)(ZK + t * 64 + sj), k1v = *(const f32x4*)(ZK + t * 64 + sj + 4);
            const f32x4 r0v = *(const f32x4*)(ZR + t * 64 + sj), r1v = *(const f32x4*)(ZR + t * 64 + sj + 4);
            const float vi = ZV[t * 64 + si];
            float sa = 0.f;
#pragma unroll
            for (int j = 0; j < 4; ++j) sa += S[j] * a0v[j] + S[4 + j] * a1v[j];
            sa += shx<1>(sa); sa += shx<2>(sa); sa += shx<4>(sa);
            float y = 0.f;
#pragma unroll
            for (int j = 0; j < 4; ++j) { S[j] = S[j] * w0v[j] + sa * b0v[j] + vi * k0v[j]; S[4 + j] = S[4 + j] * w1v[j] + sa * b1v[j] + vi * k1v[j]; y += S[j] * r0v[j] + S[4 + j] * r1v[j]; }
            y += shx<1>(y); y += shx<2>(y); y += shx<4>(y);
            if ((tid & 7) == 0) YB[t * 64 + si] = y;
        }
        __syncthreads();
        const float lw = ln_w[hc], lb = ln_b[hc];
#pragma unroll
        for (int i = 0; i < 4; ++i) { const int t = F.wave + 8 * i; const int o = t * 64 + lane;
            const float y = YB[o]; const float mu = wave_sum(y) * (1.0f / 64.0f); const float dv = y - mu; const float var = wave_sum(dv * dv) * (1.0f / 64.0f);
            const float yn = dv * (1.0f / sqrtf(var + GN_EPS)) * lw + lb;
            const float out = (yn + BON[t] * ZV[o]) * GG[o];
            PS[(row0 + t) * PSW + C_RW + h * 64 + lane] = (bf16)f2bf(out); }
        __syncthreads();
    }
}

__device__ __forceinline__ float gelu_tanh(float x) { const float u = 0.7978845608028654f * (x + 0.044715f * x * x * x); return 0.5f * x * (1.0f + tanhf(u)); }
__device__ __forceinline__ void ssm_v1(const KA& A, const Ctx& F, int l, int b, int g) {
    bf16* PS = (bf16*)(F.ws + WS_PS);
    float* L = (float*)F.lds;
    float* U = L, *XR = L + 1024, *XI = L + 1024 + 64 * 65, *CR = L + 1024 + 2 * 64 * 65, *CI = CR + 1024;
    const int tid = F.tid, lane = F.lane, p = lane;
    float are, aim, bre[16], bim[16];
    {
        const float step = __expf(A.in(16)[l * 16 + g]);
        const float lr = A.in(14)[(size_t)l * 1024 + g * 64 + p], li = A.in(15)[(size_t)l * 1024 + g * 64 + p];
        const float mag = __expf(lr * step), ang = li * step; float sn, cs; sincosf(ang, &sn, &cs);
        are = mag * cs; aim = mag * sn;
        const float inv = 1.0f / (lr * lr + li * li);
        const float fre = ((are - 1.0f) * lr + aim * li) * inv, fim = (aim * lr - (are - 1.0f) * li) * inv;
        const float* br = A.in(17) + (size_t)l * 16384 + (size_t)(g * 64 + p) * 16, *bi = A.in(18) + (size_t)l * 16384 + (size_t)(g * 64 + p) * 16;
#pragma unroll
        for (int c = 0; c < 16; ++c) { bre[c] = fre * br[c] - fim * bi[c]; bim[c] = fre * bi[c] + fim * br[c]; }
    }
    for (int e = tid; e < 1024; e += NTHREADS) { CR[e] = A.in(19)[(size_t)l * 16384 + g * 1024 + e]; CI[e] = A.in(20)[(size_t)l * 16384 + g * 1024 + e]; }
    const float* dsk = A.in(21) + l * 256 + g * 16;
    float xr = 0.f, xi = 0.f;
#pragma unroll 1
    for (int ch = 0; ch < SEQ / 64; ++ch) {
        const size_t row0 = (size_t)b * SEQ + ch * 64;
        for (int e = tid; e < 1024; e += NTHREADS) { const int t = e >> 4, c = e & 15; U[e] = bf2f(PS[(row0 + t) * PSW + C_SSM + g * 16 + c]); }
        __syncthreads();
#pragma unroll
        for (int i = 0; i < 8; ++i) { const int t = F.wave + 8 * i; float sr = 0.f, sii = 0.f;
#pragma unroll
            for (int c = 0; c < 16; ++c) { const float u = U[t * 16 + c]; sr += bre[c] * u; sii += bim[c] * u; }
            XR[t * 65 + p] = sr; XI[t * 65 + p] = sii; }
        __syncthreads();
        if (F.wave == 0) {
#pragma unroll 4
            for (int t = 0; t < 64; ++t) { const float nr = are * xr - aim * xi + XR[t * 65 + p], ni = are * xi + aim * xr + XI[t * 65 + p]; xr = nr; xi = ni; XR[t * 65 + p] = xr; XI[t * 65 + p] = xi; }
        }
        __syncthreads();
        { const int t = tid >> 3, c2 = (tid & 7) * 2;
#pragma unroll
          for (int q = 0; q < 2; ++q) { const int c = c2 + q; float y = 0.f;
#pragma unroll 4
              for (int pp = 0; pp < 64; ++pp) y += CR[c * 64 + pp] * XR[t * 65 + pp] - CI[c * 64 + pp] * XI[t * 65 + pp];
              y += dsk[c] * U[t * 16 + c];
              PS[(row0 + t) * PSW + C_SSM + g * 16 + c] = (bf16)f2bf(gelu_tanh(y)); } }
        __syncthreads();
    }
}
typedef short bf16x8_t __attribute__((ext_vector_type(8)));
typedef float f32x16 __attribute__((ext_vector_type(16)));
typedef short v4i16_t __attribute__((ext_vector_type(4)));
typedef __bf16 bf16x2_t __attribute__((ext_vector_type(2)));
typedef float f32x2_t __attribute__((ext_vector_type(2)));
__device__ __forceinline__ unsigned cvtpk(float lo, float hi) { f32x2_t v = {lo, hi}; bf16x2_t b = __builtin_convertvector(v, bf16x2_t); return __builtin_bit_cast(unsigned, b); }
__device__ __forceinline__ v4i16_t ds_tr16(const unsigned char* p) { return __builtin_amdgcn_ds_read_tr16_b64_v4i16((LAS v4i16_t*)p); }
__device__ __forceinline__ int crow16(int g, int hh) { return (g & 3) + 8 * (g >> 2) + 4 * hh; }

constexpr int ATT_VS = 96;
constexpr int ATT_ITEMS = BATCH * 6 * 16;

__device__ __forceinline__ void attn_v2(const KA& A, const Ctx& F, int blk, int nblk) {
    bf16* PS = (bf16*)(F.ws + WS_PS); float* LSE = (float*)(F.ws + WS_LSE);
    unsigned char* VI = F.lds;
    const int lane = F.lane, q = lane & 31, hh = lane >> 5, w = F.wave;
#pragma unroll 1
    for (int item = blk; item < ATT_ITEMS; item += nblk) {
        const int idx16 = item & 15, h = (item >> 4) % 6, b = item / 96;
        const int g = h >> 1, dsh = 2 * g, dil = 1 << dsh;
        const int bpr = 16 >> dsh, r = idx16 / bpr, i0 = (idx16 % bpr) * 256;
        const size_t tb = (size_t)b * SEQ + r;
#pragma unroll
        for (int ps = 0; ps < 6; ++ps) { const int row = (F.tid >> 3) + 64 * ps, ch = F.tid & 7; int ki = i0 - 128 + row; ki = ki < 0 ? 0 : ki;
            const v4u v = *(const v4u*)(PS + (tb + (size_t)ki * dil) * PSW + C_V + h * 64 + ch * 8);
            *(v4u*)(VI + (row * ATT_VS + ch * 8) * 2) = v; }
        bf16x8_t qf[4];
        { const bf16* qp = PS + (tb + (size_t)(i0 + 32 * w + q) * dil) * PSW + C_Q + h * 64 + 8 * hh;
#pragma unroll
          for (int s = 0; s < 4; ++s) qf[s] = *(const bf16x8_t*)(qp + 16 * s); }
        f32x16 p[5];
#pragma unroll
        for (int kt = 0; kt < 5; ++kt) {
            int ki = i0 + 32 * w - 128 + 32 * kt + q; ki = ki < 0 ? 0 : ki;
            const bf16* kp = PS + (tb + (size_t)ki * dil) * PSW + C_K + h * 64 + 8 * hh;
            bf16x8_t kf[4];
#pragma unroll
            for (int s = 0; s < 4; ++s) kf[s] = *(const bf16x8_t*)(kp + 16 * s);
            f32x16 acc = {};
#pragma unroll
            for (int s = 0; s < 4; ++s) acc = __builtin_amdgcn_mfma_f32_32x32x16_bf16(kf[s], qf[s], acc, 0, 0, 0);
            p[kt] = acc;
        }
        const int kbase = i0 + 32 * w - 128;
        float mx = -3.0e38f;
#pragma unroll
        for (int kt = 0; kt < 5; ++kt)
#pragma unroll
            for (int gq = 0; gq < 16; ++gq) { const int kl = crow16(gq, hh); const int dist = q + 128 - 32 * kt - kl;
                const bool ok = (dist >= 0) && (dist <= 128) && (kbase + 32 * kt + kl >= 0);
                const float s = ok ? p[kt][gq] : -3.0e38f; p[kt][gq] = s; mx = fmaxf(mx, s); }
        mx = xmax32(mx);
        const float sc = 0.125f * 1.4426950408889634f;
        float l = 0.f;
#pragma unroll
        for (int kt = 0; kt < 5; ++kt)
#pragma unroll
            for (int gq = 0; gq < 16; ++gq) { const float e = __builtin_amdgcn_exp2f((p[kt][gq] - mx) * sc); p[kt][gq] = e; l += e; }
        l = xsum32(l);
        __syncthreads();
        f32x16 o[2]; o[0] = f32x16{}; o[1] = f32x16{};
        const unsigned char* vb = VI + ((32 * w + 4 * hh + ((lane & 15) >> 2)) * ATT_VS + 16 * ((lane >> 4) & 1) + 4 * (lane & 3)) * 2;
#pragma unroll
        for (int kt = 0; kt < 5; ++kt)
#pragma unroll
            for (int s = 0; s < 2; ++s) {
                v4u pw; pw.x = cvtpk(p[kt][8 * s + 0], p[kt][8 * s + 1]); pw.y = cvtpk(p[kt][8 * s + 2], p[kt][8 * s + 3]); pw.z = cvtpk(p[kt][8 * s + 4], p[kt][8 * s + 5]); pw.w = cvtpk(p[kt][8 * s + 6], p[kt][8 * s + 7]);
                const bf16x8_t pb = __builtin_bit_cast(bf16x8_t, pw);
#pragma unroll
                for (int dt = 0; dt < 2; ++dt) {
                    const unsigned char* vp = vb + ((32 * kt + 16 * s) * ATT_VS + 32 * dt) * 2;
                    const v4i16_t lo = ds_tr16(vp), hi = ds_tr16(vp + 8 * ATT_VS * 2);
                    const bf16x8_t va = (bf16x8_t){lo[0], lo[1], lo[2], lo[3], hi[0], hi[1], hi[2], hi[3]};
                    o[dt] = __builtin_amdgcn_mfma_f32_32x32x16_bf16(va, pb, o[dt], 0, 0, 0);
                }
            }
        const float il = 1.0f / l;
        bf16* op = PS + (tb + (size_t)(i0 + 32 * w + q) * dil) * PSW + C_Q + h * 64 + 4 * hh;
#pragma unroll
        for (int dt = 0; dt < 2; ++dt)
#pragma unroll
            for (int g4 = 0; g4 < 4; ++g4) { v2u wv; wv.x = cvtpk(o[dt][4 * g4 + 0] * il, o[dt][4 * g4 + 1] * il); wv.y = cvtpk(o[dt][4 * g4 + 2] * il, o[dt][4 * g4 + 3] * il);
                *(v2u*)(op + 32 * dt + 8 * g4) = wv; }
        if (hh == 0) LSE[(tb + (size_t)(i0 + 32 * w + q) * dil) * 6 + h] = mx * 0.125f + __logf(l);
        __syncthreads();
    }
}
constexpr int TS = 72;
constexpr int RL_A = 0, RL_B = 9216, RL_K = 18432, RL_R = 27648, RL_AT = 36864, RL_VT = 46080, RL_BHT = 55296, RL_KHT = 64512,
              RL_AAK = 73728, RL_ARB = 82944, RL_ARK = 92160, RL_AABF = 101376, RL_TF = 117760, RL_PB = 134144;
constexpr int RL_TB = RL_A, RL_XT = RL_B, RL_WT = RL_K, RL_UT = RL_AAK;
constexpr int RL_WLF = 73728, RL_ALF = 90112, RL_GF = 106496, RL_LW = 122880;
static_assert(RL_LW + 16384 <= LDS_BYTES && RL_PB + 3072 <= LDS_BYTES, "rwkv LDS map");
constexpr int RW_ITEMS = BATCH * 6 * 64;
#ifndef SEC
#define SEC 0xFFFF
#endif

__device__ __forceinline__ bf16x8_t ldfrag(const unsigned char* tile, int row, int s, int hh) { return *(const bf16x8_t*)(tile + (row * TS + 16 * s + 8 * hh) * 2); }
__device__ __forceinline__ f32x16 mm64(f32x16 acc, const unsigned char* At, int arow0, const unsigned char* Bt, int brow0, int ks, int lane) {
    const int r = lane & 31, hh = lane >> 5;
#pragma unroll
    for (int s = 0; s < 4; ++s) if (s < ks) acc = __builtin_amdgcn_mfma_f32_32x32x16_bf16(ldfrag(At, arow0 + r, s, hh), ldfrag(Bt, brow0 + r, s, hh), acc, 0, 0, 0);
    return acc;
}
__device__ __forceinline__ void st_tileT(unsigned char* tile, int ncol, int m0, const f32x16& acc, int hh) {
#pragma unroll
    for (int g4 = 0; g4 < 4; ++g4) { v2u wv; wv.x = cvtpk(acc[4 * g4 + 0], acc[4 * g4 + 1]); wv.y = cvtpk(acc[4 * g4 + 2], acc[4 * g4 + 3]);
        *(v2u*)(tile + (ncol * TS + m0 + 8 * g4 + 4 * hh) * 2) = wv; }
}
__device__ __forceinline__ bf16x8_t pack8(const float (&z)[8]) { v4u pw; pw.x = cvtpk(z[0], z[1]); pw.y = cvtpk(z[2], z[3]); pw.z = cvtpk(z[4], z[5]); pw.w = cvtpk(z[6], z[7]); return __builtin_bit_cast(bf16x8_t, pw); }
__device__ __forceinline__ void unpack8(const v4u w, float (&z)[8]) { z[0] = bflo(w.x); z[1] = bfhi(w.x); z[2] = bflo(w.y); z[3] = bfhi(w.y); z[4] = bflo(w.z); z[5] = bfhi(w.z); z[6] = bflo(w.w); z[7] = bfhi(w.w); }

template <int ACT> __device__ __forceinline__ bf16x8_t lora_frag(const bf16* PS, size_t grow, bool first, int jcol, const float* mix) {
    float c[8], p[8];
    unpack8(*(const v4u*)(PS + grow * PSW + C_LORA + jcol), c);
    if (first) {
#pragma unroll
        for (int e = 0; e < 8; ++e) p[e] = 0.f;
    } else unpack8(*(const v4u*)(PS + (grow - 1) * PSW + C_LORA + jcol), p);
    const f32x4 m0 = *(const f32x4*)(mix + 1152 + jcol), m1 = *(const f32x4*)(mix + 1152 + jcol + 4);
    float z[8];
#pragma unroll
    for (int e = 0; e < 8; ++e) { const float mm = e < 4 ? m0[e] : m1[e - 4]; float v = c[e] + (p[e] - c[e]) * mm;
        if (ACT == 1) v = 1.0f - 2.0f / (__expf(2.0f * v) + 1.0f); else if (ACT == 2) v = sigm(v);
        z[e] = v; }
    return pack8(z);
}

__device__ __forceinline__ void rwkv_p1(const KA& A, const Ctx& F, int l) {
    bf16* PS = (bf16*)(F.ws + WS_PS); const bf16* BRB = (const bf16*)(F.ws + WS_BR);
    unsigned char* L = F.lds;
    unsigned char* wl = F.ws + WS_W + (size_t)l * W_LAYER;
    const bf16* W2T = (const bf16*)(wl + WO_W2); const bf16* A2T = (const bf16*)(wl + WO_A2); const bf16* G2T = (const bf16*)(wl + WO_G2);
    const float* mix = A.in(3) + (size_t)l * 1408;
    int tid = F.tid, lane = F.lane, r32 = lane & 31, hh = lane >> 5; const int w = F.wave;
#define RW_FENCE() do { __syncthreads(); asm volatile("" : "+v"(tid)); lane = tid & 63; r32 = lane & 31; hh = lane >> 5; hc = h * 64 + lane; } while (0)
#pragma unroll 1
    for (int item = F.bid; item < RW_ITEMS; item += F.G) {
        const int j = item & 63, h = (item >> 6) % 6, b = item / 384;
        const size_t row0 = (size_t)b * SEQ + 64 * j;
        int hc = h * 64 + lane;
        if (SEC & 1) {
            const int tl = (w & 3), ct = tl >> 1, tt = tl & 1;
            const size_t grow = row0 + 32 * tt + r32; const bool first = (j == 0) && (tt == 0) && (r32 == 0);
            if (w < 4) {
                f32x16 acc = {};
#pragma unroll
                for (int s = 0; s < 8; ++s) { const bf16x8_t af = *(const bf16x8_t*)(G2T + (size_t)(h * 64 + 32 * ct + r32) * 128 + 16 * s + 8 * hh);
                    acc = __builtin_amdgcn_mfma_f32_32x32x16_bf16(af, lora_frag<2>(PS, grow, first, 128 + 16 * s + 8 * hh, mix), acc, 0, 0, 0); }
                float* G = (float*)(L + RL_GF);
#pragma unroll
                for (int g4 = 0; g4 < 4; ++g4) *(f32x4*)(G + (32 * tt + r32) * 64 + 32 * ct + 8 * g4 + 4 * hh) = (f32x4){acc[4 * g4], acc[4 * g4 + 1], acc[4 * g4 + 2], acc[4 * g4 + 3]};
            } else {
                f32x16 accw = {}, acca = {};
#pragma unroll
                for (int s = 0; s < 4; ++s) {
                    const bf16x8_t wf = *(const bf16x8_t*)(W2T + (size_t)(h * 64 + 32 * ct + r32) * 64 + 16 * s + 8 * hh);
                    const bf16x8_t af = *(const bf16x8_t*)(A2T + (size_t)(h * 64 + 32 * ct + r32) * 64 + 16 * s + 8 * hh);
                    accw = __builtin_amdgcn_mfma_f32_32x32x16_bf16(wf, lora_frag<1>(PS, grow, first, 16 * s + 8 * hh, mix), accw, 0, 0, 0);
                    acca = __builtin_amdgcn_mfma_f32_32x32x16_bf16(af, lora_frag<0>(PS, grow, first, 64 + 16 * s + 8 * hh, mix), acca, 0, 0, 0); }
                float* WLp = (float*)(L + RL_WLF); float* ALp = (float*)(L + RL_ALF);
#pragma unroll
                for (int g4 = 0; g4 < 4; ++g4) { const int o = (32 * tt + r32) * 64 + 32 * ct + 8 * g4 + 4 * hh;
                    *(f32x4*)(WLp + o) = (f32x4){accw[4 * g4], accw[4 * g4 + 1], accw[4 * g4 + 2], accw[4 * g4 + 3]};
                    *(f32x4*)(ALp + o) = (f32x4){acca[4 * g4], acca[4 * g4 + 1], acca[4 * g4 + 2], acca[4 * g4 + 3]}; }
            }
        }
        float rr[8], kn[8], vv[8], kk[8], bb[8], eadd[8];
        {
            const float mr = mix[hc], mk = mix[384 + hc], mv = mix[768 + hc];
#pragma unroll
            for (int i = 0; i < 8; ++i) { const int t = w + 8 * i; const size_t g = row0 + t;
                const bf16* cp = PS + g * PSW + C_RW + hc;
                const float cr = bf2f(cp[0]), ck = bf2f(cp[384]), cv = bf2f(cp[768]);
                float pr, pk, pv;
                if (t == 0) { if (j == 0) { pr = 0.f; pk = 0.f; pv = 0.f; } else { const bf16* bp = BRB + (size_t)(b * 64 + j - 1) * PSW + C_RW + hc; pr = bf2f(bp[0]); pk = bf2f(bp[384]); pv = bf2f(bp[768]); } }
                else { const bf16* pp = cp - PSW; pr = bf2f(pp[0]); pk = bf2f(pp[384]); pv = bf2f(pp[768]); }
                rr[i] = cr + (pr - cr) * mr; kn[i] = ck + (pk - ck) * mk; vv[i] = cv + (pv - cv) * mv; }
        }
        RW_FENCE();
        if (SEC & 2) {
            const float* WLp = (const float*)(L + RL_WLF); const float* ALp = (const float*)(L + RL_ALF); const float* G = (const float*)(L + RL_GF); float* LW = (float*)(L + RL_LW);
            const float w0c = A.in(4)[l * 384 + hc], a0c = A.in(6)[l * 384 + hc], kkc = A.in(9)[l * 384 + hc], kac = A.in(10)[l * 384 + hc], rkc = A.in(11)[l * 384 + hc];
            const float lnw = A.in(12)[l * 384 + hc], lnb = A.in(13)[l * 384 + hc];
            bf16* EM = (bf16*)(F.ws + WS_REM) + (size_t)item * 4096;
#pragma unroll
            for (int i = 0; i < 8; ++i) { const int t = w + 8 * i; const int o = t * 64 + lane;
                const float x = -(w0c + WLp[o]); const float sp = (x > 20.f) ? x : log1pf(__expf(x)); const float wv = -sp - 0.5f;
                LW[o] = -__expf(wv);
                const float av = sigm(a0c + ALp[o]); const float gv = G[o];
                float kq = kn[i] * kkc; const float nrm = sqrtf(wave_sum(kq * kq)); kq = kq / fmaxf(nrm, 1e-12f);
                const float knew = kn[i] * (1.0f + (av - 1.0f) * kac);
                const float bon = wave_sum(rr[i] * knew * rkc);
                kk[i] = kq; bb[i] = kq * av; kn[i] = knew;
                EM[o] = (bf16)f2bf(lnw * gv); eadd[i] = (lnb + bon * vv[i]) * gv; }
        }
        RW_FENCE();
        if ((SEC & 4) && w == 0) { float* LW = (float*)(L + RL_LW); float c[64];
#pragma unroll
            for (int t = 0; t < 64; ++t) c[t] = LW[t * 64 + lane];
#pragma unroll
            for (int t = 1; t < 64; ++t) c[t] += c[t - 1];
#pragma unroll
            for (int t = 0; t < 64; ++t) LW[t * 64 + lane] = c[t];
            ((float*)(F.ws + WS_RGL))[(size_t)item * 64 + lane] = __expf(c[63]); }
        RW_FENCE();
        if (SEC & 8) {
            const float* CU = (const float*)(L + RL_LW); const float cl = CU[63 * 64 + lane];
            bf16* At = (bf16*)(L + RL_A), *Bt = (bf16*)(L + RL_B), *Kt = (bf16*)(L + RL_K), *Rt = (bf16*)(L + RL_R);
            bf16* ATt = (bf16*)(L + RL_AT), *VTt = (bf16*)(L + RL_VT), *BHt = (bf16*)(L + RL_BHT), *KHt = (bf16*)(L + RL_KHT);
#pragma unroll
            for (int i = 0; i < 8; ++i) { const int t = w + 8 * i;
                const float ct = CU[t * 64 + lane], cp = (t == 0) ? 0.f : CU[(t - 1) * 64 + lane];
                const float ep = __expf(cp), et = __expf(ct), ei = __expf(-ct), eh = __expf(cl - ct);
                const bf16 av = (bf16)f2bf(-kk[i] * ep);
                At[t * TS + lane] = av; ATt[lane * TS + t] = av;
                Rt[t * TS + lane] = (bf16)f2bf(rr[i] * et);
                Bt[t * TS + lane] = (bf16)f2bf(bb[i] * ei); Kt[t * TS + lane] = (bf16)f2bf(kn[i] * ei);
                VTt[lane * TS + t] = (bf16)f2bf(vv[i]); BHt[lane * TS + t] = (bf16)f2bf(bb[i] * eh); KHt[lane * TS + t] = (bf16)f2bf(kn[i] * eh); }
        }
        RW_FENCE();
#pragma unroll
        for (int rep = 0; rep < ((SEC & 16) ? 2 : 0); ++rep) { const int job = w + 8 * rep, prod = job >> 2, tt = (job >> 1) & 1, st = job & 1;
            f32x16 acc = {};
            acc = mm64(acc, L + ((prod & 1) ? RL_K : RL_B), 32 * st, L + ((prod & 2) ? RL_R : RL_A), 32 * tt, 4, lane);
            const int t = 32 * tt + r32; const int incl = prod >> 1;
#pragma unroll
            for (int g = 0; g < 16; ++g) { const int s = 32 * st + crow16(g, hh); if (!(s < t + incl)) acc[g] = 0.f; }
            if (prod == 0) { float* AF = (float*)(L + RL_AABF);
#pragma unroll
                for (int g4 = 0; g4 < 4; ++g4) *(f32x4*)(AF + t * 64 + 32 * st + 8 * g4 + 4 * hh) = (f32x4){acc[4 * g4], acc[4 * g4 + 1], acc[4 * g4 + 2], acc[4 * g4 + 3]};
            } else st_tileT(L + (prod == 1 ? RL_AAK : (prod == 2 ? RL_ARB : RL_ARK)), t, 32 * st, acc, hh);
        }
        RW_FENCE();
        if (SEC & 32) {
            const float* AF = (const float*)(L + RL_AABF); float* TF = (float*)(L + RL_TF); float* PB = (float*)(L + RL_PB);
            if (w == 0) {
                const int I = lane >> 4, jc = lane & 15; float x[16];
#pragma unroll
                for (int r = 0; r < 16; ++r) { float s = (r == jc) ? 1.f : 0.f;
#pragma unroll
                    for (int q = 0; q < 16; ++q) if (q < r) s += AF[(16 * I + r) * 64 + 16 * I + q] * x[q];
                    x[r] = s; TF[(16 * I + r) * 64 + 16 * I + jc] = s; }
            } else if (w >= 4) { const int tl = w - 4, tt = tl >> 1, it = tl & 1;
                f32x16 acc = {};
                acc = mm64(acc, L + RL_AAK, 32 * tt, L + RL_VT, 32 * it, tt ? 4 : 2, lane);
                st_tileT(L + RL_XT, 32 * it + r32, 32 * tt, acc, hh); }
            RW_FENCE();
#pragma unroll 1
            for (int dist = 1; dist < 4; ++dist) { const int nb = 4 - dist;
                for (int o = tid; o < nb * 256; o += NTHREADS) { const int J = o >> 8, I = J + dist, rw = (o >> 4) & 15, cc = o & 15; float s = 0.f;
                    for (int Kb = J; Kb < I; ++Kb)
#pragma unroll
                        for (int m = 0; m < 16; ++m) s += AF[(16 * I + rw) * 64 + 16 * Kb + m] * TF[(16 * Kb + m) * 64 + 16 * J + cc];
                    PB[o] = s; }
                __syncthreads();
                for (int o = tid; o < nb * 256; o += NTHREADS) { const int J = o >> 8, I = J + dist, rw = (o >> 4) & 15, cc = o & 15; float s = 0.f;
#pragma unroll
                    for (int m = 0; m < 16; ++m) s += TF[(16 * I + rw) * 64 + 16 * I + m] * PB[(J << 8) + m * 16 + cc];
                    TF[(16 * I + rw) * 64 + 16 * J + cc] = s; }
                __syncthreads();
            }
            bf16* TB = (bf16*)(L + RL_TB);
#pragma unroll
            for (int e = 0; e < 8; ++e) { const int o = tid + NTHREADS * e, t = o >> 6, s = o & 63; TB[t * TS + s] = ((s >> 4) > (t >> 4)) ? (bf16)0 : (bf16)f2bf(TF[o]); }
        }
        RW_FENCE();
        if (SEC & 64) { const int mat = w >> 2, tl = w & 3, tt = tl >> 1, nt = tl & 1;
          f32x16 acc = {};
          acc = mm64(acc, L + RL_TB, 32 * tt, L + (mat ? RL_XT : RL_AT), 32 * nt, tt ? 4 : 2, lane);
          st_tileT(L + (mat ? RL_UT : RL_WT), 32 * nt + r32, 32 * tt, acc, hh); }
        RW_FENCE();
        if (SEC & 128) { const int tl = w & 3, ta = tl >> 1, tb2 = tl & 1;
          if (w < 4) {
              f32x16 acc = {};
              acc = mm64(acc, L + RL_WT, 32 * ta, L + RL_BHT, 32 * tb2, 4, lane);
              bf16* MC = (bf16*)(F.ws + WS_RMC) + (size_t)item * 4096;
#pragma unroll
              for (int g4 = 0; g4 < 4; ++g4) { v2u wv; wv.x = cvtpk(acc[4 * g4], acc[4 * g4 + 1]); wv.y = cvtpk(acc[4 * g4 + 2], acc[4 * g4 + 3]); *(v2u*)(MC + (32 * tb2 + r32) * 64 + 32 * ta + 8 * g4 + 4 * hh) = wv; }
              f32x16 an = {};
              an = mm64(an, L + RL_BHT, 32 * ta, L + RL_UT, 32 * tb2, 4, lane);
              an = mm64(an, L + RL_KHT, 32 * ta, L + RL_VT, 32 * tb2, 4, lane);
              bf16* NT = (bf16*)(F.ws + WS_RNT) + (size_t)item * 4096;
#pragma unroll
              for (int g4 = 0; g4 < 4; ++g4) { v2u wv; wv.x = cvtpk(an[4 * g4], an[4 * g4 + 1]); wv.y = cvtpk(an[4 * g4 + 2], an[4 * g4 + 3]); *(v2u*)(NT + (32 * tb2 + r32) * 64 + 32 * ta + 8 * g4 + 4 * hh) = wv; }
          } else {
              f32x16 acc = {};
              acc = mm64(acc, L + RL_WT, 32 * ta, L + RL_ARB, 32 * tb2, tb2 ? 4 : 2, lane);
              const int t = 32 * tb2 + r32; const bf16* Rt = (const bf16*)(L + RL_R);
              bf16* qd = PS + (row0 + t) * PSW + C_RW + h * 64;
#pragma unroll
              for (int g4 = 0; g4 < 4; ++g4) { const int c0 = 32 * ta + 8 * g4 + 4 * hh; const v2u rv = *(const v2u*)(Rt + t * TS + c0);
                  v2u wv; wv.x = cvtpk(acc[4 * g4] + bflo(rv.x), acc[4 * g4 + 1] + bfhi(rv.x)); wv.y = cvtpk(acc[4 * g4 + 2] + bflo(rv.y), acc[4 * g4 + 3] + bfhi(rv.y)); *(v2u*)(qd + c0) = wv; }
              f32x16 ay = {};
              ay = mm64(ay, L + RL_UT, 32 * ta, L + RL_ARB, 32 * tb2, tb2 ? 4 : 2, lane);
              ay = mm64(ay, L + RL_VT, 32 * ta, L + RL_ARK, 32 * tb2, tb2 ? 4 : 2, lane);
              bf16* yd = PS + (row0 + t) * PSW + C_RW + 384 + h * 64;
#pragma unroll
              for (int g4 = 0; g4 < 4; ++g4) { v2u wv; wv.x = cvtpk(ay[4 * g4], ay[4 * g4 + 1]); wv.y = cvtpk(ay[4 * g4 + 2], ay[4 * g4 + 3]); *(v2u*)(yd + 32 * ta + 8 * g4 + 4 * hh) = wv; }
          }
#pragma unroll
          for (int i = 0; i < 8; ++i) { const int t = w + 8 * i; PS[(row0 + t) * PSW + C_RW + 768 + hc] = (bf16)f2bf(eadd[i]); }
        }
        RW_FENCE();
    }
}
#undef RW_FENCE

__device__ __forceinline__ void rwkv_scan(const KA& A, const Ctx& F, int l, int b, int h) {
    bf16* PS = (bf16*)(F.ws + WS_PS);
    unsigned char* L = F.lds;
    const int tid = F.tid, lane = F.lane, w = F.wave, r32 = lane & 31, hh = lane >> 5;
    for (int o = tid; o < 2 * 9216 / 4; o += NTHREADS) ((unsigned*)L)[o] = 0u;
    __syncthreads();
    const int ta = (w >> 1) & 1, tb2 = w & 1;
    f32x16 Hacc = {};
#pragma unroll 1
    for (int j = 0; j < 64; ++j) {
        const int item = (b * 6 + h) * 64 + j; const size_t row0 = (size_t)b * SEQ + 64 * j;
        const unsigned char* HBc = L + (j & 1) * 9216; unsigned char* HBn = L + ((j + 1) & 1) * 9216;
        if (w < 4) {
            const bf16* MC = (const bf16*)(F.ws + WS_RMC) + (size_t)item * 4096; const bf16* NT = (const bf16*)(F.ws + WS_RNT) + (size_t)item * 4096; const float* GL = (const float*)(F.ws + WS_RGL) + (size_t)item * 64;
            bf16x8_t mf[4];
#pragma unroll
            for (int s = 0; s < 4; ++s) mf[s] = *(const bf16x8_t*)(MC + (32 * ta + r32) * 64 + 16 * s + 8 * hh);
#pragma unroll
            for (int g4 = 0; g4 < 4; ++g4) { const int c0 = 32 * ta + 8 * g4 + 4 * hh; const f32x4 gl = *(const f32x4*)(GL + c0); const v2u nv = *(const v2u*)(NT + (32 * tb2 + r32) * 64 + c0);
                Hacc[4 * g4 + 0] = Hacc[4 * g4 + 0] * gl[0] + bflo(nv.x); Hacc[4 * g4 + 1] = Hacc[4 * g4 + 1] * gl[1] + bfhi(nv.x); Hacc[4 * g4 + 2] = Hacc[4 * g4 + 2] * gl[2] + bflo(nv.y); Hacc[4 * g4 + 3] = Hacc[4 * g4 + 3] * gl[3] + bfhi(nv.y); }
#pragma unroll
            for (int s = 0; s < 4; ++s) Hacc = __builtin_amdgcn_mfma_f32_32x32x16_bf16(mf[s], ldfrag(HBc, 32 * tb2 + r32, s, hh), Hacc, 0, 0, 0);
            st_tileT(HBn, 32 * tb2 + r32, 32 * ta, Hacc, hh);
        } else if (w < 6) {
            const int t = 32 * tb2 + r32;
            const bf16* qd = PS + (row0 + t) * PSW + C_RW + h * 64; const bf16* yd = qd + 384; const bf16* ed = qd + 768; const bf16* EM = (const bf16*)(F.ws + WS_REM) + (size_t)item * 4096 + t * 64;
            bf16x8_t qf[4];
#pragma unroll
            for (int s = 0; s < 4; ++s) qf[s] = *(const bf16x8_t*)(qd + 16 * s + 8 * hh);
            f32x16 y[2];
#pragma unroll
            for (int it = 0; it < 2; ++it) {
#pragma unroll
                for (int g4 = 0; g4 < 4; ++g4) { const v2u yv = *(const v2u*)(yd + 32 * it + 8 * g4 + 4 * hh); y[it][4 * g4] = bflo(yv.x); y[it][4 * g4 + 1] = bfhi(yv.x); y[it][4 * g4 + 2] = bflo(yv.y); y[it][4 * g4 + 3] = bfhi(yv.y); }
#pragma unroll
                for (int s = 0; s < 4; ++s) y[it] = __builtin_amdgcn_mfma_f32_32x32x16_bf16(ldfrag(HBc, 32 * it + r32, s, hh), qf[s], y[it], 0, 0, 0);
            }
            float s1 = 0.f, s2 = 0.f;
#pragma unroll
            for (int it = 0; it < 2; ++it)
#pragma unroll
                for (int g = 0; g < 16; ++g) { s1 += y[it][g]; s2 += y[it][g] * y[it][g]; }
            s1 = xsum32(s1); s2 = xsum32(s2);
            const float mu = s1 * (1.0f / 64.0f); const float var = fmaxf(s2 * (1.0f / 64.0f) - mu * mu, 0.f); const float rs = 1.0f / sqrtf(var + GN_EPS);
            bf16* od = PS + (row0 + t) * PSW + C_RW + h * 64;
#pragma unroll
            for (int it = 0; it < 2; ++it)
#pragma unroll
                for (int g4 = 0; g4 < 4; ++g4) { const int i0 = 32 * it + 8 * g4 + 4 * hh; const v2u em = *(const v2u*)(EM + i0); const v2u ea = *(const v2u*)(ed + i0);
                    v2u wv; wv.x = cvtpk((y[it][4 * g4] - mu) * rs * bflo(em.x) + bflo(ea.x), (y[it][4 * g4 + 1] - mu) * rs * bfhi(em.x) + bfhi(ea.x));
                    wv.y = cvtpk((y[it][4 * g4 + 2] - mu) * rs * bflo(em.y) + bflo(ea.y), (y[it][4 * g4 + 3] - mu) * rs * bfhi(em.y) + bfhi(ea.y));
                    *(v2u*)(od + i0) = wv; }
        }
        __syncthreads();
    }
}
constexpr size_t SSG_TM = 0, SSG_GM = 131072, SSG_HM = 196608, SSG_LAM = 262144, SSG_BYTES = 263168;
constexpr size_t WS_SSM = WS_RGL + 1 * MiB;
static_assert(WS_SSM + 32 * SSG_BYTES <= 512 * MiB, "ssm matrices fit the workspace");
constexpr int ZS = 132;

__device__ __forceinline__ void ssm_prep(const KA& A, const Ctx& F, int l, int g) {
    float* L = (float*)F.lds;
    float* PWr = L, *PWi = L + 17 * 64, *BBr = L + 2 * 17 * 64, *BBi = BBr + 1024, *CCr = BBi + 1024, *CCi = CCr + 1024, *KE = CCi + 1024;
    unsigned char* base = F.ws + WS_SSM + (size_t)(l * 16 + g) * SSG_BYTES;
    const int tid = F.tid;
    __syncthreads();
    if (tid < 64) { const int p = tid;
        const float step = __expf(A.in(16)[l * 16 + g]);
        const float lr = A.in(14)[(size_t)l * 1024 + g * 64 + p], li = A.in(15)[(size_t)l * 1024 + g * 64 + p];
        const float ang = li * step;
        for (int m = 0; m <= 16; ++m) { float sn, cs; sincosf(ang * (float)m, &sn, &cs); const float mg = __expf(lr * step * (float)m); PWr[m * 64 + p] = mg * cs; PWi[m * 64 + p] = mg * sn; }
        const float are = PWr[64 + p], aim = PWi[64 + p];
        const float inv = 1.0f / (lr * lr + li * li);
        const float fre = ((are - 1.0f) * lr + aim * li) * inv, fim = (aim * lr - (are - 1.0f) * li) * inv;
        const float* br = A.in(17) + (size_t)l * 16384 + (size_t)(g * 64 + p) * 16, *bi = A.in(18) + (size_t)l * 16384 + (size_t)(g * 64 + p) * 16;
        for (int c = 0; c < 16; ++c) { BBr[p * 16 + c] = fre * br[c] - fim * bi[c]; BBi[p * 16 + c] = fre * bi[c] + fim * br[c]; }
        float* lam = (float*)(base + SSG_LAM); lam[p] = PWr[16 * 64 + p]; lam[64 + p] = PWi[16 * 64 + p];
    }
    for (int e = tid; e < 1024; e += NTHREADS) { CCr[e] = A.in(19)[(size_t)l * 16384 + g * 1024 + e]; CCi[e] = A.in(20)[(size_t)l * 16384 + g * 1024 + e]; }
    __syncthreads();
    for (int e = tid; e < 4096; e += NTHREADS) { const int tau = e >> 8, c = (e >> 4) & 15, cp = e & 15; float s = 0.f;
        for (int p = 0; p < 64; ++p) { const float wr = CCr[c * 64 + p] * PWr[tau * 64 + p] - CCi[c * 64 + p] * PWi[tau * 64 + p], wi = CCr[c * 64 + p] * PWi[tau * 64 + p] + CCi[c * 64 + p] * PWr[tau * 64 + p];
            s += wr * BBr[p * 16 + cp] - wi * BBi[p * 16 + cp]; }
        KE[e] = s; }
    __syncthreads();
    const float* dsk = A.in(21) + l * 256 + g * 16;
    bf16* TM = (bf16*)(base + SSG_TM); bf16* GM = (bf16*)(base + SSG_GM); bf16* HM = (bf16*)(base + SSG_HM);
    for (int e = tid; e < 65536; e += NTHREADS) { const int n = e >> 8, k = e & 255, tp = n >> 4, c = n & 15, sp = k >> 4, cp = k & 15;
        float v = (sp <= tp) ? KE[((tp - sp) << 8) + (c << 4) + cp] : 0.f; if (sp == tp && c == cp) v += dsk[c];
        TM[e] = (bf16)f2bf(v); }
    for (int e = tid; e < 32768; e += NTHREADS) { const int n = e >> 8, k = e & 255, p = n & 63, im = n >> 6, sp = k >> 4, cp = k & 15, m = 15 - sp;
        const float wr = PWr[m * 64 + p] * BBr[p * 16 + cp] - PWi[m * 64 + p] * BBi[p * 16 + cp], wi = PWr[m * 64 + p] * BBi[p * 16 + cp] + PWi[m * 64 + p] * BBr[p * 16 + cp];
        GM[e] = (bf16)f2bf(im ? wi : wr); }
    for (int e = tid; e < 32768; e += NTHREADS) { const int n = e >> 7, k = e & 127, tp = n >> 4, c = n & 15, p = k & 63, im = k >> 6, m = tp + 1;
        const float wr = CCr[c * 64 + p] * PWr[m * 64 + p] - CCi[c * 64 + p] * PWi[m * 64 + p], wi = CCr[c * 64 + p] * PWi[m * 64 + p] + CCi[c * 64 + p] * PWr[m * 64 + p];
        HM[e] = (bf16)f2bf(im ? -wi : wr); }
    __syncthreads();
}

__device__ __forceinline__ void ssm_v2(const KA& A, const Ctx& F, int l, int b, int g) {
    bf16* PS = (bf16*)(F.ws + WS_PS);
    float* ZF = (float*)F.lds;
    const unsigned char* base = F.ws + WS_SSM + (size_t)(l * 16 + g) * SSG_BYTES;
    const bf16* TM = (const bf16*)(base + SSG_TM); const bf16* GM = (const bf16*)(base + SSG_GM); const bf16* HM = (const bf16*)(base + SSG_HM); const float* lam = (const float*)(base + SSG_LAM);
    const int lane = F.lane, w = F.wave, r32 = lane & 31, hh = lane >> 5;
    const size_t tok0 = (size_t)b * SEQ + 512 * w;
    bf16x8_t uf[16];
    { const bf16* up = PS + (tok0 + 16 * r32) * PSW + C_SSM + 16 * g + 8 * hh;
#pragma unroll
      for (int s = 0; s < 16; ++s) uf[s] = *(const bf16x8_t*)(up + (size_t)s * PSW); }
#pragma unroll 1
    for (int nt = 0; nt < 4; ++nt) {
        f32x16 acc = {};
        const bf16* gp = GM + (size_t)(32 * nt + r32) * 256 + 8 * hh;
#pragma unroll
        for (int s = 0; s < 16; ++s) acc = __builtin_amdgcn_mfma_f32_32x32x16_bf16(uf[s], *(const bf16x8_t*)(gp + 16 * s), acc, 0, 0, 0);
#pragma unroll
        for (int q = 0; q < 16; ++q) ZF[(32 * w + crow16(q, hh)) * ZS + 32 * nt + r32] = acc[q];
    }
    __syncthreads();
    if (w == 0) { const float lr = lam[lane], li = lam[64 + lane]; float xr = 0.f, xi = 0.f;
#pragma unroll 8
        for (int j = 0; j < 256; ++j) { const float zr = ZF[j * ZS + lane], zi = ZF[j * ZS + 64 + lane];
            ZF[j * ZS + lane] = xr; ZF[j * ZS + 64 + lane] = xi;
            const float nr = lr * xr - li * xi + zr, ni = lr * xi + li * xr + zi; xr = nr; xi = ni; } }
    __syncthreads();
    bf16x8_t xf[8];
    { const float* zp = ZF + (32 * w + r32) * ZS + 8 * hh;
#pragma unroll
      for (int s = 0; s < 8; ++s) { const f32x4 a0 = *(const f32x4*)(zp + 16 * s), a1 = *(const f32x4*)(zp + 16 * s + 4);
          v4u pw; pw.x = cvtpk(a0[0], a0[1]); pw.y = cvtpk(a0[2], a0[3]); pw.z = cvtpk(a1[0], a1[1]); pw.w = cvtpk(a1[2], a1[3]); xf[s] = __builtin_bit_cast(bf16x8_t, pw); } }
#pragma unroll
    for (int nt = 0; nt < 8; ++nt) {
        f32x16 acc = {};
        const bf16* tp = TM + (size_t)(32 * nt + r32) * 256 + 8 * hh; const bf16* hp = HM + (size_t)(32 * nt + r32) * 128 + 8 * hh;
#pragma unroll
        for (int s = 0; s < 16; ++s) if (s <= 2 * nt + 1) acc = __builtin_amdgcn_mfma_f32_32x32x16_bf16(uf[s], *(const bf16x8_t*)(tp + 16 * s), acc, 0, 0, 0);
#pragma unroll
        for (int s = 0; s < 8; ++s) acc = __builtin_amdgcn_mfma_f32_32x32x16_bf16(xf[s], *(const bf16x8_t*)(hp + 16 * s), acc, 0, 0, 0);
        bf16* op = PS + (tok0 + 2 * nt + (r32 >> 4)) * PSW + C_SSM + 16 * g + (r32 & 15);
#pragma unroll
        for (int q = 0; q < 16; ++q) op[(size_t)(16 * crow16(q, hh)) * PSW] = (bf16)f2bf(gelu_tanh(acc[q]));
    }
    __syncthreads();
}
typedef GAS unsigned gu32;
#define RLX_AGENT __ATOMIC_RELAXED, __HIP_MEMORY_SCOPE_AGENT
#define XB_TMO      128
#define XB_XCNT(j)  (256  + 64 * (j))
#define XB_XSUB(j)  (1280 + 64 * (j))
#define XB_XGEN(j)  (2304 + 64 * (j))
#define XB_TOP      3328
#define XB_TOPGEN   3392
#define XCD_BAR_WORDS 3456
#define XB_SPIN_CAP (1u << 18)

__device__ __forceinline__ unsigned xb_ld(unsigned* p)              { return __hip_atomic_load(p, __ATOMIC_RELAXED, __HIP_MEMORY_SCOPE_AGENT); }
__device__ __forceinline__ unsigned xb_add(unsigned* p, unsigned v) { return __hip_atomic_fetch_add(p, v, __ATOMIC_RELAXED, __HIP_MEMORY_SCOPE_AGENT); }
__device__ __forceinline__ unsigned xb_xcc_id() { return (unsigned)__builtin_amdgcn_s_getreg((3 << 11) | 20) & 0xFu; }
#define XB_SPIN(cond, bar) do { unsigned _sp = 0; while (cond) { __builtin_amdgcn_s_sleep(1); \
    if ((++_sp & 255u) == 0u) { if (xb_ld(&(bar)[XB_TMO])) break; if (_sp > XB_SPIN_CAP) { atomicAdd(&(bar)[XB_TMO], 1u); break; } } } } while (0)

struct XcdBarrier {
    unsigned* bar; unsigned x;
    volatile LAS unsigned* st;
};

__device__ __forceinline__ XcdBarrier xcd_barrier_post(unsigned* bar, volatile LAS unsigned* st) {
    XcdBarrier b; b.bar = bar; b.x = xb_xcc_id(); b.st = st;
    if (threadIdx.x == 0) (void)xb_add(&bar[XB_XCNT(b.x)], 1u);
    return b;
}
__device__ __forceinline__ void xcd_barrier_complete(unsigned* bar, unsigned x, unsigned& nloc, unsigned& nx) {
    const unsigned G = gridDim.x * gridDim.y * gridDim.z;
    unsigned sum, cnt, mine, sp = 0u;
    for (;;) {
        sum = 0u; cnt = 0u; mine = 0u;
#pragma unroll
        for (unsigned j = 0; j < 16; ++j) { const unsigned c = xb_ld(&bar[XB_XCNT(j)]); sum += c; cnt += (c > 0u) ? 1u : 0u; mine = (j == x) ? c : mine; }
        if (sum == G) break;
        __builtin_amdgcn_s_sleep(1);
        if ((++sp & 255u) == 0u) { if (xb_ld(&bar[XB_TMO])) break; if (sp > XB_SPIN_CAP) { atomicAdd(&bar[XB_TMO], 1u); break; } }
    }
    nloc = mine > 0u ? mine : 1u; nx = cnt > 0u ? cnt : 1u;
}

__device__ __forceinline__ void xcd_barrier(const XcdBarrier& b) {
    asm volatile("s_waitcnt vmcnt(0)" ::: "memory");
    __syncthreads();
    if (threadIdx.x == 0) {
        unsigned* bar = b.bar;
        __builtin_amdgcn_s_waitcnt(0);
        unsigned nloc = b.st[0], nx = b.st[1];
        if (nloc == 0u) { xcd_barrier_complete(bar, b.x, nloc, nx); b.st[0] = nloc; b.st[1] = nx; }
        const unsigned old = xb_add(&bar[XB_XSUB(b.x)], 1u);
        const unsigned gen = old / nloc;
        if (old + 1u == (gen + 1u) * nloc) {
            __builtin_amdgcn_fence(__ATOMIC_RELEASE, "agent");
            asm volatile("s_waitcnt vmcnt(0)" ::: "memory");
            const unsigned og = xb_add(&bar[XB_TOP], 1u);
            const unsigned tg = og / nx;
            if (og + 1u == (tg + 1u) * nx) xb_add(&bar[XB_TOPGEN], 1u);
            else XB_SPIN(xb_ld(&bar[XB_TOPGEN]) == tg, bar);
            __builtin_amdgcn_fence(__ATOMIC_ACQUIRE, "agent");
            xb_add(&bar[XB_XGEN(b.x)], 1u);
            asm volatile("s_waitcnt vmcnt(0)" ::: "memory");
        } else {
            XB_SPIN(xb_ld(&bar[XB_XGEN(b.x)]) == gen, bar);
            __builtin_amdgcn_fence(__ATOMIC_ACQUIRE, "agent");
            asm volatile("s_waitcnt vmcnt(0)" ::: "memory");
        }
    }
    __syncthreads();
}

constexpr int PPL = 10, NPH = 2 + DEPTH * PPL;

__device__ __forceinline__ void run_phase(const KA& A, const Ctx& F, int ph) {
    PG8_LAS unsigned char* lds3 = (PG8_LAS unsigned char*)F.lds;
    bf16* XN = (bf16*)(F.ws + WS_XN); bf16* PS = (bf16*)(F.ws + WS_PS); bf16* SO = (bf16*)(F.ws + WS_SO);
    const int l = (ph - 1) / PPL, k = (ph == 0) ? 20 : (ph == NPH - 1 ? 21 : (ph - 1) % PPL);
    unsigned char* wl = F.ws + WS_W + (size_t)l * W_LAYER;
    const float* hin = (l == 0) ? A.in(0) : F.out;
    int ngemm = 0;
    if (k == 20) { phase_prep(A, F); for (int it = F.bid; it < 32; it += F.G) ssm_prep(A, F, it >> 4, it & 15); }
    else if (k == 21) phase_rmsnorm<true>(A, F, F.out, A.in(31), F.out);
    else if (k == 0) phase_rmsnorm<false>(A, F, hin, A.in(1) + l * D, XN);
    else if (k == 7) phase_rmsnorm<false>(A, F, F.out, A.in(28) + l * D, XN);
    else if (k == 2) rwkv_p1(A, F, l);
    else if (k == 3) {
        if (F.bid < 48) rwkv_scan(A, F, l, F.bid / 6, F.bid % 6);
        else if (F.bid < 176) { const int it = F.bid - 48; ssm_v2(A, F, l, it / 16, it % 16); }
        else attn_v2(A, F, F.bid - 176, F.G - 176);
    }
    else if (k == 4) { attn_finalize(A, F); ngemm = 1; }
    else if (k == 5) ngemm = 3;
    else ngemm = 1;
#pragma unroll 1
    for (int gi = 0; gi < ngemm; ++gi) {
        pg8::Gemm g; pg8::EpiAny E; E.kind = 0; E.gi = gi; E.ws = F.ws; E.base = hin; E.out = F.out;
        if (k == 1) { g = pg8::Gemm{XN, (const bf16*)(wl + WO_IN), NIN, D, D}; E.kind = 0; }
        else if (k == 4) { g = pg8::Gemm{PS + C_SSM, (const bf16*)(wl + WO_GLU), 512, 256, PSW}; E.kind = 4; }
        else if (k == 5) { E.kind = 1;
            if (gi == 0) g = pg8::Gemm{PS + C_Q, (const bf16*)(wl + WO_BA), D, 384, PSW};
            else if (gi == 1) g = pg8::Gemm{PS + C_RW, (const bf16*)(wl + WO_BR), D, 384, PSW};
            else g = pg8::Gemm{SO, (const bf16*)(wl + WO_BS), D, 256, 256}; }
        else if (k == 6) { g = pg8::Gemm{XN, (const bf16*)(wl + WO_OUT), D, D, D}; E.kind = 2; }
        else if (k == 8) { g = pg8::Gemm{XN, (const bf16*)(wl + WO_GU), 2 * FFH, D, D}; E.kind = 3; }
        else { g = pg8::Gemm{PS, (const bf16*)(wl + WO_DN), D, FFH, FFH}; E.kind = 2; E.base = F.out; }
        pg8::StaticOrder S; S.init(g.N, F.G, F.bid);
        pg8::gemm_phase<pg8::EpiAny, pg8::StaticOrder, true>(lds3, g, S, E);
    }
}

static_assert(pg8::EP_XN == WS_XN && pg8::EP_PS == WS_PS && pg8::EP_GT == WS_GT && pg8::EP_SO == WS_SO && pg8::EP_BR == WS_BR, "epilogue workspace offsets");

__global__ void __launch_bounds__(NTHREADS, 2) mega_fwd(Args args) {
    extern __shared__ __attribute__((aligned(16))) unsigned char lds[];
#if ONE_LAUNCH
    volatile LAS unsigned* misc = (volatile LAS unsigned*)((LAS unsigned char*)lds + MISC_OFF);
    if (threadIdx.x < 32) misc[threadIdx.x] = 0u;
    __syncthreads();
    XcdBarrier bar = xcd_barrier_post((unsigned*)(args.ws + WS_CTL) + CW_BAR, misc + 8);
#endif
#pragma unroll 1
    for (int ph = args.ph_lo; ph < args.ph_hi; ++ph) {
        int nrep_ = 1;
#ifdef REP_MASK
        { const int kk_ = (ph == 0 || ph == NPH - 1) ? 99 : (ph - 1) % PPL; const int ll_ = (ph - 1) / PPL;
          if ((kk_ < 16) && ((REP_MASK >> kk_) & 1) && !(kk_ == 6 && ll_ == 1)) nrep_ = 2; }
#endif
#pragma unroll 1
        for (int rp_ = 0; rp_ < nrep_; ++rp_) {
            KA A; A.p = (kptr_t)__builtin_amdgcn_kernarg_segment_ptr(); asm volatile("" : "+s"(A.p));
            int tid = threadIdx.x, bid = blockIdx.x, G = gridDim.x; asm volatile("" : "+v"(tid), "+s"(bid), "+s"(G));
            Ctx F;
            F.lds = lds; F.ws = A.ws(); F.out = A.out();
            F.tid = tid; F.lane = tid & 63; F.wave = __builtin_amdgcn_readfirstlane(tid >> 6); F.G = G; F.bid = bid;
            run_phase(A, F, ph);
            __syncthreads();
        }
#if ONE_LAUNCH
        if (ph + 1 < args.ph_hi) {
#ifdef EXTRA_SYNCS
            for (int e_ = 0; e_ < EXTRA_SYNCS; ++e_) xcd_barrier(bar);
#endif
            if (ph == 0) { __threadfence(); cg::this_grid().sync(); }
            else xcd_barrier(bar); }
#endif
    }
}

extern "C" void kernel_launch(void* const* d_in, const int* in_sizes, int n_in, void* d_out, int out_size, void* d_ws, size_t ws_size, hipStream_t stream) {
    static int grid = 0;
    if (grid == 0) {
        if (n_in != 32 || in_sizes[0] != T * D || out_size != T * D || ws_size < WS_END) { fprintf(stderr, "kernel_launch: unexpected shapes (n_in %d, in0 %d, out %d, ws %zu); nothing launched\n", n_in, n_in > 0 ? in_sizes[0] : -1, out_size, ws_size); grid = -1; return; }
        int dev = 0, cus = 0, per_cu = 0;
        if (hipGetDevice(&dev) != hipSuccess || hipDeviceGetAttribute(&cus, hipDeviceAttributeMultiprocessorCount, dev) != hipSuccess) { grid = -1; return; }
        if (hipFuncSetAttribute((const void*)mega_fwd, hipFuncAttributeMaxDynamicSharedMemorySize, LDS_BYTES) != hipSuccess) { fprintf(stderr, "kernel_launch: hipFuncSetAttribute failed\n"); grid = -1; return; }
        if (hipOccupancyMaxActiveBlocksPerMultiprocessor(&per_cu, (const void*)mega_fwd, NTHREADS, LDS_BYTES) != hipSuccess || per_cu < 1) { fprintf(stderr, "kernel_launch: occupancy query says %d\n", per_cu); per_cu = 1; }
        (void)hipGetLastError();
        grid = cus;
        if (grid < 200) { fprintf(stderr, "kernel_launch: needs >= 200 CUs, got %d\n", grid); grid = -1; return; }
    }
    if (grid < 0) return;
    if (hipMemsetAsync((char*)d_ws + WS_CTL, 0, CTL_ZERO_BYTES, stream) != hipSuccess) { fprintf(stderr, "kernel_launch: hipMemsetAsync failed\n"); return; }
    Args a{};
    for (int i = 0; i < 32; ++i) a.in[i] = (const float*)d_in[i];
    a.out = (float*)d_out; a.ws = (unsigned char*)d_ws;
#if ONE_LAUNCH
    a.ph_lo = 0; a.ph_hi = NPH;
    void* kargs[] = {&a};
    hipError_t e = hipLaunchCooperativeKernel((const void*)mega_fwd, dim3(grid), dim3(NTHREADS), kargs, LDS_BYTES, stream);
    if (e != hipSuccess) fprintf(stderr, "kernel_launch: cooperative launch failed: %s (grid %d)\n", hipGetErrorString(e), grid);
#else
    for (int ph = 0; ph < NPH; ++ph) {
        a.ph_lo = ph; a.ph_hi = ph + 1;
        hipLaunchKernelGGL(mega_fwd, dim3(grid), dim3(NTHREADS), LDS_BYTES, stream, a);
    }
#endif
}
```

```cpp
#include <hip/hip_runtime.h>
#include <hip/hip_cooperative_groups.h>
#include <cstdio>
#include <cstdint>
namespace cg = cooperative_groups;
#ifndef ONE_LAUNCH
#define ONE_LAUNCH 1
#endif
namespace pg8 {
#define PG8_LAS __attribute__((address_space(3)))
typedef unsigned short bf16_t;
typedef short bf16x8 __attribute__((ext_vector_type(8)));
typedef float f32x4 __attribute__((ext_vector_type(4)));
typedef float f32x2 __attribute__((ext_vector_type(2)));
typedef unsigned u32x4 __attribute__((ext_vector_type(4)));
typedef unsigned u32x2 __attribute__((ext_vector_type(2)));
constexpr int BM = 256, BK = 64, HALF = 128, HTB = HALF * BK * 2  , STAGE_BYTES = 8 * HTB, NXCD = 8, WGM = 8;

__host__ __device__ __forceinline__ int lds_byte(int r, int c) { const int st = (r >> 4) * 2 + (c >> 5), rr = r & 15, cc = c & 31, ob = rr * 64 + cc * 2; return st * 1024 + (ob ^ (((ob >> 9) & 1) << 5)); }
__host__ __device__ __forceinline__ void stage_rc(int b, int& R, int& C) { const int st = b / 1024, sb = b % 1024, swz = sb ^ (((sb >> 9) & 1) << 5); R = (st >> 1) * 16 + swz / 64; C = (st & 1) * 32 + (swz % 64) / 2; }
__host__ __device__ __forceinline__ int perm32(int rho) { const int n = rho >> 4, i = rho & 15; return 8 * (i >> 2) + 4 * n + (i & 3); }

struct Unit { int pm, pn; };
constexpr size_t EP_XN = 68ull << 20, EP_PS = 132ull << 20, EP_GT = 308ull << 20, EP_SO = 404ull << 20, EP_BR = 421ull << 20;
struct Gemm { const bf16_t* A; const bf16_t* Bt; int N, K, lda; };

struct StaticOrder {
    static constexpr int nM = 128;
    int nN, G, c;
    __host__ __device__ void init(int N, int G_, int c_) { nN = N / BM; G = G_; c = c_; }
    __host__ __device__ bool next(int i, Unit& u) const {
        const int nwg = nM * nN;
        const long L = (long)i * G + c; if (L >= nwg) return false;
        int wgid = (int)L; { const int q = nwg / NXCD, r = nwg % NXCD, xcd = wgid % NXCD, off = wgid / NXCD; wgid = (xcd < r ? xcd * (q + 1) : r * (q + 1) + (xcd - r) * q) + off; }
        const int nig = WGM * nN, gid = wgid / nig, fm = gid * WGM, gsz = (nM - fm) < WGM ? (nM - fm) : WGM;
        u.pm = fm + ((wgid % nig) % gsz); u.pn = (wgid % nig) / gsz; return true;
    }
    __device__ __forceinline__ void a_ready(const Unit&) const {}
    __device__ __forceinline__ void done(const Unit&) const {}
};

__device__ __forceinline__ unsigned cvt_pk_bf16(float lo, float hi) { unsigned r; asm volatile("v_cvt_pk_bf16_f32 %0, %1, %2" : "=v"(r) : "v"(lo), "v"(hi)); return r; }
__device__ __forceinline__ float bf_lo(unsigned w) { return __uint_as_float(w << 16); }
__device__ __forceinline__ float bf_hi(unsigned w) { return __uint_as_float(w & 0xffff0000u); }
__device__ __forceinline__ float sigmoidf_(float x) { return __builtin_amdgcn_rcpf(1.0f + __expf(-x)); }


struct EpiAny;
__device__ __forceinline__ void epi_win(bf16_t* PS, unsigned char* GT, bf16_t* BRW, const f32x4 (&acc)[2][2][4][2], const Unit& u, int wr, int wc, int fr, int fq) {
        const int row0 = u.pm * BM + wr * 64 + fr;
        if (u.pn < 11) {
            const int col0 = u.pn * BM + wc * 32 + 8 * fq;
#pragma unroll
            for (int ai = 0; ai < 2; ++ai)
#pragma unroll
                for (int m = 0; m < 4; ++m) { bf16_t* rowp = PS + (size_t)(row0 + ai * HALF + m * 16) * 2816 + col0;
#pragma unroll
                    for (int bj = 0; bj < 2; ++bj) { const f32x4 v0 = acc[ai][bj][m][0], v1 = acc[ai][bj][m][1];
                        u32x4 w; w.x = cvt_pk_bf16(v0[0], v0[1]); w.y = cvt_pk_bf16(v0[2], v0[3]); w.z = cvt_pk_bf16(v1[0], v1[1]); w.w = cvt_pk_bf16(v1[2], v1[3]);
                        *(u32x4*)(rowp + bj * HALF) = w;
                        if (m == 3 && fr == 15) *(u32x4*)(BRW + (size_t)((row0 + ai * HALF + m * 16) >> 6) * 2816 + col0 + bj * HALF) = w; } }
        } else {
            const int col0 = (u.pn - 11) * BM + wc * 32 + 8 * fq;
#pragma unroll
            for (int ai = 0; ai < 2; ++ai)
#pragma unroll
                for (int m = 0; m < 4; ++m) { unsigned char* rowp = GT + (size_t)(row0 + ai * HALF + m * 16) * 3072 + col0;
#pragma unroll
                    for (int bj = 0; bj < 2; ++bj) { const f32x4 v0 = acc[ai][bj][m][0], v1 = acc[ai][bj][m][1];
                        unsigned q[8];
#pragma unroll
                        for (int k = 0; k < 4; ++k) { q[k] = (unsigned)(sigmoidf_(v0[k]) * 255.0f + 0.5f); q[4 + k] = (unsigned)(sigmoidf_(v1[k]) * 255.0f + 0.5f); }
                        u32x2 w; w.x = q[0] | (q[1] << 8) | (q[2] << 16) | (q[3] << 24); w.y = q[4] | (q[5] << 8) | (q[6] << 16) | (q[7] << 24);
                        *(u32x2*)(rowp + bj * HALF) = w; } }
        }
    }

__device__ __forceinline__ void epi_merge(bf16_t* MG, const unsigned char* GT, int gi, const f32x4 (&acc)[2][2][4][2], const Unit& u, int wr, int wc, int fr, int fq) {
        const int row0 = u.pm * BM + wr * 64 + fr, col0 = u.pn * BM + wc * 32 + 8 * fq;
#pragma unroll
        for (int ai = 0; ai < 2; ++ai)
#pragma unroll
            for (int m = 0; m < 4; ++m) { const size_t r = (size_t)(row0 + ai * HALF + m * 16);
#pragma unroll
                for (int bj = 0; bj < 2; ++bj) { const int c = col0 + bj * HALF;
                    const u32x2 gq = *(const u32x2*)(GT + r * 3072 + gi * 1024 + c);
                    float v[8];
#pragma unroll
                    for (int k = 0; k < 4; ++k) { v[k] = acc[ai][bj][m][0][k] * ((float)((gq.x >> (8 * k)) & 255u) * (1.0f / 255.0f)); v[4 + k] = acc[ai][bj][m][1][k] * ((float)((gq.y >> (8 * k)) & 255u) * (1.0f / 255.0f)); }
                    u32x4* dst = (u32x4*)(MG + r * 1024 + c);
                    if (gi > 0) { const u32x4 p = *dst;
                        v[0] += bf_lo(p.x); v[1] += bf_hi(p.x); v[2] += bf_lo(p.y); v[3] += bf_hi(p.y); v[4] += bf_lo(p.z); v[5] += bf_hi(p.z); v[6] += bf_lo(p.w); v[7] += bf_hi(p.w); }
                    u32x4 w; w.x = cvt_pk_bf16(v[0], v[1]); w.y = cvt_pk_bf16(v[2], v[3]); w.z = cvt_pk_bf16(v[4], v[5]); w.w = cvt_pk_bf16(v[6], v[7]);
                    *dst = w; } }
    }

__device__ __forceinline__ void epi_res(const float* base, float* out, const f32x4 (&acc)[2][2][4][2], const Unit& u, int wr, int wc, int fr, int fq) {
        const int row0 = u.pm * BM + wr * 64 + fr, col0 = u.pn * BM + wc * 32 + 4 * fq;
#pragma unroll
        for (int ai = 0; ai < 2; ++ai)
#pragma unroll
            for (int m = 0; m < 4; ++m) { const size_t off = (size_t)(row0 + ai * HALF + m * 16) * 1024 + col0;
#pragma unroll
                for (int bj = 0; bj < 2; ++bj)
#pragma unroll
                    for (int n = 0; n < 2; ++n) { const f32x4 b = *(const f32x4*)(base + off + bj * HALF + n * 16); *(f32x4*)(out + off + bj * HALF + n * 16) = b + acc[ai][bj][m][n]; } }
    }

template <int MODE> __device__ __forceinline__ void epi_pair(bf16_t* O, int ldo, const f32x4 (&acc)[2][2][4][2], const Unit& u, int wr, int wc, int fr, int fq) {
        const int row0 = u.pm * BM + wr * 64 + fr, col0 = u.pn * HALF + wc * 32 + 8 * fq;
#pragma unroll
        for (int ai = 0; ai < 2; ++ai)
#pragma unroll
            for (int m = 0; m < 4; ++m) { bf16_t* rowp = O + (size_t)(row0 + ai * HALF + m * 16) * ldo + col0;
                float v[8];
#pragma unroll
                for (int n = 0; n < 2; ++n)
#pragma unroll
                    for (int k = 0; k < 4; ++k) { const float a = acc[ai][0][m][n][k], b = acc[ai][1][m][n][k];
                        v[4 * n + k] = (MODE == 0) ? (a * sigmoidf_(a) * b) : (a * sigmoidf_(b)); }
                u32x4 w; w.x = cvt_pk_bf16(v[0], v[1]); w.y = cvt_pk_bf16(v[2], v[3]); w.z = cvt_pk_bf16(v[4], v[5]); w.w = cvt_pk_bf16(v[6], v[7]);
                *(u32x4*)rowp = w; }
    }


struct EpiAny {
    int kind;
    int gi; unsigned char* ws; const float* base; float* out;
    __device__ __forceinline__ bool perm() const { return kind != 2; }
    __device__ __forceinline__ void operator()(const f32x4 (&acc)[2][2][4][2], const Unit& u, int wr, int wc, int fr, int fq) const {
        if (kind == 0) epi_win((bf16_t*)(ws + EP_PS), ws + EP_GT, (bf16_t*)(ws + EP_BR), acc, u, wr, wc, fr, fq);
        else if (kind == 1) epi_merge((bf16_t*)(ws + EP_XN), ws + EP_GT, gi, acc, u, wr, wc, fr, fq);
        else if (kind == 2) epi_res(base, out, acc, u, wr, wc, fr, fq);
        else if (kind == 3) epi_pair<0>((bf16_t*)(ws + EP_PS), 2816, acc, u, wr, wc, fr, fq);
        else epi_pair<1>((bf16_t*)(ws + EP_SO), 256, acc, u, wr, wc, fr, fq);
    }
};

template <class Epi, class Sched, bool ALIGN_EPI = false>
__device__ __forceinline__ void gemm_phase(PG8_LAS unsigned char* lds, const Gemm g, const Sched& S, const Epi& E) {
    int tid_ = threadIdx.x; asm volatile("" : "+v"(tid_));
    const int tid = tid_, wid = __builtin_amdgcn_readfirstlane(tid >> 6), lane = tid & 63, wr = wid >> 2, wc = wid & 3, fr = lane & 15, fq = lane >> 4;
    const int K = g.K, lda = g.lda, nt = K / BK;
    unsigned voffA[2], voffB[2];
#pragma unroll
    for (int i = 0; i < 2; ++i) { int R, C; stage_rc(tid * 16 + i * 8192, R, C); const int Rb = E.perm() ? ((R & ~31) + perm32(R & 31)) : R;
        voffA[i] = (unsigned)(R * lda + C) * 2u; voffB[i] = (unsigned)(Rb * K + C) * 2u; }
    const size_t kstep = (size_t)(BK * 2);
    const size_t hstepA = (size_t)HALF * lda * 2, hstepB = (size_t)HALF * K * 2;
    const size_t tstepA = 2 * hstepA, tstepB = 2 * hstepB;
    const unsigned ldsw = (unsigned)wid * 1024u;
    const int aoff = lds_byte(wr * 64 + fr, fq * 8), boff = lds_byte(wc * 32 + fr, fq * 8);
#define PG8_SA(b, h) (((b) * 2 + (h)) * HTB)
#define PG8_SB(b, h) ((4 + (b) * 2 + (h)) * HTB)
#define PG8_STAGE(bufoff, gbase, voff) do { _Pragma("unroll") for (int _i = 0; _i < 2; ++_i) \
        __builtin_amdgcn_global_load_lds((const unsigned*)((const char*)(gbase) + (voff)[_i]), (PG8_LAS unsigned*)(lds + (bufoff) + ldsw + _i * 8192), 16, 0, 0); } while (0)
#define PG8_LDA(dst, b, h) do { _Pragma("unroll") for (int m = 0; m < 4; ++m) _Pragma("unroll") for (int k = 0; k < 2; ++k) dst[m][k] = *(const PG8_LAS bf16x8*)(lds + PG8_SA(b, h) + aoff + m * 2048 + k * 1024); } while (0)
#define PG8_LDB(dst, b, h) do { _Pragma("unroll") for (int n = 0; n < 2; ++n) _Pragma("unroll") for (int k = 0; k < 2; ++k) dst[n][k] = *(const PG8_LAS bf16x8*)(lds + PG8_SB(b, h) + boff + n * 2048 + k * 1024); } while (0)
#define PG8_MMA(ai, bj, At, Bt) do { __builtin_amdgcn_s_setprio(1); _Pragma("unroll") for (int m = 0; m < 4; ++m) _Pragma("unroll") for (int n = 0; n < 2; ++n) _Pragma("unroll") for (int k = 0; k < 2; ++k) \
        acc[ai][bj][m][n] = __builtin_amdgcn_mfma_f32_16x16x32_bf16(Bt[n][k], At[m][k], acc[ai][bj][m][n], 0, 0, 0); __builtin_amdgcn_s_setprio(0); } while (0)
#define PG8_WAIT_V(n) asm volatile("s_waitcnt vmcnt(" #n ")" ::: "memory")
#define PG8_WAIT_L(n) asm volatile("s_waitcnt lgkmcnt(" #n ")" ::: "memory")
#define PG8_BAR __builtin_amdgcn_s_barrier()
#define PG8_SCHED __builtin_amdgcn_sched_barrier(0)
    Unit cur, nxt; int ui = 0;
    if (!S.next(0, cur)) return;
    f32x4 acc[2][2][4][2];
#pragma unroll
    for (int a = 0; a < 2; ++a)
#pragma unroll
        for (int b = 0; b < 2; ++b)
#pragma unroll
            for (int m = 0; m < 4; ++m)
#pragma unroll
                for (int n = 0; n < 2; ++n) acc[a][b][m][n] = (f32x4){0.f, 0.f, 0.f, 0.f};
    bf16x8 At[4][2], B0[2][2], B1[2][2];
    const char* cA = (const char*)g.A + (size_t)cur.pm * tstepA; const char* cB = (const char*)g.Bt + (size_t)cur.pn * tstepB;
    S.a_ready(cur);
    PG8_STAGE(PG8_SB(0, 0), cB, voffB); PG8_STAGE(PG8_SB(0, 1), cB + hstepB, voffB); PG8_STAGE(PG8_SA(0, 0), cA, voffA); PG8_STAGE(PG8_SA(0, 1), cA + hstepA, voffA);
    if (wr == 1) PG8_BAR;
    PG8_WAIT_V(2); PG8_BAR;
    PG8_STAGE(PG8_SB(1, 0), cB + kstep, voffB); PG8_STAGE(PG8_SA(1, 0), cA + kstep, voffA); PG8_STAGE(PG8_SB(1, 1), cB + hstepB + kstep, voffB);
    PG8_WAIT_V(6); PG8_BAR;
    for (;;) {
        const bool has_next = S.next(ui + 1, nxt);
        const char* nA = has_next ? (const char*)g.A + (size_t)nxt.pm * tstepA : cA; const char* nB = has_next ? (const char*)g.Bt + (size_t)nxt.pn * tstepB : cB;
        for (int t = 0; t < nt; t += 2) {
            const bool last = (t == nt - 2);
            const char* a1 = cA + (size_t)(t + 1) * kstep;
            const char* a2 = last ? nA : cA + (size_t)(t + 2) * kstep; const char* b2 = last ? nB : cB + (size_t)(t + 2) * kstep;
            const char* a3 = a2 + kstep; const char* b3 = b2 + kstep;
            if (last && has_next) S.a_ready(nxt);
            PG8_LDB(B0, 0, 0); PG8_LDB(B1, 0, 1); PG8_SCHED; PG8_LDA(At, 0, 0); PG8_STAGE(PG8_SA(1, 1), a1 + hstepA, voffA);
            PG8_WAIT_V(8); PG8_WAIT_L(0); PG8_BAR; PG8_MMA(0, 0, At, B0); PG8_MMA(0, 1, At, B1); PG8_BAR; PG8_SCHED;
            PG8_LDA(At, 0, 1); PG8_STAGE(PG8_SB(0, 0), b2, voffB); PG8_STAGE(PG8_SB(0, 1), b2 + hstepB, voffB); PG8_STAGE(PG8_SA(0, 0), a2, voffA);
            PG8_WAIT_V(8); PG8_WAIT_L(0); PG8_BAR; PG8_MMA(1, 0, At, B0); PG8_MMA(1, 1, At, B1); PG8_BAR; PG8_SCHED;
            PG8_LDB(B0, 1, 0); PG8_LDB(B1, 1, 1); PG8_SCHED; PG8_LDA(At, 1, 0); PG8_STAGE(PG8_SA(0, 1), a2 + hstepA, voffA);
            PG8_WAIT_V(8); PG8_WAIT_L(0); PG8_BAR; PG8_MMA(0, 0, At, B0); PG8_MMA(0, 1, At, B1); PG8_BAR; PG8_SCHED;
            PG8_LDA(At, 1, 1); PG8_STAGE(PG8_SB(1, 0), b3, voffB); PG8_STAGE(PG8_SB(1, 1), b3 + hstepB, voffB); PG8_STAGE(PG8_SA(1, 0), a3, voffA);
            PG8_WAIT_V(8); PG8_WAIT_L(0); PG8_BAR; PG8_MMA(1, 0, At, B0); PG8_MMA(1, 1, At, B1); PG8_BAR; PG8_SCHED;
        }
        if constexpr (ALIGN_EPI) { if (wr == 0) PG8_BAR; }
        E(acc, cur, wr, wc, fr, fq); S.done(cur);
        if (!has_next) break;
#pragma unroll
        for (int a = 0; a < 2; ++a)
#pragma unroll
            for (int b = 0; b < 2; ++b)
#pragma unroll
                for (int m = 0; m < 4; ++m)
#pragma unroll
                    for (int n = 0; n < 2; ++n) acc[a][b][m][n] = (f32x4){0.f, 0.f, 0.f, 0.f};
        cur = nxt; cA = nA; cB = nB; ++ui;
        if constexpr (ALIGN_EPI) { if (wr == 1) PG8_BAR; }
    }
    PG8_WAIT_V(0);
    if constexpr (!ALIGN_EPI) { if (wr == 0) PG8_BAR; }
    PG8_BAR;
#undef PG8_SA
#undef PG8_SB
#undef PG8_STAGE
#undef PG8_LDA
#undef PG8_LDB
#undef PG8_MMA
#undef PG8_WAIT_V
#undef PG8_WAIT_L
#undef PG8_BAR
#undef PG8_SCHED
}
}
constexpr int NWAVES = 8, NTHREADS = 512;
constexpr int BATCH = 8, SEQ = 4096, T = BATCH * SEQ, D = 1024, DEPTH = 2;
constexpr int NIN = 5888, PSW = 2816, NGATE = 3072, FFH = 2816;
constexpr int C_Q = 0, C_K = 384, C_V = 768, C_RW = 1152, C_LORA = 2304, C_SSM = 2560;
constexpr float NORM_EPS = 1e-6f, GN_EPS = 64e-5f;

constexpr size_t MiB = 1u << 20;
constexpr size_t WS_CTL = 0, CTL_ZERO_BYTES = 1 * MiB;
constexpr size_t WS_W = 1 * MiB, W_LAYER = 33 * MiB;
constexpr size_t WO_IN = 0, WO_BA = 12 * MiB, WO_BR = WO_BA + 768 * 1024, WO_BS = WO_BR + 768 * 1024, WO_OUT = 14 * MiB, WO_GU = 16 * MiB, WO_DN = 27 * MiB, WO_GLU = 32 * MiB + 512 * 1024,
                 WO_W2 = WO_GLU + 256 * 1024, WO_A2 = WO_W2 + 48 * 1024, WO_G2 = WO_A2 + 48 * 1024;
constexpr size_t WS_XN = 68 * MiB;
constexpr size_t WS_PS = 132 * MiB;
constexpr size_t WS_GT = 308 * MiB;
constexpr size_t WS_SO = 404 * MiB;
constexpr size_t WS_LSE = 420 * MiB;
constexpr size_t WS_SCR = 421 * MiB;
constexpr size_t WS_BR = WS_SCR;
constexpr size_t WS_RMC = WS_SCR + 3 * MiB;
constexpr size_t WS_RNT = WS_RMC + 24 * MiB;
constexpr size_t WS_REM = WS_RNT + 24 * MiB;
constexpr size_t WS_RGL = WS_REM + 24 * MiB;
static_assert(WS_RGL + 1 * MiB <= 512 * MiB, "scratch map");
constexpr size_t WS_END = 512 * MiB;

constexpr int LDS_BYTES = 147456;
constexpr int MISC_OFF = LDS_BYTES - 128;
constexpr int CW_BAR = 4096;

#define GAS __attribute__((address_space(1)))
#define LAS __attribute__((address_space(3)))
typedef unsigned short bf16;
typedef unsigned v4u __attribute__((ext_vector_type(4)));
typedef unsigned v2u __attribute__((ext_vector_type(2)));
typedef float f32x4 __attribute__((ext_vector_type(4)));
#define LDS_WAIT() asm volatile("s_waitcnt lgkmcnt(0)" ::: "memory")
#define VM_WAIT() asm volatile("s_waitcnt vmcnt(0)" ::: "memory")
__device__ __forceinline__ unsigned f2bf(float f) { unsigned u = __builtin_bit_cast(unsigned, f); return (u + 0x7fffu + ((u >> 16) & 1u)) >> 16; }
__device__ __forceinline__ unsigned pk2(float lo, float hi) { return f2bf(lo) | (f2bf(hi) << 16); }
__device__ __forceinline__ float bf2f(bf16 b) { return __uint_as_float((unsigned)b << 16); }
__device__ __forceinline__ float bflo(unsigned w) { return __uint_as_float(w << 16); }
__device__ __forceinline__ float bfhi(unsigned w) { return __uint_as_float(w & 0xffff0000u); }
template <int M> __device__ __forceinline__ float shx(float v) { static_assert(M < 32, "shx: xor mask inside a 32-lane half"); return __int_as_float(__builtin_amdgcn_ds_swizzle(__float_as_int(v), (M << 10) | 0x1f)); }
__device__ __forceinline__ float xsum32(float v) { auto r = __builtin_amdgcn_permlane32_swap(__float_as_uint(v), __float_as_uint(v), false, false); return __uint_as_float(r[0]) + __uint_as_float(r[1]); }
__device__ __forceinline__ float xmax32(float v) { auto r = __builtin_amdgcn_permlane32_swap(__float_as_uint(v), __float_as_uint(v), false, false); return fmaxf(__uint_as_float(r[0]), __uint_as_float(r[1])); }
__device__ __forceinline__ float wave_sum(float v) { v += shx<1>(v); v += shx<2>(v); v += shx<4>(v); v += shx<8>(v); v += shx<16>(v); return xsum32(v); }
__device__ __forceinline__ float sigm(float x) { return 1.0f / (1.0f + __expf(-x)); }

struct Args { const float* in[32]; float* out; unsigned char* ws; int ph_lo, ph_hi; };

typedef __attribute__((address_space(4))) const unsigned char* kptr_t;
struct KA {
    kptr_t p;
    typedef const float* cfptr_t; typedef float* fptr_t; typedef unsigned char* ucptr_t;
    __device__ __forceinline__ const float* in(int i) const { return *(const __attribute__((address_space(4))) cfptr_t*)(p + 8 * i); }
    __device__ __forceinline__ float* out() const { return *(const __attribute__((address_space(4))) fptr_t*)(p + 256); }
    __device__ __forceinline__ unsigned char* ws() const { return *(const __attribute__((address_space(4))) ucptr_t*)(p + 264); }
};
static_assert(sizeof(Args) == 280, "Args layout");

#ifndef DRY_SEL
#define DRY_SEL 0
#endif
struct Ctx {
    unsigned char* lds; unsigned char* ws; float* out;
    int tid, lane, wave, G, bid;
    int dry;
};

__device__ __forceinline__ void tr_item(const float* W, int ldw, int K, int nblk, bf16* WT, int goff, float* scr, int item, int lane) {
    const int kb = item / nblk, nb = item % nblk, k0 = 64 * kb, n0 = 32 * nb;
#pragma unroll 8
    for (int i = 0; i < 32; ++i) { const int kk = 2 * i + (lane >> 5); scr[kk * 33 + (lane & 31)] = W[(size_t)(k0 + kk) * ldw + n0 + (lane & 31)]; }
    LDS_WAIT(); asm volatile("" ::: "memory");
    const int c = lane & 7;
#pragma unroll
    for (int j = 0; j < 4; ++j) { const int n = (lane >> 3) + 8 * j; const float* s = scr + (8 * c) * 33 + n;
        v4u o; o.x = pk2(s[0 * 33], s[1 * 33]); o.y = pk2(s[2 * 33], s[3 * 33]); o.z = pk2(s[4 * 33], s[5 * 33]); o.w = pk2(s[6 * 33], s[7 * 33]);
        const int nn = n0 + n; const int drow = goff < 0 ? nn : ((nn >> 7) * 256 + goff + (nn & 127));
        *(v4u*)(WT + (size_t)drow * K + k0 + 8 * c) = o; }
    LDS_WAIT(); asm volatile("" ::: "memory");
}

__device__ __forceinline__ void phase_prep(const KA& A, const Ctx& F) {
    float* scr = (float*)(F.lds + F.wave * 16384);
    const int gw = F.bid * NWAVES + F.wave, NGW = F.G * NWAVES;
    constexpr int NM = 13;
    constexpr int cnt[NM] = {16 * 184, 6 * 32, 6 * 32, 4 * 32, 16 * 32, 16 * 88, 16 * 88, 44 * 32, 4 * 8, 4 * 8, 12, 12, 24};
    constexpr int per_layer = cnt[0] + cnt[1] + cnt[2] + cnt[3] + cnt[4] + cnt[5] + cnt[6] + cnt[7] + cnt[8] + cnt[9] + cnt[10] + cnt[11] + cnt[12];
    for (int it = gw; it < DEPTH * per_layer; it += NGW) {
        const int l = it / per_layer; int r = it % per_layer;
        unsigned char* wl = F.ws + WS_W + (size_t)l * W_LAYER;
        if (r < cnt[0]) { tr_item(A.in(2) + (size_t)l * D * NIN, NIN, D, NIN / 32, (bf16*)(wl + WO_IN), -1, scr, r, F.lane); continue; } r -= cnt[0];
        if (r < cnt[1]) { tr_item(A.in(24) + (size_t)l * 384 * D, D, 384, D / 32, (bf16*)(wl + WO_BA), -1, scr, r, F.lane); continue; } r -= cnt[1];
        if (r < cnt[2]) { tr_item(A.in(25) + (size_t)l * 384 * D, D, 384, D / 32, (bf16*)(wl + WO_BR), -1, scr, r, F.lane); continue; } r -= cnt[2];
        if (r < cnt[3]) { tr_item(A.in(26) + (size_t)l * 256 * D, D, 256, D / 32, (bf16*)(wl + WO_BS), -1, scr, r, F.lane); continue; } r -= cnt[3];
        if (r < cnt[4]) { tr_item(A.in(27) + (size_t)l * D * D, D, D, D / 32, (bf16*)(wl + WO_OUT), -1, scr, r, F.lane); continue; } r -= cnt[4];
        if (r < cnt[5]) { tr_item(A.in(29) + (size_t)l * D * 2 * FFH, 2 * FFH, D, FFH / 32, (bf16*)(wl + WO_GU), 0, scr, r, F.lane); continue; } r -= cnt[5];
        if (r < cnt[6]) { tr_item(A.in(29) + (size_t)l * D * 2 * FFH + FFH, 2 * FFH, D, FFH / 32, (bf16*)(wl + WO_GU), 128, scr, r, F.lane); continue; } r -= cnt[6];
        if (r < cnt[7]) { tr_item(A.in(30) + (size_t)l * FFH * D, D, FFH, D / 32, (bf16*)(wl + WO_DN), -1, scr, r, F.lane); continue; } r -= cnt[7];
        if (r < cnt[8]) { tr_item(A.in(22) + (size_t)l * 256 * 256, 256, 256, 8, (bf16*)(wl + WO_GLU), 0, scr, r, F.lane); continue; } r -= cnt[8];
        if (r < cnt[9]) { tr_item(A.in(23) + (size_t)l * 256 * 256, 256, 256, 8, (bf16*)(wl + WO_GLU), 128, scr, r, F.lane); continue; } r -= cnt[9];
        if (r < cnt[10]) { tr_item(A.in(5) + (size_t)l * 64 * 384, 384, 64, 12, (bf16*)(wl + WO_W2), -1, scr, r, F.lane); continue; } r -= cnt[10];
        if (r < cnt[11]) { tr_item(A.in(7) + (size_t)l * 64 * 384, 384, 64, 12, (bf16*)(wl + WO_A2), -1, scr, r, F.lane); continue; } r -= cnt[11];
        tr_item(A.in(8) + (size_t)l * 128 * 384, 384, 128, 12, (bf16*)(wl + WO_G2), -1, scr, r, F.lane);
    }
}

template <bool OUT_F32> __device__ __forceinline__ void phase_rmsnorm(const KA& A, const Ctx& F, const float* src, const float* gain, void* dst) {
    const int gw = F.bid * NWAVES + F.wave, NGW = F.G * NWAVES;
    f32x4 gv[4];
#pragma unroll
    for (int j = 0; j < 4; ++j) gv[j] = *((const f32x4*)gain + F.lane + 64 * j);
    for (int m = gw; m < T; m += NGW) {
        const f32x4* xr = (const f32x4*)(src + (size_t)m * D) + F.lane;
        f32x4 v[4]; float s = 0.f;
#pragma unroll
        for (int j = 0; j < 4; ++j) { v[j] = xr[64 * j]; s += (v[j].x * v[j].x + v[j].y * v[j].y) + (v[j].z * v[j].z + v[j].w * v[j].w); }
        const float rs = 1.0f / sqrtf(wave_sum(s) * (1.0f / D) + NORM_EPS);
        if (OUT_F32) {
            f32x4* o = (f32x4*)((float*)dst + (size_t)m * D) + F.lane;
#pragma unroll
            for (int j = 0; j < 4; ++j) o[64 * j] = v[j] * rs * gv[j];
        } else {
            v2u* o = (v2u*)((bf16*)dst + (size_t)m * D) + F.lane;
#pragma unroll
            for (int j = 0; j < 4; ++j) { const f32x4 y = v[j] * rs * gv[j]; v2u w; w.x = pk2(y.x, y.y); w.y = pk2(y.z, y.w); o[64 * j] = w; }
        }
    }
}
__device__ __forceinline__ void attn_v1(const KA& A, const Ctx& F, int blk, int nblk) {
    bf16* PS = (bf16*)(F.ws + WS_PS); float* LSE = (float*)(F.ws + WS_LSE);
#pragma unroll 1
    for (int item = blk * NTHREADS + F.tid; item < T * 12; item += nblk * NTHREADS) {
        const int hf = item & 1, it2 = item >> 1;
        const int h = it2 / T, bt = it2 % T, t = bt % SEQ;
        const int g = h >> 1, dil = (g == 0) ? 1 : (g == 1 ? 4 : 16);
        unsigned qp_[16]; float o[32];
        { const v4u* qp = (const v4u*)(PS + (size_t)bt * PSW + C_Q + h * 64 + hf * 32);
#pragma unroll
          for (int c = 0; c < 4; ++c) { const v4u w = qp[c]; qp_[4 * c + 0] = w.x; qp_[4 * c + 1] = w.y; qp_[4 * c + 2] = w.z; qp_[4 * c + 3] = w.w; } }
#pragma unroll
        for (int c = 0; c < 32; ++c) o[c] = 0.f;
        float mx = -1e30f, l = 0.f;
#pragma unroll 1
        for (int j = 0; j <= 128; ++j) {
            const int tk = t - j * dil; if (tk < 0) break;
            const size_t rowk = (size_t)(bt - j * dil) * PSW;
            const v4u* kp = (const v4u*)(PS + rowk + C_K + h * 64 + hf * 32); const v4u* vp = (const v4u*)(PS + rowk + C_V + h * 64 + hf * 32);
            float s = 0.f;
#pragma unroll
            for (int c = 0; c < 4; ++c) { const v4u w = kp[c];
                s += bflo(qp_[4 * c + 0]) * bflo(w.x) + bfhi(qp_[4 * c + 0]) * bfhi(w.x) + bflo(qp_[4 * c + 1]) * bflo(w.y) + bfhi(qp_[4 * c + 1]) * bfhi(w.y)
                   + bflo(qp_[4 * c + 2]) * bflo(w.z) + bfhi(qp_[4 * c + 2]) * bfhi(w.z) + bflo(qp_[4 * c + 3]) * bflo(w.w) + bfhi(qp_[4 * c + 3]) * bfhi(w.w); }
            s += shx<1>(s);
            s *= 0.125f;
            const float mn = fmaxf(mx, s), cf = __expf(mx - mn), p = __expf(s - mn);
            l = l * cf + p; mx = mn;
#pragma unroll
            for (int c = 0; c < 4; ++c) { const v4u w = vp[c];
                o[8 * c + 0] = o[8 * c + 0] * cf + p * bflo(w.x); o[8 * c + 1] = o[8 * c + 1] * cf + p * bfhi(w.x); o[8 * c + 2] = o[8 * c + 2] * cf + p * bflo(w.y); o[8 * c + 3] = o[8 * c + 3] * cf + p * bfhi(w.y);
                o[8 * c + 4] = o[8 * c + 4] * cf + p * bflo(w.z); o[8 * c + 5] = o[8 * c + 5] * cf + p * bfhi(w.z); o[8 * c + 6] = o[8 * c + 6] * cf + p * bflo(w.w); o[8 * c + 7] = o[8 * c + 7] * cf + p * bfhi(w.w); }
        }
        const float il = 1.0f / l;
        v4u* op = (v4u*)(PS + (size_t)bt * PSW + C_Q + h * 64 + hf * 32);
#pragma unroll
        for (int c = 0; c < 4; ++c) { v4u w; w.x = pk2(o[8 * c + 0] * il, o[8 * c + 1] * il); w.y = pk2(o[8 * c + 2] * il, o[8 * c + 3] * il); w.z = pk2(o[8 * c + 4] * il, o[8 * c + 5] * il); w.w = pk2(o[8 * c + 6] * il, o[8 * c + 7] * il); op[c] = w; }
        if (hf == 0) LSE[(size_t)bt * 6 + h] = mx + __logf(l);
    }
}
__device__ __forceinline__ void attn_finalize(const KA& A, const Ctx& F) {
    bf16* PS = (bf16*)(F.ws + WS_PS); const float* LSE = (const float*)(F.ws + WS_LSE);
    for (int item = F.bid * NTHREADS + F.tid; item < T * 48; item += F.G * NTHREADS) {
        const int bt = item / 48, r = item % 48, h = r >> 3, c = r & 7, j = h & 1;
        const float l0 = LSE[(size_t)bt * 6 + j], l1 = LSE[(size_t)bt * 6 + 2 + j], l2 = LSE[(size_t)bt * 6 + 4 + j], lm = LSE[(size_t)bt * 6 + h];
        const float mx = fmaxf(l0, fmaxf(l1, l2));
        const float al = __expf(lm - mx) / (__expf(l0 - mx) + __expf(l1 - mx) + __expf(l2 - mx));
        v4u* p = (v4u*)(PS + (size_t)bt * PSW + C_Q + h * 64) + c; v4u w = *p;
        w.x = pk2(bflo(w.x) * al, bfhi(w.x) * al); w.y = pk2(bflo(w.y) * al, bfhi(w.y) * al); w.z = pk2(bflo(w.z) * al, bfhi(w.z) * al); w.w = pk2(bflo(w.w) * al, bfhi(w.w) * al);
        if (!(F.dry && (DRY_SEL & 4))) *p = w;
    }
}

__device__ __forceinline__ void rwkv_v1(const KA& A, const Ctx& F, int l, int b, int h) {
    constexpr int CH = 32;
    bf16* PS = (bf16*)(F.ws + WS_PS);
    float* L = (float*)F.lds;
    float* ZR = L, *ZK = L + CH * 64, *ZV = L + 2 * CH * 64, *ZX = L + 3 * CH * 64;
    float* WD = ZX + CH * 256, *KA = WD + CH * 64, *KB = KA + CH * 64, *GG = KB + CH * 64, *YB = GG + CH * 64, *BON = YB + CH * 64, *PREV = BON + 64;
    const float* mix = A.in(3) + (size_t)l * 1408;
    const float* w0 = A.in(4) + l * 384, *w2 = A.in(5) + (size_t)l * 64 * 384, *a0 = A.in(6) + l * 384, *a2 = A.in(7) + (size_t)l * 64 * 384, *g2 = A.in(8) + (size_t)l * 128 * 384;
    const float* k_k = A.in(9) + l * 384, *k_a = A.in(10) + l * 384, *r_k = A.in(11) + l * 384, *ln_w = A.in(12) + l * 384, *ln_b = A.in(13) + l * 384;
    const int tid = F.tid, lane = F.lane;
    const int hc = h * 64 + lane;
    float S[8];
#pragma unroll
    for (int j = 0; j < 8; ++j) S[j] = 0.f;
    const int si = tid >> 3, sj = (tid & 7) * 8;
#pragma unroll 1
    for (int ch = 0; ch < SEQ / CH; ++ch) {
        const int t0 = ch * CH; const size_t row0 = (size_t)b * SEQ + t0;
        float* PRc = PREV + (ch & 1) * 192, *PRn = PREV + ((ch + 1) & 1) * 192;
#pragma unroll 1
        for (int e = tid; e < CH * 192; e += NTHREADS) {
            const int t = e / 192, c3 = e % 192, which = c3 >> 6, c = c3 & 63;
            const int col = C_RW + which * 384 + h * 64 + c;
            const float cur = bf2f(PS[(row0 + t) * PSW + col]);
            float prev;
            if (t == 0) prev = (ch == 0) ? 0.f : PRc[c3]; else prev = bf2f(PS[(row0 + t - 1) * PSW + col]);
            if (t == CH - 1) PRn[c3] = cur;
            const float z = cur + (prev - cur) * mix[which * 384 + h * 64 + c];
            L[which * CH * 64 + t * 64 + c] = z;
        }
#pragma unroll 1
        for (int e = tid; e < CH * 256; e += NTHREADS) {
            const int t = e >> 8, j = e & 255; const int col = C_LORA + j;
            const float cur = bf2f(PS[(row0 + t) * PSW + col]);
            const float prev = (t0 + t == 0) ? 0.f : bf2f(PS[(row0 + t - 1) * PSW + col]);
            float z = cur + (prev - cur) * mix[1152 + j];
            if (j < 64) z = tanhf(z); else if (j >= 128) z = sigm(z);
            ZX[t * 256 + j] = z;
        }
        __syncthreads();
        {
            float accw[4], acca[4], accg[4];
#pragma unroll
            for (int i = 0; i < 4; ++i) { accw[i] = 0.f; acca[i] = 0.f; accg[i] = 0.f; }
#pragma unroll 2
            for (int j = 0; j < 64; ++j) { const float ww = w2[j * 384 + hc], aa = a2[j * 384 + hc];
#pragma unroll
                for (int i = 0; i < 4; ++i) { const int t = F.wave + 8 * i; accw[i] += ZX[t * 256 + j] * ww; acca[i] += ZX[t * 256 + 64 + j] * aa; } }
#pragma unroll 2
            for (int j = 0; j < 128; ++j) { const float gg = g2[j * 384 + hc];
#pragma unroll
                for (int i = 0; i < 4; ++i) { const int t = F.wave + 8 * i; accg[i] += ZX[t * 256 + 128 + j] * gg; } }
            const float w0c = w0[hc], a0c = a0[hc], kkc = k_k[hc], kac = k_a[hc], rkc = r_k[hc];
#pragma unroll
            for (int i = 0; i < 4; ++i) { const int t = F.wave + 8 * i; const int o = t * 64 + lane;
                const float x = -(w0c + accw[i]); const float sp = (x > 20.f) ? x : log1pf(__expf(x)); const float w = -sp - 0.5f;
                const float av = sigm(a0c + acca[i]);
                const float kraw = ZK[o]; float kk = kraw * kkc; const float nrm = sqrtf(wave_sum(kk * kk)); kk = kk / fmaxf(nrm, 1e-12f);
                const float knew = kraw * (1.0f + (av - 1.0f) * kac);
                const float bon = wave_sum(ZR[o] * knew * rkc);
                ZK[o] = knew; WD[o] = __expf(-__expf(w)); KA[o] = -kk; KB[o] = kk * av; GG[o] = accg[i]; if (lane == 0) BON[t] = bon; }
        }
        __syncthreads();
#pragma unroll 2
        for (int t = 0; t < CH; ++t) {
            const f32x4 a0v = *(const f32x4*)(KA + t * 64 + sj), a1v = *(const f32x4*)(KA + t * 64 + sj + 4);
            const f32x4 w0v = *(const f32x4*)(WD + t * 64 + sj), w1v = *(const f32x4*)(WD + t * 64 + sj + 4);
            const f32x4 b0v = *(const f32x4*)(KB + t * 64 + sj), b1v = *(const f32x4*)(KB + t * 64 + sj + 4);
            const f32x4 k0v = *(const f32x4*)(ZK + t * 64 + sj), k1v = *(const f32x4*)(ZK + t * 64 + sj + 4);
            const f32x4 r0v = *(const f32x4*)(ZR + t * 64 + sj), r1v = *(const f32x4*)(ZR + t * 64 + sj + 4);
            const float vi = ZV[t * 64 + si];
            float sa = 0.f;
#pragma unroll
            for (int j = 0; j < 4; ++j) sa += S[j] * a0v[j] + S[4 + j] * a1v[j];
            sa += shx<1>(sa); sa += shx<2>(sa); sa += shx<4>(sa);
            float y = 0.f;
#pragma unroll
            for (int j = 0; j < 4; ++j) { S[j] = S[j] * w0v[j] + sa * b0v[j] + vi * k0v[j]; S[4 + j] = S[4 + j] * w1v[j] + sa * b1v[j] + vi * k1v[j]; y += S[j] * r0v[j] + S[4 + j] * r1v[j]; }
            y += shx<1>(y); y += shx<2>(y); y += shx<4>(y);
            if ((tid & 7) == 0) YB[t * 64 + si] = y;
        }
        __syncthreads();
        const float lw = ln_w[hc], lb = ln_b[hc];
#pragma unroll
        for (int i = 0; i < 4; ++i) { const int t = F.wave + 8 * i; const int o = t * 64 + lane;
            const float y = YB[o]; const float mu = wave_sum(y) * (1.0f / 64.0f); const float dv = y - mu; const float var = wave_sum(dv * dv) * (1.0f / 64.0f);
            const float yn = dv * (1.0f / sqrtf(var + GN_EPS)) * lw + lb;
            const float out = (yn + BON[t] * ZV[o]) * GG[o];
            PS[(row0 + t) * PSW + C_RW + h * 64 + lane] = (bf16)f2bf(out); }
        __syncthreads();
    }
}

__device__ __forceinline__ float gelu_tanh(float x) { const float u = 0.7978845608028654f * (x + 0.044715f * x * x * x); const float th = 1.0f - 2.0f / (__expf(2.0f * u) + 1.0f); return 0.5f * x * (1.0f + th); }
__device__ __forceinline__ void ssm_v1(const KA& A, const Ctx& F, int l, int b, int g) {
    bf16* PS = (bf16*)(F.ws + WS_PS);
    float* L = (float*)F.lds;
    float* U = L, *XR = L + 1024, *XI = L + 1024 + 64 * 65, *CR = L + 1024 + 2 * 64 * 65, *CI = CR + 1024;
    const int tid = F.tid, lane = F.lane, p = lane;
    float are, aim, bre[16], bim[16];
    {
        const float step = __expf(A.in(16)[l * 16 + g]);
        const float lr = A.in(14)[(size_t)l * 1024 + g * 64 + p], li = A.in(15)[(size_t)l * 1024 + g * 64 + p];
        const float mag = __expf(lr * step), ang = li * step; float sn, cs; sincosf(ang, &sn, &cs);
        are = mag * cs; aim = mag * sn;
        const float inv = 1.0f / (lr * lr + li * li);
        const float fre = ((are - 1.0f) * lr + aim * li) * inv, fim = (aim * lr - (are - 1.0f) * li) * inv;
        const float* br = A.in(17) + (size_t)l * 16384 + (size_t)(g * 64 + p) * 16, *bi = A.in(18) + (size_t)l * 16384 + (size_t)(g * 64 + p) * 16;
#pragma unroll
        for (int c = 0; c < 16; ++c) { bre[c] = fre * br[c] - fim * bi[c]; bim[c] = fre * bi[c] + fim * br[c]; }
    }
    for (int e = tid; e < 1024; e += NTHREADS) { CR[e] = A.in(19)[(size_t)l * 16384 + g * 1024 + e]; CI[e] = A.in(20)[(size_t)l * 16384 + g * 1024 + e]; }
    const float* dsk = A.in(21) + l * 256 + g * 16;
    float xr = 0.f, xi = 0.f;
#pragma unroll 1
    for (int ch = 0; ch < SEQ / 64; ++ch) {
        const size_t row0 = (size_t)b * SEQ + ch * 64;
        for (int e = tid; e < 1024; e += NTHREADS) { const int t = e >> 4, c = e & 15; U[e] = bf2f(PS[(row0 + t) * PSW + C_SSM + g * 16 + c]); }
        __syncthreads();
#pragma unroll
        for (int i = 0; i < 8; ++i) { const int t = F.wave + 8 * i; float sr = 0.f, sii = 0.f;
#pragma unroll
            for (int c = 0; c < 16; ++c) { const float u = U[t * 16 + c]; sr += bre[c] * u; sii += bim[c] * u; }
            XR[t * 65 + p] = sr; XI[t * 65 + p] = sii; }
        __syncthreads();
        if (F.wave == 0) {
#pragma unroll 4
            for (int t = 0; t < 64; ++t) { const float nr = are * xr - aim * xi + XR[t * 65 + p], ni = are * xi + aim * xr + XI[t * 65 + p]; xr = nr; xi = ni; XR[t * 65 + p] = xr; XI[t * 65 + p] = xi; }
        }
        __syncthreads();
        { const int t = tid >> 3, c2 = (tid & 7) * 2;
#pragma unroll
          for (int q = 0; q < 2; ++q) { const int c = c2 + q; float y = 0.f;
#pragma unroll 4
              for (int pp = 0; pp < 64; ++pp) y += CR[c * 64 + pp] * XR[t * 65 + pp] - CI[c * 64 + pp] * XI[t * 65 + pp];
              y += dsk[c] * U[t * 16 + c];
              PS[(row0 + t) * PSW + C_SSM + g * 16 + c] = (bf16)f2bf(gelu_tanh(y)); } }
        __syncthreads();
    }
}
typedef short bf16x8_t __attribute__((ext_vector_type(8)));
typedef float f32x16 __attribute__((ext_vector_type(16)));
typedef short v4i16_t __attribute__((ext_vector_type(4)));
typedef __bf16 bf16x2_t __attribute__((ext_vector_type(2)));
typedef float f32x2_t __attribute__((ext_vector_type(2)));
__device__ __forceinline__ unsigned cvtpk(float lo, float hi) { f32x2_t v = {lo, hi}; bf16x2_t b = __builtin_convertvector(v, bf16x2_t); return __builtin_bit_cast(unsigned, b); }
__device__ __forceinline__ v4i16_t ds_tr16(const unsigned char* p) { return __builtin_amdgcn_ds_read_tr16_b64_v4i16((LAS v4i16_t*)p); }
__device__ __forceinline__ int crow16(int g, int hh) { return (g & 3) + 8 * (g >> 2) + 4 * hh; }

constexpr int ATT_VS = 96;
constexpr int ATT_ITEMS = BATCH * 6 * 16;

__device__ __forceinline__ void attn_v2(const KA& A, const Ctx& F, int blk, int nblk) {
    bf16* PS = (bf16*)(F.ws + WS_PS); float* LSE = (float*)(F.ws + WS_LSE);
    unsigned char* VI = F.lds;
    const int lane = F.lane, q = lane & 31, hh = lane >> 5, w = F.wave;
#pragma unroll 1
    for (int item = blk; item < ATT_ITEMS; item += nblk) {
        const int idx16 = item & 15, h = (item >> 4) % 6, b = item / 96;
        const int g = h >> 1, dsh = 2 * g, dil = 1 << dsh;
        const int bpr = 16 >> dsh, r = idx16 / bpr, i0 = (idx16 % bpr) * 256;
        const size_t tb = (size_t)b * SEQ + r;
#pragma unroll
        for (int ps = 0; ps < 6; ++ps) { const int row = (F.tid >> 3) + 64 * ps, ch = F.tid & 7; int ki = i0 - 128 + row; ki = ki < 0 ? 0 : ki;
            const v4u v = *(const v4u*)(PS + (tb + (size_t)ki * dil) * PSW + C_V + h * 64 + ch * 8);
            *(v4u*)(VI + (row * ATT_VS + ch * 8) * 2) = v; }
        bf16x8_t qf[4];
        { const bf16* qp = PS + (tb + (size_t)(i0 + 32 * w + q) * dil) * PSW + C_Q + h * 64 + 8 * hh;
#pragma unroll
          for (int s = 0; s < 4; ++s) qf[s] = *(const bf16x8_t*)(qp + 16 * s); }
        f32x16 p[5];
#pragma unroll
        for (int kt = 0; kt < 5; ++kt) {
            int ki = i0 + 32 * w - 128 + 32 * kt + q; ki = ki < 0 ? 0 : ki;
            const bf16* kp = PS + (tb + (size_t)ki * dil) * PSW + C_K + h * 64 + 8 * hh;
            bf16x8_t kf[4];
#pragma unroll
            for (int s = 0; s < 4; ++s) kf[s] = *(const bf16x8_t*)(kp + 16 * s);
            f32x16 acc = {};
#pragma unroll
            for (int s = 0; s < 4; ++s) acc = __builtin_amdgcn_mfma_f32_32x32x16_bf16(kf[s], qf[s], acc, 0, 0, 0);
            p[kt] = acc;
        }
        const int kbase = i0 + 32 * w - 128;
        float mx = -3.0e38f;
#pragma unroll
        for (int kt = 0; kt < 5; ++kt)
#pragma unroll
            for (int gq = 0; gq < 16; ++gq) { const int kl = crow16(gq, hh); const int dist = q + 128 - 32 * kt - kl;
                const bool ok = (dist >= 0) && (dist <= 128) && (kbase + 32 * kt + kl >= 0);
                const float s = ok ? p[kt][gq] : -3.0e38f; p[kt][gq] = s; mx = fmaxf(mx, s); }
        mx = xmax32(mx);
        const float sc = 0.125f * 1.4426950408889634f;
        float l = 0.f;
#pragma unroll
        for (int kt = 0; kt < 5; ++kt)
#pragma unroll
            for (int gq = 0; gq < 16; ++gq) { const float e = __builtin_amdgcn_exp2f((p[kt][gq] - mx) * sc); p[kt][gq] = e; l += e; }
        l = xsum32(l);
        __syncthreads();
        f32x16 o[2]; o[0] = f32x16{}; o[1] = f32x16{};
        const unsigned char* vb = VI + ((32 * w + 4 * hh + ((lane & 15) >> 2)) * ATT_VS + 16 * ((lane >> 4) & 1) + 4 * (lane & 3)) * 2;
#pragma unroll
        for (int kt = 0; kt < 5; ++kt)
#pragma unroll
            for (int s = 0; s < 2; ++s) {
                v4u pw; pw.x = cvtpk(p[kt][8 * s + 0], p[kt][8 * s + 1]); pw.y = cvtpk(p[kt][8 * s + 2], p[kt][8 * s + 3]); pw.z = cvtpk(p[kt][8 * s + 4], p[kt][8 * s + 5]); pw.w = cvtpk(p[kt][8 * s + 6], p[kt][8 * s + 7]);
                const bf16x8_t pb = __builtin_bit_cast(bf16x8_t, pw);
#pragma unroll
                for (int dt = 0; dt < 2; ++dt) {
                    const unsigned char* vp = vb + ((32 * kt + 16 * s) * ATT_VS + 32 * dt) * 2;
                    const v4i16_t lo = ds_tr16(vp), hi = ds_tr16(vp + 8 * ATT_VS * 2);
                    const bf16x8_t va = (bf16x8_t){lo[0], lo[1], lo[2], lo[3], hi[0], hi[1], hi[2], hi[3]};
                    o[dt] = __builtin_amdgcn_mfma_f32_32x32x16_bf16(va, pb, o[dt], 0, 0, 0);
                }
            }
        const float il = 1.0f / l;
        bf16* op = PS + (tb + (size_t)(i0 + 32 * w + q) * dil) * PSW + C_Q + h * 64 + 4 * hh;
#pragma unroll
        for (int dt = 0; dt < 2; ++dt)
#pragma unroll
            for (int g4 = 0; g4 < 4; ++g4) { v2u wv; wv.x = cvtpk(o[dt][4 * g4 + 0] * il, o[dt][4 * g4 + 1] * il); wv.y = cvtpk(o[dt][4 * g4 + 2] * il, o[dt][4 * g4 + 3] * il);
                if (!(F.dry && (DRY_SEL & 2))) *(v2u*)(op + 32 * dt + 8 * g4) = wv; }
        if (hh == 0 && !(F.dry && (DRY_SEL & 2))) LSE[(tb + (size_t)(i0 + 32 * w + q) * dil) * 6 + h] = mx * 0.125f + __logf(l);
        __syncthreads();
    }
}
constexpr int TS = 72;
constexpr int RL_A = 0, RL_B = 9216, RL_K = 18432, RL_R = 27648, RL_AT = 36864, RL_VT = 46080, RL_BHT = 55296, RL_KHT = 64512,
              RL_AAK = 73728, RL_ARB = 82944, RL_ARK = 92160, RL_AABF = 101376, RL_TF = 117760, RL_PB = 134144;
constexpr int RL_TB = RL_A, RL_XT = RL_B, RL_WT = RL_K, RL_UT = RL_AAK;
constexpr int RL_WLF = 73728, RL_ALF = 90112, RL_GF = 106496, RL_LW = 122880;
static_assert(RL_LW + 16384 <= LDS_BYTES && RL_PB + 3072 <= LDS_BYTES, "rwkv LDS map");
constexpr int RW_ITEMS = BATCH * 6 * 64;
#ifndef SEC
#define SEC 0xFFFF
#endif

__device__ __forceinline__ bf16x8_t ldfrag(const unsigned char* tile, int row, int s, int hh) { return *(const bf16x8_t*)(tile + (row * TS + 16 * s + 8 * hh) * 2); }
__device__ __forceinline__ f32x16 mm64(f32x16 acc, const unsigned char* At, int arow0, const unsigned char* Bt, int brow0, int ks, int lane) {
    const int r = lane & 31, hh = lane >> 5;
#pragma unroll
    for (int s = 0; s < 4; ++s) if (s < ks) acc = __builtin_amdgcn_mfma_f32_32x32x16_bf16(ldfrag(At, arow0 + r, s, hh), ldfrag(Bt, brow0 + r, s, hh), acc, 0, 0, 0);
    return acc;
}
__device__ __forceinline__ void st_tileT(unsigned char* tile, int ncol, int m0, const f32x16& acc, int hh) {
#pragma unroll
    for (int g4 = 0; g4 < 4; ++g4) { v2u wv; wv.x = cvtpk(acc[4 * g4 + 0], acc[4 * g4 + 1]); wv.y = cvtpk(acc[4 * g4 + 2], acc[4 * g4 + 3]);
        *(v2u*)(tile + (ncol * TS + m0 + 8 * g4 + 4 * hh) * 2) = wv; }
}
__device__ __forceinline__ bf16x8_t pack8(const float (&z)[8]) { v4u pw; pw.x = cvtpk(z[0], z[1]); pw.y = cvtpk(z[2], z[3]); pw.z = cvtpk(z[4], z[5]); pw.w = cvtpk(z[6], z[7]); return __builtin_bit_cast(bf16x8_t, pw); }
__device__ __forceinline__ void unpack8(const v4u w, float (&z)[8]) { z[0] = bflo(w.x); z[1] = bfhi(w.x); z[2] = bflo(w.y); z[3] = bfhi(w.y); z[4] = bflo(w.z); z[5] = bfhi(w.z); z[6] = bflo(w.w); z[7] = bfhi(w.w); }

template <int ACT> __device__ __forceinline__ bf16x8_t lora_frag(const bf16* PS, size_t grow, bool first, int jcol, const float* mix) {
    float c[8], p[8];
    unpack8(*(const v4u*)(PS + grow * PSW + C_LORA + jcol), c);
    if (first) {
#pragma unroll
        for (int e = 0; e < 8; ++e) p[e] = 0.f;
    } else unpack8(*(const v4u*)(PS + (grow - 1) * PSW + C_LORA + jcol), p);
    const f32x4 m0 = *(const f32x4*)(mix + 1152 + jcol), m1 = *(const f32x4*)(mix + 1152 + jcol + 4);
    float z[8];
#pragma unroll
    for (int e = 0; e < 8; ++e) { const float mm = e < 4 ? m0[e] : m1[e - 4]; float v = c[e] + (p[e] - c[e]) * mm;
        if (ACT == 1) v = 1.0f - 2.0f / (__expf(2.0f * v) + 1.0f); else if (ACT == 2) v = sigm(v);
        z[e] = v; }
    return pack8(z);
}

__device__ __forceinline__ void rwkv_p1(const KA& A, const Ctx& F, int l) {
    bf16* PS = (bf16*)(F.ws + WS_PS); const bf16* BRB = (const bf16*)(F.ws + WS_BR);
    unsigned char* L = F.lds;
    unsigned char* wl = F.ws + WS_W + (size_t)l * W_LAYER;
    const bf16* W2T = (const bf16*)(wl + WO_W2); const bf16* A2T = (const bf16*)(wl + WO_A2); const bf16* G2T = (const bf16*)(wl + WO_G2);
    const float* mix = A.in(3) + (size_t)l * 1408;
    int tid = F.tid, lane = F.lane, r32 = lane & 31, hh = lane >> 5; const int w = F.wave;
#ifdef SECD
    const int sec_ = F.dry ? SECD : 0xFFFF;
#else
    constexpr int sec_ = 0xFFFF;
#endif
#define RW_FENCE() do { __syncthreads(); asm volatile("" : "+v"(tid)); lane = tid & 63; r32 = lane & 31; hh = lane >> 5; hc = h * 64 + lane; } while (0)
#pragma unroll 1
    for (int item = F.bid; item < RW_ITEMS; item += F.G) {
        const int j = item & 63, h = (item >> 6) % 6, b = item / 384;
        const size_t row0 = (size_t)b * SEQ + 64 * j;
        int hc = h * 64 + lane;
        if (sec_ & 1) {
            const int tl = (w & 3), ct = tl >> 1, tt = tl & 1;
            const size_t grow = row0 + 32 * tt + r32; const bool first = (j == 0) && (tt == 0) && (r32 == 0);
            if (w < 4) {
                f32x16 acc = {};
#pragma unroll
                for (int s = 0; s < 8; ++s) { const bf16x8_t af = *(const bf16x8_t*)(G2T + (size_t)(h * 64 + 32 * ct + r32) * 128 + 16 * s + 8 * hh);
                    acc = __builtin_amdgcn_mfma_f32_32x32x16_bf16(af, lora_frag<2>(PS, grow, first, 128 + 16 * s + 8 * hh, mix), acc, 0, 0, 0); }
                float* G = (float*)(L + RL_GF);
#pragma unroll
                for (int g4 = 0; g4 < 4; ++g4) *(f32x4*)(G + (32 * tt + r32) * 64 + 32 * ct + 8 * g4 + 4 * hh) = (f32x4){acc[4 * g4], acc[4 * g4 + 1], acc[4 * g4 + 2], acc[4 * g4 + 3]};
            } else {
                f32x16 accw = {}, acca = {};
#pragma unroll
                for (int s = 0; s < 4; ++s) {
                    const bf16x8_t wf = *(const bf16x8_t*)(W2T + (size_t)(h * 64 + 32 * ct + r32) * 64 + 16 * s + 8 * hh);
                    const bf16x8_t af = *(const bf16x8_t*)(A2T + (size_t)(h * 64 + 32 * ct + r32) * 64 + 16 * s + 8 * hh);
                    accw = __builtin_amdgcn_mfma_f32_32x32x16_bf16(wf, lora_frag<1>(PS, grow, first, 16 * s + 8 * hh, mix), accw, 0, 0, 0);
                    acca = __builtin_amdgcn_mfma_f32_32x32x16_bf16(af, lora_frag<0>(PS, grow, first, 64 + 16 * s + 8 * hh, mix), acca, 0, 0, 0); }
                float* WLp = (float*)(L + RL_WLF); float* ALp = (float*)(L + RL_ALF);
#pragma unroll
                for (int g4 = 0; g4 < 4; ++g4) { const int o = (32 * tt + r32) * 64 + 32 * ct + 8 * g4 + 4 * hh;
                    *(f32x4*)(WLp + o) = (f32x4){accw[4 * g4], accw[4 * g4 + 1], accw[4 * g4 + 2], accw[4 * g4 + 3]};
                    *(f32x4*)(ALp + o) = (f32x4){acca[4 * g4], acca[4 * g4 + 1], acca[4 * g4 + 2], acca[4 * g4 + 3]}; }
            }
        }
        float rr[8], kn[8], vv[8], kk[8], bb[8], eadd[8];
        {
            const float mr = mix[hc], mk = mix[384 + hc], mv = mix[768 + hc];
#pragma unroll
            for (int i = 0; i < 8; ++i) { const int t = w + 8 * i; const size_t g = row0 + t;
                const bf16* cp = PS + g * PSW + C_RW + hc;
                const float cr = bf2f(cp[0]), ck = bf2f(cp[384]), cv = bf2f(cp[768]);
                float pr, pk, pv;
                if (t == 0) { if (j == 0) { pr = 0.f; pk = 0.f; pv = 0.f; } else { const bf16* bp = BRB + (size_t)(b * 64 + j - 1) * PSW + C_RW + hc; pr = bf2f(bp[0]); pk = bf2f(bp[384]); pv = bf2f(bp[768]); } }
                else { const bf16* pp = cp - PSW; pr = bf2f(pp[0]); pk = bf2f(pp[384]); pv = bf2f(pp[768]); }
                rr[i] = cr + (pr - cr) * mr; kn[i] = ck + (pk - ck) * mk; vv[i] = cv + (pv - cv) * mv; }
        }
        RW_FENCE();
        if (sec_ & 2) {
            const float* WLp = (const float*)(L + RL_WLF); const float* ALp = (const float*)(L + RL_ALF); const float* G = (const float*)(L + RL_GF); float* LW = (float*)(L + RL_LW);
            const float w0c = A.in(4)[l * 384 + hc], a0c = A.in(6)[l * 384 + hc], kkc = A.in(9)[l * 384 + hc], kac = A.in(10)[l * 384 + hc], rkc = A.in(11)[l * 384 + hc];
            const float lnw = A.in(12)[l * 384 + hc], lnb = A.in(13)[l * 384 + hc];
            bf16* EM = (bf16*)(F.ws + WS_REM) + (size_t)item * 4096;
#pragma unroll
            for (int i = 0; i < 8; ++i) { const int t = w + 8 * i; const int o = t * 64 + lane;
                const float x = -(w0c + WLp[o]); const float sp = (x > 20.f) ? x : __logf(1.0f + __expf(x)); const float wv = -sp - 0.5f;
                LW[o] = -__expf(wv);
                const float av = sigm(a0c + ALp[o]); const float gv = G[o];
                float kq = kn[i] * kkc; const float nrm = sqrtf(wave_sum(kq * kq)); kq = kq / fmaxf(nrm, 1e-12f);
                const float knew = kn[i] * (1.0f + (av - 1.0f) * kac);
                const float bon = wave_sum(rr[i] * knew * rkc);
                kk[i] = kq; bb[i] = kq * av; kn[i] = knew;
                if (!(F.dry && (DRY_SEL & 1))) EM[o] = (bf16)f2bf(lnw * gv); eadd[i] = (lnb + bon * vv[i]) * gv; }
        }
        RW_FENCE();
        if ((sec_ & 4) && w == 0) { float* LW = (float*)(L + RL_LW); float c[64];
#pragma unroll
            for (int t = 0; t < 64; ++t) c[t] = LW[t * 64 + lane];
#pragma unroll
            for (int t = 1; t < 64; ++t) c[t] += c[t - 1];
#pragma unroll
            for (int t = 0; t < 64; ++t) LW[t * 64 + lane] = c[t];
            if (!(F.dry && (DRY_SEL & 1))) ((float*)(F.ws + WS_RGL))[(size_t)item * 64 + lane] = __expf(c[63]); }
        RW_FENCE();
        if (sec_ & 8) {
            const float* CU = (const float*)(L + RL_LW); const float cl = CU[63 * 64 + lane];
            bf16* At = (bf16*)(L + RL_A), *Bt = (bf16*)(L + RL_B), *Kt = (bf16*)(L + RL_K), *Rt = (bf16*)(L + RL_R);
            bf16* ATt = (bf16*)(L + RL_AT), *VTt = (bf16*)(L + RL_VT), *BHt = (bf16*)(L + RL_BHT), *KHt = (bf16*)(L + RL_KHT);
#pragma unroll
            for (int i = 0; i < 8; ++i) { const int t = w + 8 * i;
                const float ct = CU[t * 64 + lane], cp = (t == 0) ? 0.f : CU[(t - 1) * 64 + lane];
                const float ep = __expf(cp), et = __expf(ct), ei = __expf(-ct), eh = __expf(cl - ct);
                const bf16 av = (bf16)f2bf(-kk[i] * ep);
                At[t * TS + lane] = av; ATt[lane * TS + t] = av;
                Rt[t * TS + lane] = (bf16)f2bf(rr[i] * et);
                Bt[t * TS + lane] = (bf16)f2bf(bb[i] * ei); Kt[t * TS + lane] = (bf16)f2bf(kn[i] * ei);
                VTt[lane * TS + t] = (bf16)f2bf(vv[i]); BHt[lane * TS + t] = (bf16)f2bf(bb[i] * eh); KHt[lane * TS + t] = (bf16)f2bf(kn[i] * eh); }
        }
        RW_FENCE();
#pragma unroll
        for (int rep = 0; rep < ((sec_ & 16) ? 2 : 0); ++rep) { const int job = w + 8 * rep, prod = job >> 2, tt = (job >> 1) & 1, st = job & 1;
            f32x16 acc = {};
            acc = mm64(acc, L + ((prod & 1) ? RL_K : RL_B), 32 * st, L + ((prod & 2) ? RL_R : RL_A), 32 * tt, 4, lane);
            const int t = 32 * tt + r32; const int incl = prod >> 1;
#pragma unroll
            for (int g = 0; g < 16; ++g) { const int s = 32 * st + crow16(g, hh); if (!(s < t + incl)) acc[g] = 0.f; }
            if (prod == 0) { float* AF = (float*)(L + RL_AABF);
#pragma unroll
                for (int g4 = 0; g4 < 4; ++g4) *(f32x4*)(AF + t * 64 + 32 * st + 8 * g4 + 4 * hh) = (f32x4){acc[4 * g4], acc[4 * g4 + 1], acc[4 * g4 + 2], acc[4 * g4 + 3]};
            } else st_tileT(L + (prod == 1 ? RL_AAK : (prod == 2 ? RL_ARB : RL_ARK)), t, 32 * st, acc, hh);
        }
        RW_FENCE();
        if (sec_ & 32) {
            const float* AF = (const float*)(L + RL_AABF); float* TF = (float*)(L + RL_TF); float* PB = (float*)(L + RL_PB);
            if (w == 0) {
                const int I = lane >> 4, jc = lane & 15; float x[16];
#pragma unroll
                for (int r = 0; r < 16; ++r) { float s = (r == jc) ? 1.f : 0.f;
#pragma unroll
                    for (int q = 0; q < 16; ++q) if (q < r) s += AF[(16 * I + r) * 64 + 16 * I + q] * x[q];
                    x[r] = s; TF[(16 * I + r) * 64 + 16 * I + jc] = s; }
            } else if (w >= 4) { const int tl = w - 4, tt = tl >> 1, it = tl & 1;
                f32x16 acc = {};
                acc = mm64(acc, L + RL_AAK, 32 * tt, L + RL_VT, 32 * it, tt ? 4 : 2, lane);
                st_tileT(L + RL_XT, 32 * it + r32, 32 * tt, acc, hh); }
            RW_FENCE();
#pragma unroll 1
            for (int dist = 1; dist < 4; ++dist) { const int nb = 4 - dist;
                for (int o = tid; o < nb * 256; o += NTHREADS) { const int J = o >> 8, I = J + dist, rw = (o >> 4) & 15, cc = o & 15; float s = 0.f;
                    for (int Kb = J; Kb < I; ++Kb)
#pragma unroll
                        for (int m = 0; m < 16; ++m) s += AF[(16 * I + rw) * 64 + 16 * Kb + m] * TF[(16 * Kb + m) * 64 + 16 * J + cc];
                    PB[o] = s; }
                __syncthreads();
                for (int o = tid; o < nb * 256; o += NTHREADS) { const int J = o >> 8, I = J + dist, rw = (o >> 4) & 15, cc = o & 15; float s = 0.f;
#pragma unroll
                    for (int m = 0; m < 16; ++m) s += TF[(16 * I + rw) * 64 + 16 * I + m] * PB[(J << 8) + m * 16 + cc];
                    TF[(16 * I + rw) * 64 + 16 * J + cc] = s; }
                __syncthreads();
            }
            bf16* TB = (bf16*)(L + RL_TB);
#pragma unroll
            for (int e = 0; e < 8; ++e) { const int o = tid + NTHREADS * e, t = o >> 6, s = o & 63; TB[t * TS + s] = ((s >> 4) > (t >> 4)) ? (bf16)0 : (bf16)f2bf(TF[o]); }
        }
        RW_FENCE();
        if (sec_ & 64) { const int mat = w >> 2, tl = w & 3, tt = tl >> 1, nt = tl & 1;
          f32x16 acc = {};
          acc = mm64(acc, L + RL_TB, 32 * tt, L + (mat ? RL_XT : RL_AT), 32 * nt, tt ? 4 : 2, lane);
          st_tileT(L + (mat ? RL_UT : RL_WT), 32 * nt + r32, 32 * tt, acc, hh); }
        RW_FENCE();
        if (sec_ & 128) { const int tl = w & 3, ta = tl >> 1, tb2 = tl & 1;
          if (w < 4) {
              f32x16 acc = {};
              acc = mm64(acc, L + RL_WT, 32 * ta, L + RL_BHT, 32 * tb2, 4, lane);
              bf16* MC = (bf16*)(F.ws + WS_RMC) + (size_t)item * 4096;
#pragma unroll
              for (int g4 = 0; g4 < 4; ++g4) { v2u wv; wv.x = cvtpk(acc[4 * g4], acc[4 * g4 + 1]); wv.y = cvtpk(acc[4 * g4 + 2], acc[4 * g4 + 3]); if (!(F.dry && (DRY_SEL & 1))) *(v2u*)(MC + (32 * tb2 + r32) * 64 + 32 * ta + 8 * g4 + 4 * hh) = wv; }
              f32x16 an = {};
              an = mm64(an, L + RL_BHT, 32 * ta, L + RL_UT, 32 * tb2, 4, lane);
              an = mm64(an, L + RL_KHT, 32 * ta, L + RL_VT, 32 * tb2, 4, lane);
              bf16* NT = (bf16*)(F.ws + WS_RNT) + (size_t)item * 4096;
#pragma unroll
              for (int g4 = 0; g4 < 4; ++g4) { v2u wv; wv.x = cvtpk(an[4 * g4], an[4 * g4 + 1]); wv.y = cvtpk(an[4 * g4 + 2], an[4 * g4 + 3]); if (!(F.dry && (DRY_SEL & 1))) *(v2u*)(NT + (32 * tb2 + r32) * 64 + 32 * ta + 8 * g4 + 4 * hh) = wv; }
          } else {
              f32x16 acc = {};
              acc = mm64(acc, L + RL_WT, 32 * ta, L + RL_ARB, 32 * tb2, tb2 ? 4 : 2, lane);
              const int t = 32 * tb2 + r32; const bf16* Rt = (const bf16*)(L + RL_R);
              bf16* qd = PS + (row0 + t) * PSW + C_RW + h * 64;
#pragma unroll
              for (int g4 = 0; g4 < 4; ++g4) { const int c0 = 32 * ta + 8 * g4 + 4 * hh; const v2u rv = *(const v2u*)(Rt + t * TS + c0);
                  v2u wv; wv.x = cvtpk(acc[4 * g4] + bflo(rv.x), acc[4 * g4 + 1] + bfhi(rv.x)); wv.y = cvtpk(acc[4 * g4 + 2] + bflo(rv.y), acc[4 * g4 + 3] + bfhi(rv.y)); if (!(F.dry && (DRY_SEL & 1))) *(v2u*)(qd + c0) = wv; }
              f32x16 ay = {};
              ay = mm64(ay, L + RL_UT, 32 * ta, L + RL_ARB, 32 * tb2, tb2 ? 4 : 2, lane);
              ay = mm64(ay, L + RL_VT, 32 * ta, L + RL_ARK, 32 * tb2, tb2 ? 4 : 2, lane);
              bf16* yd = PS + (row0 + t) * PSW + C_RW + 384 + h * 64;
#pragma unroll
              for (int g4 = 0; g4 < 4; ++g4) { v2u wv; wv.x = cvtpk(ay[4 * g4], ay[4 * g4 + 1]); wv.y = cvtpk(ay[4 * g4 + 2], ay[4 * g4 + 3]); if (!(F.dry && (DRY_SEL & 1))) *(v2u*)(yd + 32 * ta + 8 * g4 + 4 * hh) = wv; }
          }
#pragma unroll
          for (int i = 0; i < 8; ++i) { const int t = w + 8 * i; if (!(F.dry && (DRY_SEL & 1))) PS[(row0 + t) * PSW + C_RW + 768 + hc] = (bf16)f2bf(eadd[i]); }
        }
        RW_FENCE();
    }
}
#undef RW_FENCE

constexpr int RW_PF = 4;
constexpr size_t WS_RHS = WS_XN;
struct ScanOps { bf16x8_t mf[4]; f32x4 gl[4]; v2u nv[4]; };
__device__ __forceinline__ void scan_load(ScanOps& o, const unsigned char* ws, int item, int ta, int tb2, int r32, int hh) {
    const bf16* MC = (const bf16*)(ws + WS_RMC) + (size_t)item * 4096; const bf16* NT = (const bf16*)(ws + WS_RNT) + (size_t)item * 4096; const float* GL = (const float*)(ws + WS_RGL) + (size_t)item * 64;
#pragma unroll
    for (int s = 0; s < 4; ++s) o.mf[s] = *(const bf16x8_t*)(MC + (32 * ta + r32) * 64 + 16 * s + 8 * hh);
#pragma unroll
    for (int g4 = 0; g4 < 4; ++g4) { const int c0 = 32 * ta + 8 * g4 + 4 * hh; o.gl[g4] = *(const f32x4*)(GL + c0); o.nv[g4] = *(const v2u*)(NT + (32 * tb2 + r32) * 64 + c0); }
}
__device__ __forceinline__ void rwkv_scan(const KA& A, const Ctx& F, int l, int b, int h) {
    unsigned char* L = F.lds;
    const int tid = F.tid, lane = F.lane, w = F.wave, r32 = lane & 31, hh = lane >> 5;
    for (int o = tid; o < 2 * 9216 / 4; o += NTHREADS) ((unsigned*)L)[o] = 0u;
    __syncthreads();
    const bool act = w < 4;
    const int ta = (w >> 1) & 1, tb2 = w & 1;
    const int item0 = (b * 6 + h) * 64;
    bf16* HS = (bf16*)(F.ws + WS_RHS) + (size_t)item0 * 4096;
    f32x16 Hacc = {};
    ScanOps ops[RW_PF];
#pragma unroll
    for (int p = 0; p < RW_PF; ++p) if (act) scan_load(ops[p], F.ws, item0 + p, ta, tb2, r32, hh);
#pragma unroll 1
    for (int j0 = 0; j0 < 64; j0 += RW_PF) {
#pragma unroll
        for (int p = 0; p < RW_PF; ++p) { const int j = j0 + p;
            const unsigned char* HBc = L + (p & 1) * 9216; unsigned char* HBn = L + ((p + 1) & 1) * 9216;
            if (act) {
            if (!(F.dry && (DRY_SEL & 2))) {
#pragma unroll
                for (int g4 = 0; g4 < 4; ++g4) { v2u wv; wv.x = cvtpk(Hacc[4 * g4], Hacc[4 * g4 + 1]); wv.y = cvtpk(Hacc[4 * g4 + 2], Hacc[4 * g4 + 3]); *(v2u*)(HS + (size_t)j * 4096 + (32 * tb2 + r32) * 64 + 32 * ta + 8 * g4 + 4 * hh) = wv; } }
            const ScanOps cur = ops[p];
            if (j + RW_PF < 64) scan_load(ops[p], F.ws, item0 + j + RW_PF, ta, tb2, r32, hh);
#pragma unroll
            for (int g4 = 0; g4 < 4; ++g4) { Hacc[4 * g4 + 0] = Hacc[4 * g4 + 0] * cur.gl[g4][0] + bflo(cur.nv[g4].x); Hacc[4 * g4 + 1] = Hacc[4 * g4 + 1] * cur.gl[g4][1] + bfhi(cur.nv[g4].x);
                Hacc[4 * g4 + 2] = Hacc[4 * g4 + 2] * cur.gl[g4][2] + bflo(cur.nv[g4].y); Hacc[4 * g4 + 3] = Hacc[4 * g4 + 3] * cur.gl[g4][3] + bfhi(cur.nv[g4].y); }
#pragma unroll
            for (int s = 0; s < 4; ++s) Hacc = __builtin_amdgcn_mfma_f32_32x32x16_bf16(cur.mf[s], ldfrag(HBc, 32 * tb2 + r32, s, hh), Hacc, 0, 0, 0);
            st_tileT(HBn, 32 * tb2 + r32, 32 * ta, Hacc, hh);
            }
            asm volatile("s_waitcnt lgkmcnt(0)" ::: "memory");
            __builtin_amdgcn_s_barrier();
            asm volatile("" ::: "memory");
        }
    }
}

__device__ __forceinline__ void rwkv_p3(const KA& A, const Ctx& F) {
    bf16* PS = (bf16*)(F.ws + WS_PS);
    const int lane = F.lane, w = F.wave, r32 = lane & 31, hh = lane >> 5, tb2 = w & 1;
#pragma unroll 1
    for (int it4 = F.bid; it4 < RW_ITEMS / 4; it4 += F.G) {
        const int item = it4 * 4 + (w >> 1); const int j = item & 63, h = (item >> 6) % 6, b = item / 384;
        const size_t row0 = (size_t)b * SEQ + 64 * j;
        const int t = 32 * tb2 + r32;
        const bf16* qd = PS + (row0 + t) * PSW + C_RW + h * 64; const bf16* yd = qd + 384; const bf16* ed = qd + 768; const bf16* EM = (const bf16*)(F.ws + WS_REM) + (size_t)item * 4096 + t * 64;
        const bf16* HS = (const bf16*)(F.ws + WS_RHS) + (size_t)item * 4096;
        bf16x8_t qf[4], hf[2][4];
#pragma unroll
        for (int s = 0; s < 4; ++s) { qf[s] = *(const bf16x8_t*)(qd + 16 * s + 8 * hh); hf[0][s] = *(const bf16x8_t*)(HS + r32 * 64 + 16 * s + 8 * hh); hf[1][s] = *(const bf16x8_t*)(HS + (32 + r32) * 64 + 16 * s + 8 * hh); }
        f32x16 y[2]; v2u em[2][4], ea[2][4];
#pragma unroll
        for (int it = 0; it < 2; ++it)
#pragma unroll
            for (int g4 = 0; g4 < 4; ++g4) { const int i0 = 32 * it + 8 * g4 + 4 * hh; const v2u yv = *(const v2u*)(yd + i0); em[it][g4] = *(const v2u*)(EM + i0); ea[it][g4] = *(const v2u*)(ed + i0);
                y[it][4 * g4] = bflo(yv.x); y[it][4 * g4 + 1] = bfhi(yv.x); y[it][4 * g4 + 2] = bflo(yv.y); y[it][4 * g4 + 3] = bfhi(yv.y); }
#pragma unroll
        for (int it = 0; it < 2; ++it)
#pragma unroll
            for (int s = 0; s < 4; ++s) y[it] = __builtin_amdgcn_mfma_f32_32x32x16_bf16(hf[it][s], qf[s], y[it], 0, 0, 0);
        float s1 = 0.f, s2 = 0.f;
#pragma unroll
        for (int it = 0; it < 2; ++it)
#pragma unroll
            for (int g = 0; g < 16; ++g) { s1 += y[it][g]; s2 += y[it][g] * y[it][g]; }
        s1 = xsum32(s1); s2 = xsum32(s2);
        const float mu = s1 * (1.0f / 64.0f); const float var = fmaxf(s2 * (1.0f / 64.0f) - mu * mu, 0.f); const float rs = 1.0f / sqrtf(var + GN_EPS);
        bf16* od = PS + (row0 + t) * PSW + C_RW + h * 64;
#pragma unroll
        for (int it = 0; it < 2; ++it)
#pragma unroll
            for (int g4 = 0; g4 < 4; ++g4) { const int i0 = 32 * it + 8 * g4 + 4 * hh; const v2u emv = em[it][g4], eav = ea[it][g4];
                v2u wv; wv.x = cvtpk((y[it][4 * g4] - mu) * rs * bflo(emv.x) + bflo(eav.x), (y[it][4 * g4 + 1] - mu) * rs * bfhi(emv.x) + bfhi(eav.x));
                wv.y = cvtpk((y[it][4 * g4 + 2] - mu) * rs * bflo(emv.y) + bflo(eav.y), (y[it][4 * g4 + 3] - mu) * rs * bfhi(emv.y) + bfhi(eav.y));
                if (!(F.dry && (DRY_SEL & 4))) *(v2u*)(od + i0) = wv; }
    }
}
constexpr size_t SSG_TM = 0, SSG_GM = 131072, SSG_HM = 196608, SSG_LAM = 262144, SSG_BYTES = 263168;
constexpr size_t WS_SSM = WS_RGL + 1 * MiB;
static_assert(WS_SSM + 32 * SSG_BYTES <= 512 * MiB, "ssm matrices fit the workspace");
constexpr int ZS = 132;

__device__ __forceinline__ void ssm_prep(const KA& A, const Ctx& F, int l, int g) {
    float* L = (float*)F.lds;
    float* PWr = L, *PWi = L + 17 * 64, *BBr = L + 2 * 17 * 64, *BBi = BBr + 1024, *CCr = BBi + 1024, *CCi = CCr + 1024, *KE = CCi + 1024;
    unsigned char* base = F.ws + WS_SSM + (size_t)(l * 16 + g) * SSG_BYTES;
    const int tid = F.tid;
    __syncthreads();
    if (tid < 64) { const int p = tid;
        const float step = __expf(A.in(16)[l * 16 + g]);
        const float lr = A.in(14)[(size_t)l * 1024 + g * 64 + p], li = A.in(15)[(size_t)l * 1024 + g * 64 + p];
        const float ang = li * step;
        for (int m = 0; m <= 16; ++m) { const float sn = __sinf(ang * (float)m), cs = __cosf(ang * (float)m); const float mg = __expf(lr * step * (float)m); PWr[m * 64 + p] = mg * cs; PWi[m * 64 + p] = mg * sn; }
        const float are = PWr[64 + p], aim = PWi[64 + p];
        const float inv = 1.0f / (lr * lr + li * li);
        const float fre = ((are - 1.0f) * lr + aim * li) * inv, fim = (aim * lr - (are - 1.0f) * li) * inv;
        const float* br = A.in(17) + (size_t)l * 16384 + (size_t)(g * 64 + p) * 16, *bi = A.in(18) + (size_t)l * 16384 + (size_t)(g * 64 + p) * 16;
        for (int c = 0; c < 16; ++c) { BBr[p * 16 + c] = fre * br[c] - fim * bi[c]; BBi[p * 16 + c] = fre * bi[c] + fim * br[c]; }
        float* lam = (float*)(base + SSG_LAM); lam[p] = PWr[16 * 64 + p]; lam[64 + p] = PWi[16 * 64 + p];
    }
    for (int e = tid; e < 1024; e += NTHREADS) { CCr[e] = A.in(19)[(size_t)l * 16384 + g * 1024 + e]; CCi[e] = A.in(20)[(size_t)l * 16384 + g * 1024 + e]; }
    __syncthreads();
    for (int e = tid; e < 4096; e += NTHREADS) { const int tau = e >> 8, c = (e >> 4) & 15, cp = e & 15; float s = 0.f;
        for (int p = 0; p < 64; ++p) { const float wr = CCr[c * 64 + p] * PWr[tau * 64 + p] - CCi[c * 64 + p] * PWi[tau * 64 + p], wi = CCr[c * 64 + p] * PWi[tau * 64 + p] + CCi[c * 64 + p] * PWr[tau * 64 + p];
            s += wr * BBr[p * 16 + cp] - wi * BBi[p * 16 + cp]; }
        KE[e] = s; }
    __syncthreads();
    const float* dsk = A.in(21) + l * 256 + g * 16;
    bf16* TM = (bf16*)(base + SSG_TM); bf16* GM = (bf16*)(base + SSG_GM); bf16* HM = (bf16*)(base + SSG_HM);
    for (int e = tid; e < 65536; e += NTHREADS) { const int n = e >> 8, k = e & 255, tp = n >> 4, c = n & 15, sp = k >> 4, cp = k & 15;
        float v = (sp <= tp) ? KE[((tp - sp) << 8) + (c << 4) + cp] : 0.f; if (sp == tp && c == cp) v += dsk[c];
        TM[e] = (bf16)f2bf(v); }
    for (int e = tid; e < 32768; e += NTHREADS) { const int n = e >> 8, k = e & 255, p = n & 63, im = n >> 6, sp = k >> 4, cp = k & 15, m = 15 - sp;
        const float wr = PWr[m * 64 + p] * BBr[p * 16 + cp] - PWi[m * 64 + p] * BBi[p * 16 + cp], wi = PWr[m * 64 + p] * BBi[p * 16 + cp] + PWi[m * 64 + p] * BBr[p * 16 + cp];
        GM[e] = (bf16)f2bf(im ? wi : wr); }
    for (int e = tid; e < 32768; e += NTHREADS) { const int n = e >> 7, k = e & 127, tp = n >> 4, c = n & 15, p = k & 63, im = k >> 6, m = tp + 1;
        const float wr = CCr[c * 64 + p] * PWr[m * 64 + p] - CCi[c * 64 + p] * PWi[m * 64 + p], wi = CCr[c * 64 + p] * PWi[m * 64 + p] + CCi[c * 64 + p] * PWr[m * 64 + p];
        HM[e] = (bf16)f2bf(im ? -wi : wr); }
    __syncthreads();
}

__device__ __forceinline__ void ssm_v2(const KA& A, const Ctx& F, int l, int b, int g) {
    bf16* PS = (bf16*)(F.ws + WS_PS);
    float* ZF = (float*)F.lds;
    const unsigned char* base = F.ws + WS_SSM + (size_t)(l * 16 + g) * SSG_BYTES;
    const bf16* TM = (const bf16*)(base + SSG_TM); const bf16* GM = (const bf16*)(base + SSG_GM); const bf16* HM = (const bf16*)(base + SSG_HM); const float* lam = (const float*)(base + SSG_LAM);
    const int lane = F.lane, w = F.wave, r32 = lane & 31, hh = lane >> 5;
    const size_t tok0 = (size_t)b * SEQ + 512 * w;
    bf16x8_t uf[16];
    { const bf16* up = PS + (tok0 + 16 * r32) * PSW + C_SSM + 16 * g + 8 * hh;
#pragma unroll
      for (int s = 0; s < 16; ++s) uf[s] = *(const bf16x8_t*)(up + (size_t)s * PSW); }
#pragma unroll 1
    for (int nt = 0; nt < 4; ++nt) {
        f32x16 acc = {};
        const bf16* gp = GM + (size_t)(32 * nt + r32) * 256 + 8 * hh;
#pragma unroll
        for (int s = 0; s < 16; ++s) acc = __builtin_amdgcn_mfma_f32_32x32x16_bf16(uf[s], *(const bf16x8_t*)(gp + 16 * s), acc, 0, 0, 0);
#pragma unroll
        for (int q = 0; q < 16; ++q) ZF[(32 * w + crow16(q, hh)) * ZS + 32 * nt + r32] = acc[q];
    }
    __syncthreads();
    if (w == 0) { const float lr = lam[lane], li = lam[64 + lane]; float xr = 0.f, xi = 0.f;
#pragma unroll 8
        for (int j = 0; j < 256; ++j) { const float zr = ZF[j * ZS + lane], zi = ZF[j * ZS + 64 + lane];
            ZF[j * ZS + lane] = xr; ZF[j * ZS + 64 + lane] = xi;
            const float nr = lr * xr - li * xi + zr, ni = lr * xi + li * xr + zi; xr = nr; xi = ni; } }
    __syncthreads();
    bf16x8_t xf[8];
    { const float* zp = ZF + (32 * w + r32) * ZS + 8 * hh;
#pragma unroll
      for (int s = 0; s < 8; ++s) { const f32x4 a0 = *(const f32x4*)(zp + 16 * s), a1 = *(const f32x4*)(zp + 16 * s + 4);
          v4u pw; pw.x = cvtpk(a0[0], a0[1]); pw.y = cvtpk(a0[2], a0[3]); pw.z = cvtpk(a1[0], a1[1]); pw.w = cvtpk(a1[2], a1[3]); xf[s] = __builtin_bit_cast(bf16x8_t, pw); } }
#pragma unroll
    for (int nt = 0; nt < 8; ++nt) {
        f32x16 acc = {};
        const bf16* tp = TM + (size_t)(32 * nt + r32) * 256 + 8 * hh; const bf16* hp = HM + (size_t)(32 * nt + r32) * 128 + 8 * hh;
#pragma unroll
        for (int s = 0; s < 16; ++s) if (s <= 2 * nt + 1) acc = __builtin_amdgcn_mfma_f32_32x32x16_bf16(uf[s], *(const bf16x8_t*)(tp + 16 * s), acc, 0, 0, 0);
#pragma unroll
        for (int s = 0; s < 8; ++s) acc = __builtin_amdgcn_mfma_f32_32x32x16_bf16(xf[s], *(const bf16x8_t*)(hp + 16 * s), acc, 0, 0, 0);
        bf16* op = PS + (tok0 + 2 * nt + (r32 >> 4)) * PSW + C_SSM + 16 * g + (r32 & 15);
#pragma unroll
        for (int q = 0; q < 16; ++q) { const bf16 gv_ = (bf16)f2bf(gelu_tanh(acc[q])); if (!(F.dry && (DRY_SEL & 2))) op[(size_t)(16 * crow16(q, hh)) * PSW] = gv_; }
    }
    __syncthreads();
}
typedef GAS unsigned gu32;
#define RLX_AGENT __ATOMIC_RELAXED, __HIP_MEMORY_SCOPE_AGENT
#define XB_TMO      128
#define XB_XCNT(j)  (256  + 64 * (j))
#define XB_XSUB(j)  (1280 + 64 * (j))
#define XB_XGEN(j)  (2304 + 64 * (j))
#define XB_TOP      3328
#define XB_TOPGEN   3392
#define XCD_BAR_WORDS 3456
#define XB_SPIN_CAP (1u << 18)

__device__ __forceinline__ unsigned xb_ld(unsigned* p)              { return __hip_atomic_load(p, __ATOMIC_RELAXED, __HIP_MEMORY_SCOPE_AGENT); }
__device__ __forceinline__ unsigned xb_add(unsigned* p, unsigned v) { return __hip_atomic_fetch_add(p, v, __ATOMIC_RELAXED, __HIP_MEMORY_SCOPE_AGENT); }
__device__ __forceinline__ unsigned xb_xcc_id() { return (unsigned)__builtin_amdgcn_s_getreg((3 << 11) | 20) & 0xFu; }
#define XB_SPIN(cond, bar) do { unsigned _sp = 0; while (cond) { __builtin_amdgcn_s_sleep(1); \
    if ((++_sp & 255u) == 0u) { if (xb_ld(&(bar)[XB_TMO])) break; if (_sp > XB_SPIN_CAP) { atomicAdd(&(bar)[XB_TMO], 1u); break; } } } } while (0)

struct XcdBarrier {
    unsigned* bar; unsigned x;
    volatile LAS unsigned* st;
};

__device__ __forceinline__ XcdBarrier xcd_barrier_post(unsigned* bar, volatile LAS unsigned* st) {
    XcdBarrier b; b.bar = bar; b.x = xb_xcc_id(); b.st = st;
    if (threadIdx.x == 0) (void)xb_add(&bar[XB_XCNT(b.x)], 1u);
    return b;
}
__device__ __forceinline__ void xcd_barrier_complete(unsigned* bar, unsigned x, unsigned& nloc, unsigned& nx) {
    const unsigned G = gridDim.x * gridDim.y * gridDim.z;
    unsigned sum, cnt, mine, sp = 0u;
    for (;;) {
        sum = 0u; cnt = 0u; mine = 0u;
#pragma unroll
        for (unsigned j = 0; j < 16; ++j) { const unsigned c = xb_ld(&bar[XB_XCNT(j)]); sum += c; cnt += (c > 0u) ? 1u : 0u; mine = (j == x) ? c : mine; }
        if (sum == G) break;
        __builtin_amdgcn_s_sleep(1);
        if ((++sp & 255u) == 0u) { if (xb_ld(&bar[XB_TMO])) break; if (sp > XB_SPIN_CAP) { atomicAdd(&bar[XB_TMO], 1u); break; } }
    }
    nloc = mine > 0u ? mine : 1u; nx = cnt > 0u ? cnt : 1u;
}

__device__ __forceinline__ void xcd_barrier(const XcdBarrier& b) {
    asm volatile("s_waitcnt vmcnt(0)" ::: "memory");
    __syncthreads();
    if (threadIdx.x == 0) {
        unsigned* bar = b.bar;
        __builtin_amdgcn_s_waitcnt(0);
        unsigned nloc = b.st[0], nx = b.st[1];
        if (nloc == 0u) { xcd_barrier_complete(bar, b.x, nloc, nx); b.st[0] = nloc; b.st[1] = nx; }
        const unsigned old = xb_add(&bar[XB_XSUB(b.x)], 1u);
        const unsigned gen = old / nloc;
        if (old + 1u == (gen + 1u) * nloc) {
            __builtin_amdgcn_fence(__ATOMIC_RELEASE, "agent");
            asm volatile("s_waitcnt vmcnt(0)" ::: "memory");
            const unsigned og = xb_add(&bar[XB_TOP], 1u);
            const unsigned tg = og / nx;
            if (og + 1u == (tg + 1u) * nx) xb_add(&bar[XB_TOPGEN], 1u);
            else XB_SPIN(xb_ld(&bar[XB_TOPGEN]) == tg, bar);
            __builtin_amdgcn_fence(__ATOMIC_ACQUIRE, "agent");
            xb_add(&bar[XB_XGEN(b.x)], 1u);
            asm volatile("s_waitcnt vmcnt(0)" ::: "memory");
        } else {
            XB_SPIN(xb_ld(&bar[XB_XGEN(b.x)]) == gen, bar);
            __builtin_amdgcn_fence(__ATOMIC_ACQUIRE, "agent");
            asm volatile("s_waitcnt vmcnt(0)" ::: "memory");
        }
    }
    __syncthreads();
}

constexpr int PPL = 10, NPH = 2 + DEPTH * PPL;

__device__ __forceinline__ void run_phase(const KA& A, const Ctx& F, int ph) {
    PG8_LAS unsigned char* lds3 = (PG8_LAS unsigned char*)F.lds;
    bf16* XN = (bf16*)(F.ws + WS_XN); bf16* PS = (bf16*)(F.ws + WS_PS); bf16* SO = (bf16*)(F.ws + WS_SO);
    const int l = (ph - 1) / PPL, k = (ph == 0) ? 20 : (ph == NPH - 1 ? 21 : (ph - 1) % PPL);
    unsigned char* wl = F.ws + WS_W + (size_t)l * W_LAYER;
    const float* hin = (l == 0) ? A.in(0) : F.out;
    int ngemm = 0;
    if (k == 20) { phase_prep(A, F); for (int it = F.bid; it < 32; it += F.G) ssm_prep(A, F, it >> 4, it & 15); }
    else if (k == 21) phase_rmsnorm<true>(A, F, F.out, A.in(31), F.out);
    else if (k == 0) phase_rmsnorm<false>(A, F, hin, A.in(1) + l * D, XN);
    else if (k == 7) phase_rmsnorm<false>(A, F, F.out, A.in(28) + l * D, XN);
    else if (k == 2) rwkv_p1(A, F, l);
    else if (k == 3) {
        if (F.bid < 48) rwkv_scan(A, F, l, F.bid / 6, F.bid % 6);
        else if (F.bid < 176) { const int it = F.bid - 48; ssm_v2(A, F, l, it / 16, it % 16); }
        else attn_v2(A, F, F.bid - 176, F.G - 176);
    }
    else if (k == 4) { rwkv_p3(A, F); attn_finalize(A, F); ngemm = 1; }
    else if (k == 5) ngemm = 3;
    else ngemm = 1;
#pragma unroll 1
    for (int gi = 0; gi < ngemm; ++gi) {
        pg8::Gemm g; pg8::EpiAny E; E.kind = 0; E.gi = gi; E.ws = F.ws; E.base = hin; E.out = F.out;
        if (k == 1) { g = pg8::Gemm{XN, (const bf16*)(wl + WO_IN), NIN, D, D}; E.kind = 0; }
        else if (k == 4) { g = pg8::Gemm{PS + C_SSM, (const bf16*)(wl + WO_GLU), 512, 256, PSW}; E.kind = 4; }
        else if (k == 5) { E.kind = 1;
            if (gi == 0) g = pg8::Gemm{PS + C_Q, (const bf16*)(wl + WO_BA), D, 384, PSW};
            else if (gi == 1) g = pg8::Gemm{PS + C_RW, (const bf16*)(wl + WO_BR), D, 384, PSW};
            else g = pg8::Gemm{SO, (const bf16*)(wl + WO_BS), D, 256, 256}; }
        else if (k == 6) { g = pg8::Gemm{XN, (const bf16*)(wl + WO_OUT), D, D, D}; E.kind = 2; }
        else if (k == 8) { g = pg8::Gemm{XN, (const bf16*)(wl + WO_GU), 2 * FFH, D, D}; E.kind = 3; }
        else { g = pg8::Gemm{PS, (const bf16*)(wl + WO_DN), D, FFH, FFH}; E.kind = 2; E.base = F.out; }
        pg8::StaticOrder S; S.init(g.N, F.G, F.bid);
        pg8::gemm_phase<pg8::EpiAny, pg8::StaticOrder, true>(lds3, g, S, E);
    }
}

static_assert(pg8::EP_XN == WS_XN && pg8::EP_PS == WS_PS && pg8::EP_GT == WS_GT && pg8::EP_SO == WS_SO && pg8::EP_BR == WS_BR, "epilogue workspace offsets");

__global__ void __launch_bounds__(NTHREADS, 2) mega_fwd(Args args) {
    extern __shared__ __attribute__((aligned(16))) unsigned char lds[];
#if ONE_LAUNCH
    volatile LAS unsigned* misc = (volatile LAS unsigned*)((LAS unsigned char*)lds + MISC_OFF);
    if (threadIdx.x < 32) misc[threadIdx.x] = 0u;
    __syncthreads();
    XcdBarrier bar = xcd_barrier_post((unsigned*)(args.ws + WS_CTL) + CW_BAR, misc + 8);
#endif
#pragma unroll 1
    for (int ph = args.ph_lo; ph < args.ph_hi; ++ph) {
        int nrep_ = 1;
#ifdef REP_MASK
        { const int kk_ = (ph == 0 || ph == NPH - 1) ? 99 : (ph - 1) % PPL; const int ll_ = (ph - 1) / PPL;
          if ((kk_ < 16) && ((REP_MASK >> kk_) & 1) && !(kk_ == 6 && ll_ == 1)) nrep_ = 2; }
#endif
#pragma unroll 1
        for (int rp_ = 0; rp_ < nrep_; ++rp_) {
            KA A; A.p = (kptr_t)__builtin_amdgcn_kernarg_segment_ptr(); asm volatile("" : "+s"(A.p));
            int tid = threadIdx.x, bid = blockIdx.x, G = gridDim.x; asm volatile("" : "+v"(tid), "+s"(bid), "+s"(G));
            Ctx F;
            F.lds = lds; F.ws = A.ws(); F.out = A.out();
            F.tid = tid; F.lane = tid & 63; F.wave = __builtin_amdgcn_readfirstlane(tid >> 6); F.G = G; F.bid = bid; F.dry = (nrep_ == 2 && rp_ == 0) ? 1 : 0;
            run_phase(A, F, ph);
            __syncthreads();
        }
#if ONE_LAUNCH
        if (ph + 1 < args.ph_hi) {
#ifdef EXTRA_SYNCS
            for (int e_ = 0; e_ < EXTRA_SYNCS; ++e_) { XcdBarrier b2 = bar; asm volatile("" : "+s"(b2.bar)); xcd_barrier(b2); }
#endif
            if (ph == 0) { __threadfence(); cg::this_grid().sync(); }
            else { XcdBarrier b2 = bar; asm volatile("" : "+s"(b2.bar)); xcd_barrier(b2); } }
#endif
    }
}

extern "C" void kernel_launch(void* const* d_in, const int* in_sizes, int n_in, void* d_out, int out_size, void* d_ws, size_t ws_size, hipStream_t stream) {
    static int grid = 0;
    if (grid == 0) {
        if (n_in != 32 || in_sizes[0] != T * D || out_size != T * D || ws_size < WS_END) { fprintf(stderr, "kernel_launch: unexpected shapes (n_in %d, in0 %d, out %d, ws %zu); nothing launched\n", n_in, n_in > 0 ? in_sizes[0] : -1, out_size, ws_size); grid = -1; return; }
        int dev = 0, cus = 0, per_cu = 0;
        if (hipGetDevice(&dev) != hipSuccess || hipDeviceGetAttribute(&cus, hipDeviceAttributeMultiprocessorCount, dev) != hipSuccess) { grid = -1; return; }
        if (hipFuncSetAttribute((const void*)mega_fwd, hipFuncAttributeMaxDynamicSharedMemorySize, LDS_BYTES) != hipSuccess) { fprintf(stderr, "kernel_launch: hipFuncSetAttribute failed\n"); grid = -1; return; }
        if (hipOccupancyMaxActiveBlocksPerMultiprocessor(&per_cu, (const void*)mega_fwd, NTHREADS, LDS_BYTES) != hipSuccess || per_cu < 1) { fprintf(stderr, "kernel_launch: occupancy query says %d\n", per_cu); per_cu = 1; }
        (void)hipGetLastError();
        grid = cus;
        if (grid < 200) { fprintf(stderr, "kernel_launch: needs >= 200 CUs, got %d\n", grid); grid = -1; return; }
    }
    if (grid < 0) return;
    if (hipMemsetAsync((char*)d_ws + WS_CTL, 0, CTL_ZERO_BYTES, stream) != hipSuccess) { fprintf(stderr, "kernel_launch: hipMemsetAsync failed\n"); return; }
    Args a{};
    for (int i = 0; i < 32; ++i) a.in[i] = (const float*)d_in[i];
    a.out = (float*)d_out; a.ws = (unsigned char*)d_ws;
#if ONE_LAUNCH
    a.ph_lo = 0; a.ph_hi = NPH;
    void* kargs[] = {&a};
    hipError_t e = hipLaunchCooperativeKernel((const void*)mega_fwd, dim3(grid), dim3(NTHREADS), kargs, LDS_BYTES, stream);
    if (e != hipSuccess) fprintf(stderr, "kernel_launch: cooperative launch failed: %s (grid %d)\n", hipGetErrorString(e), grid);
#else
    for (int ph = 0; ph < NPH; ++ph) {
        a.ph_lo = ph; a.ph_hi = ph + 1;
        hipLaunchKernelGGL(mega_fwd, dim3(grid), dim3(NTHREADS), LDS_BYTES, stream, a);
    }
#endif
}
```

```cpp
#include <hip/hip_runtime.h>
#include <hip/hip_cooperative_groups.h>
#include <cstdio>
#include <cstdint>
namespace cg = cooperative_groups;
#ifndef ONE_LAUNCH
#define ONE_LAUNCH 1
#endif
namespace pg8 {
#define PG8_LAS __attribute__((address_space(3)))
typedef unsigned short bf16_t;
typedef short bf16x8 __attribute__((ext_vector_type(8)));
typedef float f32x4 __attribute__((ext_vector_type(4)));
typedef float f32x2 __attribute__((ext_vector_type(2)));
typedef unsigned u32x4 __attribute__((ext_vector_type(4)));
typedef unsigned u32x2 __attribute__((ext_vector_type(2)));
constexpr int BM = 256, BK = 64, HALF = 128, HTB = HALF * BK * 2  , STAGE_BYTES = 8 * HTB, NXCD = 8, WGM = 8;

__host__ __device__ __forceinline__ int lds_byte(int r, int c) { const int st = (r >> 4) * 2 + (c >> 5), rr = r & 15, cc = c & 31, ob = rr * 64 + cc * 2; return st * 1024 + (ob ^ (((ob >> 9) & 1) << 5)); }
__host__ __device__ __forceinline__ void stage_rc(int b, int& R, int& C) { const int st = b / 1024, sb = b % 1024, swz = sb ^ (((sb >> 9) & 1) << 5); R = (st >> 1) * 16 + swz / 64; C = (st & 1) * 32 + (swz % 64) / 2; }
__host__ __device__ __forceinline__ int perm32(int rho) { const int n = rho >> 4, i = rho & 15; return 8 * (i >> 2) + 4 * n + (i & 3); }

struct Unit { int pm, pn; };
constexpr size_t EP_XN = 68ull << 20, EP_PS = 132ull << 20, EP_GT = 308ull << 20, EP_SO = 404ull << 20, EP_BR = 421ull << 20;
struct Gemm { const bf16_t* A; const bf16_t* Bt; int N, K, lda; };

struct StaticOrder {
    static constexpr int nM = 128;
    int nN, G, c;
    __host__ __device__ void init(int N, int G_, int c_) { nN = N / BM; G = G_; c = c_; }
    __host__ __device__ bool next(int i, Unit& u) const {
        const int nwg = nM * nN;
        const long L = (long)i * G + c; if (L >= nwg) return false;
        int wgid = (int)L; { const int q = nwg / NXCD, r = nwg % NXCD, xcd = wgid % NXCD, off = wgid / NXCD; wgid = (xcd < r ? xcd * (q + 1) : r * (q + 1) + (xcd - r) * q) + off; }
        const int nig = WGM * nN, gid = wgid / nig, fm = gid * WGM, gsz = (nM - fm) < WGM ? (nM - fm) : WGM;
        u.pm = fm + ((wgid % nig) % gsz); u.pn = (wgid % nig) / gsz; return true;
    }
    __device__ __forceinline__ void a_ready(const Unit&) const {}
    __device__ __forceinline__ void done(const Unit&) const {}
};

__device__ __forceinline__ unsigned cvt_pk_bf16(float lo, float hi) { unsigned r; asm volatile("v_cvt_pk_bf16_f32 %0, %1, %2" : "=v"(r) : "v"(lo), "v"(hi)); return r; }
__device__ __forceinline__ float bf_lo(unsigned w) { return __uint_as_float(w << 16); }
__device__ __forceinline__ float bf_hi(unsigned w) { return __uint_as_float(w & 0xffff0000u); }
__device__ __forceinline__ float sigmoidf_(float x) { return __builtin_amdgcn_rcpf(1.0f + __expf(-x)); }


struct EpiAny;
__device__ __forceinline__ void epi_win(bf16_t* PS, unsigned char* GT, bf16_t* BRW, const f32x4 (&acc)[2][2][4][2], const Unit& u, int wr, int wc, int fr, int fq) {
        const int row0 = u.pm * BM + wr * 64 + fr;
        if (u.pn < 11) {
            const int col0 = u.pn * BM + wc * 32 + 8 * fq;
#pragma unroll
            for (int ai = 0; ai < 2; ++ai)
#pragma unroll
                for (int m = 0; m < 4; ++m) { bf16_t* rowp = PS + (size_t)(row0 + ai * HALF + m * 16) * 2816 + col0;
#pragma unroll
                    for (int bj = 0; bj < 2; ++bj) { const f32x4 v0 = acc[ai][bj][m][0], v1 = acc[ai][bj][m][1];
                        u32x4 w; w.x = cvt_pk_bf16(v0[0], v0[1]); w.y = cvt_pk_bf16(v0[2], v0[3]); w.z = cvt_pk_bf16(v1[0], v1[1]); w.w = cvt_pk_bf16(v1[2], v1[3]);
                        *(u32x4*)(rowp + bj * HALF) = w;
                        if (m == 3 && fr == 15) *(u32x4*)(BRW + (size_t)((row0 + ai * HALF + m * 16) >> 6) * 2816 + col0 + bj * HALF) = w; } }
        } else {
            const int col0 = (u.pn - 11) * BM + wc * 32 + 8 * fq;
#pragma unroll
            for (int ai = 0; ai < 2; ++ai)
#pragma unroll
                for (int m = 0; m < 4; ++m) { unsigned char* rowp = GT + (size_t)(row0 + ai * HALF + m * 16) * 3072 + col0;
#pragma unroll
                    for (int bj = 0; bj < 2; ++bj) { const f32x4 v0 = acc[ai][bj][m][0], v1 = acc[ai][bj][m][1];
                        unsigned q[8];
#pragma unroll
                        for (int k = 0; k < 4; ++k) { q[k] = (unsigned)(sigmoidf_(v0[k]) * 255.0f + 0.5f); q[4 + k] = (unsigned)(sigmoidf_(v1[k]) * 255.0f + 0.5f); }
                        u32x2 w; w.x = q[0] | (q[1] << 8) | (q[2] << 16) | (q[3] << 24); w.y = q[4] | (q[5] << 8) | (q[6] << 16) | (q[7] << 24);
                        *(u32x2*)(rowp + bj * HALF) = w; } }
        }
    }

__device__ __forceinline__ void epi_merge(bf16_t* MG, const unsigned char* GT, int gi, const f32x4 (&acc)[2][2][4][2], const Unit& u, int wr, int wc, int fr, int fq) {
        const int row0 = u.pm * BM + wr * 64 + fr, col0 = u.pn * BM + wc * 32 + 8 * fq;
#pragma unroll
        for (int ai = 0; ai < 2; ++ai)
#pragma unroll
            for (int m = 0; m < 4; ++m) { const size_t r = (size_t)(row0 + ai * HALF + m * 16);
#pragma unroll
                for (int bj = 0; bj < 2; ++bj) { const int c = col0 + bj * HALF;
                    const u32x2 gq = *(const u32x2*)(GT + r * 3072 + gi * 1024 + c);
                    float v[8];
#pragma unroll
                    for (int k = 0; k < 4; ++k) { v[k] = acc[ai][bj][m][0][k] * ((float)((gq.x >> (8 * k)) & 255u) * (1.0f / 255.0f)); v[4 + k] = acc[ai][bj][m][1][k] * ((float)((gq.y >> (8 * k)) & 255u) * (1.0f / 255.0f)); }
                    u32x4* dst = (u32x4*)(MG + r * 1024 + c);
                    if (gi > 0) { const u32x4 p = *dst;
                        v[0] += bf_lo(p.x); v[1] += bf_hi(p.x); v[2] += bf_lo(p.y); v[3] += bf_hi(p.y); v[4] += bf_lo(p.z); v[5] += bf_hi(p.z); v[6] += bf_lo(p.w); v[7] += bf_hi(p.w); }
                    u32x4 w; w.x = cvt_pk_bf16(v[0], v[1]); w.y = cvt_pk_bf16(v[2], v[3]); w.z = cvt_pk_bf16(v[4], v[5]); w.w = cvt_pk_bf16(v[6], v[7]);
                    *dst = w; } }
    }

__device__ __forceinline__ void epi_res(const float* base, float* out, const f32x4 (&acc)[2][2][4][2], const Unit& u, int wr, int wc, int fr, int fq) {
        const int row0 = u.pm * BM + wr * 64 + fr, col0 = u.pn * BM + wc * 32 + 4 * fq;
#pragma unroll
        for (int ai = 0; ai < 2; ++ai)
#pragma unroll
            for (int m = 0; m < 4; ++m) { const size_t off = (size_t)(row0 + ai * HALF + m * 16) * 1024 + col0;
#pragma unroll
                for (int bj = 0; bj < 2; ++bj)
#pragma unroll
                    for (int n = 0; n < 2; ++n) { const f32x4 b = *(const f32x4*)(base + off + bj * HALF + n * 16); *(f32x4*)(out + off + bj * HALF + n * 16) = b + acc[ai][bj][m][n]; } }
    }

template <int MODE> __device__ __forceinline__ void epi_pair(bf16_t* O, int ldo, const f32x4 (&acc)[2][2][4][2], const Unit& u, int wr, int wc, int fr, int fq) {
        const int row0 = u.pm * BM + wr * 64 + fr, col0 = u.pn * HALF + wc * 32 + 8 * fq;
#pragma unroll
        for (int ai = 0; ai < 2; ++ai)
#pragma unroll
            for (int m = 0; m < 4; ++m) { bf16_t* rowp = O + (size_t)(row0 + ai * HALF + m * 16) * ldo + col0;
                float v[8];
#pragma unroll
                for (int n = 0; n < 2; ++n)
#pragma unroll
                    for (int k = 0; k < 4; ++k) { const float a = acc[ai][0][m][n][k], b = acc[ai][1][m][n][k];
                        v[4 * n + k] = (MODE == 0) ? (a * sigmoidf_(a) * b) : (a * sigmoidf_(b)); }
                u32x4 w; w.x = cvt_pk_bf16(v[0], v[1]); w.y = cvt_pk_bf16(v[2], v[3]); w.z = cvt_pk_bf16(v[4], v[5]); w.w = cvt_pk_bf16(v[6], v[7]);
                *(u32x4*)rowp = w; }
    }


struct EpiAny {
    int kind;
    int gi; unsigned char* ws; const float* base; float* out;
    __device__ __forceinline__ bool perm() const { return kind != 2; }
    __device__ __forceinline__ void operator()(const f32x4 (&acc)[2][2][4][2], const Unit& u, int wr, int wc, int fr, int fq) const {
        if (kind == 0) epi_win((bf16_t*)(ws + EP_PS), ws + EP_GT, (bf16_t*)(ws + EP_BR), acc, u, wr, wc, fr, fq);
        else if (kind == 1) epi_merge((bf16_t*)(ws + EP_XN), ws + EP_GT, gi, acc, u, wr, wc, fr, fq);
        else if (kind == 2) epi_res(base, out, acc, u, wr, wc, fr, fq);
        else if (kind == 3) epi_pair<0>((bf16_t*)(ws + EP_PS), 2816, acc, u, wr, wc, fr, fq);
        else epi_pair<1>((bf16_t*)(ws + EP_SO), 256, acc, u, wr, wc, fr, fq);
    }
};

template <class Epi, class Sched, bool ALIGN_EPI = false>
__device__ __forceinline__ void gemm_phase(PG8_LAS unsigned char* lds, const Gemm g, const Sched& S, const Epi& E) {
    int tid_ = threadIdx.x; asm volatile("" : "+v"(tid_));
    const int tid = tid_, wid = __builtin_amdgcn_readfirstlane(tid >> 6), lane = tid & 63, wr = wid >> 2, wc = wid & 3, fr = lane & 15, fq = lane >> 4;
    const int K = g.K, lda = g.lda, nt = K / BK;
    unsigned voffA[2], voffB[2];
#pragma unroll
    for (int i = 0; i < 2; ++i) { int R, C; stage_rc(tid * 16 + i * 8192, R, C); const int Rb = E.perm() ? ((R & ~31) + perm32(R & 31)) : R;
        voffA[i] = (unsigned)(R * lda + C) * 2u; voffB[i] = (unsigned)(Rb * K + C) * 2u; }
    const size_t kstep = (size_t)(BK * 2);
    const size_t hstepA = (size_t)HALF * lda * 2, hstepB = (size_t)HALF * K * 2;
    const size_t tstepA = 2 * hstepA, tstepB = 2 * hstepB;
    const unsigned ldsw = (unsigned)wid * 1024u;
    const int aoff = lds_byte(wr * 64 + fr, fq * 8), boff = lds_byte(wc * 32 + fr, fq * 8);
#define PG8_SA(b, h) (((b) * 2 + (h)) * HTB)
#define PG8_SB(b, h) ((4 + (b) * 2 + (h)) * HTB)
#define PG8_STAGE(bufoff, gbase, voff) do { _Pragma("unroll") for (int _i = 0; _i < 2; ++_i) \
        __builtin_amdgcn_global_load_lds((const unsigned*)((const char*)(gbase) + (voff)[_i]), (PG8_LAS unsigned*)(lds + (bufoff) + ldsw + _i * 8192), 16, 0, 0); } while (0)
#define PG8_LDA(dst, b, h) do { _Pragma("unroll") for (int m = 0; m < 4; ++m) _Pragma("unroll") for (int k = 0; k < 2; ++k) dst[m][k] = *(const PG8_LAS bf16x8*)(lds + PG8_SA(b, h) + aoff + m * 2048 + k * 1024); } while (0)
#define PG8_LDB(dst, b, h) do { _Pragma("unroll") for (int n = 0; n < 2; ++n) _Pragma("unroll") for (int k = 0; k < 2; ++k) dst[n][k] = *(const PG8_LAS bf16x8*)(lds + PG8_SB(b, h) + boff + n * 2048 + k * 1024); } while (0)
#define PG8_MMA(ai, bj, At, Bt) do { __builtin_amdgcn_s_setprio(1); _Pragma("unroll") for (int m = 0; m < 4; ++m) _Pragma("unroll") for (int n = 0; n < 2; ++n) _Pragma("unroll") for (int k = 0; k < 2; ++k) \
        acc[ai][bj][m][n] = __builtin_amdgcn_mfma_f32_16x16x32_bf16(Bt[n][k], At[m][k], acc[ai][bj][m][n], 0, 0, 0); __builtin_amdgcn_s_setprio(0); } while (0)
#define PG8_WAIT_V(n) asm volatile("s_waitcnt vmcnt(" #n ")" ::: "memory")
#define PG8_WAIT_L(n) asm volatile("s_waitcnt lgkmcnt(" #n ")" ::: "memory")
#define PG8_BAR __builtin_amdgcn_s_barrier()
#define PG8_SCHED __builtin_amdgcn_sched_barrier(0)
    Unit cur, nxt; int ui = 0;
    if (!S.next(0, cur)) return;
    f32x4 acc[2][2][4][2];
#pragma unroll
    for (int a = 0; a < 2; ++a)
#pragma unroll
        for (int b = 0; b < 2; ++b)
#pragma unroll
            for (int m = 0; m < 4; ++m)
#pragma unroll
                for (int n = 0; n < 2; ++n) acc[a][b][m][n] = (f32x4){0.f, 0.f, 0.f, 0.f};
    bf16x8 At[4][2], B0[2][2], B1[2][2];
    const char* cA = (const char*)g.A + (size_t)cur.pm * tstepA; const char* cB = (const char*)g.Bt + (size_t)cur.pn * tstepB;
    S.a_ready(cur);
    PG8_STAGE(PG8_SB(0, 0), cB, voffB); PG8_STAGE(PG8_SB(0, 1), cB + hstepB, voffB); PG8_STAGE(PG8_SA(0, 0), cA, voffA); PG8_STAGE(PG8_SA(0, 1), cA + hstepA, voffA);
    if (wr == 1) PG8_BAR;
    PG8_WAIT_V(2); PG8_BAR;
    PG8_STAGE(PG8_SB(1, 0), cB + kstep, voffB); PG8_STAGE(PG8_SA(1, 0), cA + kstep, voffA); PG8_STAGE(PG8_SB(1, 1), cB + hstepB + kstep, voffB);
    PG8_WAIT_V(6); PG8_BAR;
    for (;;) {
        const bool has_next = S.next(ui + 1, nxt);
        const char* nA = has_next ? (const char*)g.A + (size_t)nxt.pm * tstepA : cA; const char* nB = has_next ? (const char*)g.Bt + (size_t)nxt.pn * tstepB : cB;
        for (int t = 0; t < nt; t += 2) {
            const bool last = (t == nt - 2);
            const char* a1 = cA + (size_t)(t + 1) * kstep;
            const char* a2 = last ? nA : cA + (size_t)(t + 2) * kstep; const char* b2 = last ? nB : cB + (size_t)(t + 2) * kstep;
            const char* a3 = a2 + kstep; const char* b3 = b2 + kstep;
            if (last && has_next) S.a_ready(nxt);
            PG8_LDB(B0, 0, 0); PG8_LDB(B1, 0, 1); PG8_SCHED; PG8_LDA(At, 0, 0); PG8_STAGE(PG8_SA(1, 1), a1 + hstepA, voffA);
            PG8_WAIT_V(8); PG8_WAIT_L(0); PG8_BAR; PG8_MMA(0, 0, At, B0); PG8_MMA(0, 1, At, B1); PG8_BAR; PG8_SCHED;
            PG8_LDA(At, 0, 1); PG8_STAGE(PG8_SB(0, 0), b2, voffB); PG8_STAGE(PG8_SB(0, 1), b2 + hstepB, voffB); PG8_STAGE(PG8_SA(0, 0), a2, voffA);
            PG8_WAIT_V(8); PG8_WAIT_L(0); PG8_BAR; PG8_MMA(1, 0, At, B0); PG8_MMA(1, 1, At, B1); PG8_BAR; PG8_SCHED;
            PG8_LDB(B0, 1, 0); PG8_LDB(B1, 1, 1); PG8_SCHED; PG8_LDA(At, 1, 0); PG8_STAGE(PG8_SA(0, 1), a2 + hstepA, voffA);
            PG8_WAIT_V(8); PG8_WAIT_L(0); PG8_BAR; PG8_MMA(0, 0, At, B0); PG8_MMA(0, 1, At, B1); PG8_BAR; PG8_SCHED;
            PG8_LDA(At, 1, 1); PG8_STAGE(PG8_SB(1, 0), b3, voffB); PG8_STAGE(PG8_SB(1, 1), b3 + hstepB, voffB); PG8_STAGE(PG8_SA(1, 0), a3, voffA);
            PG8_WAIT_V(8); PG8_WAIT_L(0); PG8_BAR; PG8_MMA(1, 0, At, B0); PG8_MMA(1, 1, At, B1); PG8_BAR; PG8_SCHED;
        }
        if constexpr (ALIGN_EPI) { if (wr == 0) PG8_BAR; }
        E(acc, cur, wr, wc, fr, fq); S.done(cur);
        if (!has_next) break;
#pragma unroll
        for (int a = 0; a < 2; ++a)
#pragma unroll
            for (int b = 0; b < 2; ++b)
#pragma unroll
                for (int m = 0; m < 4; ++m)
#pragma unroll
                    for (int n = 0; n < 2; ++n) acc[a][b][m][n] = (f32x4){0.f, 0.f, 0.f, 0.f};
        cur = nxt; cA = nA; cB = nB; ++ui;
        if constexpr (ALIGN_EPI) { if (wr == 1) PG8_BAR; }
    }
    PG8_WAIT_V(0);
    if constexpr (!ALIGN_EPI) { if (wr == 0) PG8_BAR; }
    PG8_BAR;
#undef PG8_SA
#undef PG8_SB
#undef PG8_STAGE
#undef PG8_LDA
#undef PG8_LDB
#undef PG8_MMA
#undef PG8_WAIT_V
#undef PG8_WAIT_L
#undef PG8_BAR
#undef PG8_SCHED
}
}
constexpr int NWAVES = 8, NTHREADS = 512;
constexpr int BATCH = 8, SEQ = 4096, T = BATCH * SEQ, D = 1024, DEPTH = 2;
constexpr int NIN = 5888, PSW = 2816, NGATE = 3072, FFH = 2816;
constexpr int C_Q = 0, C_K = 384, C_V = 768, C_RW = 1152, C_LORA = 2304, C_SSM = 2560;
constexpr float NORM_EPS = 1e-6f, GN_EPS = 64e-5f;

constexpr size_t MiB = 1u << 20;
constexpr size_t WS_CTL = 0, CTL_ZERO_BYTES = 1 * MiB;
constexpr size_t WS_W = 1 * MiB, W_LAYER = 33 * MiB;
constexpr size_t WO_IN = 0, WO_BA = 12 * MiB, WO_BR = WO_BA + 768 * 1024, WO_BS = WO_BR + 768 * 1024, WO_OUT = 14 * MiB, WO_GU = 16 * MiB, WO_DN = 27 * MiB, WO_GLU = 32 * MiB + 512 * 1024,
                 WO_W2 = WO_GLU + 256 * 1024, WO_A2 = WO_W2 + 48 * 1024, WO_G2 = WO_A2 + 48 * 1024;
constexpr size_t WS_XN = 68 * MiB;
constexpr size_t WS_PS = 132 * MiB;
constexpr size_t WS_GT = 308 * MiB;
constexpr size_t WS_SO = 404 * MiB;
constexpr size_t WS_LSE = 420 * MiB;
constexpr size_t WS_SCR = 421 * MiB;
constexpr size_t WS_BR = WS_SCR;
constexpr size_t WS_RMC = WS_SCR + 3 * MiB;
constexpr size_t WS_RNT = WS_RMC + 24 * MiB;
constexpr size_t WS_REM = WS_RNT + 24 * MiB;
constexpr size_t WS_RGL = WS_REM + 24 * MiB;
static_assert(WS_RGL + 1 * MiB <= 512 * MiB, "scratch map");
constexpr size_t WS_END = 512 * MiB;

constexpr int LDS_BYTES = 147456;
constexpr int MISC_OFF = LDS_BYTES - 128;
constexpr int CW_ATT = 1024;
constexpr int CW_BAR = 4096;

#define GAS __attribute__((address_space(1)))
#define LAS __attribute__((address_space(3)))
typedef unsigned short bf16;
typedef unsigned v4u __attribute__((ext_vector_type(4)));
typedef unsigned v2u __attribute__((ext_vector_type(2)));
typedef float f32x4 __attribute__((ext_vector_type(4)));
#define LDS_WAIT() asm volatile("s_waitcnt lgkmcnt(0)" ::: "memory")
#define VM_WAIT() asm volatile("s_waitcnt vmcnt(0)" ::: "memory")
__device__ __forceinline__ unsigned f2bf(float f) { unsigned u = __builtin_bit_cast(unsigned, f); return (u + 0x7fffu + ((u >> 16) & 1u)) >> 16; }
__device__ __forceinline__ unsigned pk2(float lo, float hi) { return f2bf(lo) | (f2bf(hi) << 16); }
__device__ __forceinline__ float bf2f(bf16 b) { return __uint_as_float((unsigned)b << 16); }
__device__ __forceinline__ float bflo(unsigned w) { return __uint_as_float(w << 16); }
__device__ __forceinline__ float bfhi(unsigned w) { return __uint_as_float(w & 0xffff0000u); }
template <int M> __device__ __forceinline__ float shx(float v) { static_assert(M < 32, "shx: xor mask inside a 32-lane half"); return __int_as_float(__builtin_amdgcn_ds_swizzle(__float_as_int(v), (M << 10) | 0x1f)); }
__device__ __forceinline__ float xsum32(float v) { auto r = __builtin_amdgcn_permlane32_swap(__float_as_uint(v), __float_as_uint(v), false, false); return __uint_as_float(r[0]) + __uint_as_float(r[1]); }
__device__ __forceinline__ float xmax32(float v) { auto r = __builtin_amdgcn_permlane32_swap(__float_as_uint(v), __float_as_uint(v), false, false); return fmaxf(__uint_as_float(r[0]), __uint_as_float(r[1])); }
template <int CTRL> __device__ __forceinline__ float dppf(float v) { return __int_as_float(__builtin_amdgcn_update_dpp(0, __float_as_int(v), CTRL, 0xf, 0xf, true)); }
__device__ __forceinline__ float wave_sum(float v) { v += dppf<0xB1>(v); v += dppf<0x4E>(v); v += dppf<0x141>(v); v += dppf<0x140>(v); v += shx<16>(v); return xsum32(v); }
__device__ __forceinline__ float sigm(float x) { return 1.0f / (1.0f + __expf(-x)); }

struct Args { const float* in[32]; float* out; unsigned char* ws; int ph_lo, ph_hi; };

typedef __attribute__((address_space(4))) const unsigned char* kptr_t;
struct KA {
    kptr_t p;
    typedef const float* cfptr_t; typedef float* fptr_t; typedef unsigned char* ucptr_t;
    __device__ __forceinline__ const float* in(int i) const { return *(const __attribute__((address_space(4))) cfptr_t*)(p + 8 * i); }
    __device__ __forceinline__ float* out() const { return *(const __attribute__((address_space(4))) fptr_t*)(p + 256); }
    __device__ __forceinline__ unsigned char* ws() const { return *(const __attribute__((address_space(4))) ucptr_t*)(p + 264); }
};
static_assert(sizeof(Args) == 280, "Args layout");

#ifndef DRY_SEL
#define DRY_SEL 0
#endif
struct Ctx {
    unsigned char* lds; unsigned char* ws; float* out;
    int tid, lane, wave, G, bid;
    int dry;
};

__device__ __forceinline__ void tr_item(const float* W, int ldw, int K, int nblk, bf16* WT, int goff, float* scr, int item, int lane) {
    const int kb = item / nblk, nb = item % nblk, k0 = 64 * kb, n0 = 32 * nb;
#pragma unroll 8
    for (int i = 0; i < 32; ++i) { const int kk = 2 * i + (lane >> 5); scr[kk * 33 + (lane & 31)] = W[(size_t)(k0 + kk) * ldw + n0 + (lane & 31)]; }
    LDS_WAIT(); asm volatile("" ::: "memory");
    const int c = lane & 7;
#pragma unroll
    for (int j = 0; j < 4; ++j) { const int n = (lane >> 3) + 8 * j; const float* s = scr + (8 * c) * 33 + n;
        v4u o; o.x = pk2(s[0 * 33], s[1 * 33]); o.y = pk2(s[2 * 33], s[3 * 33]); o.z = pk2(s[4 * 33], s[5 * 33]); o.w = pk2(s[6 * 33], s[7 * 33]);
        const int nn = n0 + n; const int drow = goff < 0 ? nn : ((nn >> 7) * 256 + goff + (nn & 127));
        *(v4u*)(WT + (size_t)drow * K + k0 + 8 * c) = o; }
    LDS_WAIT(); asm volatile("" ::: "memory");
}

__device__ __forceinline__ void phase_prep(const KA& A, const Ctx& F) {
    float* scr = (float*)(F.lds + F.wave * 16384);
    const int gw = F.bid * NWAVES + F.wave, NGW = F.G * NWAVES;
    constexpr int NM = 13;
    constexpr int cnt[NM] = {16 * 184, 6 * 32, 6 * 32, 4 * 32, 16 * 32, 16 * 88, 16 * 88, 44 * 32, 4 * 8, 4 * 8, 12, 12, 24};
    constexpr int per_layer = cnt[0] + cnt[1] + cnt[2] + cnt[3] + cnt[4] + cnt[5] + cnt[6] + cnt[7] + cnt[8] + cnt[9] + cnt[10] + cnt[11] + cnt[12];
    for (int it = gw; it < DEPTH * per_layer; it += NGW) {
        const int l = it / per_layer; int r = it % per_layer;
        unsigned char* wl = F.ws + WS_W + (size_t)l * W_LAYER;
        if (r < cnt[0]) { tr_item(A.in(2) + (size_t)l * D * NIN, NIN, D, NIN / 32, (bf16*)(wl + WO_IN), -1, scr, r, F.lane); continue; } r -= cnt[0];
        if (r < cnt[1]) { tr_item(A.in(24) + (size_t)l * 384 * D, D, 384, D / 32, (bf16*)(wl + WO_BA), -1, scr, r, F.lane); continue; } r -= cnt[1];
        if (r < cnt[2]) { tr_item(A.in(25) + (size_t)l * 384 * D, D, 384, D / 32, (bf16*)(wl + WO_BR), -1, scr, r, F.lane); continue; } r -= cnt[2];
        if (r < cnt[3]) { tr_item(A.in(26) + (size_t)l * 256 * D, D, 256, D / 32, (bf16*)(wl + WO_BS), -1, scr, r, F.lane); continue; } r -= cnt[3];
        if (r < cnt[4]) { tr_item(A.in(27) + (size_t)l * D * D, D, D, D / 32, (bf16*)(wl + WO_OUT), -1, scr, r, F.lane); continue; } r -= cnt[4];
        if (r < cnt[5]) { tr_item(A.in(29) + (size_t)l * D * 2 * FFH, 2 * FFH, D, FFH / 32, (bf16*)(wl + WO_GU), 0, scr, r, F.lane); continue; } r -= cnt[5];
        if (r < cnt[6]) { tr_item(A.in(29) + (size_t)l * D * 2 * FFH + FFH, 2 * FFH, D, FFH / 32, (bf16*)(wl + WO_GU), 128, scr, r, F.lane); continue; } r -= cnt[6];
        if (r < cnt[7]) { tr_item(A.in(30) + (size_t)l * FFH * D, D, FFH, D / 32, (bf16*)(wl + WO_DN), -1, scr, r, F.lane); continue; } r -= cnt[7];
        if (r < cnt[8]) { tr_item(A.in(22) + (size_t)l * 256 * 256, 256, 256, 8, (bf16*)(wl + WO_GLU), 0, scr, r, F.lane); continue; } r -= cnt[8];
        if (r < cnt[9]) { tr_item(A.in(23) + (size_t)l * 256 * 256, 256, 256, 8, (bf16*)(wl + WO_GLU), 128, scr, r, F.lane); continue; } r -= cnt[9];
        if (r < cnt[10]) { tr_item(A.in(5) + (size_t)l * 64 * 384, 384, 64, 12, (bf16*)(wl + WO_W2), -1, scr, r, F.lane); continue; } r -= cnt[10];
        if (r < cnt[11]) { tr_item(A.in(7) + (size_t)l * 64 * 384, 384, 64, 12, (bf16*)(wl + WO_A2), -1, scr, r, F.lane); continue; } r -= cnt[11];
        tr_item(A.in(8) + (size_t)l * 128 * 384, 384, 128, 12, (bf16*)(wl + WO_G2), -1, scr, r, F.lane);
    }
}

template <bool OUT_F32> __device__ __forceinline__ void phase_rmsnorm(const KA& A, const Ctx& F, const float* src, const float* gain, void* dst) {
    const int gw = F.bid * NWAVES + F.wave, NGW = F.G * NWAVES;
    f32x4 gv[4];
#pragma unroll
    for (int j = 0; j < 4; ++j) gv[j] = *((const f32x4*)gain + F.lane + 64 * j);
    for (int m = gw; m < T; m += NGW) {
        const f32x4* xr = (const f32x4*)(src + (size_t)m * D) + F.lane;
        f32x4 v[4]; float s = 0.f;
#pragma unroll
        for (int j = 0; j < 4; ++j) { v[j] = xr[64 * j]; s += (v[j].x * v[j].x + v[j].y * v[j].y) + (v[j].z * v[j].z + v[j].w * v[j].w); }
        const float rs = 1.0f / sqrtf(wave_sum(s) * (1.0f / D) + NORM_EPS);
        if (OUT_F32) {
            f32x4* o = (f32x4*)((float*)dst + (size_t)m * D) + F.lane;
#pragma unroll
            for (int j = 0; j < 4; ++j) o[64 * j] = v[j] * rs * gv[j];
        } else {
            v2u* o = (v2u*)((bf16*)dst + (size_t)m * D) + F.lane;
#pragma unroll
            for (int j = 0; j < 4; ++j) { const f32x4 y = v[j] * rs * gv[j]; v2u w; w.x = pk2(y.x, y.y); w.y = pk2(y.z, y.w); o[64 * j] = w; }
        }
    }
}
__device__ __forceinline__ void attn_v1(const KA& A, const Ctx& F, int blk, int nblk) {
    bf16* PS = (bf16*)(F.ws + WS_PS); float* LSE = (float*)(F.ws + WS_LSE);
#pragma unroll 1
    for (int item = blk * NTHREADS + F.tid; item < T * 12; item += nblk * NTHREADS) {
        const int hf = item & 1, it2 = item >> 1;
        const int h = it2 / T, bt = it2 % T, t = bt % SEQ;
        const int g = h >> 1, dil = (g == 0) ? 1 : (g == 1 ? 4 : 16);
        unsigned qp_[16]; float o[32];
        { const v4u* qp = (const v4u*)(PS + (size_t)bt * PSW + C_Q + h * 64 + hf * 32);
#pragma unroll
          for (int c = 0; c < 4; ++c) { const v4u w = qp[c]; qp_[4 * c + 0] = w.x; qp_[4 * c + 1] = w.y; qp_[4 * c + 2] = w.z; qp_[4 * c + 3] = w.w; } }
#pragma unroll
        for (int c = 0; c < 32; ++c) o[c] = 0.f;
        float mx = -1e30f, l = 0.f;
#pragma unroll 1
        for (int j = 0; j <= 128; ++j) {
            const int tk = t - j * dil; if (tk < 0) break;
            const size_t rowk = (size_t)(bt - j * dil) * PSW;
            const v4u* kp = (const v4u*)(PS + rowk + C_K + h * 64 + hf * 32); const v4u* vp = (const v4u*)(PS + rowk + C_V + h * 64 + hf * 32);
            float s = 0.f;
#pragma unroll
            for (int c = 0; c < 4; ++c) { const v4u w = kp[c];
                s += bflo(qp_[4 * c + 0]) * bflo(w.x) + bfhi(qp_[4 * c + 0]) * bfhi(w.x) + bflo(qp_[4 * c + 1]) * bflo(w.y) + bfhi(qp_[4 * c + 1]) * bfhi(w.y)
                   + bflo(qp_[4 * c + 2]) * bflo(w.z) + bfhi(qp_[4 * c + 2]) * bfhi(w.z) + bflo(qp_[4 * c + 3]) * bflo(w.w) + bfhi(qp_[4 * c + 3]) * bfhi(w.w); }
            s += shx<1>(s);
            s *= 0.125f;
            const float mn = fmaxf(mx, s), cf = __expf(mx - mn), p = __expf(s - mn);
            l = l * cf + p; mx = mn;
#pragma unroll
            for (int c = 0; c < 4; ++c) { const v4u w = vp[c];
                o[8 * c + 0] = o[8 * c + 0] * cf + p * bflo(w.x); o[8 * c + 1] = o[8 * c + 1] * cf + p * bfhi(w.x); o[8 * c + 2] = o[8 * c + 2] * cf + p * bflo(w.y); o[8 * c + 3] = o[8 * c + 3] * cf + p * bfhi(w.y);
                o[8 * c + 4] = o[8 * c + 4] * cf + p * bflo(w.z); o[8 * c + 5] = o[8 * c + 5] * cf + p * bfhi(w.z); o[8 * c + 6] = o[8 * c + 6] * cf + p * bflo(w.w); o[8 * c + 7] = o[8 * c + 7] * cf + p * bfhi(w.w); }
        }
        const float il = 1.0f / l;
        v4u* op = (v4u*)(PS + (size_t)bt * PSW + C_Q + h * 64 + hf * 32);
#pragma unroll
        for (int c = 0; c < 4; ++c) { v4u w; w.x = pk2(o[8 * c + 0] * il, o[8 * c + 1] * il); w.y = pk2(o[8 * c + 2] * il, o[8 * c + 3] * il); w.z = pk2(o[8 * c + 4] * il, o[8 * c + 5] * il); w.w = pk2(o[8 * c + 6] * il, o[8 * c + 7] * il); op[c] = w; }
        if (hf == 0) LSE[(size_t)bt * 6 + h] = mx + __logf(l);
    }
}
__device__ __forceinline__ void attn_finalize(const KA& A, const Ctx& F) {
    bf16* PS = (bf16*)(F.ws + WS_PS); const float* LSE = (const float*)(F.ws + WS_LSE);
    for (int item = F.bid * NTHREADS + F.tid; item < T * 48; item += F.G * NTHREADS) {
        const int bt = item / 48, r = item % 48, h = r >> 3, c = r & 7, j = h & 1;
        const float l0 = LSE[(size_t)bt * 6 + j], l1 = LSE[(size_t)bt * 6 + 2 + j], l2 = LSE[(size_t)bt * 6 + 4 + j], lm = LSE[(size_t)bt * 6 + h];
        const float mx = fmaxf(l0, fmaxf(l1, l2));
        const float al = __expf(lm - mx) / (__expf(l0 - mx) + __expf(l1 - mx) + __expf(l2 - mx));
        v4u* p = (v4u*)(PS + (size_t)bt * PSW + C_Q + h * 64) + c; v4u w = *p;
        w.x = pk2(bflo(w.x) * al, bfhi(w.x) * al); w.y = pk2(bflo(w.y) * al, bfhi(w.y) * al); w.z = pk2(bflo(w.z) * al, bfhi(w.z) * al); w.w = pk2(bflo(w.w) * al, bfhi(w.w) * al);
        if (!(F.dry && (DRY_SEL & 4))) *p = w;
    }
}

__device__ __forceinline__ void rwkv_v1(const KA& A, const Ctx& F, int l, int b, int h) {
    constexpr int CH = 32;
    bf16* PS = (bf16*)(F.ws + WS_PS);
    float* L = (float*)F.lds;
    float* ZR = L, *ZK = L + CH * 64, *ZV = L + 2 * CH * 64, *ZX = L + 3 * CH * 64;
    float* WD = ZX + CH * 256, *KA = WD + CH * 64, *KB = KA + CH * 64, *GG = KB + CH * 64, *YB = GG + CH * 64, *BON = YB + CH * 64, *PREV = BON + 64;
    const float* mix = A.in(3) + (size_t)l * 1408;
    const float* w0 = A.in(4) + l * 384, *w2 = A.in(5) + (size_t)l * 64 * 384, *a0 = A.in(6) + l * 384, *a2 = A.in(7) + (size_t)l * 64 * 384, *g2 = A.in(8) + (size_t)l * 128 * 384;
    const float* k_k = A.in(9) + l * 384, *k_a = A.in(10) + l * 384, *r_k = A.in(11) + l * 384, *ln_w = A.in(12) + l * 384, *ln_b = A.in(13) + l * 384;
    const int tid = F.tid, lane = F.lane;
    const int hc = h * 64 + lane;
    float S[8];
#pragma unroll
    for (int j = 0; j < 8; ++j) S[j] = 0.f;
    const int si = tid >> 3, sj = (tid & 7) * 8;
#pragma unroll 1
    for (int ch = 0; ch < SEQ / CH; ++ch) {
        const int t0 = ch * CH; const size_t row0 = (size_t)b * SEQ + t0;
        float* PRc = PREV + (ch & 1) * 192, *PRn = PREV + ((ch + 1) & 1) * 192;
#pragma unroll 1
        for (int e = tid; e < CH * 192; e += NTHREADS) {
            const int t = e / 192, c3 = e % 192, which = c3 >> 6, c = c3 & 63;
            const int col = C_RW + which * 384 + h * 64 + c;
            const float cur = bf2f(PS[(row0 + t) * PSW + col]);
            float prev;
            if (t == 0) prev = (ch == 0) ? 0.f : PRc[c3]; else prev = bf2f(PS[(row0 + t - 1) * PSW + col]);
            if (t == CH - 1) PRn[c3] = cur;
            const float z = cur + (prev - cur) * mix[which * 384 + h * 64 + c];
            L[which * CH * 64 + t * 64 + c] = z;
        }
#pragma unroll 1
        for (int e = tid; e < CH * 256; e += NTHREADS) {
            const int t = e >> 8, j = e & 255; const int col = C_LORA + j;
            const float cur = bf2f(PS[(row0 + t) * PSW + col]);
            const float prev = (t0 + t == 0) ? 0.f : bf2f(PS[(row0 + t - 1) * PSW + col]);
            float z = cur + (prev - cur) * mix[1152 + j];
            if (j < 64) z = tanhf(z); else if (j >= 128) z = sigm(z);
            ZX[t * 256 + j] = z;
        }
        __syncthreads();
        {
            float accw[4], acca[4], accg[4];
#pragma unroll
            for (int i = 0; i < 4; ++i) { accw[i] = 0.f; acca[i] = 0.f; accg[i] = 0.f; }
#pragma unroll 2
            for (int j = 0; j < 64; ++j) { const float ww = w2[j * 384 + hc], aa = a2[j * 384 + hc];
#pragma unroll
                for (int i = 0; i < 4; ++i) { const int t = F.wave + 8 * i; accw[i] += ZX[t * 256 + j] * ww; acca[i] += ZX[t * 256 + 64 + j] * aa; } }
#pragma unroll 2
            for (int j = 0; j < 128; ++j) { const float gg = g2[j * 384 + hc];
#pragma unroll
                for (int i = 0; i < 4; ++i) { const int t = F.wave + 8 * i; accg[i] += ZX[t * 256 + 128 + j] * gg; } }
            const float w0c = w0[hc], a0c = a0[hc], kkc = k_k[hc], kac = k_a[hc], rkc = r_k[hc];
#pragma unroll
            for (int i = 0; i < 4; ++i) { const int t = F.wave + 8 * i; const int o = t * 64 + lane;
                const float x = -(w0c + accw[i]); const float sp = (x > 20.f) ? x : log1pf(__expf(x)); const float w = -sp - 0.5f;
                const float av = sigm(a0c + acca[i]);
                const float kraw = ZK[o]; float kk = kraw * kkc; const float nrm = sqrtf(wave_sum(kk * kk)); kk = kk / fmaxf(nrm, 1e-12f);
                const float knew = kraw * (1.0f + (av - 1.0f) * kac);
                const float bon = wave_sum(ZR[o] * knew * rkc);
                ZK[o] = knew; WD[o] = __expf(-__expf(w)); KA[o] = -kk; KB[o] = kk * av; GG[o] = accg[i]; if (lane == 0) BON[t] = bon; }
        }
        __syncthreads();
#pragma unroll 2
        for (int t = 0; t < CH; ++t) {
            const f32x4 a0v = *(const f32x4*)(KA + t * 64 + sj), a1v = *(const f32x4*)(KA + t * 64 + sj + 4);
            const f32x4 w0v = *(const f32x4*)(WD + t * 64 + sj), w1v = *(const f32x4*)(WD + t * 64 + sj + 4);
            const f32x4 b0v = *(const f32x4*)(KB + t * 64 + sj), b1v = *(const f32x4*)(KB + t * 64 + sj + 4);
            const f32x4 k0v = *(const f32x4*)(ZK + t * 64 + sj), k1v = *(const f32x4*)(ZK + t * 64 + sj + 4);
            const f32x4 r0v = *(const f32x4*)(ZR + t * 64 + sj), r1v = *(const f32x4*)(ZR + t * 64 + sj + 4);
            const float vi = ZV[t * 64 + si];
            float sa = 0.f;
#pragma unroll
            for (int j = 0; j < 4; ++j) sa += S[j] * a0v[j] + S[4 + j] * a1v[j];
            sa += shx<1>(sa); sa += shx<2>(sa); sa += shx<4>(sa);
            float y = 0.f;
#pragma unroll
            for (int j = 0; j < 4; ++j) { S[j] = S[j] * w0v[j] + sa * b0v[j] + vi * k0v[j]; S[4 + j] = S[4 + j] * w1v[j] + sa * b1v[j] + vi * k1v[j]; y += S[j] * r0v[j] + S[4 + j] * r1v[j]; }
            y += shx<1>(y); y += shx<2>(y); y += shx<4>(y);
            if ((tid & 7) == 0) YB[t * 64 + si] = y;
        }
        __syncthreads();
        const float lw = ln_w[hc], lb = ln_b[hc];
#pragma unroll
        for (int i = 0; i < 4; ++i) { const int t = F.wave + 8 * i; const int o = t * 64 + lane;
            const float y = YB[o]; const float mu = wave_sum(y) * (1.0f / 64.0f); const float dv = y - mu; const float var = wave_sum(dv * dv) * (1.0f / 64.0f);
            const float yn = dv * (1.0f / sqrtf(var + GN_EPS)) * lw + lb;
            const float out = (yn + BON[t] * ZV[o]) * GG[o];
            PS[(row0 + t) * PSW + C_RW + h * 64 + lane] = (bf16)f2bf(out); }
        __syncthreads();
    }
}

__device__ __forceinline__ float gelu_tanh(float x) { const float u = 0.7978845608028654f * (x + 0.044715f * x * x * x); const float th = 1.0f - 2.0f / (__expf(2.0f * u) + 1.0f); return 0.5f * x * (1.0f + th); }
__device__ __forceinline__ void ssm_v1(const KA& A, const Ctx& F, int l, int b, int g) {
    bf16* PS = (bf16*)(F.ws + WS_PS);
    float* L = (float*)F.lds;
    float* U = L, *XR = L + 1024, *XI = L + 1024 + 64 * 65, *CR = L + 1024 + 2 * 64 * 65, *CI = CR + 1024;
    const int tid = F.tid, lane = F.lane, p = lane;
    float are, aim, bre[16], bim[16];
    {
        const float step = __expf(A.in(16)[l * 16 + g]);
        const float lr = A.in(14)[(size_t)l * 1024 + g * 64 + p], li = A.in(15)[(size_t)l * 1024 + g * 64 + p];
        const float mag = __expf(lr * step), ang = li * step; float sn, cs; sincosf(ang, &sn, &cs);
        are = mag * cs; aim = mag * sn;
        const float inv = 1.0f / (lr * lr + li * li);
        const float fre = ((are - 1.0f) * lr + aim * li) * inv, fim = (aim * lr - (are - 1.0f) * li) * inv;
        const float* br = A.in(17) + (size_t)l * 16384 + (size_t)(g * 64 + p) * 16, *bi = A.in(18) + (size_t)l * 16384 + (size_t)(g * 64 + p) * 16;
#pragma unroll
        for (int c = 0; c < 16; ++c) { bre[c] = fre * br[c] - fim * bi[c]; bim[c] = fre * bi[c] + fim * br[c]; }
    }
    for (int e = tid; e < 1024; e += NTHREADS) { CR[e] = A.in(19)[(size_t)l * 16384 + g * 1024 + e]; CI[e] = A.in(20)[(size_t)l * 16384 + g * 1024 + e]; }
    const float* dsk = A.in(21) + l * 256 + g * 16;
    float xr = 0.f, xi = 0.f;
#pragma unroll 1
    for (int ch = 0; ch < SEQ / 64; ++ch) {
        const size_t row0 = (size_t)b * SEQ + ch * 64;
        for (int e = tid; e < 1024; e += NTHREADS) { const int t = e >> 4, c = e & 15; U[e] = bf2f(PS[(row0 + t) * PSW + C_SSM + g * 16 + c]); }
        __syncthreads();
#pragma unroll
        for (int i = 0; i < 8; ++i) { const int t = F.wave + 8 * i; float sr = 0.f, sii = 0.f;
#pragma unroll
            for (int c = 0; c < 16; ++c) { const float u = U[t * 16 + c]; sr += bre[c] * u; sii += bim[c] * u; }
            XR[t * 65 + p] = sr; XI[t * 65 + p] = sii; }
        __syncthreads();
        if (F.wave == 0) {
#pragma unroll 4
            for (int t = 0; t < 64; ++t) { const float nr = are * xr - aim * xi + XR[t * 65 + p], ni = are * xi + aim * xr + XI[t * 65 + p]; xr = nr; xi = ni; XR[t * 65 + p] = xr; XI[t * 65 + p] = xi; }
        }
        __syncthreads();
        { const int t = tid >> 3, c2 = (tid & 7) * 2;
#pragma unroll
          for (int q = 0; q < 2; ++q) { const int c = c2 + q; float y = 0.f;
#pragma unroll 4
              for (int pp = 0; pp < 64; ++pp) y += CR[c * 64 + pp] * XR[t * 65 + pp] - CI[c * 64 + pp] * XI[t * 65 + pp];
              y += dsk[c] * U[t * 16 + c];
              PS[(row0 + t) * PSW + C_SSM + g * 16 + c] = (bf16)f2bf(gelu_tanh(y)); } }
        __syncthreads();
    }
}
typedef short bf16x8_t __attribute__((ext_vector_type(8)));
typedef float f32x16 __attribute__((ext_vector_type(16)));
typedef short v4i16_t __attribute__((ext_vector_type(4)));
typedef __bf16 bf16x2_t __attribute__((ext_vector_type(2)));
typedef float f32x2_t __attribute__((ext_vector_type(2)));
__device__ __forceinline__ unsigned cvtpk(float lo, float hi) { f32x2_t v = {lo, hi}; bf16x2_t b = __builtin_convertvector(v, bf16x2_t); return __builtin_bit_cast(unsigned, b); }
__device__ __forceinline__ v4i16_t ds_tr16(const unsigned char* p) { return __builtin_amdgcn_ds_read_tr16_b64_v4i16((LAS v4i16_t*)p); }
__device__ __forceinline__ int crow16(int g, int hh) { return (g & 3) + 8 * (g >> 2) + 4 * hh; }

constexpr int ATT_VS = 96;
constexpr int ATT_ITEMS = BATCH * 6 * 16;

__device__ __forceinline__ void attn_v2(const KA& A, const Ctx& F, int l) {
    bf16* PS = (bf16*)(F.ws + WS_PS); float* LSE = (float*)(F.ws + WS_LSE);
    unsigned char* VI = F.lds;
    const int lane = F.lane, q = lane & 31, hh = lane >> 5, w = F.wave;
    unsigned* ctr = (unsigned*)(F.ws + WS_CTL) + CW_ATT + 64 * l + ((F.dry && (DRY_SEL & 2)) ? 32 : 0); volatile unsigned* slot = (volatile unsigned*)(F.lds + MISC_OFF + 64);
#pragma unroll 1
    for (;;) {
        if (F.tid == 0) *slot = __hip_atomic_fetch_add(ctr, 1u, __ATOMIC_RELAXED, __HIP_MEMORY_SCOPE_AGENT);
        __syncthreads();
        const int item = (int)*slot;
        if (item >= ATT_ITEMS) break;
        const int idx16 = item & 15, h = (item >> 4) % 6, b = item / 96;
        const int g = h >> 1, dsh = 2 * g, dil = 1 << dsh;
        const int bpr = 16 >> dsh, r = idx16 / bpr, i0 = (idx16 % bpr) * 256;
        const size_t tb = (size_t)b * SEQ + r;
#pragma unroll
        for (int ps = 0; ps < 6; ++ps) { const int row = (F.tid >> 3) + 64 * ps, ch = F.tid & 7; int ki = i0 - 128 + row; ki = ki < 0 ? 0 : ki;
            const v4u v = *(const v4u*)(PS + (tb + (size_t)ki * dil) * PSW + C_V + h * 64 + ch * 8);
            *(v4u*)(VI + (row * ATT_VS + ch * 8) * 2) = v; }
        bf16x8_t qf[4];
        { const bf16* qp = PS + (tb + (size_t)(i0 + 32 * w + q) * dil) * PSW + C_Q + h * 64 + 8 * hh;
#pragma unroll
          for (int s = 0; s < 4; ++s) qf[s] = *(const bf16x8_t*)(qp + 16 * s); }
        f32x16 p[5];
#pragma unroll
        for (int kt = 0; kt < 5; ++kt) {
            int ki = i0 + 32 * w - 128 + 32 * kt + q; ki = ki < 0 ? 0 : ki;
            const bf16* kp = PS + (tb + (size_t)ki * dil) * PSW + C_K + h * 64 + 8 * hh;
            bf16x8_t kf[4];
#pragma unroll
            for (int s = 0; s < 4; ++s) kf[s] = *(const bf16x8_t*)(kp + 16 * s);
            f32x16 acc = {};
#pragma unroll
            for (int s = 0; s < 4; ++s) acc = __builtin_amdgcn_mfma_f32_32x32x16_bf16(kf[s], qf[s], acc, 0, 0, 0);
            p[kt] = acc;
        }
        const int kbase = i0 + 32 * w - 128;
        float mx = -3.0e38f;
#pragma unroll
        for (int kt = 0; kt < 5; ++kt)
#pragma unroll
            for (int gq = 0; gq < 16; ++gq) { const int kl = crow16(gq, hh); const int dist = q + 128 - 32 * kt - kl;
                const bool ok = (dist >= 0) && (dist <= 128) && (kbase + 32 * kt + kl >= 0);
                const float s = ok ? p[kt][gq] : -3.0e38f; p[kt][gq] = s; mx = fmaxf(mx, s); }
        mx = xmax32(mx);
        const float sc = 0.125f * 1.4426950408889634f;
        float l = 0.f;
#pragma unroll
        for (int kt = 0; kt < 5; ++kt)
#pragma unroll
            for (int gq = 0; gq < 16; ++gq) { const float e = __builtin_amdgcn_exp2f((p[kt][gq] - mx) * sc); p[kt][gq] = e; l += e; }
        l = xsum32(l);
        __syncthreads();
        f32x16 o[2]; o[0] = f32x16{}; o[1] = f32x16{};
        const unsigned char* vb = VI + ((32 * w + 4 * hh + ((lane & 15) >> 2)) * ATT_VS + 16 * ((lane >> 4) & 1) + 4 * (lane & 3)) * 2;
#pragma unroll
        for (int kt = 0; kt < 5; ++kt)
#pragma unroll
            for (int s = 0; s < 2; ++s) {
                v4u pw; pw.x = cvtpk(p[kt][8 * s + 0], p[kt][8 * s + 1]); pw.y = cvtpk(p[kt][8 * s + 2], p[kt][8 * s + 3]); pw.z = cvtpk(p[kt][8 * s + 4], p[kt][8 * s + 5]); pw.w = cvtpk(p[kt][8 * s + 6], p[kt][8 * s + 7]);
                const bf16x8_t pb = __builtin_bit_cast(bf16x8_t, pw);
#pragma unroll
                for (int dt = 0; dt < 2; ++dt) {
                    const unsigned char* vp = vb + ((32 * kt + 16 * s) * ATT_VS + 32 * dt) * 2;
                    const v4i16_t lo = ds_tr16(vp), hi = ds_tr16(vp + 8 * ATT_VS * 2);
                    const bf16x8_t va = (bf16x8_t){lo[0], lo[1], lo[2], lo[3], hi[0], hi[1], hi[2], hi[3]};
                    o[dt] = __builtin_amdgcn_mfma_f32_32x32x16_bf16(va, pb, o[dt], 0, 0, 0);
                }
            }
        const float il = 1.0f / l;
        bf16* op = PS + (tb + (size_t)(i0 + 32 * w + q) * dil) * PSW + C_Q + h * 64 + 4 * hh;
#pragma unroll
        for (int dt = 0; dt < 2; ++dt)
#pragma unroll
            for (int g4 = 0; g4 < 4; ++g4) { v2u wv; wv.x = cvtpk(o[dt][4 * g4 + 0] * il, o[dt][4 * g4 + 1] * il); wv.y = cvtpk(o[dt][4 * g4 + 2] * il, o[dt][4 * g4 + 3] * il);
                if (!(F.dry && (DRY_SEL & 2))) *(v2u*)(op + 32 * dt + 8 * g4) = wv; }
        if (hh == 0 && !(F.dry && (DRY_SEL & 2))) LSE[(tb + (size_t)(i0 + 32 * w + q) * dil) * 6 + h] = mx * 0.125f + __logf(l);
        __syncthreads();
    }
}
constexpr int TS = 72;
constexpr int TILE = 64 * TS * 2;
constexpr int RL_A = 0 * TILE, RL_B = 1 * TILE, RL_K = 2 * TILE, RL_R = 3 * TILE, RL_V = 4 * TILE, RL_BH = 5 * TILE, RL_KH = 6 * TILE,
              RL_AK = 7 * TILE, RL_RB = 8 * TILE, RL_RK = 9 * TILE, RL_AABF = 10 * TILE, RL_E1 = RL_AABF + 16384, RL_E2 = RL_E1 + TILE, RL_E3 = RL_E2 + TILE, RL_END = RL_E3 + TILE;
constexpr int RL_D = RL_B, RL_LP = RL_K, RL_X = RL_E1, RL_M = RL_E2, RL_M2 = RL_E3, RL_S = RL_AK, RL_T = RL_K, RL_W = RL_E2, RL_U = RL_E3;
constexpr int RL_WLF = RL_AK, RL_ALF = RL_WLF + 16384, RL_GF = RL_ALF + 16384, RL_TOT = RL_GF + 16384;
static_assert(RL_END <= MISC_OFF && RL_TOT + 2048 <= MISC_OFF, "rwkv LDS map");
constexpr int RW_ITEMS = BATCH * 6 * 64;
#ifndef SEC
#define SEC 0xFFFF
#endif

__device__ __forceinline__ bf16x8_t ldfrag(const unsigned char* tile, int row, int s, int hh) { return *(const bf16x8_t*)(tile + (row * TS + 16 * s + 8 * hh) * 2); }
__device__ __forceinline__ bf16x8_t ldfrag_tr(const unsigned char* tile, int n0, int s, int lane) {
    const int hh = lane >> 5;
    const unsigned char* p = tile + ((16 * s + 8 * hh + ((lane & 15) >> 2)) * TS + n0 + 16 * ((lane >> 4) & 1) + 4 * (lane & 3)) * 2;
    const v4i16_t lo = ds_tr16(p), hi = ds_tr16(p + 4 * TS * 2);
    return (bf16x8_t){lo[0], lo[1], lo[2], lo[3], hi[0], hi[1], hi[2], hi[3]};
}
template <bool AT, bool BT> __device__ __forceinline__ f32x16 mmx(f32x16 acc, const unsigned char* At, int m0, const unsigned char* Bt, int n0, int ks0, int ks1, int lane) {
    const int r = lane & 31, hh = lane >> 5;
#pragma unroll
    for (int s = 0; s < 4; ++s) if (s >= ks0 && s < ks1) {
        const bf16x8_t a = AT ? ldfrag_tr(At, m0, s, lane) : ldfrag(At, m0 + r, s, hh);
        const bf16x8_t b = BT ? ldfrag_tr(Bt, n0, s, lane) : ldfrag(Bt, n0 + r, s, hh);
        acc = __builtin_amdgcn_mfma_f32_32x32x16_bf16(a, b, acc, 0, 0, 0); }
    return acc;
}
__device__ __forceinline__ void st_tileT(unsigned char* tile, int ncol, int m0, const f32x16& acc, int hh) {
#pragma unroll
    for (int g4 = 0; g4 < 4; ++g4) { v2u wv; wv.x = cvtpk(acc[4 * g4 + 0], acc[4 * g4 + 1]); wv.y = cvtpk(acc[4 * g4 + 2], acc[4 * g4 + 3]);
        *(v2u*)(tile + (ncol * TS + m0 + 8 * g4 + 4 * hh) * 2) = wv; }
}
__device__ __forceinline__ bf16x8_t pack8(const float (&z)[8]) { v4u pw; pw.x = cvtpk(z[0], z[1]); pw.y = cvtpk(z[2], z[3]); pw.z = cvtpk(z[4], z[5]); pw.w = cvtpk(z[6], z[7]); return __builtin_bit_cast(bf16x8_t, pw); }
__device__ __forceinline__ void unpack8(const v4u w, float (&z)[8]) { z[0] = bflo(w.x); z[1] = bfhi(w.x); z[2] = bflo(w.y); z[3] = bfhi(w.y); z[4] = bflo(w.z); z[5] = bfhi(w.z); z[6] = bflo(w.w); z[7] = bfhi(w.w); }

template <int ACT> __device__ __forceinline__ bf16x8_t lora_frag(const bf16* PS, size_t grow, bool first, int jcol, const float* mix) {
    float c[8], p[8];
    unpack8(*(const v4u*)(PS + grow * PSW + C_LORA + jcol), c);
    unpack8(*(const v4u*)(PS + (grow - (first ? 0 : 1)) * PSW + C_LORA + jcol), p);
    const f32x4 m0 = *(const f32x4*)(mix + 1152 + jcol), m1 = *(const f32x4*)(mix + 1152 + jcol + 4);
    float z[8];
#pragma unroll
    for (int e = 0; e < 8; ++e) { const float mm = e < 4 ? m0[e] : m1[e - 4]; const float pe = first ? 0.f : p[e]; float v = c[e] + (pe - c[e]) * mm;
        if (ACT == 1) v = 1.0f - 2.0f / (__expf(2.0f * v) + 1.0f); else if (ACT == 2) v = sigm(v);
        z[e] = v; }
    return pack8(z);
}

__device__ __forceinline__ void rwkv_p1(const KA& A, const Ctx& F, int l) {
    bf16* PS = (bf16*)(F.ws + WS_PS); const bf16* BRB = (const bf16*)(F.ws + WS_BR);
    unsigned char* L = F.lds;
    unsigned char* wl = F.ws + WS_W + (size_t)l * W_LAYER;
    const bf16* W2T = (const bf16*)(wl + WO_W2); const bf16* A2T = (const bf16*)(wl + WO_A2); const bf16* G2T = (const bf16*)(wl + WO_G2);
    const float* mix = A.in(3) + (size_t)l * 1408;
    int tid = F.tid, lane = F.lane, r32 = lane & 31, hh = lane >> 5; const int w = F.wave;
#ifdef SECD
    const int sec_ = F.dry ? SECD : 0xFFFF;
#else
    constexpr int sec_ = 0xFFFF;
#endif
    const bool wr_ = !(F.dry && (DRY_SEL & 1));
#define RW_FENCE() do { __syncthreads(); asm volatile("" : "+v"(tid)); lane = tid & 63; r32 = lane & 31; hh = lane >> 5; hc = h * 64 + lane; } while (0)
#pragma unroll 1
    for (int item = F.bid; item < RW_ITEMS; item += F.G) {
        const int j = item & 63, h = (item >> 6) % 6, b = item / 384;
        const size_t row0 = (size_t)b * SEQ + 64 * j;
        int hc = h * 64 + lane;
        if (sec_ & 1) {
            const int tl = (w & 3), ct = tl >> 1, tt = tl & 1;
            const size_t grow = row0 + 32 * tt + r32; const bool first = (j == 0) && (tt == 0) && (r32 == 0);
            if (w < 4) {
                f32x16 acc = {};
#pragma unroll
                for (int s = 0; s < 8; ++s) { const bf16x8_t af = *(const bf16x8_t*)(G2T + (size_t)(h * 64 + 32 * ct + r32) * 128 + 16 * s + 8 * hh);
                    acc = __builtin_amdgcn_mfma_f32_32x32x16_bf16(af, lora_frag<2>(PS, grow, first, 128 + 16 * s + 8 * hh, mix), acc, 0, 0, 0); }
                float* G = (float*)(L + RL_GF);
#pragma unroll
                for (int g4 = 0; g4 < 4; ++g4) *(f32x4*)(G + (32 * tt + r32) * 64 + 32 * ct + 8 * g4 + 4 * hh) = (f32x4){acc[4 * g4], acc[4 * g4 + 1], acc[4 * g4 + 2], acc[4 * g4 + 3]};
            } else {
                f32x16 accw = {}, acca = {};
#pragma unroll
                for (int s = 0; s < 4; ++s) {
                    const bf16x8_t wf = *(const bf16x8_t*)(W2T + (size_t)(h * 64 + 32 * ct + r32) * 64 + 16 * s + 8 * hh);
                    const bf16x8_t af = *(const bf16x8_t*)(A2T + (size_t)(h * 64 + 32 * ct + r32) * 64 + 16 * s + 8 * hh);
                    accw = __builtin_amdgcn_mfma_f32_32x32x16_bf16(wf, lora_frag<1>(PS, grow, first, 16 * s + 8 * hh, mix), accw, 0, 0, 0);
                    acca = __builtin_amdgcn_mfma_f32_32x32x16_bf16(af, lora_frag<0>(PS, grow, first, 64 + 16 * s + 8 * hh, mix), acca, 0, 0, 0); }
                float* WLp = (float*)(L + RL_WLF); float* ALp = (float*)(L + RL_ALF);
#pragma unroll
                for (int g4 = 0; g4 < 4; ++g4) { const int o = (32 * tt + r32) * 64 + 32 * ct + 8 * g4 + 4 * hh;
                    *(f32x4*)(WLp + o) = (f32x4){accw[4 * g4], accw[4 * g4 + 1], accw[4 * g4 + 2], accw[4 * g4 + 3]};
                    *(f32x4*)(ALp + o) = (f32x4){acca[4 * g4], acca[4 * g4 + 1], acca[4 * g4 + 2], acca[4 * g4 + 3]}; }
            }
        }
        float rr[8], kn[8], vv[8], kk[8], bb[8], eadd[8], lp[8];
        {
            const float mr = mix[hc], mk = mix[384 + hc], mv = mix[768 + hc];
            float pr, pk, pv;
            if (w == 0) { if (j == 0) { pr = 0.f; pk = 0.f; pv = 0.f; } else { const bf16* bp = BRB + (size_t)(b * 64 + j - 1) * PSW + C_RW + hc; pr = bf2f(bp[0]); pk = bf2f(bp[384]); pv = bf2f(bp[768]); } }
            else { const bf16* pp = PS + (row0 + 8 * w - 1) * PSW + C_RW + hc; pr = bf2f(pp[0]); pk = bf2f(pp[384]); pv = bf2f(pp[768]); }
            float cr[8], ck[8], cv[8];
#pragma unroll
            for (int i = 0; i < 8; ++i) { const bf16* cp = PS + (row0 + 8 * w + i) * PSW + C_RW + hc; cr[i] = bf2f(cp[0]); ck[i] = bf2f(cp[384]); cv[i] = bf2f(cp[768]); }
#pragma unroll
            for (int i = 0; i < 8; ++i) { rr[i] = cr[i] + (pr - cr[i]) * mr; kn[i] = ck[i] + (pk - ck[i]) * mk; vv[i] = cv[i] + (pv - cv[i]) * mv; pr = cr[i]; pk = ck[i]; pv = cv[i]; }
        }
        RW_FENCE();
        if (sec_ & 2) {
            const float* WLp = (const float*)(L + RL_WLF); const float* ALp = (const float*)(L + RL_ALF); const float* G = (const float*)(L + RL_GF); float* TOT = (float*)(L + RL_TOT);
            const float w0c = A.in(4)[l * 384 + hc], a0c = A.in(6)[l * 384 + hc], kkc = A.in(9)[l * 384 + hc], kac = A.in(10)[l * 384 + hc], rkc = A.in(11)[l * 384 + hc];
            const float lnw = A.in(12)[l * 384 + hc], lnb = A.in(13)[l * 384 + hc];
            bf16* EM = (bf16*)(F.ws + WS_REM) + (size_t)item * 4096;
            float run = 0.f;
#pragma unroll
            for (int i = 0; i < 8; ++i) { const int t = 8 * w + i; const int o = t * 64 + lane;
                const float x = -(w0c + WLp[o]); const float sp = (x > 20.f) ? x : __logf(1.0f + __expf(x)); const float wv = -sp - 0.5f;
                run += -__expf(wv); lp[i] = run;
                const float av = sigm(a0c + ALp[o]); const float gv = G[o];
                float kq = kn[i] * kkc; const float nrm = __builtin_amdgcn_sqrtf(wave_sum(kq * kq)); kq = kq * __builtin_amdgcn_rcpf(fmaxf(nrm, 1e-12f));
                const float knew = kn[i] * (1.0f + (av - 1.0f) * kac);
                const float bon = wave_sum(rr[i] * knew * rkc);
                kk[i] = kq; bb[i] = kq * av; kn[i] = knew;
                if (wr_) EM[o] = (bf16)f2bf(lnw * gv); eadd[i] = (lnb + bon * vv[i]) * gv; }
            TOT[w * 64 + lane] = run;
        }
        RW_FENCE();
        if (sec_ & 8) {
            const float* TOT = (const float*)(L + RL_TOT);
            float off = 0.f, cl = 0.f;
#pragma unroll
            for (int q = 0; q < 8; ++q) { const float tq = TOT[q * 64 + lane]; cl += tq; if (q < w) off += tq; }
            if (w == 7 && wr_) ((float*)(F.ws + WS_RGL))[(size_t)item * 64 + lane] = __expf(cl);
            bf16* At = (bf16*)(L + RL_A), *Bt = (bf16*)(L + RL_B), *Kt = (bf16*)(L + RL_K), *Rt = (bf16*)(L + RL_R), *Vt = (bf16*)(L + RL_V), *BHt = (bf16*)(L + RL_BH), *KHt = (bf16*)(L + RL_KH);
            float cp = off;
#pragma unroll
            for (int i = 0; i < 8; ++i) { const int o = (8 * w + i) * TS + lane;
                const float ct = off + lp[i];
                const float ep = __expf(cp), et = __expf(ct), ei = __expf(-ct), eh = __expf(cl - ct);
                At[o] = (bf16)f2bf(-kk[i] * ep); Rt[o] = (bf16)f2bf(rr[i] * et);
                Bt[o] = (bf16)f2bf(bb[i] * ei); Kt[o] = (bf16)f2bf(kn[i] * ei);
                Vt[o] = (bf16)f2bf(vv[i]); BHt[o] = (bf16)f2bf(bb[i] * eh); KHt[o] = (bf16)f2bf(kn[i] * eh);
                cp = ct; }
        }
        RW_FENCE();
        if (sec_ & 16) {
#pragma unroll
        for (int rep = 0; rep < 2; ++rep) { const int job = w + 8 * rep, prod = job >> 2, tt = (job >> 1) & 1, st = job & 1;
            f32x16 acc = {};
            acc = mmx<false, false>(acc, L + ((prod & 1) ? RL_K : RL_B), 32 * st, L + ((prod & 2) ? RL_R : RL_A), 32 * tt, 0, 4, lane);
            const int t = 32 * tt + r32; const int incl = prod >> 1;
#pragma unroll
            for (int g = 0; g < 16; ++g) { const int s = 32 * st + crow16(g, hh); if (!(s < t + incl)) acc[g] = 0.f; }
            if (prod == 0) { float* AF = (float*)(L + RL_AABF);
#pragma unroll
                for (int g4 = 0; g4 < 4; ++g4) *(f32x4*)(AF + t * 64 + 32 * st + 8 * g4 + 4 * hh) = (f32x4){acc[4 * g4], acc[4 * g4 + 1], acc[4 * g4 + 2], acc[4 * g4 + 3]};
            } else st_tileT(L + (prod == 1 ? RL_AK : (prod == 2 ? RL_RB : RL_RK)), t, 32 * st, acc, hh);
        } }
        RW_FENCE();
        if (sec_ & 32) {
            const float* AF = (const float*)(L + RL_AABF); bf16* Dt = (bf16*)(L + RL_D); bf16* LPt = (bf16*)(L + RL_LP);
            if (w == 0) {
                const int I = lane >> 4, jc = lane & 15; float x[16];
#pragma unroll
                for (int r = 0; r < 16; ++r) { float s = (r == jc) ? 1.f : 0.f;
#pragma unroll
                    for (int q = 0; q < 16; ++q) if (q < r) s += AF[(16 * I + r) * 64 + 16 * I + q] * x[q];
                    x[r] = s; Dt[(16 * I + r) * TS + 16 * I + jc] = (bf16)f2bf(s); }
            } else if (w < 4) {
                for (int o = tid - 64; o < 4096; o += 192) { const int t = o >> 6, s = o & 63; const bool offd = (t >> 4) != (s >> 4);
                    LPt[t * TS + s] = ((t >> 4) > (s >> 4)) ? (bf16)f2bf(AF[o]) : (bf16)0; if (offd) Dt[t * TS + s] = (bf16)0; }
            } else { const int tl = w - 4, it = tl >> 1, tt = tl & 1;
                f32x16 acc = {};
                acc = mmx<true, false>(acc, L + RL_V, 32 * it, L + RL_AK, 32 * tt, 0, tt ? 4 : 2, lane);
                st_tileT(L + RL_X, 32 * tt + r32, 32 * it, acc, hh); }
        }
        RW_FENCE();
        if (sec_ & 32) {
#pragma unroll 1
            for (int stg = 0; stg < 4; ++stg) {
                const int pt = (stg == 0) ? RL_LP : (stg == 1 ? RL_M : (stg == 2 ? RL_M2 : RL_D));
                const int qt = (stg == 0) ? RL_D : (stg == 3 ? RL_S : RL_M);
                const int dt = (stg == 0) ? RL_M : (stg == 1 ? RL_M2 : (stg == 2 ? RL_S : RL_T));
                if (w < 3) { const int st = (w == 2) ? 1 : 0, tt = (w == 0) ? 0 : 1;
                    f32x16 acc = {};
                    acc = mmx<true, false>(acc, L + pt, 32 * st, L + qt, 32 * tt, 2 * st, 2 * tt + 2, lane);
                    const int t = 32 * tt + r32;
                    if (stg == 2) {
                        const bf16* Mt = (const bf16*)(L + RL_M); const bf16* M2t = (const bf16*)(L + RL_M2);
#pragma unroll
                        for (int g4 = 0; g4 < 4; ++g4) { const int s0 = 32 * st + 8 * g4 + 4 * hh; const v2u mv = *(const v2u*)(Mt + t * TS + s0), m2v = *(const v2u*)(M2t + t * TS + s0);
                            const bool lowt = (tt > st);
                            acc[4 * g4 + 0] += bflo(mv.x) + bflo(m2v.x) + ((s0 + 0 == t) ? 1.f : 0.f); acc[4 * g4 + 1] += bfhi(mv.x) + bfhi(m2v.x) + ((s0 + 1 == t) ? 1.f : 0.f);
                            acc[4 * g4 + 2] += bflo(mv.y) + bflo(m2v.y) + ((s0 + 2 == t) ? 1.f : 0.f); acc[4 * g4 + 3] += bfhi(mv.y) + bfhi(m2v.y) + ((s0 + 3 == t) ? 1.f : 0.f); (void)lowt; }
                    }
                    st_tileT(L + dt, t, 32 * st, acc, hh); }
                RW_FENCE();
            }
        }
        if (sec_ & 64) { const int mat = w >> 2, tl = w & 3, nt = tl >> 1, tt = tl & 1;
          f32x16 acc = {};
          acc = mmx<true, false>(acc, L + (mat ? RL_X : RL_A), 32 * nt, L + RL_T, 32 * tt, 0, tt ? 4 : 2, lane);
          st_tileT(L + (mat ? RL_U : RL_W), 32 * tt + r32, 32 * nt, acc, hh); }
        RW_FENCE();
        if (sec_ & 128) { const int tl = w & 3, ta = tl >> 1, tb2 = tl & 1;
          if (w < 4) {
              f32x16 acc = {};
              acc = mmx<true, true>(acc, L + RL_W, 32 * ta, L + RL_BH, 32 * tb2, 0, 4, lane);
              bf16* MC = (bf16*)(F.ws + WS_RMC) + (size_t)item * 4096;
#pragma unroll
              for (int g4 = 0; g4 < 4; ++g4) { v2u wv; wv.x = cvtpk(acc[4 * g4], acc[4 * g4 + 1]); wv.y = cvtpk(acc[4 * g4 + 2], acc[4 * g4 + 3]); if (wr_) *(v2u*)(MC + (32 * tb2 + r32) * 64 + 32 * ta + 8 * g4 + 4 * hh) = wv; }
              f32x16 an = {};
              an = mmx<true, true>(an, L + RL_BH, 32 * ta, L + RL_U, 32 * tb2, 0, 4, lane);
              an = mmx<true, true>(an, L + RL_KH, 32 * ta, L + RL_V, 32 * tb2, 0, 4, lane);
              bf16* NT = (bf16*)(F.ws + WS_RNT) + (size_t)item * 4096;
#pragma unroll
              for (int g4 = 0; g4 < 4; ++g4) { v2u wv; wv.x = cvtpk(an[4 * g4], an[4 * g4 + 1]); wv.y = cvtpk(an[4 * g4 + 2], an[4 * g4 + 3]); if (wr_) *(v2u*)(NT + (32 * tb2 + r32) * 64 + 32 * ta + 8 * g4 + 4 * hh) = wv; }
          } else {
              f32x16 acc = {};
              acc = mmx<true, false>(acc, L + RL_W, 32 * ta, L + RL_RB, 32 * tb2, 0, tb2 ? 4 : 2, lane);
              const int t = 32 * tb2 + r32; const bf16* Rt = (const bf16*)(L + RL_R);
              bf16* qd = PS + (row0 + t) * PSW + C_RW + h * 64;
#pragma unroll
              for (int g4 = 0; g4 < 4; ++g4) { const int c0 = 32 * ta + 8 * g4 + 4 * hh; const v2u rv = *(const v2u*)(Rt + t * TS + c0);
                  v2u wv; wv.x = cvtpk(acc[4 * g4] + bflo(rv.x), acc[4 * g4 + 1] + bfhi(rv.x)); wv.y = cvtpk(acc[4 * g4 + 2] + bflo(rv.y), acc[4 * g4 + 3] + bfhi(rv.y)); if (wr_) *(v2u*)(qd + c0) = wv; }
              f32x16 ay = {};
              ay = mmx<true, false>(ay, L + RL_U, 32 * ta, L + RL_RB, 32 * tb2, 0, tb2 ? 4 : 2, lane);
              ay = mmx<true, false>(ay, L + RL_V, 32 * ta, L + RL_RK, 32 * tb2, 0, tb2 ? 4 : 2, lane);
              bf16* yd = PS + (row0 + t) * PSW + C_RW + 384 + h * 64;
#pragma unroll
              for (int g4 = 0; g4 < 4; ++g4) { v2u wv; wv.x = cvtpk(ay[4 * g4], ay[4 * g4 + 1]); wv.y = cvtpk(ay[4 * g4 + 2], ay[4 * g4 + 3]); if (wr_) *(v2u*)(yd + 32 * ta + 8 * g4 + 4 * hh) = wv; }
          }
#pragma unroll
          for (int i = 0; i < 8; ++i) { if (wr_) PS[(row0 + 8 * w + i) * PSW + C_RW + 768 + hc] = (bf16)f2bf(eadd[i]); }
        }
        RW_FENCE();
    }
#undef RW_FENCE
}

constexpr int RW_PF = 4;
constexpr size_t WS_RHS = WS_XN;
struct ScanOps { bf16x8_t mf[4]; f32x4 gl[4]; v2u nv[4]; };
__device__ __forceinline__ void scan_load(ScanOps& o, const unsigned char* ws, int item, int ta, int tb2, int r32, int hh) {
    const bf16* MC = (const bf16*)(ws + WS_RMC) + (size_t)item * 4096; const bf16* NT = (const bf16*)(ws + WS_RNT) + (size_t)item * 4096; const float* GL = (const float*)(ws + WS_RGL) + (size_t)item * 64;
#pragma unroll
    for (int s = 0; s < 4; ++s) o.mf[s] = *(const bf16x8_t*)(MC + (32 * ta + r32) * 64 + 16 * s + 8 * hh);
#pragma unroll
    for (int g4 = 0; g4 < 4; ++g4) { const int c0 = 32 * ta + 8 * g4 + 4 * hh; o.gl[g4] = *(const f32x4*)(GL + c0); o.nv[g4] = *(const v2u*)(NT + (32 * tb2 + r32) * 64 + c0); }
}
__device__ __forceinline__ void rwkv_scan(const KA& A, const Ctx& F, int l, int b, int h) {
    unsigned char* L = F.lds;
    const int tid = F.tid, lane = F.lane, w = F.wave, r32 = lane & 31, hh = lane >> 5;
    for (int o = tid; o < 2 * 9216 / 4; o += NTHREADS) ((unsigned*)L)[o] = 0u;
    __syncthreads();
    const bool act = w < 4;
    const int ta = (w >> 1) & 1, tb2 = w & 1;
    const int item0 = (b * 6 + h) * 64;
    bf16* HS = (bf16*)(F.ws + WS_RHS) + (size_t)item0 * 4096;
    f32x16 Hacc = {};
    ScanOps ops[RW_PF];
#pragma unroll
    for (int p = 0; p < RW_PF; ++p) if (act) scan_load(ops[p], F.ws, item0 + p, ta, tb2, r32, hh);
#pragma unroll 1
    for (int j0 = 0; j0 < 64; j0 += RW_PF) {
#pragma unroll
        for (int p = 0; p < RW_PF; ++p) { const int j = j0 + p;
            const unsigned char* HBc = L + (p & 1) * 9216; unsigned char* HBn = L + ((p + 1) & 1) * 9216;
            if (act) {
            if (!(F.dry && (DRY_SEL & 2))) {
#pragma unroll
                for (int g4 = 0; g4 < 4; ++g4) { v2u wv; wv.x = cvtpk(Hacc[4 * g4], Hacc[4 * g4 + 1]); wv.y = cvtpk(Hacc[4 * g4 + 2], Hacc[4 * g4 + 3]); *(v2u*)(HS + (size_t)j * 4096 + (32 * tb2 + r32) * 64 + 32 * ta + 8 * g4 + 4 * hh) = wv; } }
            const ScanOps cur = ops[p];
            if (j + RW_PF < 64) scan_load(ops[p], F.ws, item0 + j + RW_PF, ta, tb2, r32, hh);
#pragma unroll
            for (int g4 = 0; g4 < 4; ++g4) { Hacc[4 * g4 + 0] = Hacc[4 * g4 + 0] * cur.gl[g4][0] + bflo(cur.nv[g4].x); Hacc[4 * g4 + 1] = Hacc[4 * g4 + 1] * cur.gl[g4][1] + bfhi(cur.nv[g4].x);
                Hacc[4 * g4 + 2] = Hacc[4 * g4 + 2] * cur.gl[g4][2] + bflo(cur.nv[g4].y); Hacc[4 * g4 + 3] = Hacc[4 * g4 + 3] * cur.gl[g4][3] + bfhi(cur.nv[g4].y); }
#pragma unroll
            for (int s = 0; s < 4; ++s) Hacc = __builtin_amdgcn_mfma_f32_32x32x16_bf16(cur.mf[s], ldfrag(HBc, 32 * tb2 + r32, s, hh), Hacc, 0, 0, 0);
            st_tileT(HBn, 32 * tb2 + r32, 32 * ta, Hacc, hh);
            }
            asm volatile("s_waitcnt lgkmcnt(0)" ::: "memory");
            __builtin_amdgcn_s_barrier();
            asm volatile("" ::: "memory");
        }
    }
}

__device__ __forceinline__ void rwkv_p3(const KA& A, const Ctx& F) {
    bf16* PS = (bf16*)(F.ws + WS_PS);
    const int lane = F.lane, w = F.wave, r32 = lane & 31, hh = lane >> 5, tb2 = w & 1;
#pragma unroll 1
    for (int it4 = F.bid; it4 < RW_ITEMS / 4; it4 += F.G) {
        const int item = it4 * 4 + (w >> 1); const int j = item & 63, h = (item >> 6) % 6, b = item / 384;
        const size_t row0 = (size_t)b * SEQ + 64 * j;
        const int t = 32 * tb2 + r32;
        const bf16* qd = PS + (row0 + t) * PSW + C_RW + h * 64; const bf16* yd = qd + 384; const bf16* ed = qd + 768; const bf16* EM = (const bf16*)(F.ws + WS_REM) + (size_t)item * 4096 + t * 64;
        const bf16* HS = (const bf16*)(F.ws + WS_RHS) + (size_t)item * 4096;
        bf16x8_t qf[4], hf[2][4];
#pragma unroll
        for (int s = 0; s < 4; ++s) { qf[s] = *(const bf16x8_t*)(qd + 16 * s + 8 * hh); hf[0][s] = *(const bf16x8_t*)(HS + r32 * 64 + 16 * s + 8 * hh); hf[1][s] = *(const bf16x8_t*)(HS + (32 + r32) * 64 + 16 * s + 8 * hh); }
        f32x16 y[2]; v2u em[2][4], ea[2][4];
#pragma unroll
        for (int it = 0; it < 2; ++it)
#pragma unroll
            for (int g4 = 0; g4 < 4; ++g4) { const int i0 = 32 * it + 8 * g4 + 4 * hh; const v2u yv = *(const v2u*)(yd + i0); em[it][g4] = *(const v2u*)(EM + i0); ea[it][g4] = *(const v2u*)(ed + i0);
                y[it][4 * g4] = bflo(yv.x); y[it][4 * g4 + 1] = bfhi(yv.x); y[it][4 * g4 + 2] = bflo(yv.y); y[it][4 * g4 + 3] = bfhi(yv.y); }
#pragma unroll
        for (int it = 0; it < 2; ++it)
#pragma unroll
            for (int s = 0; s < 4; ++s) y[it] = __builtin_amdgcn_mfma_f32_32x32x16_bf16(hf[it][s], qf[s], y[it], 0, 0, 0);
        float s1 = 0.f, s2 = 0.f;
#pragma unroll
        for (int it = 0; it < 2; ++it)
#pragma unroll
            for (int g = 0; g < 16; ++g) { s1 += y[it][g]; s2 += y[it][g] * y[it][g]; }
        s1 = xsum32(s1); s2 = xsum32(s2);
        const float mu = s1 * (1.0f / 64.0f); const float var = fmaxf(s2 * (1.0f / 64.0f) - mu * mu, 0.f); const float rs = 1.0f / sqrtf(var + GN_EPS);
        bf16* od = PS + (row0 + t) * PSW + C_RW + h * 64;
#pragma unroll
        for (int it = 0; it < 2; ++it)
#pragma unroll
            for (int g4 = 0; g4 < 4; ++g4) { const int i0 = 32 * it + 8 * g4 + 4 * hh; const v2u emv = em[it][g4], eav = ea[it][g4];
                v2u wv; wv.x = cvtpk((y[it][4 * g4] - mu) * rs * bflo(emv.x) + bflo(eav.x), (y[it][4 * g4 + 1] - mu) * rs * bfhi(emv.x) + bfhi(eav.x));
                wv.y = cvtpk((y[it][4 * g4 + 2] - mu) * rs * bflo(emv.y) + bflo(eav.y), (y[it][4 * g4 + 3] - mu) * rs * bfhi(emv.y) + bfhi(eav.y));
                if (!(F.dry && (DRY_SEL & 4))) *(v2u*)(od + i0) = wv; }
    }
}
constexpr size_t SSG_TM = 0, SSG_GM = 131072, SSG_HM = 196608, SSG_LAM = 262144, SSG_BYTES = 263168;
constexpr size_t WS_SSM = WS_RGL + 1 * MiB;
static_assert(WS_SSM + 32 * SSG_BYTES <= 512 * MiB, "ssm matrices fit the workspace");
constexpr int ZS = 132;

__device__ __forceinline__ void ssm_prep(const KA& A, const Ctx& F, int l, int g) {
    float* L = (float*)F.lds;
    float* PWr = L, *PWi = L + 17 * 64, *BBr = L + 2 * 17 * 64, *BBi = BBr + 1024, *CCr = BBi + 1024, *CCi = CCr + 1024, *KE = CCi + 1024;
    unsigned char* base = F.ws + WS_SSM + (size_t)(l * 16 + g) * SSG_BYTES;
    const int tid = F.tid;
    __syncthreads();
    if (tid < 64) { const int p = tid;
        const float step = __expf(A.in(16)[l * 16 + g]);
        const float lr = A.in(14)[(size_t)l * 1024 + g * 64 + p], li = A.in(15)[(size_t)l * 1024 + g * 64 + p];
        const float ang = li * step;
        for (int m = 0; m <= 16; ++m) { const float sn = __sinf(ang * (float)m), cs = __cosf(ang * (float)m); const float mg = __expf(lr * step * (float)m); PWr[m * 64 + p] = mg * cs; PWi[m * 64 + p] = mg * sn; }
        const float are = PWr[64 + p], aim = PWi[64 + p];
        const float inv = 1.0f / (lr * lr + li * li);
        const float fre = ((are - 1.0f) * lr + aim * li) * inv, fim = (aim * lr - (are - 1.0f) * li) * inv;
        const float* br = A.in(17) + (size_t)l * 16384 + (size_t)(g * 64 + p) * 16, *bi = A.in(18) + (size_t)l * 16384 + (size_t)(g * 64 + p) * 16;
        for (int c = 0; c < 16; ++c) { BBr[p * 16 + c] = fre * br[c] - fim * bi[c]; BBi[p * 16 + c] = fre * bi[c] + fim * br[c]; }
        float* lam = (float*)(base + SSG_LAM); lam[p] = PWr[16 * 64 + p]; lam[64 + p] = PWi[16 * 64 + p];
    }
    for (int e = tid; e < 1024; e += NTHREADS) { CCr[e] = A.in(19)[(size_t)l * 16384 + g * 1024 + e]; CCi[e] = A.in(20)[(size_t)l * 16384 + g * 1024 + e]; }
    __syncthreads();
    for (int e = tid; e < 4096; e += NTHREADS) { const int tau = e >> 8, c = (e >> 4) & 15, cp = e & 15; float s = 0.f;
        for (int p = 0; p < 64; ++p) { const float wr = CCr[c * 64 + p] * PWr[tau * 64 + p] - CCi[c * 64 + p] * PWi[tau * 64 + p], wi = CCr[c * 64 + p] * PWi[tau * 64 + p] + CCi[c * 64 + p] * PWr[tau * 64 + p];
            s += wr * BBr[p * 16 + cp] - wi * BBi[p * 16 + cp]; }
        KE[e] = s; }
    __syncthreads();
    const float* dsk = A.in(21) + l * 256 + g * 16;
    bf16* TM = (bf16*)(base + SSG_TM); bf16* GM = (bf16*)(base + SSG_GM); bf16* HM = (bf16*)(base + SSG_HM);
    for (int e = tid; e < 65536; e += NTHREADS) { const int n = e >> 8, k = e & 255, tp = n >> 4, c = n & 15, sp = k >> 4, cp = k & 15;
        float v = (sp <= tp) ? KE[((tp - sp) << 8) + (c << 4) + cp] : 0.f; if (sp == tp && c == cp) v += dsk[c];
        TM[e] = (bf16)f2bf(v); }
    for (int e = tid; e < 32768; e += NTHREADS) { const int n = e >> 8, k = e & 255, p = n & 63, im = n >> 6, sp = k >> 4, cp = k & 15, m = 15 - sp;
        const float wr = PWr[m * 64 + p] * BBr[p * 16 + cp] - PWi[m * 64 + p] * BBi[p * 16 + cp], wi = PWr[m * 64 + p] * BBi[p * 16 + cp] + PWi[m * 64 + p] * BBr[p * 16 + cp];
        GM[e] = (bf16)f2bf(im ? wi : wr); }
    for (int e = tid; e < 32768; e += NTHREADS) { const int n = e >> 7, k = e & 127, tp = n >> 4, c = n & 15, p = k & 63, im = k >> 6, m = tp + 1;
        const float wr = CCr[c * 64 + p] * PWr[m * 64 + p] - CCi[c * 64 + p] * PWi[m * 64 + p], wi = CCr[c * 64 + p] * PWi[m * 64 + p] + CCi[c * 64 + p] * PWr[m * 64 + p];
        HM[e] = (bf16)f2bf(im ? -wi : wr); }
    __syncthreads();
}

__device__ __forceinline__ void ssm_v2(const KA& A, const Ctx& F, int l, int b, int g) {
    bf16* PS = (bf16*)(F.ws + WS_PS);
    float* ZF = (float*)F.lds;
    const unsigned char* base = F.ws + WS_SSM + (size_t)(l * 16 + g) * SSG_BYTES;
    const bf16* TM = (const bf16*)(base + SSG_TM); const bf16* GM = (const bf16*)(base + SSG_GM); const bf16* HM = (const bf16*)(base + SSG_HM); const float* lam = (const float*)(base + SSG_LAM);
    const int lane = F.lane, w = F.wave, r32 = lane & 31, hh = lane >> 5;
    const size_t tok0 = (size_t)b * SEQ + 512 * w;
    bf16x8_t uf[16];
    { const bf16* up = PS + (tok0 + 16 * r32) * PSW + C_SSM + 16 * g + 8 * hh;
#pragma unroll
      for (int s = 0; s < 16; ++s) uf[s] = *(const bf16x8_t*)(up + (size_t)s * PSW); }
#pragma unroll 1
    for (int nt = 0; nt < 4; ++nt) {
        f32x16 acc = {};
        const bf16* gp = GM + (size_t)(32 * nt + r32) * 256 + 8 * hh;
#pragma unroll
        for (int s = 0; s < 16; ++s) acc = __builtin_amdgcn_mfma_f32_32x32x16_bf16(uf[s], *(const bf16x8_t*)(gp + 16 * s), acc, 0, 0, 0);
#pragma unroll
        for (int q = 0; q < 16; ++q) ZF[(32 * w + crow16(q, hh)) * ZS + 32 * nt + r32] = acc[q];
    }
    __syncthreads();
    if (w == 0) { const float lr = lam[lane], li = lam[64 + lane]; float xr = 0.f, xi = 0.f;
#pragma unroll 8
        for (int j = 0; j < 256; ++j) { const float zr = ZF[j * ZS + lane], zi = ZF[j * ZS + 64 + lane];
            ZF[j * ZS + lane] = xr; ZF[j * ZS + 64 + lane] = xi;
            const float nr = lr * xr - li * xi + zr, ni = lr * xi + li * xr + zi; xr = nr; xi = ni; } }
    __syncthreads();
    bf16x8_t xf[8];
    { const float* zp = ZF + (32 * w + r32) * ZS + 8 * hh;
#pragma unroll
      for (int s = 0; s < 8; ++s) { const f32x4 a0 = *(const f32x4*)(zp + 16 * s), a1 = *(const f32x4*)(zp + 16 * s + 4);
          v4u pw; pw.x = cvtpk(a0[0], a0[1]); pw.y = cvtpk(a0[2], a0[3]); pw.z = cvtpk(a1[0], a1[1]); pw.w = cvtpk(a1[2], a1[3]); xf[s] = __builtin_bit_cast(bf16x8_t, pw); } }
#pragma unroll
    for (int nt = 0; nt < 8; ++nt) {
        f32x16 acc = {};
        const bf16* tp = TM + (size_t)(32 * nt + r32) * 256 + 8 * hh; const bf16* hp = HM + (size_t)(32 * nt + r32) * 128 + 8 * hh;
#pragma unroll
        for (int s = 0; s < 16; ++s) if (s <= 2 * nt + 1) acc = __builtin_amdgcn_mfma_f32_32x32x16_bf16(uf[s], *(const bf16x8_t*)(tp + 16 * s), acc, 0, 0, 0);
#pragma unroll
        for (int s = 0; s < 8; ++s) acc = __builtin_amdgcn_mfma_f32_32x32x16_bf16(xf[s], *(const bf16x8_t*)(hp + 16 * s), acc, 0, 0, 0);
        bf16* op = PS + (tok0 + 2 * nt + (r32 >> 4)) * PSW + C_SSM + 16 * g + (r32 & 15);
#pragma unroll
        for (int q = 0; q < 16; ++q) { const bf16 gv_ = (bf16)f2bf(gelu_tanh(acc[q])); if (!(F.dry && (DRY_SEL & 2))) op[(size_t)(16 * crow16(q, hh)) * PSW] = gv_; }
    }
    __syncthreads();
}
typedef GAS unsigned gu32;
#define RLX_AGENT __ATOMIC_RELAXED, __HIP_MEMORY_SCOPE_AGENT
#define XB_TMO      128
#define XB_XCNT(j)  (256  + 64 * (j))
#define XB_XSUB(j)  (1280 + 64 * (j))
#define XB_XGEN(j)  (2304 + 64 * (j))
#define XB_TOP      3328
#define XB_TOPGEN   3392
#define XCD_BAR_WORDS 3456
#define XB_SPIN_CAP (1u << 18)

__device__ __forceinline__ unsigned xb_ld(unsigned* p)              { return __hip_atomic_load(p, __ATOMIC_RELAXED, __HIP_MEMORY_SCOPE_AGENT); }
__device__ __forceinline__ unsigned xb_add(unsigned* p, unsigned v) { return __hip_atomic_fetch_add(p, v, __ATOMIC_RELAXED, __HIP_MEMORY_SCOPE_AGENT); }
__device__ __forceinline__ unsigned xb_xcc_id() { return (unsigned)__builtin_amdgcn_s_getreg((3 << 11) | 20) & 0xFu; }
#define XB_SPIN(cond, bar) do { unsigned _sp = 0; while (cond) { __builtin_amdgcn_s_sleep(1); \
    if ((++_sp & 255u) == 0u) { if (xb_ld(&(bar)[XB_TMO])) break; if (_sp > XB_SPIN_CAP) { atomicAdd(&(bar)[XB_TMO], 1u); break; } } } } while (0)

struct XcdBarrier {
    unsigned* bar; unsigned x;
    volatile LAS unsigned* st;
};

__device__ __forceinline__ XcdBarrier xcd_barrier_post(unsigned* bar, volatile LAS unsigned* st) {
    XcdBarrier b; b.bar = bar; b.x = xb_xcc_id(); b.st = st;
    if (threadIdx.x == 0) (void)xb_add(&bar[XB_XCNT(b.x)], 1u);
    return b;
}
__device__ __forceinline__ void xcd_barrier_complete(unsigned* bar, unsigned x, unsigned& nloc, unsigned& nx) {
    const unsigned G = gridDim.x * gridDim.y * gridDim.z;
    unsigned sum, cnt, mine, sp = 0u;
    for (;;) {
        sum = 0u; cnt = 0u; mine = 0u;
#pragma unroll
        for (unsigned j = 0; j < 16; ++j) { const unsigned c = xb_ld(&bar[XB_XCNT(j)]); sum += c; cnt += (c > 0u) ? 1u : 0u; mine = (j == x) ? c : mine; }
        if (sum == G) break;
        __builtin_amdgcn_s_sleep(1);
        if ((++sp & 255u) == 0u) { if (xb_ld(&bar[XB_TMO])) break; if (sp > XB_SPIN_CAP) { atomicAdd(&bar[XB_TMO], 1u); break; } }
    }
    nloc = mine > 0u ? mine : 1u; nx = cnt > 0u ? cnt : 1u;
}

__device__ __forceinline__ void xcd_barrier(const XcdBarrier& b) {
    asm volatile("s_waitcnt vmcnt(0)" ::: "memory");
    __syncthreads();
    if (threadIdx.x == 0) {
        unsigned* bar = b.bar;
        __builtin_amdgcn_s_waitcnt(0);
        unsigned nloc = b.st[0], nx = b.st[1];
        if (nloc == 0u) { xcd_barrier_complete(bar, b.x, nloc, nx); b.st[0] = nloc; b.st[1] = nx; }
        const unsigned old = xb_add(&bar[XB_XSUB(b.x)], 1u);
        const unsigned gen = old / nloc;
        if (old + 1u == (gen + 1u) * nloc) {
            __builtin_amdgcn_fence(__ATOMIC_RELEASE, "agent");
            asm volatile("s_waitcnt vmcnt(0)" ::: "memory");
            const unsigned og = xb_add(&bar[XB_TOP], 1u);
            const unsigned tg = og / nx;
            if (og + 1u == (tg + 1u) * nx) xb_add(&bar[XB_TOPGEN], 1u);
            else XB_SPIN(xb_ld(&bar[XB_TOPGEN]) == tg, bar);
            __builtin_amdgcn_fence(__ATOMIC_ACQUIRE, "agent");
            xb_add(&bar[XB_XGEN(b.x)], 1u);
            asm volatile("s_waitcnt vmcnt(0)" ::: "memory");
        } else {
            XB_SPIN(xb_ld(&bar[XB_XGEN(b.x)]) == gen, bar);
            __builtin_amdgcn_fence(__ATOMIC_ACQUIRE, "agent");
            asm volatile("s_waitcnt vmcnt(0)" ::: "memory");
        }
    }
    __syncthreads();
}

constexpr int PPL = 10, NPH = 2 + DEPTH * PPL;

__device__ __forceinline__ void run_phase(const KA& A, const Ctx& F, int ph) {
    PG8_LAS unsigned char* lds3 = (PG8_LAS unsigned char*)F.lds;
    bf16* XN = (bf16*)(F.ws + WS_XN); bf16* PS = (bf16*)(F.ws + WS_PS); bf16* SO = (bf16*)(F.ws + WS_SO);
    const int l = (ph - 1) / PPL, k = (ph == 0) ? 20 : (ph == NPH - 1 ? 21 : (ph - 1) % PPL);
    unsigned char* wl = F.ws + WS_W + (size_t)l * W_LAYER;
    const float* hin = (l == 0) ? A.in(0) : F.out;
    int ngemm = 0;
    if (k == 20) { phase_prep(A, F); for (int it = F.bid; it < 32; it += F.G) ssm_prep(A, F, it >> 4, it & 15); }
    else if (k == 21) phase_rmsnorm<true>(A, F, F.out, A.in(31), F.out);
    else if (k == 0) phase_rmsnorm<false>(A, F, hin, A.in(1) + l * D, XN);
    else if (k == 7) phase_rmsnorm<false>(A, F, F.out, A.in(28) + l * D, XN);
    else if (k == 2) rwkv_p1(A, F, l);
    else if (k == 3) {
        if (F.bid < 48) rwkv_scan(A, F, l, F.bid / 6, F.bid % 6);
        else if (F.bid < 176) { const int it = F.bid - 48; ssm_v2(A, F, l, it / 16, it % 16); }
        __syncthreads();
        attn_v2(A, F, l);
    }
    else if (k == 4) { rwkv_p3(A, F); attn_finalize(A, F); ngemm = 1; }
    else if (k == 5) ngemm = 3;
    else ngemm = 1;
#pragma unroll 1
    for (int gi = 0; gi < ngemm; ++gi) {
        pg8::Gemm g; pg8::EpiAny E; E.kind = 0; E.gi = gi; E.ws = F.ws; E.base = hin; E.out = F.out;
        if (k == 1) { g = pg8::Gemm{XN, (const bf16*)(wl + WO_IN), NIN, D, D}; E.kind = 0; }
        else if (k == 4) { g = pg8::Gemm{PS + C_SSM, (const bf16*)(wl + WO_GLU), 512, 256, PSW}; E.kind = 4; }
        else if (k == 5) { E.kind = 1;
            if (gi == 0) g = pg8::Gemm{PS + C_Q, (const bf16*)(wl + WO_BA), D, 384, PSW};
            else if (gi == 1) g = pg8::Gemm{PS + C_RW, (const bf16*)(wl + WO_BR), D, 384, PSW};
            else g = pg8::Gemm{SO, (const bf16*)(wl + WO_BS), D, 256, 256}; }
        else if (k == 6) { g = pg8::Gemm{XN, (const bf16*)(wl + WO_OUT), D, D, D}; E.kind = 2; }
        else if (k == 8) { g = pg8::Gemm{XN, (const bf16*)(wl + WO_GU), 2 * FFH, D, D}; E.kind = 3; }
        else { g = pg8::Gemm{PS, (const bf16*)(wl + WO_DN), D, FFH, FFH}; E.kind = 2; E.base = F.out; }
        pg8::StaticOrder S; S.init(g.N, F.G, F.bid);
        pg8::gemm_phase<pg8::EpiAny, pg8::StaticOrder, true>(lds3, g, S, E);
    }
}

static_assert(pg8::EP_XN == WS_XN && pg8::EP_PS == WS_PS && pg8::EP_GT == WS_GT && pg8::EP_SO == WS_SO && pg8::EP_BR == WS_BR, "epilogue workspace offsets");

__global__ void __launch_bounds__(NTHREADS, 2) mega_fwd(Args args) {
    extern __shared__ __attribute__((aligned(16))) unsigned char lds[];
#if ONE_LAUNCH
    volatile LAS unsigned* misc = (volatile LAS unsigned*)((LAS unsigned char*)lds + MISC_OFF);
    if (threadIdx.x < 32) misc[threadIdx.x] = 0u;
    __syncthreads();
    XcdBarrier bar = xcd_barrier_post((unsigned*)(args.ws + WS_CTL) + CW_BAR, misc + 8);
#endif
#pragma unroll 1
    for (int ph = args.ph_lo; ph < args.ph_hi; ++ph) {
        int nrep_ = 1;
#ifdef REP_MASK
        { const int kk_ = (ph == 0 || ph == NPH - 1) ? 99 : (ph - 1) % PPL; const int ll_ = (ph - 1) / PPL;
          if ((kk_ < 16) && ((REP_MASK >> kk_) & 1) && !(kk_ == 6 && ll_ == 1)) nrep_ = 2;
          if (ph == 0 && ((REP_MASK >> 15) & 1)) nrep_ = 2; }
#endif
#pragma unroll 1
        for (int rp_ = 0; rp_ < nrep_; ++rp_) {
            KA A; A.p = (kptr_t)__builtin_amdgcn_kernarg_segment_ptr(); asm volatile("" : "+s"(A.p));
            int tid = threadIdx.x, bid = blockIdx.x, G = gridDim.x; asm volatile("" : "+v"(tid), "+s"(bid), "+s"(G));
            Ctx F;
            F.lds = lds; F.ws = A.ws(); F.out = A.out();
            F.tid = tid; F.lane = tid & 63; F.wave = __builtin_amdgcn_readfirstlane(tid >> 6); F.G = G; F.bid = bid; F.dry = (nrep_ == 2 && rp_ == 0) ? 1 : 0;
            run_phase(A, F, ph);
            __syncthreads();
        }
#if ONE_LAUNCH
        if (ph + 1 < args.ph_hi) {
#ifdef EXTRA_SYNCS
            for (int e_ = 0; e_ < EXTRA_SYNCS; ++e_) { XcdBarrier b2 = bar; asm volatile("" : "+s"(b2.bar)); xcd_barrier(b2); }
#endif
            if (ph == 0) { __threadfence(); cg::this_grid().sync(); }
            else { XcdBarrier b2 = bar; asm volatile("" : "+s"(b2.bar)); xcd_barrier(b2); } }
#endif
    }
}

extern "C" void kernel_launch(void* const* d_in, const int* in_sizes, int n_in, void* d_out, int out_size, void* d_ws, size_t ws_size, hipStream_t stream) {
    static int grid = 0;
    if (grid == 0) {
        if (n_in != 32 || in_sizes[0] != T * D || out_size != T * D || ws_size < WS_END) { fprintf(stderr, "kernel_launch: unexpected shapes (n_in %d, in0 %d, out %d, ws %zu); nothing launched\n", n_in, n_in > 0 ? in_sizes[0] : -1, out_size, ws_size); grid = -1; return; }
        int dev = 0, cus = 0, per_cu = 0;
        if (hipGetDevice(&dev) != hipSuccess || hipDeviceGetAttribute(&cus, hipDeviceAttributeMultiprocessorCount, dev) != hipSuccess) { grid = -1; return; }
        if (hipFuncSetAttribute((const void*)mega_fwd, hipFuncAttributeMaxDynamicSharedMemorySize, LDS_BYTES) != hipSuccess) { fprintf(stderr, "kernel_launch: hipFuncSetAttribute failed\n"); grid = -1; return; }
        if (hipOccupancyMaxActiveBlocksPerMultiprocessor(&per_cu, (const void*)mega_fwd, NTHREADS, LDS_BYTES) != hipSuccess || per_cu < 1) { fprintf(stderr, "kernel_launch: occupancy query says %d\n", per_cu); per_cu = 1; }
        (void)hipGetLastError();
        grid = cus;
        if (grid < 200) { fprintf(stderr, "kernel_launch: needs >= 200 CUs, got %d\n", grid); grid = -1; return; }
    }
    if (grid < 0) return;
    if (hipMemsetAsync((char*)d_ws + WS_CTL, 0, CTL_ZERO_BYTES, stream) != hipSuccess) { fprintf(stderr, "kernel_launch: hipMemsetAsync failed\n"); return; }
    Args a{};
    for (int i = 0; i < 32; ++i) a.in[i] = (const float*)d_in[i];
    a.out = (float*)d_out; a.ws = (unsigned char*)d_ws;
#if ONE_LAUNCH
    a.ph_lo = 0; a.ph_hi = NPH;
    void* kargs[] = {&a};
    hipError_t e = hipLaunchCooperativeKernel((const void*)mega_fwd, dim3(grid), dim3(NTHREADS), kargs, LDS_BYTES, stream);
    if (e != hipSuccess) fprintf(stderr, "kernel_launch: cooperative launch failed: %s (grid %d)\n", hipGetErrorString(e), grid);
#else
    for (int ph = 0; ph < NPH; ++ph) {
        a.ph_lo = ph; a.ph_hi = ph + 1;
        hipLaunchKernelGGL(mega_fwd, dim3(grid), dim3(NTHREADS), LDS_BYTES, stream, a);
    }
#endif
}
```

```cpp
#include <hip/hip_runtime.h>
#include <hip/hip_cooperative_groups.h>
#include <cstdio>
#include <cstdint>
namespace cg = cooperative_groups;
#ifndef ONE_LAUNCH
#define ONE_LAUNCH 1
#endif
namespace pg8 {
#define PG8_LAS __attribute__((address_space(3)))
typedef unsigned short bf16_t;
typedef short bf16x8 __attribute__((ext_vector_type(8)));
typedef float f32x4 __attribute__((ext_vector_type(4)));
typedef float f32x2 __attribute__((ext_vector_type(2)));
typedef unsigned u32x4 __attribute__((ext_vector_type(4)));
typedef unsigned u32x2 __attribute__((ext_vector_type(2)));
constexpr int BM = 256, BK = 64, HALF = 128, HTB = HALF * BK * 2  , STAGE_BYTES = 8 * HTB, NXCD = 8, WGM = 8;

__host__ __device__ __forceinline__ int lds_byte(int r, int c) { const int st = (r >> 4) * 2 + (c >> 5), rr = r & 15, cc = c & 31, ob = rr * 64 + cc * 2; return st * 1024 + (ob ^ (((ob >> 9) & 1) << 5)); }
__host__ __device__ __forceinline__ void stage_rc(int b, int& R, int& C) { const int st = b / 1024, sb = b % 1024, swz = sb ^ (((sb >> 9) & 1) << 5); R = (st >> 1) * 16 + swz / 64; C = (st & 1) * 32 + (swz % 64) / 2; }
__host__ __device__ __forceinline__ int perm32(int rho) { const int n = rho >> 4, i = rho & 15; return 8 * (i >> 2) + 4 * n + (i & 3); }

struct Unit { int pm, pn; };
constexpr size_t EP_XN = 68ull << 20, EP_PS = 132ull << 20, EP_GT = 308ull << 20, EP_SO = 404ull << 20, EP_BR = 421ull << 20;
struct Gemm { const bf16_t* A; const bf16_t* Bt; int N, K, lda; };

struct StaticOrder {
    static constexpr int nM = 128;
    int nN, G, c;
    __host__ __device__ void init(int N, int G_, int c_) { nN = N / BM; G = G_; c = c_; }
    __host__ __device__ bool next(int i, Unit& u) const {
        const int L = i * G + c; if (L >= nM * nN) return false;
        const int xcd = L & 7, off = L >> 3, nig = 8 * nN, hi = (off >= nig) ? 1 : 0, rem = off - hi * nig;
        u.pm = (2 * xcd + hi) * 8 + (rem & 7); u.pn = rem >> 3; return true;
    }
    __device__ __forceinline__ void a_ready(const Unit&) const {}
    __device__ __forceinline__ void done(const Unit&) const {}
};

__device__ __forceinline__ unsigned cvt_pk_bf16(float lo, float hi) { unsigned r; asm volatile("v_cvt_pk_bf16_f32 %0, %1, %2" : "=v"(r) : "v"(lo), "v"(hi)); return r; }
__device__ __forceinline__ float bf_lo(unsigned w) { return __uint_as_float(w << 16); }
__device__ __forceinline__ float bf_hi(unsigned w) { return __uint_as_float(w & 0xffff0000u); }
__device__ __forceinline__ float sigmoidf_(float x) { return __builtin_amdgcn_rcpf(1.0f + __expf(-x)); }


struct EpiAny;
__device__ __forceinline__ void epi_win(bf16_t* PS, unsigned char* GT, bf16_t* BRW, const f32x4 (&acc)[2][2][4][2], const Unit& u, int wr, int wc, int fr, int fq) {
        const int row0 = u.pm * BM + wr * 64 + fr;
        if (u.pn < 11) {
            const int col0 = u.pn * BM + wc * 32 + 8 * fq;
#pragma unroll
            for (int ai = 0; ai < 2; ++ai)
#pragma unroll
                for (int m = 0; m < 4; ++m) { bf16_t* rowp = PS + (size_t)(row0 + ai * HALF + m * 16) * 2816 + col0;
#pragma unroll
                    for (int bj = 0; bj < 2; ++bj) { const f32x4 v0 = acc[ai][bj][m][0], v1 = acc[ai][bj][m][1];
                        u32x4 w; w.x = cvt_pk_bf16(v0[0], v0[1]); w.y = cvt_pk_bf16(v0[2], v0[3]); w.z = cvt_pk_bf16(v1[0], v1[1]); w.w = cvt_pk_bf16(v1[2], v1[3]);
                        *(u32x4*)(rowp + bj * HALF) = w;
                        if (m == 3 && fr == 15) *(u32x4*)(BRW + (size_t)((row0 + ai * HALF + m * 16) >> 6) * 2816 + col0 + bj * HALF) = w; } }
        } else {
            const int col0 = (u.pn - 11) * BM + wc * 32 + 8 * fq;
#pragma unroll
            for (int ai = 0; ai < 2; ++ai)
#pragma unroll
                for (int m = 0; m < 4; ++m) { unsigned char* rowp = GT + (size_t)(row0 + ai * HALF + m * 16) * 3072 + col0;
#pragma unroll
                    for (int bj = 0; bj < 2; ++bj) { const f32x4 v0 = acc[ai][bj][m][0], v1 = acc[ai][bj][m][1];
                        unsigned q[8];
#pragma unroll
                        for (int k = 0; k < 4; ++k) { q[k] = (unsigned)(sigmoidf_(v0[k]) * 255.0f + 0.5f); q[4 + k] = (unsigned)(sigmoidf_(v1[k]) * 255.0f + 0.5f); }
                        u32x2 w; w.x = q[0] | (q[1] << 8) | (q[2] << 16) | (q[3] << 24); w.y = q[4] | (q[5] << 8) | (q[6] << 16) | (q[7] << 24);
                        *(u32x2*)(rowp + bj * HALF) = w; } }
        }
    }

__device__ __forceinline__ void epi_merge(bf16_t* MG, const unsigned char* GT, int gi, const f32x4 (&acc)[2][2][4][2], const Unit& u, int wr, int wc, int fr, int fq) {
        const int row0 = u.pm * BM + wr * 64 + fr, col0 = u.pn * BM + wc * 32 + 8 * fq;
#pragma unroll
        for (int ai = 0; ai < 2; ++ai)
#pragma unroll
            for (int m = 0; m < 4; ++m) { const size_t r = (size_t)(row0 + ai * HALF + m * 16);
#pragma unroll
                for (int bj = 0; bj < 2; ++bj) { const int c = col0 + bj * HALF;
                    const u32x2 gq = *(const u32x2*)(GT + r * 3072 + gi * 1024 + c);
                    float v[8];
#pragma unroll
                    for (int k = 0; k < 4; ++k) { v[k] = acc[ai][bj][m][0][k] * ((float)((gq.x >> (8 * k)) & 255u) * (1.0f / 255.0f)); v[4 + k] = acc[ai][bj][m][1][k] * ((float)((gq.y >> (8 * k)) & 255u) * (1.0f / 255.0f)); }
                    u32x4* dst = (u32x4*)(MG + r * 1024 + c);
                    if (gi > 0) { const u32x4 p = *dst;
                        v[0] += bf_lo(p.x); v[1] += bf_hi(p.x); v[2] += bf_lo(p.y); v[3] += bf_hi(p.y); v[4] += bf_lo(p.z); v[5] += bf_hi(p.z); v[6] += bf_lo(p.w); v[7] += bf_hi(p.w); }
                    u32x4 w; w.x = cvt_pk_bf16(v[0], v[1]); w.y = cvt_pk_bf16(v[2], v[3]); w.z = cvt_pk_bf16(v[4], v[5]); w.w = cvt_pk_bf16(v[6], v[7]);
                    *dst = w; } }
    }

__device__ __forceinline__ void epi_res(const float* base, float* out, const f32x4 (&acc)[2][2][4][2], const Unit& u, int wr, int wc, int fr, int fq) {
        const int row0 = u.pm * BM + wr * 64 + fr, col0 = u.pn * BM + wc * 32 + 4 * fq;
#pragma unroll
        for (int ai = 0; ai < 2; ++ai)
#pragma unroll
            for (int m = 0; m < 4; ++m) { const size_t off = (size_t)(row0 + ai * HALF + m * 16) * 1024 + col0;
#pragma unroll
                for (int bj = 0; bj < 2; ++bj)
#pragma unroll
                    for (int n = 0; n < 2; ++n) { const f32x4 b = *(const f32x4*)(base + off + bj * HALF + n * 16); *(f32x4*)(out + off + bj * HALF + n * 16) = b + acc[ai][bj][m][n]; } }
    }

template <int MODE> __device__ __forceinline__ void epi_pair(bf16_t* O, int ldo, const f32x4 (&acc)[2][2][4][2], const Unit& u, int wr, int wc, int fr, int fq) {
        const int row0 = u.pm * BM + wr * 64 + fr, col0 = u.pn * HALF + wc * 32 + 8 * fq;
#pragma unroll
        for (int ai = 0; ai < 2; ++ai)
#pragma unroll
            for (int m = 0; m < 4; ++m) { bf16_t* rowp = O + (size_t)(row0 + ai * HALF + m * 16) * ldo + col0;
                float v[8];
#pragma unroll
                for (int n = 0; n < 2; ++n)
#pragma unroll
                    for (int k = 0; k < 4; ++k) { const float a = acc[ai][0][m][n][k], b = acc[ai][1][m][n][k];
                        v[4 * n + k] = (MODE == 0) ? (a * sigmoidf_(a) * b) : (a * sigmoidf_(b)); }
                u32x4 w; w.x = cvt_pk_bf16(v[0], v[1]); w.y = cvt_pk_bf16(v[2], v[3]); w.z = cvt_pk_bf16(v[4], v[5]); w.w = cvt_pk_bf16(v[6], v[7]);
                *(u32x4*)rowp = w; }
    }


struct EpiAny {
    int kind;
    int gi; unsigned char* ws; const float* base; float* out;
    __device__ __forceinline__ bool perm() const { return kind != 2; }
    __device__ __forceinline__ void operator()(const f32x4 (&acc)[2][2][4][2], const Unit& u, int wr, int wc, int fr, int fq) const {
        if (kind == 0) epi_win((bf16_t*)(ws + EP_PS), ws + EP_GT, (bf16_t*)(ws + EP_BR), acc, u, wr, wc, fr, fq);
        else if (kind == 1) epi_merge((bf16_t*)(ws + EP_XN), ws + EP_GT, gi, acc, u, wr, wc, fr, fq);
        else if (kind == 2) epi_res(base, out, acc, u, wr, wc, fr, fq);
        else if (kind == 3) epi_pair<0>((bf16_t*)(ws + EP_PS), 2816, acc, u, wr, wc, fr, fq);
        else epi_pair<1>((bf16_t*)(ws + EP_SO), 256, acc, u, wr, wc, fr, fq);
    }
};

template <class Epi, class Sched, bool ALIGN_EPI = false>
__device__ __forceinline__ void gemm_phase(PG8_LAS unsigned char* lds, const Gemm g, const Sched& S, const Epi& E) {
    int tid_ = threadIdx.x; asm volatile("" : "+v"(tid_));
    const int tid = tid_, wid = __builtin_amdgcn_readfirstlane(tid >> 6), lane = tid & 63, wr = wid >> 2, wc = wid & 3, fr = lane & 15, fq = lane >> 4;
    const int K = g.K, lda = g.lda, nt = K / BK;
    unsigned voffA[2], voffB[2];
#pragma unroll
    for (int i = 0; i < 2; ++i) { int R, C; stage_rc(tid * 16 + i * 8192, R, C); const int Rb = E.perm() ? ((R & ~31) + perm32(R & 31)) : R;
        voffA[i] = (unsigned)(R * lda + C) * 2u; voffB[i] = (unsigned)(Rb * K + C) * 2u; }
    const size_t kstep = (size_t)(BK * 2);
    const size_t hstepA = (size_t)HALF * lda * 2, hstepB = (size_t)HALF * K * 2;
    const size_t tstepA = 2 * hstepA, tstepB = 2 * hstepB;
    const unsigned ldsw = (unsigned)wid * 1024u;
    const int aoff = lds_byte(wr * 64 + fr, fq * 8), boff = lds_byte(wc * 32 + fr, fq * 8);
#define PG8_SA(b, h) (((b) * 2 + (h)) * HTB)
#define PG8_SB(b, h) ((4 + (b) * 2 + (h)) * HTB)
#define PG8_STAGE(bufoff, gbase, voff) do { _Pragma("unroll") for (int _i = 0; _i < 2; ++_i) \
        __builtin_amdgcn_global_load_lds((const unsigned*)((const char*)(gbase) + (voff)[_i]), (PG8_LAS unsigned*)(lds + (bufoff) + ldsw + _i * 8192), 16, 0, 0); } while (0)
#define PG8_LDA(dst, b, h) do { _Pragma("unroll") for (int m = 0; m < 4; ++m) _Pragma("unroll") for (int k = 0; k < 2; ++k) dst[m][k] = *(const PG8_LAS bf16x8*)(lds + PG8_SA(b, h) + aoff + m * 2048 + k * 1024); } while (0)
#define PG8_LDB(dst, b, h) do { _Pragma("unroll") for (int n = 0; n < 2; ++n) _Pragma("unroll") for (int k = 0; k < 2; ++k) dst[n][k] = *(const PG8_LAS bf16x8*)(lds + PG8_SB(b, h) + boff + n * 2048 + k * 1024); } while (0)
#define PG8_MMA(ai, bj, At, Bt) do { __builtin_amdgcn_s_setprio(1); _Pragma("unroll") for (int m = 0; m < 4; ++m) _Pragma("unroll") for (int n = 0; n < 2; ++n) _Pragma("unroll") for (int k = 0; k < 2; ++k) \
        acc[ai][bj][m][n] = __builtin_amdgcn_mfma_f32_16x16x32_bf16(Bt[n][k], At[m][k], acc[ai][bj][m][n], 0, 0, 0); __builtin_amdgcn_s_setprio(0); } while (0)
#define PG8_WAIT_V(n) asm volatile("s_waitcnt vmcnt(" #n ")" ::: "memory")
#define PG8_WAIT_L(n) asm volatile("s_waitcnt lgkmcnt(" #n ")" ::: "memory")
#define PG8_BAR __builtin_amdgcn_s_barrier()
#define PG8_SCHED __builtin_amdgcn_sched_barrier(0)
    Unit cur, nxt; int ui = 0;
    if (!S.next(0, cur)) return;
    f32x4 acc[2][2][4][2];
#pragma unroll
    for (int a = 0; a < 2; ++a)
#pragma unroll
        for (int b = 0; b < 2; ++b)
#pragma unroll
            for (int m = 0; m < 4; ++m)
#pragma unroll
                for (int n = 0; n < 2; ++n) acc[a][b][m][n] = (f32x4){0.f, 0.f, 0.f, 0.f};
    bf16x8 At[4][2], B0[2][2], B1[2][2];
    const char* cA = (const char*)g.A + (size_t)cur.pm * tstepA; const char* cB = (const char*)g.Bt + (size_t)cur.pn * tstepB;
    S.a_ready(cur);
    PG8_STAGE(PG8_SB(0, 0), cB, voffB); PG8_STAGE(PG8_SB(0, 1), cB + hstepB, voffB); PG8_STAGE(PG8_SA(0, 0), cA, voffA); PG8_STAGE(PG8_SA(0, 1), cA + hstepA, voffA);
    if (wr == 1) PG8_BAR;
    PG8_WAIT_V(2); PG8_BAR;
    PG8_STAGE(PG8_SB(1, 0), cB + kstep, voffB); PG8_STAGE(PG8_SA(1, 0), cA + kstep, voffA); PG8_STAGE(PG8_SB(1, 1), cB + hstepB + kstep, voffB);
    PG8_WAIT_V(6); PG8_BAR;
    for (;;) {
        const bool has_next = S.next(ui + 1, nxt);
        const char* nA = has_next ? (const char*)g.A + (size_t)nxt.pm * tstepA : cA; const char* nB = has_next ? (const char*)g.Bt + (size_t)nxt.pn * tstepB : cB;
        for (int t = 0; t < nt; t += 2) {
            const bool last = (t == nt - 2);
            const char* a1 = cA + (size_t)(t + 1) * kstep;
            const char* a2 = last ? nA : cA + (size_t)(t + 2) * kstep; const char* b2 = last ? nB : cB + (size_t)(t + 2) * kstep;
            const char* a3 = a2 + kstep; const char* b3 = b2 + kstep;
            if (last && has_next) S.a_ready(nxt);
            PG8_LDB(B0, 0, 0); PG8_LDB(B1, 0, 1); PG8_SCHED; PG8_LDA(At, 0, 0); PG8_STAGE(PG8_SA(1, 1), a1 + hstepA, voffA);
            PG8_WAIT_V(8); PG8_WAIT_L(0); PG8_BAR; PG8_MMA(0, 0, At, B0); PG8_MMA(0, 1, At, B1); PG8_BAR; PG8_SCHED;
            PG8_LDA(At, 0, 1); PG8_STAGE(PG8_SB(0, 0), b2, voffB); PG8_STAGE(PG8_SB(0, 1), b2 + hstepB, voffB); PG8_STAGE(PG8_SA(0, 0), a2, voffA);
            PG8_WAIT_V(8); PG8_WAIT_L(0); PG8_BAR; PG8_MMA(1, 0, At, B0); PG8_MMA(1, 1, At, B1); PG8_BAR; PG8_SCHED;
            PG8_LDB(B0, 1, 0); PG8_LDB(B1, 1, 1); PG8_SCHED; PG8_LDA(At, 1, 0); PG8_STAGE(PG8_SA(0, 1), a2 + hstepA, voffA);
            PG8_WAIT_V(8); PG8_WAIT_L(0); PG8_BAR; PG8_MMA(0, 0, At, B0); PG8_MMA(0, 1, At, B1); PG8_BAR; PG8_SCHED;
            PG8_LDA(At, 1, 1); PG8_STAGE(PG8_SB(1, 0), b3, voffB); PG8_STAGE(PG8_SB(1, 1), b3 + hstepB, voffB); PG8_STAGE(PG8_SA(1, 0), a3, voffA);
            PG8_WAIT_V(8); PG8_WAIT_L(0); PG8_BAR; PG8_MMA(1, 0, At, B0); PG8_MMA(1, 1, At, B1); PG8_BAR; PG8_SCHED;
        }
        if constexpr (ALIGN_EPI) { if (wr == 0) PG8_BAR; }
        E(acc, cur, wr, wc, fr, fq); S.done(cur);
        if (!has_next) break;
#pragma unroll
        for (int a = 0; a < 2; ++a)
#pragma unroll
            for (int b = 0; b < 2; ++b)
#pragma unroll
                for (int m = 0; m < 4; ++m)
#pragma unroll
                    for (int n = 0; n < 2; ++n) acc[a][b][m][n] = (f32x4){0.f, 0.f, 0.f, 0.f};
        cur = nxt; cA = nA; cB = nB; ++ui;
        if constexpr (ALIGN_EPI) { if (wr == 1) PG8_BAR; }
    }
    PG8_WAIT_V(0);
    if constexpr (!ALIGN_EPI) { if (wr == 0) PG8_BAR; }
    PG8_BAR;
#undef PG8_SA
#undef PG8_SB
#undef PG8_STAGE
#undef PG8_LDA
#undef PG8_LDB
#undef PG8_MMA
#undef PG8_WAIT_V
#undef PG8_WAIT_L
#undef PG8_BAR
#undef PG8_SCHED
}
}
constexpr int NWAVES = 8, NTHREADS = 512;
constexpr int BATCH = 8, SEQ = 4096, T = BATCH * SEQ, D = 1024, DEPTH = 2;
constexpr int NIN = 5888, PSW = 2816, NGATE = 3072, FFH = 2816;
constexpr int C_Q = 0, C_K = 384, C_V = 768, C_RW = 1152, C_LORA = 2304, C_SSM = 2560;
constexpr float NORM_EPS = 1e-6f, GN_EPS = 64e-5f;

constexpr size_t MiB = 1u << 20;
constexpr size_t WS_CTL = 0, CTL_ZERO_BYTES = 1 * MiB;
constexpr size_t WS_W = 1 * MiB, W_LAYER = 33 * MiB;
constexpr size_t WO_IN = 0, WO_BA = 12 * MiB, WO_BR = WO_BA + 768 * 1024, WO_BS = WO_BR + 768 * 1024, WO_OUT = 14 * MiB, WO_GU = 16 * MiB, WO_DN = 27 * MiB, WO_GLU = 32 * MiB + 512 * 1024,
                 WO_W2 = WO_GLU + 256 * 1024, WO_A2 = WO_W2 + 48 * 1024, WO_G2 = WO_A2 + 48 * 1024;
constexpr size_t WS_XN = 68 * MiB;
constexpr size_t WS_PS = 132 * MiB;
constexpr size_t WS_GT = 308 * MiB;
constexpr size_t WS_SO = 404 * MiB;
constexpr size_t WS_LSE = 420 * MiB;
constexpr size_t WS_SCR = 421 * MiB;
constexpr size_t WS_BR = WS_SCR;
constexpr size_t WS_RMC = WS_SCR + 3 * MiB;
constexpr size_t WS_RNT = WS_RMC + 24 * MiB;
constexpr size_t WS_REM = WS_RNT + 24 * MiB;
constexpr size_t WS_RGL = WS_REM + 24 * MiB;
static_assert(WS_RGL + 1 * MiB <= 512 * MiB, "scratch map");
constexpr size_t WS_END = 512 * MiB;

constexpr int LDS_BYTES = 147456;
constexpr int MISC_OFF = LDS_BYTES - 128;
constexpr int CW_ATT = 1024;
constexpr int CW_BAR = 4096;

#define GAS __attribute__((address_space(1)))
#define LAS __attribute__((address_space(3)))
typedef unsigned short bf16;
typedef unsigned v4u __attribute__((ext_vector_type(4)));
typedef unsigned v2u __attribute__((ext_vector_type(2)));
typedef float f32x4 __attribute__((ext_vector_type(4)));
#define LDS_WAIT() asm volatile("s_waitcnt lgkmcnt(0)" ::: "memory")
#define VM_WAIT() asm volatile("s_waitcnt vmcnt(0)" ::: "memory")
__device__ __forceinline__ unsigned f2bf(float f) { unsigned u = __builtin_bit_cast(unsigned, f); return (u + 0x7fffu + ((u >> 16) & 1u)) >> 16; }
__device__ __forceinline__ unsigned pk2(float lo, float hi) { return f2bf(lo) | (f2bf(hi) << 16); }
__device__ __forceinline__ float bf2f(bf16 b) { return __uint_as_float((unsigned)b << 16); }
__device__ __forceinline__ float bflo(unsigned w) { return __uint_as_float(w << 16); }
__device__ __forceinline__ float bfhi(unsigned w) { return __uint_as_float(w & 0xffff0000u); }
template <int M> __device__ __forceinline__ float shx(float v) { static_assert(M < 32, "shx: xor mask inside a 32-lane half"); return __int_as_float(__builtin_amdgcn_ds_swizzle(__float_as_int(v), (M << 10) | 0x1f)); }
__device__ __forceinline__ float xsum32(float v) { auto r = __builtin_amdgcn_permlane32_swap(__float_as_uint(v), __float_as_uint(v), false, false); return __uint_as_float(r[0]) + __uint_as_float(r[1]); }
__device__ __forceinline__ float xmax32(float v) { auto r = __builtin_amdgcn_permlane32_swap(__float_as_uint(v), __float_as_uint(v), false, false); return fmaxf(__uint_as_float(r[0]), __uint_as_float(r[1])); }
template <int CTRL> __device__ __forceinline__ float dppf(float v) { return __int_as_float(__builtin_amdgcn_update_dpp(0, __float_as_int(v), CTRL, 0xf, 0xf, true)); }
__device__ __forceinline__ float wave_sum(float v) { v += dppf<0xB1>(v); v += dppf<0x4E>(v); v += dppf<0x141>(v); v += dppf<0x140>(v); v += shx<16>(v); return xsum32(v); }
__device__ __forceinline__ float sigm(float x) { return 1.0f / (1.0f + __expf(-x)); }

struct Args { const float* in[32]; float* out; unsigned char* ws; int ph_lo, ph_hi; };

typedef __attribute__((address_space(4))) const unsigned char* kptr_t;
struct KA {
    kptr_t p;
    typedef const float* cfptr_t; typedef float* fptr_t; typedef unsigned char* ucptr_t;
    __device__ __forceinline__ const float* in(int i) const { return *(const __attribute__((address_space(4))) cfptr_t*)(p + 8 * i); }
    __device__ __forceinline__ float* out() const { return *(const __attribute__((address_space(4))) fptr_t*)(p + 256); }
    __device__ __forceinline__ unsigned char* ws() const { return *(const __attribute__((address_space(4))) ucptr_t*)(p + 264); }
};
static_assert(sizeof(Args) == 280, "Args layout");

#ifndef DRY_SEL
#define DRY_SEL 0
#endif
struct Ctx {
    unsigned char* lds; unsigned char* ws; float* out;
    int tid, lane, wave, G, bid;
    int dry;
};

__device__ __forceinline__ void tr_item(const float* W, int ldw, int K, int nblk, bf16* WT, int goff, float* scr, int item, int lane) {
    const int kb = item / nblk, nb = item % nblk, k0 = 64 * kb, n0 = 32 * nb;
#pragma unroll 8
    for (int i = 0; i < 32; ++i) { const int kk = 2 * i + (lane >> 5); scr[kk * 33 + (lane & 31)] = W[(size_t)(k0 + kk) * ldw + n0 + (lane & 31)]; }
    LDS_WAIT(); asm volatile("" ::: "memory");
    const int c = lane & 7;
#pragma unroll
    for (int j = 0; j < 4; ++j) { const int n = (lane >> 3) + 8 * j; const float* s = scr + (8 * c) * 33 + n;
        v4u o; o.x = pk2(s[0 * 33], s[1 * 33]); o.y = pk2(s[2 * 33], s[3 * 33]); o.z = pk2(s[4 * 33], s[5 * 33]); o.w = pk2(s[6 * 33], s[7 * 33]);
        const int nn = n0 + n; const int drow = goff < 0 ? nn : ((nn >> 7) * 256 + goff + (nn & 127));
        *(v4u*)(WT + (size_t)drow * K + k0 + 8 * c) = o; }
    LDS_WAIT(); asm volatile("" ::: "memory");
}

__device__ __forceinline__ void phase_prep(const KA& A, const Ctx& F) {
    float* scr = (float*)(F.lds + F.wave * 16384);
    const int gw = F.bid * NWAVES + F.wave, NGW = F.G * NWAVES;
    constexpr int NM = 13;
    constexpr int cnt[NM] = {16 * 184, 6 * 32, 6 * 32, 4 * 32, 16 * 32, 16 * 88, 16 * 88, 44 * 32, 4 * 8, 4 * 8, 12, 12, 24};
    constexpr int per_layer = cnt[0] + cnt[1] + cnt[2] + cnt[3] + cnt[4] + cnt[5] + cnt[6] + cnt[7] + cnt[8] + cnt[9] + cnt[10] + cnt[11] + cnt[12];
    for (int it = gw; it < DEPTH * per_layer; it += NGW) {
        const int l = it / per_layer; int r = it % per_layer;
        unsigned char* wl = F.ws + WS_W + (size_t)l * W_LAYER;
        if (r < cnt[0]) { tr_item(A.in(2) + (size_t)l * D * NIN, NIN, D, NIN / 32, (bf16*)(wl + WO_IN), -1, scr, r, F.lane); continue; } r -= cnt[0];
        if (r < cnt[1]) { tr_item(A.in(24) + (size_t)l * 384 * D, D, 384, D / 32, (bf16*)(wl + WO_BA), -1, scr, r, F.lane); continue; } r -= cnt[1];
        if (r < cnt[2]) { tr_item(A.in(25) + (size_t)l * 384 * D, D, 384, D / 32, (bf16*)(wl + WO_BR), -1, scr, r, F.lane); continue; } r -= cnt[2];
        if (r < cnt[3]) { tr_item(A.in(26) + (size_t)l * 256 * D, D, 256, D / 32, (bf16*)(wl + WO_BS), -1, scr, r, F.lane); continue; } r -= cnt[3];
        if (r < cnt[4]) { tr_item(A.in(27) + (size_t)l * D * D, D, D, D / 32, (bf16*)(wl + WO_OUT), -1, scr, r, F.lane); continue; } r -= cnt[4];
        if (r < cnt[5]) { tr_item(A.in(29) + (size_t)l * D * 2 * FFH, 2 * FFH, D, FFH / 32, (bf16*)(wl + WO_GU), 0, scr, r, F.lane); continue; } r -= cnt[5];
        if (r < cnt[6]) { tr_item(A.in(29) + (size_t)l * D * 2 * FFH + FFH, 2 * FFH, D, FFH / 32, (bf16*)(wl + WO_GU), 128, scr, r, F.lane); continue; } r -= cnt[6];
        if (r < cnt[7]) { tr_item(A.in(30) + (size_t)l * FFH * D, D, FFH, D / 32, (bf16*)(wl + WO_DN), -1, scr, r, F.lane); continue; } r -= cnt[7];
        if (r < cnt[8]) { tr_item(A.in(22) + (size_t)l * 256 * 256, 256, 256, 8, (bf16*)(wl + WO_GLU), 0, scr, r, F.lane); continue; } r -= cnt[8];
        if (r < cnt[9]) { tr_item(A.in(23) + (size_t)l * 256 * 256, 256, 256, 8, (bf16*)(wl + WO_GLU), 128, scr, r, F.lane); continue; } r -= cnt[9];
        if (r < cnt[10]) { tr_item(A.in(5) + (size_t)l * 64 * 384, 384, 64, 12, (bf16*)(wl + WO_W2), -1, scr, r, F.lane); continue; } r -= cnt[10];
        if (r < cnt[11]) { tr_item(A.in(7) + (size_t)l * 64 * 384, 384, 64, 12, (bf16*)(wl + WO_A2), -1, scr, r, F.lane); continue; } r -= cnt[11];
        tr_item(A.in(8) + (size_t)l * 128 * 384, 384, 128, 12, (bf16*)(wl + WO_G2), -1, scr, r, F.lane);
    }
}

template <bool OUT_F32> __device__ __forceinline__ void phase_rmsnorm(const KA& A, const Ctx& F, const float* src, const float* gain, void* dst) {
    const int gw = F.bid * NWAVES + F.wave, NGW = F.G * NWAVES;
    f32x4 gv[4];
#pragma unroll
    for (int j = 0; j < 4; ++j) gv[j] = *((const f32x4*)gain + F.lane + 64 * j);
    for (int m = gw; m < T; m += NGW) {
        const f32x4* xr = (const f32x4*)(src + (size_t)m * D) + F.lane;
        f32x4 v[4]; float s = 0.f;
#pragma unroll
        for (int j = 0; j < 4; ++j) { v[j] = xr[64 * j]; s += (v[j].x * v[j].x + v[j].y * v[j].y) + (v[j].z * v[j].z + v[j].w * v[j].w); }
        const float rs = 1.0f / sqrtf(wave_sum(s) * (1.0f / D) + NORM_EPS);
        if (OUT_F32) {
            f32x4* o = (f32x4*)((float*)dst + (size_t)m * D) + F.lane;
#pragma unroll
            for (int j = 0; j < 4; ++j) o[64 * j] = v[j] * rs * gv[j];
        } else {
            v2u* o = (v2u*)((bf16*)dst + (size_t)m * D) + F.lane;
#pragma unroll
            for (int j = 0; j < 4; ++j) { const f32x4 y = v[j] * rs * gv[j]; v2u w; w.x = pk2(y.x, y.y); w.y = pk2(y.z, y.w); o[64 * j] = w; }
        }
    }
}
__device__ __forceinline__ void attn_v1(const KA& A, const Ctx& F, int blk, int nblk) {
    bf16* PS = (bf16*)(F.ws + WS_PS); float* LSE = (float*)(F.ws + WS_LSE);
#pragma unroll 1
    for (int item = blk * NTHREADS + F.tid; item < T * 12; item += nblk * NTHREADS) {
        const int hf = item & 1, it2 = item >> 1;
        const int h = it2 / T, bt = it2 % T, t = bt % SEQ;
        const int g = h >> 1, dil = (g == 0) ? 1 : (g == 1 ? 4 : 16);
        unsigned qp_[16]; float o[32];
        { const v4u* qp = (const v4u*)(PS + (size_t)bt * PSW + C_Q + h * 64 + hf * 32);
#pragma unroll
          for (int c = 0; c < 4; ++c) { const v4u w = qp[c]; qp_[4 * c + 0] = w.x; qp_[4 * c + 1] = w.y; qp_[4 * c + 2] = w.z; qp_[4 * c + 3] = w.w; } }
#pragma unroll
        for (int c = 0; c < 32; ++c) o[c] = 0.f;
        float mx = -1e30f, l = 0.f;
#pragma unroll 1
        for (int j = 0; j <= 128; ++j) {
            const int tk = t - j * dil; if (tk < 0) break;
            const size_t rowk = (size_t)(bt - j * dil) * PSW;
            const v4u* kp = (const v4u*)(PS + rowk + C_K + h * 64 + hf * 32); const v4u* vp = (const v4u*)(PS + rowk + C_V + h * 64 + hf * 32);
            float s = 0.f;
#pragma unroll
            for (int c = 0; c < 4; ++c) { const v4u w = kp[c];
                s += bflo(qp_[4 * c + 0]) * bflo(w.x) + bfhi(qp_[4 * c + 0]) * bfhi(w.x) + bflo(qp_[4 * c + 1]) * bflo(w.y) + bfhi(qp_[4 * c + 1]) * bfhi(w.y)
                   + bflo(qp_[4 * c + 2]) * bflo(w.z) + bfhi(qp_[4 * c + 2]) * bfhi(w.z) + bflo(qp_[4 * c + 3]) * bflo(w.w) + bfhi(qp_[4 * c + 3]) * bfhi(w.w); }
            s += shx<1>(s);
            s *= 0.125f;
            const float mn = fmaxf(mx, s), cf = __expf(mx - mn), p = __expf(s - mn);
            l = l * cf + p; mx = mn;
#pragma unroll
            for (int c = 0; c < 4; ++c) { const v4u w = vp[c];
                o[8 * c + 0] = o[8 * c + 0] * cf + p * bflo(w.x); o[8 * c + 1] = o[8 * c + 1] * cf + p * bfhi(w.x); o[8 * c + 2] = o[8 * c + 2] * cf + p * bflo(w.y); o[8 * c + 3] = o[8 * c + 3] * cf + p * bfhi(w.y);
                o[8 * c + 4] = o[8 * c + 4] * cf + p * bflo(w.z); o[8 * c + 5] = o[8 * c + 5] * cf + p * bfhi(w.z); o[8 * c + 6] = o[8 * c + 6] * cf + p * bflo(w.w); o[8 * c + 7] = o[8 * c + 7] * cf + p * bfhi(w.w); }
        }
        const float il = 1.0f / l;
        v4u* op = (v4u*)(PS + (size_t)bt * PSW + C_Q + h * 64 + hf * 32);
#pragma unroll
        for (int c = 0; c < 4; ++c) { v4u w; w.x = pk2(o[8 * c + 0] * il, o[8 * c + 1] * il); w.y = pk2(o[8 * c + 2] * il, o[8 * c + 3] * il); w.z = pk2(o[8 * c + 4] * il, o[8 * c + 5] * il); w.w = pk2(o[8 * c + 6] * il, o[8 * c + 7] * il); op[c] = w; }
        if (hf == 0) LSE[(size_t)bt * 6 + h] = mx + __logf(l);
    }
}
__device__ __forceinline__ void attn_finalize(const KA& A, const Ctx& F) {
    bf16* PS = (bf16*)(F.ws + WS_PS); const float* LSE = (const float*)(F.ws + WS_LSE);
    for (int item = F.bid * NTHREADS + F.tid; item < T * 48; item += F.G * NTHREADS) {
        const int bt = item / 48, r = item % 48, h = r >> 3, c = r & 7, j = h & 1;
        const float l0 = LSE[(size_t)bt * 6 + j], l1 = LSE[(size_t)bt * 6 + 2 + j], l2 = LSE[(size_t)bt * 6 + 4 + j], lm = LSE[(size_t)bt * 6 + h];
        const float mx = fmaxf(l0, fmaxf(l1, l2));
        const float al = __expf(lm - mx) / (__expf(l0 - mx) + __expf(l1 - mx) + __expf(l2 - mx));
        v4u* p = (v4u*)(PS + (size_t)bt * PSW + C_Q + h * 64) + c; v4u w = *p;
        w.x = pk2(bflo(w.x) * al, bfhi(w.x) * al); w.y = pk2(bflo(w.y) * al, bfhi(w.y) * al); w.z = pk2(bflo(w.z) * al, bfhi(w.z) * al); w.w = pk2(bflo(w.w) * al, bfhi(w.w) * al);
        if (!(F.dry && (DRY_SEL & 4))) *p = w;
    }
}

__device__ __forceinline__ void rwkv_v1(const KA& A, const Ctx& F, int l, int b, int h) {
    constexpr int CH = 32;
    bf16* PS = (bf16*)(F.ws + WS_PS);
    float* L = (float*)F.lds;
    float* ZR = L, *ZK = L + CH * 64, *ZV = L + 2 * CH * 64, *ZX = L + 3 * CH * 64;
    float* WD = ZX + CH * 256, *KA = WD + CH * 64, *KB = KA + CH * 64, *GG = KB + CH * 64, *YB = GG + CH * 64, *BON = YB + CH * 64, *PREV = BON + 64;
    const float* mix = A.in(3) + (size_t)l * 1408;
    const float* w0 = A.in(4) + l * 384, *w2 = A.in(5) + (size_t)l * 64 * 384, *a0 = A.in(6) + l * 384, *a2 = A.in(7) + (size_t)l * 64 * 384, *g2 = A.in(8) + (size_t)l * 128 * 384;
    const float* k_k = A.in(9) + l * 384, *k_a = A.in(10) + l * 384, *r_k = A.in(11) + l * 384, *ln_w = A.in(12) + l * 384, *ln_b = A.in(13) + l * 384;
    const int tid = F.tid, lane = F.lane;
    const int hc = h * 64 + lane;
    float S[8];
#pragma unroll
    for (int j = 0; j < 8; ++j) S[j] = 0.f;
    const int si = tid >> 3, sj = (tid & 7) * 8;
#pragma unroll 1
    for (int ch = 0; ch < SEQ / CH; ++ch) {
        const int t0 = ch * CH; const size_t row0 = (size_t)b * SEQ + t0;
        float* PRc = PREV + (ch & 1) * 192, *PRn = PREV + ((ch + 1) & 1) * 192;
#pragma unroll 1
        for (int e = tid; e < CH * 192; e += NTHREADS) {
            const int t = e / 192, c3 = e % 192, which = c3 >> 6, c = c3 & 63;
            const int col = C_RW + which * 384 + h * 64 + c;
            const float cur = bf2f(PS[(row0 + t) * PSW + col]);
            float prev;
            if (t == 0) prev = (ch == 0) ? 0.f : PRc[c3]; else prev = bf2f(PS[(row0 + t - 1) * PSW + col]);
            if (t == CH - 1) PRn[c3] = cur;
            const float z = cur + (prev - cur) * mix[which * 384 + h * 64 + c];
            L[which * CH * 64 + t * 64 + c] = z;
        }
#pragma unroll 1
        for (int e = tid; e < CH * 256; e += NTHREADS) {
            const int t = e >> 8, j = e & 255; const int col = C_LORA + j;
            const float cur = bf2f(PS[(row0 + t) * PSW + col]);
            const float prev = (t0 + t == 0) ? 0.f : bf2f(PS[(row0 + t - 1) * PSW + col]);
            float z = cur + (prev - cur) * mix[1152 + j];
            if (j < 64) z = tanhf(z); else if (j >= 128) z = sigm(z);
            ZX[t * 256 + j] = z;
        }
        __syncthreads();
        {
            float accw[4], acca[4], accg[4];
#pragma unroll
            for (int i = 0; i < 4; ++i) { accw[i] = 0.f; acca[i] = 0.f; accg[i] = 0.f; }
#pragma unroll 2
            for (int j = 0; j < 64; ++j) { const float ww = w2[j * 384 + hc], aa = a2[j * 384 + hc];
#pragma unroll
                for (int i = 0; i < 4; ++i) { const int t = F.wave + 8 * i; accw[i] += ZX[t * 256 + j] * ww; acca[i] += ZX[t * 256 + 64 + j] * aa; } }
#pragma unroll 2
            for (int j = 0; j < 128; ++j) { const float gg = g2[j * 384 + hc];
#pragma unroll
                for (int i = 0; i < 4; ++i) { const int t = F.wave + 8 * i; accg[i] += ZX[t * 256 + 128 + j] * gg; } }
            const float w0c = w0[hc], a0c = a0[hc], kkc = k_k[hc], kac = k_a[hc], rkc = r_k[hc];
#pragma unroll
            for (int i = 0; i < 4; ++i) { const int t = F.wave + 8 * i; const int o = t * 64 + lane;
                const float x = -(w0c + accw[i]); const float sp = (x > 20.f) ? x : log1pf(__expf(x)); const float w = -sp - 0.5f;
                const float av = sigm(a0c + acca[i]);
                const float kraw = ZK[o]; float kk = kraw * kkc; const float nrm = sqrtf(wave_sum(kk * kk)); kk = kk / fmaxf(nrm, 1e-12f);
                const float knew = kraw * (1.0f + (av - 1.0f) * kac);
                const float bon = wave_sum(ZR[o] * knew * rkc);
                ZK[o] = knew; WD[o] = __expf(-__expf(w)); KA[o] = -kk; KB[o] = kk * av; GG[o] = accg[i]; if (lane == 0) BON[t] = bon; }
        }
        __syncthreads();
#pragma unroll 2
        for (int t = 0; t < CH; ++t) {
            const f32x4 a0v = *(const f32x4*)(KA + t * 64 + sj), a1v = *(const f32x4*)(KA + t * 64 + sj + 4);
            const f32x4 w0v = *(const f32x4*)(WD + t * 64 + sj), w1v = *(const f32x4*)(WD + t * 64 + sj + 4);
            const f32x4 b0v = *(const f32x4*)(KB + t * 64 + sj), b1v = *(const f32x4*)(KB + t * 64 + sj + 4);
            const f32x4 k0v = *(const f32x4*)(ZK + t * 64 + sj), k1v = *(const f32x4*)(ZK + t * 64 + sj + 4);
            const f32x4 r0v = *(const f32x4*)(ZR + t * 64 + sj), r1v = *(const f32x4*)(ZR + t * 64 + sj + 4);
            const float vi = ZV[t * 64 + si];
            float sa = 0.f;
#pragma unroll
            for (int j = 0; j < 4; ++j) sa += S[j] * a0v[j] + S[4 + j] * a1v[j];
            sa += shx<1>(sa); sa += shx<2>(sa); sa += shx<4>(sa);
            float y = 0.f;
#pragma unroll
            for (int j = 0; j < 4; ++j) { S[j] = S[j] * w0v[j] + sa * b0v[j] + vi * k0v[j]; S[4 + j] = S[4 + j] * w1v[j] + sa * b1v[j] + vi * k1v[j]; y += S[j] * r0v[j] + S[4 + j] * r1v[j]; }
            y += shx<1>(y); y += shx<2>(y); y += shx<4>(y);
            if ((tid & 7) == 0) YB[t * 64 + si] = y;
        }
        __syncthreads();
        const float lw = ln_w[hc], lb = ln_b[hc];
#pragma unroll
        for (int i = 0; i < 4; ++i) { const int t = F.wave + 8 * i; const int o = t * 64 + lane;
            const float y = YB[o]; const float mu = wave_sum(y) * (1.0f / 64.0f); const float dv = y - mu; const float var = wave_sum(dv * dv) * (1.0f / 64.0f);
            const float yn = dv * (1.0f / sqrtf(var + GN_EPS)) * lw + lb;
            const float out = (yn + BON[t] * ZV[o]) * GG[o];
            PS[(row0 + t) * PSW + C_RW + h * 64 + lane] = (bf16)f2bf(out); }
        __syncthreads();
    }
}

__device__ __forceinline__ float gelu_tanh(float x) { const float u = 0.7978845608028654f * (x + 0.044715f * x * x * x); const float th = 1.0f - 2.0f / (__expf(2.0f * u) + 1.0f); return 0.5f * x * (1.0f + th); }
__device__ __forceinline__ void ssm_v1(const KA& A, const Ctx& F, int l, int b, int g) {
    bf16* PS = (bf16*)(F.ws + WS_PS);
    float* L = (float*)F.lds;
    float* U = L, *XR = L + 1024, *XI = L + 1024 + 64 * 65, *CR = L + 1024 + 2 * 64 * 65, *CI = CR + 1024;
    const int tid = F.tid, lane = F.lane, p = lane;
    float are, aim, bre[16], bim[16];
    {
        const float step = __expf(A.in(16)[l * 16 + g]);
        const float lr = A.in(14)[(size_t)l * 1024 + g * 64 + p], li = A.in(15)[(size_t)l * 1024 + g * 64 + p];
        const float mag = __expf(lr * step), ang = li * step; float sn, cs; sincosf(ang, &sn, &cs);
        are = mag * cs; aim = mag * sn;
        const float inv = 1.0f / (lr * lr + li * li);
        const float fre = ((are - 1.0f) * lr + aim * li) * inv, fim = (aim * lr - (are - 1.0f) * li) * inv;
        const float* br = A.in(17) + (size_t)l * 16384 + (size_t)(g * 64 + p) * 16, *bi = A.in(18) + (size_t)l * 16384 + (size_t)(g * 64 + p) * 16;
#pragma unroll
        for (int c = 0; c < 16; ++c) { bre[c] = fre * br[c] - fim * bi[c]; bim[c] = fre * bi[c] + fim * br[c]; }
    }
    for (int e = tid; e < 1024; e += NTHREADS) { CR[e] = A.in(19)[(size_t)l * 16384 + g * 1024 + e]; CI[e] = A.in(20)[(size_t)l * 16384 + g * 1024 + e]; }
    const float* dsk = A.in(21) + l * 256 + g * 16;
    float xr = 0.f, xi = 0.f;
#pragma unroll 1
    for (int ch = 0; ch < SEQ / 64; ++ch) {
        const size_t row0 = (size_t)b * SEQ + ch * 64;
        for (int e = tid; e < 1024; e += NTHREADS) { const int t = e >> 4, c = e & 15; U[e] = bf2f(PS[(row0 + t) * PSW + C_SSM + g * 16 + c]); }
        __syncthreads();
#pragma unroll
        for (int i = 0; i < 8; ++i) { const int t = F.wave + 8 * i; float sr = 0.f, sii = 0.f;
#pragma unroll
            for (int c = 0; c < 16; ++c) { const float u = U[t * 16 + c]; sr += bre[c] * u; sii += bim[c] * u; }
            XR[t * 65 + p] = sr; XI[t * 65 + p] = sii; }
        __syncthreads();
        if (F.wave == 0) {
#pragma unroll 4
            for (int t = 0; t < 64; ++t) { const float nr = are * xr - aim * xi + XR[t * 65 + p], ni = are * xi + aim * xr + XI[t * 65 + p]; xr = nr; xi = ni; XR[t * 65 + p] = xr; XI[t * 65 + p] = xi; }
        }
        __syncthreads();
        { const int t = tid >> 3, c2 = (tid & 7) * 2;
#pragma unroll
          for (int q = 0; q < 2; ++q) { const int c = c2 + q; float y = 0.f;
#pragma unroll 4
              for (int pp = 0; pp < 64; ++pp) y += CR[c * 64 + pp] * XR[t * 65 + pp] - CI[c * 64 + pp] * XI[t * 65 + pp];
              y += dsk[c] * U[t * 16 + c];
              PS[(row0 + t) * PSW + C_SSM + g * 16 + c] = (bf16)f2bf(gelu_tanh(y)); } }
        __syncthreads();
    }
}
typedef short bf16x8_t __attribute__((ext_vector_type(8)));
typedef float f32x16 __attribute__((ext_vector_type(16)));
typedef short v4i16_t __attribute__((ext_vector_type(4)));
typedef __bf16 bf16x2_t __attribute__((ext_vector_type(2)));
typedef float f32x2_t __attribute__((ext_vector_type(2)));
__device__ __forceinline__ unsigned cvtpk(float lo, float hi) { f32x2_t v = {lo, hi}; bf16x2_t b = __builtin_convertvector(v, bf16x2_t); return __builtin_bit_cast(unsigned, b); }
__device__ __forceinline__ v4i16_t ds_tr16(const unsigned char* p) { return __builtin_amdgcn_ds_read_tr16_b64_v4i16((LAS v4i16_t*)p); }
__device__ __forceinline__ int crow16(int g, int hh) { return (g & 3) + 8 * (g >> 2) + 4 * hh; }

constexpr int ATT_VS = 96;
constexpr int ATT_ITEMS = BATCH * 6 * 16;

__device__ __forceinline__ void attn_v2(const KA& A, const Ctx& F, int l) {
    bf16* PS = (bf16*)(F.ws + WS_PS); float* LSE = (float*)(F.ws + WS_LSE);
    unsigned char* VI = F.lds;
    const int lane = F.lane, q = lane & 31, hh = lane >> 5, w = F.wave;
    unsigned* ctr = (unsigned*)(F.ws + WS_CTL) + CW_ATT + 64 * l + ((F.dry && (DRY_SEL & 2)) ? 32 : 0); volatile unsigned* slot = (volatile unsigned*)(F.lds + MISC_OFF + 64);
#pragma unroll 1
    for (;;) {
        if (F.tid == 0) *slot = __hip_atomic_fetch_add(ctr, 1u, __ATOMIC_RELAXED, __HIP_MEMORY_SCOPE_AGENT);
        __syncthreads();
        const int item = (int)*slot;
        if (item >= ATT_ITEMS) break;
        const int idx16 = item & 15, h = (item >> 4) % 6, b = item / 96;
        const int g = h >> 1, dsh = 2 * g, dil = 1 << dsh;
        const int bpr = 16 >> dsh, r = idx16 >> (4 - dsh), i0 = (idx16 & (bpr - 1)) * 256;
        const size_t tb = (size_t)b * SEQ + r;
#pragma unroll
        for (int ps = 0; ps < 6; ++ps) { const int row = (F.tid >> 3) + 64 * ps, ch = F.tid & 7; int ki = i0 - 128 + row; ki = ki < 0 ? 0 : ki;
            const v4u v = *(const v4u*)(PS + (tb + (size_t)ki * dil) * PSW + C_V + h * 64 + ch * 8);
            *(v4u*)(VI + (row * ATT_VS + ch * 8) * 2) = v; }
        bf16x8_t qf[4];
        { const bf16* qp = PS + (tb + (size_t)(i0 + 32 * w + q) * dil) * PSW + C_Q + h * 64 + 8 * hh;
#pragma unroll
          for (int s = 0; s < 4; ++s) qf[s] = *(const bf16x8_t*)(qp + 16 * s); }
        f32x16 p[5];
#pragma unroll
        for (int kt = 0; kt < 5; ++kt) {
            int ki = i0 + 32 * w - 128 + 32 * kt + q; ki = ki < 0 ? 0 : ki;
            const bf16* kp = PS + (tb + (size_t)ki * dil) * PSW + C_K + h * 64 + 8 * hh;
            bf16x8_t kf[4];
#pragma unroll
            for (int s = 0; s < 4; ++s) kf[s] = *(const bf16x8_t*)(kp + 16 * s);
            f32x16 acc = {};
#pragma unroll
            for (int s = 0; s < 4; ++s) acc = __builtin_amdgcn_mfma_f32_32x32x16_bf16(kf[s], qf[s], acc, 0, 0, 0);
            p[kt] = acc;
        }
        const int kbase = i0 + 32 * w - 128;
        float mx = -3.0e38f;
#pragma unroll
        for (int kt = 0; kt < 5; ++kt)
#pragma unroll
            for (int gq = 0; gq < 16; ++gq) { const int kl = crow16(gq, hh); const int dist = q + 128 - 32 * kt - kl;
                const bool ok = (dist >= 0) && (dist <= 128) && (kbase + 32 * kt + kl >= 0);
                const float s = ok ? p[kt][gq] : -3.0e38f; p[kt][gq] = s; mx = fmaxf(mx, s); }
        mx = xmax32(mx);
        const float sc = 0.125f * 1.4426950408889634f;
        float l = 0.f;
#pragma unroll
        for (int kt = 0; kt < 5; ++kt)
#pragma unroll
            for (int gq = 0; gq < 16; ++gq) { const float e = __builtin_amdgcn_exp2f((p[kt][gq] - mx) * sc); p[kt][gq] = e; l += e; }
        l = xsum32(l);
        asm volatile("s_waitcnt lgkmcnt(0)" ::: "memory"); __builtin_amdgcn_s_barrier(); asm volatile("" ::: "memory");
        f32x16 o[2]; o[0] = f32x16{}; o[1] = f32x16{};
        const unsigned char* vb = VI + ((32 * w + 4 * hh + ((lane & 15) >> 2)) * ATT_VS + 16 * ((lane >> 4) & 1) + 4 * (lane & 3)) * 2;
#pragma unroll
        for (int kt = 0; kt < 5; ++kt)
#pragma unroll
            for (int s = 0; s < 2; ++s) {
                v4u pw; pw.x = cvtpk(p[kt][8 * s + 0], p[kt][8 * s + 1]); pw.y = cvtpk(p[kt][8 * s + 2], p[kt][8 * s + 3]); pw.z = cvtpk(p[kt][8 * s + 4], p[kt][8 * s + 5]); pw.w = cvtpk(p[kt][8 * s + 6], p[kt][8 * s + 7]);
                const bf16x8_t pb = __builtin_bit_cast(bf16x8_t, pw);
#pragma unroll
                for (int dt = 0; dt < 2; ++dt) {
                    const unsigned char* vp = vb + ((32 * kt + 16 * s) * ATT_VS + 32 * dt) * 2;
                    const v4i16_t lo = ds_tr16(vp), hi = ds_tr16(vp + 8 * ATT_VS * 2);
                    const bf16x8_t va = (bf16x8_t){lo[0], lo[1], lo[2], lo[3], hi[0], hi[1], hi[2], hi[3]};
                    o[dt] = __builtin_amdgcn_mfma_f32_32x32x16_bf16(va, pb, o[dt], 0, 0, 0);
                }
            }
        const float il = 1.0f / l;
        bf16* op = PS + (tb + (size_t)(i0 + 32 * w + q) * dil) * PSW + C_Q + h * 64 + 4 * hh;
#pragma unroll
        for (int dt = 0; dt < 2; ++dt)
#pragma unroll
            for (int g4 = 0; g4 < 4; ++g4) { v2u wv; wv.x = cvtpk(o[dt][4 * g4 + 0] * il, o[dt][4 * g4 + 1] * il); wv.y = cvtpk(o[dt][4 * g4 + 2] * il, o[dt][4 * g4 + 3] * il);
                if (!(F.dry && (DRY_SEL & 2))) *(v2u*)(op + 32 * dt + 8 * g4) = wv; }
        if (hh == 0 && !(F.dry && (DRY_SEL & 2))) LSE[(tb + (size_t)(i0 + 32 * w + q) * dil) * 6 + h] = mx * 0.125f + __logf(l);
        asm volatile("s_waitcnt lgkmcnt(0)" ::: "memory"); __builtin_amdgcn_s_barrier(); asm volatile("" ::: "memory");
    }
}
constexpr int TS = 72;
constexpr int TILE = 64 * TS * 2;
constexpr int RL_A = 0 * TILE, RL_B = 1 * TILE, RL_K = 2 * TILE, RL_R = 3 * TILE, RL_V = 4 * TILE, RL_BH = 5 * TILE, RL_KH = 6 * TILE,
              RL_AK = 7 * TILE, RL_RB = 8 * TILE, RL_RK = 9 * TILE, RL_AABF = 10 * TILE, RL_E1 = RL_AABF + 16384, RL_E2 = RL_E1 + TILE, RL_E3 = RL_E2 + TILE, RL_END = RL_E3 + TILE;
constexpr int RL_D = RL_B, RL_LP = RL_K, RL_X = RL_E1, RL_M = RL_E2, RL_M2 = RL_E3, RL_S = RL_AK, RL_T = RL_K, RL_W = RL_E2, RL_U = RL_E3;
constexpr int RL_WLF = RL_AK, RL_ALF = RL_WLF + 16384, RL_GF = RL_ALF + 16384, RL_TOT = RL_GF + 16384;
static_assert(RL_END <= MISC_OFF && RL_TOT + 2048 <= MISC_OFF, "rwkv LDS map");
constexpr int RW_ITEMS = BATCH * 6 * 64;
#ifndef SEC
#define SEC 0xFFFF
#endif

__device__ __forceinline__ bf16x8_t ldfrag(const unsigned char* tile, int row, int s, int hh) { return *(const bf16x8_t*)(tile + (row * TS + 16 * s + 8 * hh) * 2); }
__device__ __forceinline__ bf16x8_t ldfrag_tr(const unsigned char* tile, int n0, int s, int lane) {
    const int hh = lane >> 5;
    const unsigned char* p = tile + ((16 * s + 8 * hh + ((lane & 15) >> 2)) * TS + n0 + 16 * ((lane >> 4) & 1) + 4 * (lane & 3)) * 2;
    const v4i16_t lo = ds_tr16(p), hi = ds_tr16(p + 4 * TS * 2);
    return (bf16x8_t){lo[0], lo[1], lo[2], lo[3], hi[0], hi[1], hi[2], hi[3]};
}
template <bool AT, bool BT> __device__ __forceinline__ f32x16 mmx(f32x16 acc, const unsigned char* At, int m0, const unsigned char* Bt, int n0, int ks0, int ks1, int lane) {
    const int r = lane & 31, hh = lane >> 5;
#pragma unroll
    for (int s = 0; s < 4; ++s) if (s >= ks0 && s < ks1) {
        const bf16x8_t a = AT ? ldfrag_tr(At, m0, s, lane) : ldfrag(At, m0 + r, s, hh);
        const bf16x8_t b = BT ? ldfrag_tr(Bt, n0, s, lane) : ldfrag(Bt, n0 + r, s, hh);
        acc = __builtin_amdgcn_mfma_f32_32x32x16_bf16(a, b, acc, 0, 0, 0); }
    return acc;
}
__device__ __forceinline__ void st_tileT(unsigned char* tile, int ncol, int m0, const f32x16& acc, int hh) {
#pragma unroll
    for (int g4 = 0; g4 < 4; ++g4) { v2u wv; wv.x = cvtpk(acc[4 * g4 + 0], acc[4 * g4 + 1]); wv.y = cvtpk(acc[4 * g4 + 2], acc[4 * g4 + 3]);
        *(v2u*)(tile + (ncol * TS + m0 + 8 * g4 + 4 * hh) * 2) = wv; }
}
__device__ __forceinline__ bf16x8_t pack8(const float (&z)[8]) { v4u pw; pw.x = cvtpk(z[0], z[1]); pw.y = cvtpk(z[2], z[3]); pw.z = cvtpk(z[4], z[5]); pw.w = cvtpk(z[6], z[7]); return __builtin_bit_cast(bf16x8_t, pw); }
__device__ __forceinline__ void unpack8(const v4u w, float (&z)[8]) { z[0] = bflo(w.x); z[1] = bfhi(w.x); z[2] = bflo(w.y); z[3] = bfhi(w.y); z[4] = bflo(w.z); z[5] = bfhi(w.z); z[6] = bflo(w.w); z[7] = bfhi(w.w); }

template <int ACT> __device__ __forceinline__ bf16x8_t lora_frag(const bf16* PS, size_t grow, bool first, int jcol, const float* mix) {
    float c[8], p[8];
    unpack8(*(const v4u*)(PS + grow * PSW + C_LORA + jcol), c);
    unpack8(*(const v4u*)(PS + (grow - (first ? 0 : 1)) * PSW + C_LORA + jcol), p);
    const f32x4 m0 = *(const f32x4*)(mix + 1152 + jcol), m1 = *(const f32x4*)(mix + 1152 + jcol + 4);
    float z[8];
#pragma unroll
    for (int e = 0; e < 8; ++e) { const float mm = e < 4 ? m0[e] : m1[e - 4]; const float pe = first ? 0.f : p[e]; float v = c[e] + (pe - c[e]) * mm;
        if (ACT == 1) v = 1.0f - 2.0f / (__expf(2.0f * v) + 1.0f); else if (ACT == 2) v = sigm(v);
        z[e] = v; }
    return pack8(z);
}

__device__ __forceinline__ void rwkv_p1(const KA& A, const Ctx& F, int l) {
    bf16* PS = (bf16*)(F.ws + WS_PS); const bf16* BRB = (const bf16*)(F.ws + WS_BR);
    unsigned char* L = F.lds;
    unsigned char* wl = F.ws + WS_W + (size_t)l * W_LAYER;
    const bf16* W2T = (const bf16*)(wl + WO_W2); const bf16* A2T = (const bf16*)(wl + WO_A2); const bf16* G2T = (const bf16*)(wl + WO_G2);
    const float* mix = A.in(3) + (size_t)l * 1408;
    int tid = F.tid, lane = F.lane, r32 = lane & 31, hh = lane >> 5; const int w = F.wave;
#ifdef SECD
    const int sec_ = F.dry ? SECD : 0xFFFF;
#else
    constexpr int sec_ = 0xFFFF;
#endif
    const bool wr_ = !(F.dry && (DRY_SEL & 1));
#define RW_FENCE() do { asm volatile("s_waitcnt lgkmcnt(0)" ::: "memory"); __builtin_amdgcn_s_barrier(); asm volatile("" : "+v"(tid) :: "memory");     \
    lane = tid & 63; r32 = lane & 31; hh = lane >> 5; hc = h * 64 + lane; } while (0)
#pragma unroll 1
    for (int grp = F.bid; grp < RW_ITEMS / 6; grp += F.G) {
      const int j = grp & 63, b = grp >> 6;
      const size_t row0 = (size_t)b * SEQ + 64 * j;
      bf16x8_t xf[8];
      { const int tt = w & 1; const size_t grow = row0 + 32 * tt + r32; const bool first = (j == 0) && (tt == 0) && (r32 == 0);
        if (w < 4) {
#pragma unroll
            for (int s = 0; s < 8; ++s) xf[s] = lora_frag<2>(PS, grow, first, 128 + 16 * s + 8 * hh, mix);
        } else {
#pragma unroll
            for (int s = 0; s < 4; ++s) { xf[s] = lora_frag<1>(PS, grow, first, 16 * s + 8 * hh, mix); xf[4 + s] = lora_frag<0>(PS, grow, first, 64 + 16 * s + 8 * hh, mix); }
        } }
#pragma unroll 1
      for (int h = 0; h < 6; ++h) {
        const int item = (b * 6 + h) * 64 + j;
        int hc = h * 64 + lane;
        if (sec_ & 1) {
            const int tl = (w & 3), ct = tl >> 1, tt = tl & 1;
            if (w < 4) {
                f32x16 acc = {};
#pragma unroll
                for (int s = 0; s < 8; ++s) { const bf16x8_t af = *(const bf16x8_t*)(G2T + (size_t)(h * 64 + 32 * ct + r32) * 128 + 16 * s + 8 * hh);
                    acc = __builtin_amdgcn_mfma_f32_32x32x16_bf16(af, xf[s], acc, 0, 0, 0); }
                float* G = (float*)(L + RL_GF);
#pragma unroll
                for (int g4 = 0; g4 < 4; ++g4) *(f32x4*)(G + (32 * tt + r32) * 64 + 32 * ct + 8 * g4 + 4 * hh) = (f32x4){acc[4 * g4], acc[4 * g4 + 1], acc[4 * g4 + 2], acc[4 * g4 + 3]};
            } else {
                f32x16 accw = {}, acca = {};
#pragma unroll
                for (int s = 0; s < 4; ++s) {
                    const bf16x8_t wf = *(const bf16x8_t*)(W2T + (size_t)(h * 64 + 32 * ct + r32) * 64 + 16 * s + 8 * hh);
                    const bf16x8_t af = *(const bf16x8_t*)(A2T + (size_t)(h * 64 + 32 * ct + r32) * 64 + 16 * s + 8 * hh);
                    accw = __builtin_amdgcn_mfma_f32_32x32x16_bf16(wf, xf[s], accw, 0, 0, 0);
                    acca = __builtin_amdgcn_mfma_f32_32x32x16_bf16(af, xf[4 + s], acca, 0, 0, 0); }
                float* WLp = (float*)(L + RL_WLF); float* ALp = (float*)(L + RL_ALF);
#pragma unroll
                for (int g4 = 0; g4 < 4; ++g4) { const int o = (32 * tt + r32) * 64 + 32 * ct + 8 * g4 + 4 * hh;
                    *(f32x4*)(WLp + o) = (f32x4){accw[4 * g4], accw[4 * g4 + 1], accw[4 * g4 + 2], accw[4 * g4 + 3]};
                    *(f32x4*)(ALp + o) = (f32x4){acca[4 * g4], acca[4 * g4 + 1], acca[4 * g4 + 2], acca[4 * g4 + 3]}; }
            }
        }
        float rr[8], kn[8], vv[8], kk[8], bb[8], eadd[8], lp[8];
        {
            const float mr = mix[hc], mk = mix[384 + hc], mv = mix[768 + hc];
            float pr, pk, pv;
            if (w == 0) { if (j == 0) { pr = 0.f; pk = 0.f; pv = 0.f; } else { const bf16* bp = BRB + (size_t)(b * 64 + j - 1) * PSW + C_RW + hc; pr = bf2f(bp[0]); pk = bf2f(bp[384]); pv = bf2f(bp[768]); } }
            else { const bf16* pp = PS + (row0 + 8 * w - 1) * PSW + C_RW + hc; pr = bf2f(pp[0]); pk = bf2f(pp[384]); pv = bf2f(pp[768]); }
            float cr[8], ck[8], cv[8];
#pragma unroll
            for (int i = 0; i < 8; ++i) { const bf16* cp = PS + (row0 + 8 * w + i) * PSW + C_RW + hc; cr[i] = bf2f(cp[0]); ck[i] = bf2f(cp[384]); cv[i] = bf2f(cp[768]); }
#pragma unroll
            for (int i = 0; i < 8; ++i) { rr[i] = cr[i] + (pr - cr[i]) * mr; kn[i] = ck[i] + (pk - ck[i]) * mk; vv[i] = cv[i] + (pv - cv[i]) * mv; pr = cr[i]; pk = ck[i]; pv = cv[i]; }
        }
        RW_FENCE();
        if (sec_ & 2) {
            const float* WLp = (const float*)(L + RL_WLF); const float* ALp = (const float*)(L + RL_ALF); const float* G = (const float*)(L + RL_GF); float* TOT = (float*)(L + RL_TOT);
            const float w0c = A.in(4)[l * 384 + hc], a0c = A.in(6)[l * 384 + hc], kkc = A.in(9)[l * 384 + hc], kac = A.in(10)[l * 384 + hc], rkc = A.in(11)[l * 384 + hc];
            const float lnw = A.in(12)[l * 384 + hc], lnb = A.in(13)[l * 384 + hc];
            bf16* EM = (bf16*)(F.ws + WS_REM) + (size_t)item * 4096;
            float run = 0.f;
#pragma unroll
            for (int i = 0; i < 8; ++i) { const int t = 8 * w + i; const int o = t * 64 + lane;
                const float x = -(w0c + WLp[o]); const float sp = (x > 20.f) ? x : __logf(1.0f + __expf(x)); const float wv = -sp - 0.5f;
                run += -__expf(wv); lp[i] = run;
                const float av = sigm(a0c + ALp[o]); const float gv = G[o];
                float kq = kn[i] * kkc; const float nrm = __builtin_amdgcn_sqrtf(wave_sum(kq * kq)); kq = kq * __builtin_amdgcn_rcpf(fmaxf(nrm, 1e-12f));
                const float knew = kn[i] * (1.0f + (av - 1.0f) * kac);
                const float bon = wave_sum(rr[i] * knew * rkc);
                kk[i] = kq; bb[i] = kq * av; kn[i] = knew;
                if (wr_) EM[o] = (bf16)f2bf(lnw * gv); eadd[i] = (lnb + bon * vv[i]) * gv; }
            TOT[w * 64 + lane] = run;
        }
        RW_FENCE();
        if (sec_ & 8) {
            const float* TOT = (const float*)(L + RL_TOT);
            float off = 0.f, cl = 0.f;
#pragma unroll
            for (int q = 0; q < 8; ++q) { const float tq = TOT[q * 64 + lane]; cl += tq; if (q < w) off += tq; }
            if (w == 7 && wr_) ((float*)(F.ws + WS_RGL))[(size_t)item * 64 + lane] = __expf(cl);
            bf16* At = (bf16*)(L + RL_A), *Bt = (bf16*)(L + RL_B), *Kt = (bf16*)(L + RL_K), *Rt = (bf16*)(L + RL_R), *Vt = (bf16*)(L + RL_V), *BHt = (bf16*)(L + RL_BH), *KHt = (bf16*)(L + RL_KH);
            float cp = off;
#pragma unroll
            for (int i = 0; i < 8; ++i) { const int o = (8 * w + i) * TS + lane;
                const float ct = off + lp[i];
                const float ep = __expf(cp), et = __expf(ct), ei = __expf(-ct), eh = __expf(cl - ct);
                At[o] = (bf16)f2bf(-kk[i] * ep); Rt[o] = (bf16)f2bf(rr[i] * et);
                Bt[o] = (bf16)f2bf(bb[i] * ei); Kt[o] = (bf16)f2bf(kn[i] * ei);
                Vt[o] = (bf16)f2bf(vv[i]); BHt[o] = (bf16)f2bf(bb[i] * eh); KHt[o] = (bf16)f2bf(kn[i] * eh);
                cp = ct; }
        }
        RW_FENCE();
        if (sec_ & 16) {
#pragma unroll
        for (int rep = 0; rep < 2; ++rep) { const int job = w + 8 * rep, prod = job >> 2, tt = (job >> 1) & 1, st = job & 1;
            f32x16 acc = {};
            acc = mmx<false, false>(acc, L + ((prod & 1) ? RL_K : RL_B), 32 * st, L + ((prod & 2) ? RL_R : RL_A), 32 * tt, 0, 4, lane);
            const int t = 32 * tt + r32; const int incl = prod >> 1;
#pragma unroll
            for (int g = 0; g < 16; ++g) { const int s = 32 * st + crow16(g, hh); if (!(s < t + incl)) acc[g] = 0.f; }
            if (prod == 0) { float* AF = (float*)(L + RL_AABF);
#pragma unroll
                for (int g4 = 0; g4 < 4; ++g4) *(f32x4*)(AF + t * 64 + 32 * st + 8 * g4 + 4 * hh) = (f32x4){acc[4 * g4], acc[4 * g4 + 1], acc[4 * g4 + 2], acc[4 * g4 + 3]};
            } else st_tileT(L + (prod == 1 ? RL_AK : (prod == 2 ? RL_RB : RL_RK)), t, 32 * st, acc, hh);
        } }
        RW_FENCE();
        if (sec_ & 32) {
            const float* AF = (const float*)(L + RL_AABF); bf16* Dt = (bf16*)(L + RL_D); bf16* LPt = (bf16*)(L + RL_LP);
            if (w == 0) {
                const int I = lane >> 4, jc = lane & 15; float x[16];
#pragma unroll
                for (int r = 0; r < 16; ++r) { float s = (r == jc) ? 1.f : 0.f;
#pragma unroll
                    for (int q = 0; q < 16; ++q) if (q < r) s += AF[(16 * I + r) * 64 + 16 * I + q] * x[q];
                    x[r] = s; Dt[(16 * I + r) * TS + 16 * I + jc] = (bf16)f2bf(s); }
            } else if (w < 4) {
                for (int o = tid - 64; o < 4096; o += 192) { const int t = o >> 6, s = o & 63; const bool offd = (t >> 4) != (s >> 4);
                    LPt[t * TS + s] = ((t >> 4) > (s >> 4)) ? (bf16)f2bf(AF[o]) : (bf16)0; if (offd) Dt[t * TS + s] = (bf16)0; }
            } else { const int tl = w - 4, it = tl >> 1, tt = tl & 1;
                f32x16 acc = {};
                acc = mmx<true, false>(acc, L + RL_V, 32 * it, L + RL_AK, 32 * tt, 0, tt ? 4 : 2, lane);
                st_tileT(L + RL_X, 32 * tt + r32, 32 * it, acc, hh); }
        }
        RW_FENCE();
        if (sec_ & 32) {
#pragma unroll 1
            for (int stg = 0; stg < 4; ++stg) {
                const int pt = (stg == 0) ? RL_LP : (stg == 1 ? RL_M : (stg == 2 ? RL_M2 : RL_D));
                const int qt = (stg == 0) ? RL_D : (stg == 3 ? RL_S : RL_M);
                const int dt = (stg == 0) ? RL_M : (stg == 1 ? RL_M2 : (stg == 2 ? RL_S : RL_T));
                if (w < 3) { const int st = (w == 2) ? 1 : 0, tt = (w == 0) ? 0 : 1;
                    f32x16 acc = {};
                    acc = mmx<true, false>(acc, L + pt, 32 * st, L + qt, 32 * tt, 2 * st, 2 * tt + 2, lane);
                    const int t = 32 * tt + r32;
                    if (stg == 2) {
                        const bf16* Mt = (const bf16*)(L + RL_M); const bf16* M2t = (const bf16*)(L + RL_M2);
#pragma unroll
                        for (int g4 = 0; g4 < 4; ++g4) { const int s0 = 32 * st + 8 * g4 + 4 * hh; const v2u mv = *(const v2u*)(Mt + t * TS + s0), m2v = *(const v2u*)(M2t + t * TS + s0);
                            const bool lowt = (tt > st);
                            acc[4 * g4 + 0] += bflo(mv.x) + bflo(m2v.x) + ((s0 + 0 == t) ? 1.f : 0.f); acc[4 * g4 + 1] += bfhi(mv.x) + bfhi(m2v.x) + ((s0 + 1 == t) ? 1.f : 0.f);
                            acc[4 * g4 + 2] += bflo(mv.y) + bflo(m2v.y) + ((s0 + 2 == t) ? 1.f : 0.f); acc[4 * g4 + 3] += bfhi(mv.y) + bfhi(m2v.y) + ((s0 + 3 == t) ? 1.f : 0.f); (void)lowt; }
                    }
                    st_tileT(L + dt, t, 32 * st, acc, hh); }
                RW_FENCE();
            }
        }
        if (sec_ & 64) { const int mat = w >> 2, tl = w & 3, nt = tl >> 1, tt = tl & 1;
          f32x16 acc = {};
          acc = mmx<true, false>(acc, L + (mat ? RL_X : RL_A), 32 * nt, L + RL_T, 32 * tt, 0, tt ? 4 : 2, lane);
          st_tileT(L + (mat ? RL_U : RL_W), 32 * tt + r32, 32 * nt, acc, hh); }
        RW_FENCE();
        if (sec_ & 128) { const int tl = w & 3, ta = tl >> 1, tb2 = tl & 1;
          if (w < 4) {
              f32x16 acc = {};
              acc = mmx<true, true>(acc, L + RL_W, 32 * ta, L + RL_BH, 32 * tb2, 0, 4, lane);
              bf16* MC = (bf16*)(F.ws + WS_RMC) + (size_t)item * 4096;
#pragma unroll
              for (int g4 = 0; g4 < 4; ++g4) { v2u wv; wv.x = cvtpk(acc[4 * g4], acc[4 * g4 + 1]); wv.y = cvtpk(acc[4 * g4 + 2], acc[4 * g4 + 3]); if (wr_) *(v2u*)(MC + (32 * tb2 + r32) * 64 + 32 * ta + 8 * g4 + 4 * hh) = wv; }
              f32x16 an = {};
              an = mmx<true, true>(an, L + RL_BH, 32 * ta, L + RL_U, 32 * tb2, 0, 4, lane);
              an = mmx<true, true>(an, L + RL_KH, 32 * ta, L + RL_V, 32 * tb2, 0, 4, lane);
              bf16* NT = (bf16*)(F.ws + WS_RNT) + (size_t)item * 4096;
#pragma unroll
              for (int g4 = 0; g4 < 4; ++g4) { v2u wv; wv.x = cvtpk(an[4 * g4], an[4 * g4 + 1]); wv.y = cvtpk(an[4 * g4 + 2], an[4 * g4 + 3]); if (wr_) *(v2u*)(NT + (32 * tb2 + r32) * 64 + 32 * ta + 8 * g4 + 4 * hh) = wv; }
          } else {
              f32x16 acc = {};
              acc = mmx<true, false>(acc, L + RL_W, 32 * ta, L + RL_RB, 32 * tb2, 0, tb2 ? 4 : 2, lane);
              const int t = 32 * tb2 + r32; const bf16* Rt = (const bf16*)(L + RL_R);
              bf16* qd = PS + (row0 + t) * PSW + C_RW + h * 64;
#pragma unroll
              for (int g4 = 0; g4 < 4; ++g4) { const int c0 = 32 * ta + 8 * g4 + 4 * hh; const v2u rv = *(const v2u*)(Rt + t * TS + c0);
                  v2u wv; wv.x = cvtpk(acc[4 * g4] + bflo(rv.x), acc[4 * g4 + 1] + bfhi(rv.x)); wv.y = cvtpk(acc[4 * g4 + 2] + bflo(rv.y), acc[4 * g4 + 3] + bfhi(rv.y)); if (wr_) *(v2u*)(qd + c0) = wv; }
              f32x16 ay = {};
              ay = mmx<true, false>(ay, L + RL_U, 32 * ta, L + RL_RB, 32 * tb2, 0, tb2 ? 4 : 2, lane);
              ay = mmx<true, false>(ay, L + RL_V, 32 * ta, L + RL_RK, 32 * tb2, 0, tb2 ? 4 : 2, lane);
              bf16* yd = PS + (row0 + t) * PSW + C_RW + 384 + h * 64;
#pragma unroll
              for (int g4 = 0; g4 < 4; ++g4) { v2u wv; wv.x = cvtpk(ay[4 * g4], ay[4 * g4 + 1]); wv.y = cvtpk(ay[4 * g4 + 2], ay[4 * g4 + 3]); if (wr_) *(v2u*)(yd + 32 * ta + 8 * g4 + 4 * hh) = wv; }
          }
#pragma unroll
          for (int i = 0; i < 8; ++i) { if (wr_) PS[(row0 + 8 * w + i) * PSW + C_RW + 768 + hc] = (bf16)f2bf(eadd[i]); }
        }
        RW_FENCE();
      }
    }
#undef RW_FENCE
}

constexpr int RW_PF = 4;
constexpr size_t WS_RHS = WS_XN;
struct ScanOps { bf16x8_t mf[4]; f32x4 gl[4]; v2u nv[4]; };
__device__ __forceinline__ void scan_load(ScanOps& o, const unsigned char* ws, int item, int ta, int tb2, int r32, int hh) {
    const bf16* MC = (const bf16*)(ws + WS_RMC) + (size_t)item * 4096; const bf16* NT = (const bf16*)(ws + WS_RNT) + (size_t)item * 4096; const float* GL = (const float*)(ws + WS_RGL) + (size_t)item * 64;
#pragma unroll
    for (int s = 0; s < 4; ++s) o.mf[s] = *(const bf16x8_t*)(MC + (32 * ta + r32) * 64 + 16 * s + 8 * hh);
#pragma unroll
    for (int g4 = 0; g4 < 4; ++g4) { const int c0 = 32 * ta + 8 * g4 + 4 * hh; o.gl[g4] = *(const f32x4*)(GL + c0); o.nv[g4] = *(const v2u*)(NT + (32 * tb2 + r32) * 64 + c0); }
}
__device__ __forceinline__ void rwkv_scan(const KA& A, const Ctx& F, int l, int b, int h) {
    unsigned char* L = F.lds;
    const int tid = F.tid, lane = F.lane, w = F.wave, r32 = lane & 31, hh = lane >> 5;
    for (int o = tid; o < 2 * 9216 / 4; o += NTHREADS) ((unsigned*)L)[o] = 0u;
    __syncthreads();
    const bool act = w < 4;
    const int ta = (w >> 1) & 1, tb2 = w & 1;
    const int item0 = (b * 6 + h) * 64;
    bf16* HS = (bf16*)(F.ws + WS_RHS) + (size_t)item0 * 4096;
    f32x16 Hacc = {};
    ScanOps ops[RW_PF];
#pragma unroll
    for (int p = 0; p < RW_PF; ++p) if (act) scan_load(ops[p], F.ws, item0 + p, ta, tb2, r32, hh);
#pragma unroll 1
    for (int j0 = 0; j0 < 64; j0 += RW_PF) {
#pragma unroll
        for (int p = 0; p < RW_PF; ++p) { const int j = j0 + p;
            const unsigned char* HBc = L + (p & 1) * 9216; unsigned char* HBn = L + ((p + 1) & 1) * 9216;
            if (act) {
            if (!(F.dry && (DRY_SEL & 2))) {
#pragma unroll
                for (int g4 = 0; g4 < 4; ++g4) { v2u wv; wv.x = cvtpk(Hacc[4 * g4], Hacc[4 * g4 + 1]); wv.y = cvtpk(Hacc[4 * g4 + 2], Hacc[4 * g4 + 3]); *(v2u*)(HS + (size_t)j * 4096 + (32 * tb2 + r32) * 64 + 32 * ta + 8 * g4 + 4 * hh) = wv; } }
            const ScanOps cur = ops[p];
            if (j + RW_PF < 64) scan_load(ops[p], F.ws, item0 + j + RW_PF, ta, tb2, r32, hh);
#pragma unroll
            for (int g4 = 0; g4 < 4; ++g4) { Hacc[4 * g4 + 0] = Hacc[4 * g4 + 0] * cur.gl[g4][0] + bflo(cur.nv[g4].x); Hacc[4 * g4 + 1] = Hacc[4 * g4 + 1] * cur.gl[g4][1] + bfhi(cur.nv[g4].x);
                Hacc[4 * g4 + 2] = Hacc[4 * g4 + 2] * cur.gl[g4][2] + bflo(cur.nv[g4].y); Hacc[4 * g4 + 3] = Hacc[4 * g4 + 3] * cur.gl[g4][3] + bfhi(cur.nv[g4].y); }
#pragma unroll
            for (int s = 0; s < 4; ++s) Hacc = __builtin_amdgcn_mfma_f32_32x32x16_bf16(cur.mf[s], ldfrag(HBc, 32 * tb2 + r32, s, hh), Hacc, 0, 0, 0);
            st_tileT(HBn, 32 * tb2 + r32, 32 * ta, Hacc, hh);
            }
            asm volatile("s_waitcnt lgkmcnt(0)" ::: "memory");
            __builtin_amdgcn_s_barrier();
            asm volatile("" ::: "memory");
        }
    }
}

__device__ __forceinline__ void rwkv_p3(const KA& A, const Ctx& F) {
    bf16* PS = (bf16*)(F.ws + WS_PS);
    const int lane = F.lane, w = F.wave, r32 = lane & 31, hh = lane >> 5, tb2 = w & 1;
#pragma unroll 1
    for (int it4 = F.bid; it4 < RW_ITEMS / 4; it4 += F.G) {
        const int item = it4 * 4 + (w >> 1); const int j = item & 63, h = (item >> 6) % 6, b = item / 384;
        const size_t row0 = (size_t)b * SEQ + 64 * j;
        const int t = 32 * tb2 + r32;
        const bf16* qd = PS + (row0 + t) * PSW + C_RW + h * 64; const bf16* yd = qd + 384; const bf16* ed = qd + 768; const bf16* EM = (const bf16*)(F.ws + WS_REM) + (size_t)item * 4096 + t * 64;
        const bf16* HS = (const bf16*)(F.ws + WS_RHS) + (size_t)item * 4096;
        bf16x8_t qf[4], hf[2][4];
#pragma unroll
        for (int s = 0; s < 4; ++s) { qf[s] = *(const bf16x8_t*)(qd + 16 * s + 8 * hh); hf[0][s] = *(const bf16x8_t*)(HS + r32 * 64 + 16 * s + 8 * hh); hf[1][s] = *(const bf16x8_t*)(HS + (32 + r32) * 64 + 16 * s + 8 * hh); }
        f32x16 y[2]; v2u em[2][4], ea[2][4];
#pragma unroll
        for (int it = 0; it < 2; ++it)
#pragma unroll
            for (int g4 = 0; g4 < 4; ++g4) { const int i0 = 32 * it + 8 * g4 + 4 * hh; const v2u yv = *(const v2u*)(yd + i0); em[it][g4] = *(const v2u*)(EM + i0); ea[it][g4] = *(const v2u*)(ed + i0);
                y[it][4 * g4] = bflo(yv.x); y[it][4 * g4 + 1] = bfhi(yv.x); y[it][4 * g4 + 2] = bflo(yv.y); y[it][4 * g4 + 3] = bfhi(yv.y); }
#pragma unroll
        for (int it = 0; it < 2; ++it)
#pragma unroll
            for (int s = 0; s < 4; ++s) y[it] = __builtin_amdgcn_mfma_f32_32x32x16_bf16(hf[it][s], qf[s], y[it], 0, 0, 0);
        float s1 = 0.f, s2 = 0.f;
#pragma unroll
        for (int it = 0; it < 2; ++it)
#pragma unroll
            for (int g = 0; g < 16; ++g) { s1 += y[it][g]; s2 += y[it][g] * y[it][g]; }
        s1 = xsum32(s1); s2 = xsum32(s2);
        const float mu = s1 * (1.0f / 64.0f); const float var = fmaxf(s2 * (1.0f / 64.0f) - mu * mu, 0.f); const float rs = 1.0f / sqrtf(var + GN_EPS);
        bf16* od = PS + (row0 + t) * PSW + C_RW + h * 64;
#pragma unroll
        for (int it = 0; it < 2; ++it)
#pragma unroll
            for (int g4 = 0; g4 < 4; ++g4) { const int i0 = 32 * it + 8 * g4 + 4 * hh; const v2u emv = em[it][g4], eav = ea[it][g4];
                v2u wv; wv.x = cvtpk((y[it][4 * g4] - mu) * rs * bflo(emv.x) + bflo(eav.x), (y[it][4 * g4 + 1] - mu) * rs * bfhi(emv.x) + bfhi(eav.x));
                wv.y = cvtpk((y[it][4 * g4 + 2] - mu) * rs * bflo(emv.y) + bflo(eav.y), (y[it][4 * g4 + 3] - mu) * rs * bfhi(emv.y) + bfhi(eav.y));
                if (!(F.dry && (DRY_SEL & 4))) *(v2u*)(od + i0) = wv; }
    }
}
constexpr size_t SSG_TM = 0, SSG_GM = 131072, SSG_HM = 196608, SSG_LAM = 262144, SSG_BYTES = 263168;
constexpr size_t WS_SSM = WS_RGL + 1 * MiB;
static_assert(WS_SSM + 32 * SSG_BYTES <= 512 * MiB, "ssm matrices fit the workspace");
constexpr int ZS = 132;

__device__ __forceinline__ void ssm_prep(const KA& A, const Ctx& F, int l, int g) {
    float* L = (float*)F.lds;
    float* PWr = L, *PWi = L + 17 * 64, *BBr = L + 2 * 17 * 64, *BBi = BBr + 1024, *CCr = BBi + 1024, *CCi = CCr + 1024, *KE = CCi + 1024;
    unsigned char* base = F.ws + WS_SSM + (size_t)(l * 16 + g) * SSG_BYTES;
    const int tid = F.tid;
    __syncthreads();
    if (tid < 64) { const int p = tid;
        const float step = __expf(A.in(16)[l * 16 + g]);
        const float lr = A.in(14)[(size_t)l * 1024 + g * 64 + p], li = A.in(15)[(size_t)l * 1024 + g * 64 + p];
        const float ang = li * step;
        for (int m = 0; m <= 16; ++m) { const float sn = __sinf(ang * (float)m), cs = __cosf(ang * (float)m); const float mg = __expf(lr * step * (float)m); PWr[m * 64 + p] = mg * cs; PWi[m * 64 + p] = mg * sn; }
        const float are = PWr[64 + p], aim = PWi[64 + p];
        const float inv = 1.0f / (lr * lr + li * li);
        const float fre = ((are - 1.0f) * lr + aim * li) * inv, fim = (aim * lr - (are - 1.0f) * li) * inv;
        const float* br = A.in(17) + (size_t)l * 16384 + (size_t)(g * 64 + p) * 16, *bi = A.in(18) + (size_t)l * 16384 + (size_t)(g * 64 + p) * 16;
        for (int c = 0; c < 16; ++c) { BBr[p * 16 + c] = fre * br[c] - fim * bi[c]; BBi[p * 16 + c] = fre * bi[c] + fim * br[c]; }
        float* lam = (float*)(base + SSG_LAM); lam[p] = PWr[16 * 64 + p]; lam[64 + p] = PWi[16 * 64 + p];
    }
    for (int e = tid; e < 1024; e += NTHREADS) { CCr[e] = A.in(19)[(size_t)l * 16384 + g * 1024 + e]; CCi[e] = A.in(20)[(size_t)l * 16384 + g * 1024 + e]; }
    __syncthreads();
    for (int e = tid; e < 4096; e += NTHREADS) { const int tau = e >> 8, c = (e >> 4) & 15, cp = e & 15; float s = 0.f;
        for (int p = 0; p < 64; ++p) { const float wr = CCr[c * 64 + p] * PWr[tau * 64 + p] - CCi[c * 64 + p] * PWi[tau * 64 + p], wi = CCr[c * 64 + p] * PWi[tau * 64 + p] + CCi[c * 64 + p] * PWr[tau * 64 + p];
            s += wr * BBr[p * 16 + cp] - wi * BBi[p * 16 + cp]; }
        KE[e] = s; }
    __syncthreads();
    const float* dsk = A.in(21) + l * 256 + g * 16;
    bf16* TM = (bf16*)(base + SSG_TM); bf16* GM = (bf16*)(base + SSG_GM); bf16* HM = (bf16*)(base + SSG_HM);
    for (int e = tid; e < 65536; e += NTHREADS) { const int n = e >> 8, k = e & 255, tp = n >> 4, c = n & 15, sp = k >> 4, cp = k & 15;
        float v = (sp <= tp) ? KE[((tp - sp) << 8) + (c << 4) + cp] : 0.f; if (sp == tp && c == cp) v += dsk[c];
        TM[e] = (bf16)f2bf(v); }
    for (int e = tid; e < 32768; e += NTHREADS) { const int n = e >> 8, k = e & 255, p = n & 63, im = n >> 6, sp = k >> 4, cp = k & 15, m = 15 - sp;
        const float wr = PWr[m * 64 + p] * BBr[p * 16 + cp] - PWi[m * 64 + p] * BBi[p * 16 + cp], wi = PWr[m * 64 + p] * BBi[p * 16 + cp] + PWi[m * 64 + p] * BBr[p * 16 + cp];
        GM[e] = (bf16)f2bf(im ? wi : wr); }
    for (int e = tid; e < 32768; e += NTHREADS) { const int n = e >> 7, k = e & 127, tp = n >> 4, c = n & 15, p = k & 63, im = k >> 6, m = tp + 1;
        const float wr = CCr[c * 64 + p] * PWr[m * 64 + p] - CCi[c * 64 + p] * PWi[m * 64 + p], wi = CCr[c * 64 + p] * PWi[m * 64 + p] + CCi[c * 64 + p] * PWr[m * 64 + p];
        HM[e] = (bf16)f2bf(im ? -wi : wr); }
    __syncthreads();
}

__device__ __forceinline__ void ssm_v2(const KA& A, const Ctx& F, int l, int b, int g) {
    bf16* PS = (bf16*)(F.ws + WS_PS);
    float* ZF = (float*)F.lds;
    const unsigned char* base = F.ws + WS_SSM + (size_t)(l * 16 + g) * SSG_BYTES;
    const bf16* TM = (const bf16*)(base + SSG_TM); const bf16* GM = (const bf16*)(base + SSG_GM); const bf16* HM = (const bf16*)(base + SSG_HM); const float* lam = (const float*)(base + SSG_LAM);
    const int lane = F.lane, w = F.wave, r32 = lane & 31, hh = lane >> 5;
    const size_t tok0 = (size_t)b * SEQ + 512 * w;
    bf16x8_t uf[16];
    { const bf16* up = PS + (tok0 + 16 * r32) * PSW + C_SSM + 16 * g + 8 * hh;
#pragma unroll
      for (int s = 0; s < 16; ++s) uf[s] = *(const bf16x8_t*)(up + (size_t)s * PSW); }
#pragma unroll 1
    for (int nt = 0; nt < 4; ++nt) {
        f32x16 acc = {};
        const bf16* gp = GM + (size_t)(32 * nt + r32) * 256 + 8 * hh;
#pragma unroll
        for (int s = 0; s < 16; ++s) acc = __builtin_amdgcn_mfma_f32_32x32x16_bf16(uf[s], *(const bf16x8_t*)(gp + 16 * s), acc, 0, 0, 0);
#pragma unroll
        for (int q = 0; q < 16; ++q) ZF[(32 * w + crow16(q, hh)) * ZS + 32 * nt + r32] = acc[q];
    }
    __syncthreads();
    if (w == 0) { const float lr = lam[lane], li = lam[64 + lane]; float xr = 0.f, xi = 0.f;
#pragma unroll 8
        for (int j = 0; j < 256; ++j) { const float zr = ZF[j * ZS + lane], zi = ZF[j * ZS + 64 + lane];
            ZF[j * ZS + lane] = xr; ZF[j * ZS + 64 + lane] = xi;
            const float nr = lr * xr - li * xi + zr, ni = lr * xi + li * xr + zi; xr = nr; xi = ni; } }
    __syncthreads();
    bf16x8_t xf[8];
    { const float* zp = ZF + (32 * w + r32) * ZS + 8 * hh;
#pragma unroll
      for (int s = 0; s < 8; ++s) { const f32x4 a0 = *(const f32x4*)(zp + 16 * s), a1 = *(const f32x4*)(zp + 16 * s + 4);
          v4u pw; pw.x = cvtpk(a0[0], a0[1]); pw.y = cvtpk(a0[2], a0[3]); pw.z = cvtpk(a1[0], a1[1]); pw.w = cvtpk(a1[2], a1[3]); xf[s] = __builtin_bit_cast(bf16x8_t, pw); } }
#pragma unroll
    for (int nt = 0; nt < 8; ++nt) {
        f32x16 acc = {};
        const bf16* tp = TM + (size_t)(32 * nt + r32) * 256 + 8 * hh; const bf16* hp = HM + (size_t)(32 * nt + r32) * 128 + 8 * hh;
#pragma unroll
        for (int s = 0; s < 16; ++s) if (s <= 2 * nt + 1) acc = __builtin_amdgcn_mfma_f32_32x32x16_bf16(uf[s], *(const bf16x8_t*)(tp + 16 * s), acc, 0, 0, 0);
#pragma unroll
        for (int s = 0; s < 8; ++s) acc = __builtin_amdgcn_mfma_f32_32x32x16_bf16(xf[s], *(const bf16x8_t*)(hp + 16 * s), acc, 0, 0, 0);
        bf16* op = PS + (tok0 + 2 * nt + (r32 >> 4)) * PSW + C_SSM + 16 * g + (r32 & 15);
#pragma unroll
        for (int q = 0; q < 16; ++q) { const bf16 gv_ = (bf16)f2bf(gelu_tanh(acc[q])); if (!(F.dry && (DRY_SEL & 2))) op[(size_t)(16 * crow16(q, hh)) * PSW] = gv_; }
    }
    __syncthreads();
}
typedef GAS unsigned gu32;
#define RLX_AGENT __ATOMIC_RELAXED, __HIP_MEMORY_SCOPE_AGENT
#define XB_TMO      128
#define XB_XCNT(j)  (256  + 64 * (j))
#define XB_XSUB(j)  (1280 + 64 * (j))
#define XB_XGEN(j)  (2304 + 64 * (j))
#define XB_TOP      3328
#define XB_TOPGEN   3392
#define XCD_BAR_WORDS 3456
#define XB_SPIN_CAP (1u << 18)

__device__ __forceinline__ unsigned xb_ld(unsigned* p)              { return __hip_atomic_load(p, __ATOMIC_RELAXED, __HIP_MEMORY_SCOPE_AGENT); }
__device__ __forceinline__ unsigned xb_add(unsigned* p, unsigned v) { return __hip_atomic_fetch_add(p, v, __ATOMIC_RELAXED, __HIP_MEMORY_SCOPE_AGENT); }
__device__ __forceinline__ unsigned xb_xcc_id() { return (unsigned)__builtin_amdgcn_s_getreg((3 << 11) | 20) & 0xFu; }
#define XB_SPIN(cond, bar) do { unsigned _sp = 0; while (cond) { __builtin_amdgcn_s_sleep(1); \
    if ((++_sp & 255u) == 0u) { if (xb_ld(&(bar)[XB_TMO])) break; if (_sp > XB_SPIN_CAP) { atomicAdd(&(bar)[XB_TMO], 1u); break; } } } } while (0)

struct XcdBarrier {
    unsigned* bar; unsigned x;
    volatile LAS unsigned* st;
};

__device__ __forceinline__ XcdBarrier xcd_barrier_post(unsigned* bar, volatile LAS unsigned* st) {
    XcdBarrier b; b.bar = bar; b.x = xb_xcc_id(); b.st = st;
    if (threadIdx.x == 0) (void)xb_add(&bar[XB_XCNT(b.x)], 1u);
    return b;
}
__device__ __forceinline__ void xcd_barrier_complete(unsigned* bar, unsigned x, unsigned& nloc, unsigned& nx) {
    const unsigned G = gridDim.x * gridDim.y * gridDim.z;
    unsigned sum, cnt, mine, sp = 0u;
    for (;;) {
        sum = 0u; cnt = 0u; mine = 0u;
#pragma unroll
        for (unsigned j = 0; j < 16; ++j) { const unsigned c = xb_ld(&bar[XB_XCNT(j)]); sum += c; cnt += (c > 0u) ? 1u : 0u; mine = (j == x) ? c : mine; }
        if (sum == G) break;
        __builtin_amdgcn_s_sleep(1);
        if ((++sp & 255u) == 0u) { if (xb_ld(&bar[XB_TMO])) break; if (sp > XB_SPIN_CAP) { atomicAdd(&bar[XB_TMO], 1u); break; } }
    }
    nloc = mine > 0u ? mine : 1u; nx = cnt > 0u ? cnt : 1u;
}

__device__ __forceinline__ void xcd_barrier(const XcdBarrier& b) {
    asm volatile("s_waitcnt vmcnt(0)" ::: "memory");
    __syncthreads();
    if (threadIdx.x == 0) {
        unsigned* bar = b.bar;
        __builtin_amdgcn_s_waitcnt(0);
        unsigned nloc = b.st[0], nx = b.st[1];
        if (nloc == 0u) { xcd_barrier_complete(bar, b.x, nloc, nx); b.st[0] = nloc; b.st[1] = nx; }
        const unsigned old = xb_add(&bar[XB_XSUB(b.x)], 1u);
        const unsigned gen = old / nloc;
        if (old + 1u == (gen + 1u) * nloc) {
            __builtin_amdgcn_fence(__ATOMIC_RELEASE, "agent");
            asm volatile("s_waitcnt vmcnt(0)" ::: "memory");
            const unsigned og = xb_add(&bar[XB_TOP], 1u);
            const unsigned tg = og / nx;
            if (og + 1u == (tg + 1u) * nx) xb_add(&bar[XB_TOPGEN], 1u);
            else XB_SPIN(xb_ld(&bar[XB_TOPGEN]) == tg, bar);
            __builtin_amdgcn_fence(__ATOMIC_ACQUIRE, "agent");
            xb_add(&bar[XB_XGEN(b.x)], 1u);
            asm volatile("s_waitcnt vmcnt(0)" ::: "memory");
        } else {
            XB_SPIN(xb_ld(&bar[XB_XGEN(b.x)]) == gen, bar);
            __builtin_amdgcn_fence(__ATOMIC_ACQUIRE, "agent");
            asm volatile("s_waitcnt vmcnt(0)" ::: "memory");
        }
    }
    __syncthreads();
}

constexpr int PPL = 10, NPH = 2 + DEPTH * PPL;

__device__ __forceinline__ void run_phase(const KA& A, const Ctx& F, int ph) {
    PG8_LAS unsigned char* lds3 = (PG8_LAS unsigned char*)F.lds;
    bf16* XN = (bf16*)(F.ws + WS_XN); bf16* PS = (bf16*)(F.ws + WS_PS); bf16* SO = (bf16*)(F.ws + WS_SO);
    const int l = (ph - 1) / PPL, k = (ph == 0) ? 20 : (ph == NPH - 1 ? 21 : (ph - 1) % PPL);
    unsigned char* wl = F.ws + WS_W + (size_t)l * W_LAYER;
    const float* hin = (l == 0) ? A.in(0) : F.out;
    int ngemm = 0;
    if (k == 20) { phase_prep(A, F); for (int it = F.bid; it < 32; it += F.G) ssm_prep(A, F, it >> 4, it & 15); }
    else if (k == 21) phase_rmsnorm<true>(A, F, F.out, A.in(31), F.out);
    else if (k == 0) phase_rmsnorm<false>(A, F, hin, A.in(1) + l * D, XN);
    else if (k == 7) phase_rmsnorm<false>(A, F, F.out, A.in(28) + l * D, XN);
    else if (k == 2) rwkv_p1(A, F, l);
    else if (k == 3) {
        if (F.bid < 48) rwkv_scan(A, F, l, F.bid / 6, F.bid % 6);
        else if (F.bid < 176) { const int it = F.bid - 48; ssm_v2(A, F, l, it / 16, it % 16); }
        __syncthreads();
        attn_v2(A, F, l);
    }
    else if (k == 4) { rwkv_p3(A, F); attn_finalize(A, F); ngemm = 1; }
    else if (k == 5) ngemm = 3;
    else ngemm = 1;
#pragma unroll 1
    for (int gi = 0; gi < ngemm; ++gi) {
        pg8::Gemm g; pg8::EpiAny E; E.kind = 0; E.gi = gi; E.ws = F.ws; E.base = hin; E.out = F.out;
        if (k == 1) { g = pg8::Gemm{XN, (const bf16*)(wl + WO_IN), NIN, D, D}; E.kind = 0; }
        else if (k == 4) { g = pg8::Gemm{PS + C_SSM, (const bf16*)(wl + WO_GLU), 512, 256, PSW}; E.kind = 4; }
        else if (k == 5) { E.kind = 1;
            if (gi == 0) g = pg8::Gemm{PS + C_Q, (const bf16*)(wl + WO_BA), D, 384, PSW};
            else if (gi == 1) g = pg8::Gemm{PS + C_RW, (const bf16*)(wl + WO_BR), D, 384, PSW};
            else g = pg8::Gemm{SO, (const bf16*)(wl + WO_BS), D, 256, 256}; }
        else if (k == 6) { g = pg8::Gemm{XN, (const bf16*)(wl + WO_OUT), D, D, D}; E.kind = 2; }
        else if (k == 8) { g = pg8::Gemm{XN, (const bf16*)(wl + WO_GU), 2 * FFH, D, D}; E.kind = 3; }
        else { g = pg8::Gemm{PS, (const bf16*)(wl + WO_DN), D, FFH, FFH}; E.kind = 2; E.base = F.out; }
        pg8::StaticOrder S; S.init(g.N, F.G, F.bid);
        pg8::gemm_phase<pg8::EpiAny, pg8::StaticOrder, true>(lds3, g, S, E);
    }
}

static_assert(pg8::EP_XN == WS_XN && pg8::EP_PS == WS_PS && pg8::EP_GT == WS_GT && pg8::EP_SO == WS_SO && pg8::EP_BR == WS_BR, "epilogue workspace offsets");

__global__ void __launch_bounds__(NTHREADS, 2) mega_fwd(Args args) {
    extern __shared__ __attribute__((aligned(16))) unsigned char lds[];
#if ONE_LAUNCH
    volatile LAS unsigned* misc = (volatile LAS unsigned*)((LAS unsigned char*)lds + MISC_OFF);
    if (threadIdx.x < 32) misc[threadIdx.x] = 0u;
    __syncthreads();
    XcdBarrier bar = xcd_barrier_post((unsigned*)(args.ws + WS_CTL) + CW_BAR, misc + 8);
#endif
#pragma unroll 1
    for (int ph = args.ph_lo; ph < args.ph_hi; ++ph) {
        int nrep_ = 1;
#ifdef REP_MASK
        { const int kk_ = (ph == 0 || ph == NPH - 1) ? 99 : (ph - 1) % PPL; const int ll_ = (ph - 1) / PPL;
          if ((kk_ < 16) && ((REP_MASK >> kk_) & 1) && !(kk_ == 6 && ll_ == 1)) nrep_ = 2;
          if (ph == 0 && ((REP_MASK >> 15) & 1)) nrep_ = 2; }
#endif
#pragma unroll 1
        for (int rp_ = 0; rp_ < nrep_; ++rp_) {
            KA A; A.p = (kptr_t)__builtin_amdgcn_kernarg_segment_ptr(); asm volatile("" : "+s"(A.p));
            int tid = threadIdx.x, bid = blockIdx.x, G = gridDim.x; asm volatile("" : "+v"(tid), "+s"(bid), "+s"(G));
            Ctx F;
            F.lds = lds; F.ws = A.ws(); F.out = A.out();
            F.tid = tid; F.lane = tid & 63; F.wave = __builtin_amdgcn_readfirstlane(tid >> 6); F.G = G; F.bid = bid; F.dry = (nrep_ == 2 && rp_ == 0) ? 1 : 0;
            run_phase(A, F, ph);
            __syncthreads();
        }
#if ONE_LAUNCH
        if (ph + 1 < args.ph_hi) {
#ifdef EXTRA_SYNCS
            for (int e_ = 0; e_ < EXTRA_SYNCS; ++e_) { XcdBarrier b2 = bar; asm volatile("" : "+s"(b2.bar)); xcd_barrier(b2); }
#endif
            if (ph == 0) { __threadfence(); cg::this_grid().sync(); }
            else { XcdBarrier b2 = bar; asm volatile("" : "+s"(b2.bar)); xcd_barrier(b2); } }
#endif
    }
}

extern "C" void kernel_launch(void* const* d_in, const int* in_sizes, int n_in, void* d_out, int out_size, void* d_ws, size_t ws_size, hipStream_t stream) {
    static int grid = 0;
    if (grid == 0) {
        if (n_in != 32 || in_sizes[0] != T * D || out_size != T * D || ws_size < WS_END) { fprintf(stderr, "kernel_launch: unexpected shapes (n_in %d, in0 %d, out %d, ws %zu); nothing launched\n", n_in, n_in > 0 ? in_sizes[0] : -1, out_size, ws_size); grid = -1; return; }
        int dev = 0, cus = 0, per_cu = 0;
        if (hipGetDevice(&dev) != hipSuccess || hipDeviceGetAttribute(&cus, hipDeviceAttributeMultiprocessorCount, dev) != hipSuccess) { grid = -1; return; }
        if (hipFuncSetAttribute((const void*)mega_fwd, hipFuncAttributeMaxDynamicSharedMemorySize, LDS_BYTES) != hipSuccess) { fprintf(stderr, "kernel_launch: hipFuncSetAttribute failed\n"); grid = -1; return; }
        if (hipOccupancyMaxActiveBlocksPerMultiprocessor(&per_cu, (const void*)mega_fwd, NTHREADS, LDS_BYTES) != hipSuccess || per_cu < 1) { fprintf(stderr, "kernel_launch: occupancy query says %d\n", per_cu); per_cu = 1; }
        (void)hipGetLastError();
        grid = cus;
        if (grid < 200) { fprintf(stderr, "kernel_launch: needs >= 200 CUs, got %d\n", grid); grid = -1; return; }
    }
    if (grid < 0) return;
    if (hipMemsetAsync((char*)d_ws + WS_CTL, 0, CTL_ZERO_BYTES, stream) != hipSuccess) { fprintf(stderr, "kernel_launch: hipMemsetAsync failed\n"); return; }
    Args a{};
    for (int i = 0; i < 32; ++i) a.in[i] = (const float*)d_in[i];
    a.out = (float*)d_out; a.ws = (unsigned char*)d_ws;
#if ONE_LAUNCH
    a.ph_lo = 0; a.ph_hi = NPH;
    void* kargs[] = {&a};
    hipError_t e = hipLaunchCooperativeKernel((const void*)mega_fwd, dim3(grid), dim3(NTHREADS), kargs, LDS_BYTES, stream);
    if (e != hipSuccess) fprintf(stderr, "kernel_launch: cooperative launch failed: %s (grid %d)\n", hipGetErrorString(e), grid);
#else
    for (int ph = 0; ph < NPH; ++ph) {
        a.ph_lo = ph; a.ph_hi = ph + 1;
        hipLaunchKernelGGL(mega_fwd, dim3(grid), dim3(NTHREADS), LDS_BYTES, stream, a);
    }
#endif
}
```

```cpp
#include <hip/hip_runtime.h>
#include <hip/hip_cooperative_groups.h>
#include <cstdio>
#include <cstdint>
namespace cg = cooperative_groups;
#ifndef ONE_LAUNCH
#define ONE_LAUNCH 1
#endif
namespace pg8 {
#define PG8_LAS __attribute__((address_space(3)))
typedef unsigned short bf16_t;
typedef short bf16x8 __attribute__((ext_vector_type(8)));
typedef float f32x4 __attribute__((ext_vector_type(4)));
typedef float f32x2 __attribute__((ext_vector_type(2)));
typedef unsigned u32x4 __attribute__((ext_vector_type(4)));
typedef unsigned u32x2 __attribute__((ext_vector_type(2)));
constexpr int BM = 256, BK = 64, HALF = 128, HTB = HALF * BK * 2  , STAGE_BYTES = 8 * HTB, NXCD = 8, WGM = 8;

__host__ __device__ __forceinline__ int lds_byte(int r, int c) { const int st = (r >> 4) * 2 + (c >> 5), rr = r & 15, cc = c & 31, ob = rr * 64 + cc * 2; return st * 1024 + (ob ^ (((ob >> 9) & 1) << 5)); }
__host__ __device__ __forceinline__ void stage_rc(int b, int& R, int& C) { const int st = b / 1024, sb = b % 1024, swz = sb ^ (((sb >> 9) & 1) << 5); R = (st >> 1) * 16 + swz / 64; C = (st & 1) * 32 + (swz % 64) / 2; }
__host__ __device__ __forceinline__ int perm32(int rho) { const int n = rho >> 4, i = rho & 15; return 8 * (i >> 2) + 4 * n + (i & 3); }

struct Unit { int pm, pn; };
constexpr size_t EP_XN = 68ull << 20, EP_PS = 132ull << 20, EP_GT = 308ull << 20, EP_SO = 404ull << 20, EP_BR = 421ull << 20;
struct Gemm { const bf16_t* A; const bf16_t* Bt; int N, K, lda; };

struct StaticOrder {
    static constexpr int nM = 128;
    int nN, G, c;
    __host__ __device__ void init(int N, int G_, int c_) { nN = N / BM; G = G_; c = c_; }
    __host__ __device__ bool next(int i, Unit& u) const {
        const int L = i * G + c; if (L >= nM * nN) return false;
        const int xcd = L & 7, off = L >> 3, nig = 8 * nN, hi = (off >= nig) ? 1 : 0, rem = off - hi * nig;
        u.pm = (2 * xcd + hi) * 8 + (rem & 7); u.pn = rem >> 3; return true;
    }
    __device__ __forceinline__ void a_ready(const Unit&) const {}
    __device__ __forceinline__ void done(const Unit&) const {}
};

__device__ __forceinline__ unsigned cvt_pk_bf16(float lo, float hi) { unsigned r; asm volatile("v_cvt_pk_bf16_f32 %0, %1, %2" : "=v"(r) : "v"(lo), "v"(hi)); return r; }
__device__ __forceinline__ float bf_lo(unsigned w) { return __uint_as_float(w << 16); }
__device__ __forceinline__ float bf_hi(unsigned w) { return __uint_as_float(w & 0xffff0000u); }
__device__ __forceinline__ float sigmoidf_(float x) { return __builtin_amdgcn_rcpf(1.0f + __expf(-x)); }


struct EpiAny;
__device__ __forceinline__ void epi_win(bf16_t* PS, unsigned char* GT, bf16_t* BRW, const f32x4 (&acc)[2][2][4][2], const Unit& u, int wr, int wc, int fr, int fq) {
        const int row0 = u.pm * BM + wr * 64 + fr;
        if (u.pn < 11) {
            const int col0 = u.pn * BM + wc * 32 + 8 * fq;
#pragma unroll
            for (int ai = 0; ai < 2; ++ai)
#pragma unroll
                for (int m = 0; m < 4; ++m) { bf16_t* rowp = PS + (size_t)(row0 + ai * HALF + m * 16) * 2816 + col0;
#pragma unroll
                    for (int bj = 0; bj < 2; ++bj) { const f32x4 v0 = acc[ai][bj][m][0], v1 = acc[ai][bj][m][1];
                        u32x4 w; w.x = cvt_pk_bf16(v0[0], v0[1]); w.y = cvt_pk_bf16(v0[2], v0[3]); w.z = cvt_pk_bf16(v1[0], v1[1]); w.w = cvt_pk_bf16(v1[2], v1[3]);
                        *(u32x4*)(rowp + bj * HALF) = w;
                        if (m == 3 && fr == 15) *(u32x4*)(BRW + (size_t)((row0 + ai * HALF + m * 16) >> 6) * 2816 + col0 + bj * HALF) = w; } }
        } else {
            const int col0 = (u.pn - 11) * BM + wc * 32 + 8 * fq;
#pragma unroll
            for (int ai = 0; ai < 2; ++ai)
#pragma unroll
                for (int m = 0; m < 4; ++m) { unsigned char* rowp = GT + (size_t)(row0 + ai * HALF + m * 16) * 3072 + col0;
#pragma unroll
                    for (int bj = 0; bj < 2; ++bj) { const f32x4 v0 = acc[ai][bj][m][0], v1 = acc[ai][bj][m][1];
                        unsigned q[8];
#pragma unroll
                        for (int k = 0; k < 4; ++k) { q[k] = (unsigned)(sigmoidf_(v0[k]) * 255.0f + 0.5f); q[4 + k] = (unsigned)(sigmoidf_(v1[k]) * 255.0f + 0.5f); }
                        u32x2 w; w.x = q[0] | (q[1] << 8) | (q[2] << 16) | (q[3] << 24); w.y = q[4] | (q[5] << 8) | (q[6] << 16) | (q[7] << 24);
                        *(u32x2*)(rowp + bj * HALF) = w; } }
        }
    }

__device__ __forceinline__ void epi_merge(bf16_t* MG, const unsigned char* GT, int gi, const f32x4 (&acc)[2][2][4][2], const Unit& u, int wr, int wc, int fr, int fq) {
        const int row0 = u.pm * BM + wr * 64 + fr, col0 = u.pn * BM + wc * 32 + 8 * fq;
#pragma unroll
        for (int ai = 0; ai < 2; ++ai)
#pragma unroll
            for (int m = 0; m < 4; ++m) { const size_t r = (size_t)(row0 + ai * HALF + m * 16);
#pragma unroll
                for (int bj = 0; bj < 2; ++bj) { const int c = col0 + bj * HALF;
                    const u32x2 gq = *(const u32x2*)(GT + r * 3072 + gi * 1024 + c);
                    float v[8];
#pragma unroll
                    for (int k = 0; k < 4; ++k) { v[k] = acc[ai][bj][m][0][k] * ((float)((gq.x >> (8 * k)) & 255u) * (1.0f / 255.0f)); v[4 + k] = acc[ai][bj][m][1][k] * ((float)((gq.y >> (8 * k)) & 255u) * (1.0f / 255.0f)); }
                    u32x4* dst = (u32x4*)(MG + r * 1024 + c);
                    if (gi > 0) { const u32x4 p = *dst;
                        v[0] += bf_lo(p.x); v[1] += bf_hi(p.x); v[2] += bf_lo(p.y); v[3] += bf_hi(p.y); v[4] += bf_lo(p.z); v[5] += bf_hi(p.z); v[6] += bf_lo(p.w); v[7] += bf_hi(p.w); }
                    u32x4 w; w.x = cvt_pk_bf16(v[0], v[1]); w.y = cvt_pk_bf16(v[2], v[3]); w.z = cvt_pk_bf16(v[4], v[5]); w.w = cvt_pk_bf16(v[6], v[7]);
                    *dst = w; } }
    }

__device__ __forceinline__ void epi_res(const float* base, float* out, const f32x4 (&acc)[2][2][4][2], const Unit& u, int wr, int wc, int fr, int fq) {
        const int row0 = u.pm * BM + wr * 64 + fr, col0 = u.pn * BM + wc * 32 + 4 * fq;
#pragma unroll
        for (int ai = 0; ai < 2; ++ai)
#pragma unroll
            for (int m = 0; m < 4; ++m) { const size_t off = (size_t)(row0 + ai * HALF + m * 16) * 1024 + col0;
#pragma unroll
                for (int bj = 0; bj < 2; ++bj)
#pragma unroll
                    for (int n = 0; n < 2; ++n) { const f32x4 b = *(const f32x4*)(base + off + bj * HALF + n * 16); *(f32x4*)(out + off + bj * HALF + n * 16) = b + acc[ai][bj][m][n]; } }
    }

template <int MODE> __device__ __forceinline__ void epi_pair(bf16_t* O, int ldo, const f32x4 (&acc)[2][2][4][2], const Unit& u, int wr, int wc, int fr, int fq) {
        const int row0 = u.pm * BM + wr * 64 + fr, col0 = u.pn * HALF + wc * 32 + 8 * fq;
#pragma unroll
        for (int ai = 0; ai < 2; ++ai)
#pragma unroll
            for (int m = 0; m < 4; ++m) { bf16_t* rowp = O + (size_t)(row0 + ai * HALF + m * 16) * ldo + col0;
                float v[8];
#pragma unroll
                for (int n = 0; n < 2; ++n)
#pragma unroll
                    for (int k = 0; k < 4; ++k) { const float a = acc[ai][0][m][n][k], b = acc[ai][1][m][n][k];
                        v[4 * n + k] = (MODE == 0) ? (a * sigmoidf_(a) * b) : (a * sigmoidf_(b)); }
                u32x4 w; w.x = cvt_pk_bf16(v[0], v[1]); w.y = cvt_pk_bf16(v[2], v[3]); w.z = cvt_pk_bf16(v[4], v[5]); w.w = cvt_pk_bf16(v[6], v[7]);
                *(u32x4*)rowp = w; }
    }


struct EpiAny {
    int kind;
    int gi; unsigned char* ws; const float* base; float* out;
    __device__ __forceinline__ bool perm() const { return kind != 2; }
    __device__ __forceinline__ void operator()(const f32x4 (&acc)[2][2][4][2], const Unit& u, int wr, int wc, int fr, int fq) const {
        if (kind == 0) epi_win((bf16_t*)(ws + EP_PS), ws + EP_GT, (bf16_t*)(ws + EP_BR), acc, u, wr, wc, fr, fq);
        else if (kind == 1) epi_merge((bf16_t*)(ws + EP_XN), ws + EP_GT, gi, acc, u, wr, wc, fr, fq);
        else if (kind == 2) epi_res(base, out, acc, u, wr, wc, fr, fq);
        else if (kind == 3) epi_pair<0>((bf16_t*)(ws + EP_PS), 2816, acc, u, wr, wc, fr, fq);
        else epi_pair<1>((bf16_t*)(ws + EP_SO), 256, acc, u, wr, wc, fr, fq);
    }
};

template <class Epi, class Sched, bool ALIGN_EPI = false>
__device__ __forceinline__ void gemm_phase(PG8_LAS unsigned char* lds, const Gemm g, const Sched& S, const Epi& E) {
    int tid_ = threadIdx.x; asm volatile("" : "+v"(tid_));
    const int tid = tid_, wid = __builtin_amdgcn_readfirstlane(tid >> 6), lane = tid & 63, wr = wid >> 2, wc = wid & 3, fr = lane & 15, fq = lane >> 4;
    const int K = g.K, lda = g.lda, nt = K / BK;
    unsigned voffA[2], voffB[2];
#pragma unroll
    for (int i = 0; i < 2; ++i) { int R, C; stage_rc(tid * 16 + i * 8192, R, C); const int Rb = E.perm() ? ((R & ~31) + perm32(R & 31)) : R;
        voffA[i] = (unsigned)(R * lda + C) * 2u; voffB[i] = (unsigned)(Rb * K + C) * 2u; }
    const size_t kstep = (size_t)(BK * 2);
    const size_t hstepA = (size_t)HALF * lda * 2, hstepB = (size_t)HALF * K * 2;
    const size_t tstepA = 2 * hstepA, tstepB = 2 * hstepB;
    const unsigned ldsw = (unsigned)wid * 1024u;
    const int aoff = lds_byte(wr * 64 + fr, fq * 8), boff = lds_byte(wc * 32 + fr, fq * 8);
#define PG8_SA(b, h) (((b) * 2 + (h)) * HTB)
#define PG8_SB(b, h) ((4 + (b) * 2 + (h)) * HTB)
#define PG8_STAGE(bufoff, gbase, voff) do { _Pragma("unroll") for (int _i = 0; _i < 2; ++_i) \
        __builtin_amdgcn_global_load_lds((const unsigned*)((const char*)(gbase) + (voff)[_i]), (PG8_LAS unsigned*)(lds + (bufoff) + ldsw + _i * 8192), 16, 0, 0); } while (0)
#define PG8_LDA(dst, b, h) do { _Pragma("unroll") for (int m = 0; m < 4; ++m) _Pragma("unroll") for (int k = 0; k < 2; ++k) dst[m][k] = *(const PG8_LAS bf16x8*)(lds + PG8_SA(b, h) + aoff + m * 2048 + k * 1024); } while (0)
#define PG8_LDB(dst, b, h) do { _Pragma("unroll") for (int n = 0; n < 2; ++n) _Pragma("unroll") for (int k = 0; k < 2; ++k) dst[n][k] = *(const PG8_LAS bf16x8*)(lds + PG8_SB(b, h) + boff + n * 2048 + k * 1024); } while (0)
#define PG8_MMA(ai, bj, At, Bt) do { __builtin_amdgcn_s_setprio(1); _Pragma("unroll") for (int m = 0; m < 4; ++m) _Pragma("unroll") for (int n = 0; n < 2; ++n) _Pragma("unroll") for (int k = 0; k < 2; ++k) \
        acc[ai][bj][m][n] = __builtin_amdgcn_mfma_f32_16x16x32_bf16(Bt[n][k], At[m][k], acc[ai][bj][m][n], 0, 0, 0); __builtin_amdgcn_s_setprio(0); } while (0)
#define PG8_WAIT_V(n) asm volatile("s_waitcnt vmcnt(" #n ")" ::: "memory")
#define PG8_WAIT_L(n) asm volatile("s_waitcnt lgkmcnt(" #n ")" ::: "memory")
#define PG8_BAR __builtin_amdgcn_s_barrier()
#define PG8_SCHED __builtin_amdgcn_sched_barrier(0)
    Unit cur, nxt; int ui = 0;
    if (!S.next(0, cur)) return;
    f32x4 acc[2][2][4][2];
#pragma unroll
    for (int a = 0; a < 2; ++a)
#pragma unroll
        for (int b = 0; b < 2; ++b)
#pragma unroll
            for (int m = 0; m < 4; ++m)
#pragma unroll
                for (int n = 0; n < 2; ++n) acc[a][b][m][n] = (f32x4){0.f, 0.f, 0.f, 0.f};
    bf16x8 At[4][2], B0[2][2], B1[2][2];
    const char* cA = (const char*)g.A + (size_t)cur.pm * tstepA; const char* cB = (const char*)g.Bt + (size_t)cur.pn * tstepB;
    S.a_ready(cur);
    PG8_STAGE(PG8_SB(0, 0), cB, voffB); PG8_STAGE(PG8_SB(0, 1), cB + hstepB, voffB); PG8_STAGE(PG8_SA(0, 0), cA, voffA); PG8_STAGE(PG8_SA(0, 1), cA + hstepA, voffA);
    if (wr == 1) PG8_BAR;
    PG8_WAIT_V(2); PG8_BAR;
    PG8_STAGE(PG8_SB(1, 0), cB + kstep, voffB); PG8_STAGE(PG8_SA(1, 0), cA + kstep, voffA); PG8_STAGE(PG8_SB(1, 1), cB + hstepB + kstep, voffB);
    PG8_WAIT_V(6); PG8_BAR;
    for (;;) {
        const bool has_next = S.next(ui + 1, nxt);
        const char* nA = has_next ? (const char*)g.A + (size_t)nxt.pm * tstepA : cA; const char* nB = has_next ? (const char*)g.Bt + (size_t)nxt.pn * tstepB : cB;
        for (int t = 0; t < nt; t += 2) {
            const bool last = (t == nt - 2);
            const char* a1 = cA + (size_t)(t + 1) * kstep;
            const char* a2 = last ? nA : cA + (size_t)(t + 2) * kstep; const char* b2 = last ? nB : cB + (size_t)(t + 2) * kstep;
            const char* a3 = a2 + kstep; const char* b3 = b2 + kstep;
            if (last && has_next) S.a_ready(nxt);
            PG8_LDB(B0, 0, 0); PG8_LDB(B1, 0, 1); PG8_SCHED; PG8_LDA(At, 0, 0); PG8_STAGE(PG8_SA(1, 1), a1 + hstepA, voffA);
            PG8_WAIT_V(8); PG8_WAIT_L(0); PG8_BAR; PG8_MMA(0, 0, At, B0); PG8_MMA(0, 1, At, B1); PG8_BAR; PG8_SCHED;
            PG8_LDA(At, 0, 1); PG8_STAGE(PG8_SB(0, 0), b2, voffB); PG8_STAGE(PG8_SB(0, 1), b2 + hstepB, voffB); PG8_STAGE(PG8_SA(0, 0), a2, voffA);
            PG8_WAIT_V(8); PG8_WAIT_L(0); PG8_BAR; PG8_MMA(1, 0, At, B0); PG8_MMA(1, 1, At, B1); PG8_BAR; PG8_SCHED;
            PG8_LDB(B0, 1, 0); PG8_LDB(B1, 1, 1); PG8_SCHED; PG8_LDA(At, 1, 0); PG8_STAGE(PG8_SA(0, 1), a2 + hstepA, voffA);
            PG8_WAIT_V(8); PG8_WAIT_L(0); PG8_BAR; PG8_MMA(0, 0, At, B0); PG8_MMA(0, 1, At, B1); PG8_BAR; PG8_SCHED;
            PG8_LDA(At, 1, 1); PG8_STAGE(PG8_SB(1, 0), b3, voffB); PG8_STAGE(PG8_SB(1, 1), b3 + hstepB, voffB); PG8_STAGE(PG8_SA(1, 0), a3, voffA);
            PG8_WAIT_V(8); PG8_WAIT_L(0); PG8_BAR; PG8_MMA(1, 0, At, B0); PG8_MMA(1, 1, At, B1); PG8_BAR; PG8_SCHED;
        }
        if constexpr (ALIGN_EPI) { if (wr == 0) PG8_BAR; }
        E(acc, cur, wr, wc, fr, fq); S.done(cur);
        if (!has_next) break;
#pragma unroll
        for (int a = 0; a < 2; ++a)
#pragma unroll
            for (int b = 0; b < 2; ++b)
#pragma unroll
                for (int m = 0; m < 4; ++m)
#pragma unroll
                    for (int n = 0; n < 2; ++n) acc[a][b][m][n] = (f32x4){0.f, 0.f, 0.f, 0.f};
        cur = nxt; cA = nA; cB = nB; ++ui;
        if constexpr (ALIGN_EPI) { if (wr == 1) PG8_BAR; }
    }
    PG8_WAIT_V(0);
    if constexpr (!ALIGN_EPI) { if (wr == 0) PG8_BAR; }
    PG8_BAR;
#undef PG8_SA
#undef PG8_SB
#undef PG8_STAGE
#undef PG8_LDA
#undef PG8_LDB
#undef PG8_MMA
#undef PG8_WAIT_V
#undef PG8_WAIT_L
#undef PG8_BAR
#undef PG8_SCHED
}
}
constexpr int NWAVES = 8, NTHREADS = 512;
constexpr int BATCH = 8, SEQ = 4096, T = BATCH * SEQ, D = 1024, DEPTH = 2;
constexpr int NIN = 5888, PSW = 2816, NGATE = 3072, FFH = 2816;
constexpr int C_Q = 0, C_K = 384, C_V = 768, C_RW = 1152, C_LORA = 2304, C_SSM = 2560;
constexpr float NORM_EPS = 1e-6f, GN_EPS = 64e-5f;

constexpr size_t MiB = 1u << 20;
constexpr size_t WS_CTL = 0, CTL_ZERO_BYTES = 1 * MiB;
constexpr size_t WS_W = 1 * MiB, W_LAYER = 33 * MiB;
constexpr size_t WO_IN = 0, WO_BA = 12 * MiB, WO_BR = WO_BA + 768 * 1024, WO_BS = WO_BR + 768 * 1024, WO_OUT = 14 * MiB, WO_GU = 16 * MiB, WO_DN = 27 * MiB, WO_GLU = 32 * MiB + 512 * 1024,
                 WO_W2 = WO_GLU + 256 * 1024, WO_A2 = WO_W2 + 48 * 1024, WO_G2 = WO_A2 + 48 * 1024;
constexpr size_t WS_XN = 68 * MiB;
constexpr size_t WS_PS = 132 * MiB;
constexpr size_t WS_GT = 308 * MiB;
constexpr size_t WS_SO = 404 * MiB;
constexpr size_t WS_LSE = 420 * MiB;
constexpr size_t WS_SCR = 421 * MiB;
constexpr size_t WS_BR = WS_SCR;
constexpr size_t WS_RMC = WS_SCR + 3 * MiB;
constexpr size_t WS_RNT = WS_RMC + 24 * MiB;
constexpr size_t WS_REM = WS_RNT + 24 * MiB;
constexpr size_t WS_RGL = WS_REM + 24 * MiB;
static_assert(WS_RGL + 1 * MiB <= 512 * MiB, "scratch map");
constexpr size_t WS_END = 512 * MiB;

constexpr int LDS_BYTES = 147456;
constexpr int MISC_OFF = LDS_BYTES - 128;
constexpr int CW_ATT = 1024;
constexpr int CW_BAR = 4096;

#define GAS __attribute__((address_space(1)))
#define LAS __attribute__((address_space(3)))
typedef unsigned short bf16;
typedef unsigned v4u __attribute__((ext_vector_type(4)));
typedef unsigned v2u __attribute__((ext_vector_type(2)));
typedef float f32x4 __attribute__((ext_vector_type(4)));
#define LDS_WAIT() asm volatile("s_waitcnt lgkmcnt(0)" ::: "memory")
#define VM_WAIT() asm volatile("s_waitcnt vmcnt(0)" ::: "memory")
__device__ __forceinline__ unsigned f2bf(float f) { unsigned u = __builtin_bit_cast(unsigned, f); return (u + 0x7fffu + ((u >> 16) & 1u)) >> 16; }
__device__ __forceinline__ unsigned pk2(float lo, float hi) { return f2bf(lo) | (f2bf(hi) << 16); }
__device__ __forceinline__ float bf2f(bf16 b) { return __uint_as_float((unsigned)b << 16); }
__device__ __forceinline__ float bflo(unsigned w) { return __uint_as_float(w << 16); }
__device__ __forceinline__ float bfhi(unsigned w) { return __uint_as_float(w & 0xffff0000u); }
template <int M> __device__ __forceinline__ float shx(float v) { static_assert(M < 32, "shx: xor mask inside a 32-lane half"); return __int_as_float(__builtin_amdgcn_ds_swizzle(__float_as_int(v), (M << 10) | 0x1f)); }
__device__ __forceinline__ float xsum32(float v) { auto r = __builtin_amdgcn_permlane32_swap(__float_as_uint(v), __float_as_uint(v), false, false); return __uint_as_float(r[0]) + __uint_as_float(r[1]); }
__device__ __forceinline__ float xmax32(float v) { auto r = __builtin_amdgcn_permlane32_swap(__float_as_uint(v), __float_as_uint(v), false, false); return fmaxf(__uint_as_float(r[0]), __uint_as_float(r[1])); }
template <int CTRL> __device__ __forceinline__ float dppf(float v) { return __int_as_float(__builtin_amdgcn_update_dpp(0, __float_as_int(v), CTRL, 0xf, 0xf, true)); }
__device__ __forceinline__ float wave_sum(float v) { v += dppf<0xB1>(v); v += dppf<0x4E>(v); v += dppf<0x141>(v); v += dppf<0x140>(v); v += shx<16>(v); return xsum32(v); }
__device__ __forceinline__ float sigm(float x) { return 1.0f / (1.0f + __expf(-x)); }

struct Args { const float* in[32]; float* out; unsigned char* ws; int ph_lo, ph_hi; };

typedef __attribute__((address_space(4))) const unsigned char* kptr_t;
struct KA {
    kptr_t p;
    typedef const float* cfptr_t; typedef float* fptr_t; typedef unsigned char* ucptr_t;
    __device__ __forceinline__ const float* in(int i) const { return *(const __attribute__((address_space(4))) cfptr_t*)(p + 8 * i); }
    __device__ __forceinline__ float* out() const { return *(const __attribute__((address_space(4))) fptr_t*)(p + 256); }
    __device__ __forceinline__ unsigned char* ws() const { return *(const __attribute__((address_space(4))) ucptr_t*)(p + 264); }
};
static_assert(sizeof(Args) == 280, "Args layout");

#ifndef DRY_SEL
#define DRY_SEL 0
#endif
struct Ctx {
    unsigned char* lds; unsigned char* ws; float* out;
    int tid, lane, wave, G, bid;
    int dry;
};

__device__ __forceinline__ void tr_item(const float* W, int ldw, int K, int nblk, bf16* WT, int goff, float* scr, int item, int lane) {
    const int kb = item / nblk, nb = item % nblk, k0 = 64 * kb, n0 = 32 * nb;
#pragma unroll 8
    for (int i = 0; i < 32; ++i) { const int kk = 2 * i + (lane >> 5); scr[kk * 33 + (lane & 31)] = W[(size_t)(k0 + kk) * ldw + n0 + (lane & 31)]; }
    LDS_WAIT(); asm volatile("" ::: "memory");
    const int c = lane & 7;
#pragma unroll
    for (int j = 0; j < 4; ++j) { const int n = (lane >> 3) + 8 * j; const float* s = scr + (8 * c) * 33 + n;
        v4u o; o.x = pk2(s[0 * 33], s[1 * 33]); o.y = pk2(s[2 * 33], s[3 * 33]); o.z = pk2(s[4 * 33], s[5 * 33]); o.w = pk2(s[6 * 33], s[7 * 33]);
        const int nn = n0 + n; const int drow = goff < 0 ? nn : ((nn >> 7) * 256 + goff + (nn & 127));
        *(v4u*)(WT + (size_t)drow * K + k0 + 8 * c) = o; }
    LDS_WAIT(); asm volatile("" ::: "memory");
}

__device__ __forceinline__ void phase_prep(const KA& A, const Ctx& F) {
    float* scr = (float*)(F.lds + F.wave * 16384);
    const int gw = F.bid * NWAVES + F.wave, NGW = F.G * NWAVES;
    constexpr int NM = 13;
    constexpr int cnt[NM] = {16 * 184, 6 * 32, 6 * 32, 4 * 32, 16 * 32, 16 * 88, 16 * 88, 44 * 32, 4 * 8, 4 * 8, 12, 12, 24};
    constexpr int per_layer = cnt[0] + cnt[1] + cnt[2] + cnt[3] + cnt[4] + cnt[5] + cnt[6] + cnt[7] + cnt[8] + cnt[9] + cnt[10] + cnt[11] + cnt[12];
    for (int it = gw; it < DEPTH * per_layer; it += NGW) {
        const int l = it / per_layer; int r = it % per_layer;
        unsigned char* wl = F.ws + WS_W + (size_t)l * W_LAYER;
        if (r < cnt[0]) { tr_item(A.in(2) + (size_t)l * D * NIN, NIN, D, NIN / 32, (bf16*)(wl + WO_IN), -1, scr, r, F.lane); continue; } r -= cnt[0];
        if (r < cnt[1]) { tr_item(A.in(24) + (size_t)l * 384 * D, D, 384, D / 32, (bf16*)(wl + WO_BA), -1, scr, r, F.lane); continue; } r -= cnt[1];
        if (r < cnt[2]) { tr_item(A.in(25) + (size_t)l * 384 * D, D, 384, D / 32, (bf16*)(wl + WO_BR), -1, scr, r, F.lane); continue; } r -= cnt[2];
        if (r < cnt[3]) { tr_item(A.in(26) + (size_t)l * 256 * D, D, 256, D / 32, (bf16*)(wl + WO_BS), -1, scr, r, F.lane); continue; } r -= cnt[3];
        if (r < cnt[4]) { tr_item(A.in(27) + (size_t)l * D * D, D, D, D / 32, (bf16*)(wl + WO_OUT), -1, scr, r, F.lane); continue; } r -= cnt[4];
        if (r < cnt[5]) { tr_item(A.in(29) + (size_t)l * D * 2 * FFH, 2 * FFH, D, FFH / 32, (bf16*)(wl + WO_GU), 0, scr, r, F.lane); continue; } r -= cnt[5];
        if (r < cnt[6]) { tr_item(A.in(29) + (size_t)l * D * 2 * FFH + FFH, 2 * FFH, D, FFH / 32, (bf16*)(wl + WO_GU), 128, scr, r, F.lane); continue; } r -= cnt[6];
        if (r < cnt[7]) { tr_item(A.in(30) + (size_t)l * FFH * D, D, FFH, D / 32, (bf16*)(wl + WO_DN), -1, scr, r, F.lane); continue; } r -= cnt[7];
        if (r < cnt[8]) { tr_item(A.in(22) + (size_t)l * 256 * 256, 256, 256, 8, (bf16*)(wl + WO_GLU), 0, scr, r, F.lane); continue; } r -= cnt[8];
        if (r < cnt[9]) { tr_item(A.in(23) + (size_t)l * 256 * 256, 256, 256, 8, (bf16*)(wl + WO_GLU), 128, scr, r, F.lane); continue; } r -= cnt[9];
        if (r < cnt[10]) { tr_item(A.in(5) + (size_t)l * 64 * 384, 384, 64, 12, (bf16*)(wl + WO_W2), -1, scr, r, F.lane); continue; } r -= cnt[10];
        if (r < cnt[11]) { tr_item(A.in(7) + (size_t)l * 64 * 384, 384, 64, 12, (bf16*)(wl + WO_A2), -1, scr, r, F.lane); continue; } r -= cnt[11];
        tr_item(A.in(8) + (size_t)l * 128 * 384, 384, 128, 12, (bf16*)(wl + WO_G2), -1, scr, r, F.lane);
    }
}

template <bool OUT_F32> __device__ __forceinline__ void phase_rmsnorm(const KA& A, const Ctx& F, const float* src, const float* gain, void* dst) {
    const int gw = F.bid * NWAVES + F.wave, NGW = F.G * NWAVES;
    f32x4 gv[4];
#pragma unroll
    for (int j = 0; j < 4; ++j) gv[j] = *((const f32x4*)gain + F.lane + 64 * j);
    for (int m = gw; m < T; m += NGW) {
        const f32x4* xr = (const f32x4*)(src + (size_t)m * D) + F.lane;
        f32x4 v[4]; float s = 0.f;
#pragma unroll
        for (int j = 0; j < 4; ++j) { v[j] = xr[64 * j]; s += (v[j].x * v[j].x + v[j].y * v[j].y) + (v[j].z * v[j].z + v[j].w * v[j].w); }
        const float rs = 1.0f / sqrtf(wave_sum(s) * (1.0f / D) + NORM_EPS);
        if (OUT_F32) {
            f32x4* o = (f32x4*)((float*)dst + (size_t)m * D) + F.lane;
#pragma unroll
            for (int j = 0; j < 4; ++j) o[64 * j] = v[j] * rs * gv[j];
        } else {
            v2u* o = (v2u*)((bf16*)dst + (size_t)m * D) + F.lane;
#pragma unroll
            for (int j = 0; j < 4; ++j) { const f32x4 y = v[j] * rs * gv[j]; v2u w; w.x = pk2(y.x, y.y); w.y = pk2(y.z, y.w); o[64 * j] = w; }
        }
    }
}
__device__ __forceinline__ void attn_v1(const KA& A, const Ctx& F, int blk, int nblk) {
    bf16* PS = (bf16*)(F.ws + WS_PS); float* LSE = (float*)(F.ws + WS_LSE);
#pragma unroll 1
    for (int item = blk * NTHREADS + F.tid; item < T * 12; item += nblk * NTHREADS) {
        const int hf = item & 1, it2 = item >> 1;
        const int h = it2 / T, bt = it2 % T, t = bt % SEQ;
        const int g = h >> 1, dil = (g == 0) ? 1 : (g == 1 ? 4 : 16);
        unsigned qp_[16]; float o[32];
        { const v4u* qp = (const v4u*)(PS + (size_t)bt * PSW + C_Q + h * 64 + hf * 32);
#pragma unroll
          for (int c = 0; c < 4; ++c) { const v4u w = qp[c]; qp_[4 * c + 0] = w.x; qp_[4 * c + 1] = w.y; qp_[4 * c + 2] = w.z; qp_[4 * c + 3] = w.w; } }
#pragma unroll
        for (int c = 0; c < 32; ++c) o[c] = 0.f;
        float mx = -1e30f, l = 0.f;
#pragma unroll 1
        for (int j = 0; j <= 128; ++j) {
            const int tk = t - j * dil; if (tk < 0) break;
            const size_t rowk = (size_t)(bt - j * dil) * PSW;
            const v4u* kp = (const v4u*)(PS + rowk + C_K + h * 64 + hf * 32); const v4u* vp = (const v4u*)(PS + rowk + C_V + h * 64 + hf * 32);
            float s = 0.f;
#pragma unroll
            for (int c = 0; c < 4; ++c) { const v4u w = kp[c];
                s += bflo(qp_[4 * c + 0]) * bflo(w.x) + bfhi(qp_[4 * c + 0]) * bfhi(w.x) + bflo(qp_[4 * c + 1]) * bflo(w.y) + bfhi(qp_[4 * c + 1]) * bfhi(w.y)
                   + bflo(qp_[4 * c + 2]) * bflo(w.z) + bfhi(qp_[4 * c + 2]) * bfhi(w.z) + bflo(qp_[4 * c + 3]) * bflo(w.w) + bfhi(qp_[4 * c + 3]) * bfhi(w.w); }
            s += shx<1>(s);
            s *= 0.125f;
            const float mn = fmaxf(mx, s), cf = __expf(mx - mn), p = __expf(s - mn);
            l = l * cf + p; mx = mn;
#pragma unroll
            for (int c = 0; c < 4; ++c) { const v4u w = vp[c];
                o[8 * c + 0] = o[8 * c + 0] * cf + p * bflo(w.x); o[8 * c + 1] = o[8 * c + 1] * cf + p * bfhi(w.x); o[8 * c + 2] = o[8 * c + 2] * cf + p * bflo(w.y); o[8 * c + 3] = o[8 * c + 3] * cf + p * bfhi(w.y);
                o[8 * c + 4] = o[8 * c + 4] * cf + p * bflo(w.z); o[8 * c + 5] = o[8 * c + 5] * cf + p * bfhi(w.z); o[8 * c + 6] = o[8 * c + 6] * cf + p * bflo(w.w); o[8 * c + 7] = o[8 * c + 7] * cf + p * bfhi(w.w); }
        }
        const float il = 1.0f / l;
        v4u* op = (v4u*)(PS + (size_t)bt * PSW + C_Q + h * 64 + hf * 32);
#pragma unroll
        for (int c = 0; c < 4; ++c) { v4u w; w.x = pk2(o[8 * c + 0] * il, o[8 * c + 1] * il); w.y = pk2(o[8 * c + 2] * il, o[8 * c + 3] * il); w.z = pk2(o[8 * c + 4] * il, o[8 * c + 5] * il); w.w = pk2(o[8 * c + 6] * il, o[8 * c + 7] * il); op[c] = w; }
        if (hf == 0) LSE[(size_t)bt * 6 + h] = mx + __logf(l);
    }
}
__device__ __forceinline__ void attn_finalize(const KA& A, const Ctx& F) {
    bf16* PS = (bf16*)(F.ws + WS_PS); const float* LSE = (const float*)(F.ws + WS_LSE);
    for (int item = F.bid * NTHREADS + F.tid; item < T * 48; item += F.G * NTHREADS) {
        const int bt = item / 48, r = item % 48, h = r >> 3, c = r & 7, j = h & 1;
        const float l0 = LSE[(size_t)bt * 6 + j], l1 = LSE[(size_t)bt * 6 + 2 + j], l2 = LSE[(size_t)bt * 6 + 4 + j], lm = LSE[(size_t)bt * 6 + h];
        const float mx = fmaxf(l0, fmaxf(l1, l2));
        const float al = __expf(lm - mx) / (__expf(l0 - mx) + __expf(l1 - mx) + __expf(l2 - mx));
        v4u* p = (v4u*)(PS + (size_t)bt * PSW + C_Q + h * 64) + c; v4u w = *p;
        w.x = pk2(bflo(w.x) * al, bfhi(w.x) * al); w.y = pk2(bflo(w.y) * al, bfhi(w.y) * al); w.z = pk2(bflo(w.z) * al, bfhi(w.z) * al); w.w = pk2(bflo(w.w) * al, bfhi(w.w) * al);
        if (!(F.dry && (DRY_SEL & 4))) *p = w;
    }
}

__device__ __forceinline__ void rwkv_v1(const KA& A, const Ctx& F, int l, int b, int h) {
    constexpr int CH = 32;
    bf16* PS = (bf16*)(F.ws + WS_PS);
    float* L = (float*)F.lds;
    float* ZR = L, *ZK = L + CH * 64, *ZV = L + 2 * CH * 64, *ZX = L + 3 * CH * 64;
    float* WD = ZX + CH * 256, *KA = WD + CH * 64, *KB = KA + CH * 64, *GG = KB + CH * 64, *YB = GG + CH * 64, *BON = YB + CH * 64, *PREV = BON + 64;
    const float* mix = A.in(3) + (size_t)l * 1408;
    const float* w0 = A.in(4) + l * 384, *w2 = A.in(5) + (size_t)l * 64 * 384, *a0 = A.in(6) + l * 384, *a2 = A.in(7) + (size_t)l * 64 * 384, *g2 = A.in(8) + (size_t)l * 128 * 384;
    const float* k_k = A.in(9) + l * 384, *k_a = A.in(10) + l * 384, *r_k = A.in(11) + l * 384, *ln_w = A.in(12) + l * 384, *ln_b = A.in(13) + l * 384;
    const int tid = F.tid, lane = F.lane;
    const int hc = h * 64 + lane;
    float S[8];
#pragma unroll
    for (int j = 0; j < 8; ++j) S[j] = 0.f;
    const int si = tid >> 3, sj = (tid & 7) * 8;
#pragma unroll 1
    for (int ch = 0; ch < SEQ / CH; ++ch) {
        const int t0 = ch * CH; const size_t row0 = (size_t)b * SEQ + t0;
        float* PRc = PREV + (ch & 1) * 192, *PRn = PREV + ((ch + 1) & 1) * 192;
#pragma unroll 1
        for (int e = tid; e < CH * 192; e += NTHREADS) {
            const int t = e / 192, c3 = e % 192, which = c3 >> 6, c = c3 & 63;
            const int col = C_RW + which * 384 + h * 64 + c;
            const float cur = bf2f(PS[(row0 + t) * PSW + col]);
            float prev;
            if (t == 0) prev = (ch == 0) ? 0.f : PRc[c3]; else prev = bf2f(PS[(row0 + t - 1) * PSW + col]);
            if (t == CH - 1) PRn[c3] = cur;
            const float z = cur + (prev - cur) * mix[which * 384 + h * 64 + c];
            L[which * CH * 64 + t * 64 + c] = z;
        }
#pragma unroll 1
        for (int e = tid; e < CH * 256; e += NTHREADS) {
            const int t = e >> 8, j = e & 255; const int col = C_LORA + j;
            const float cur = bf2f(PS[(row0 + t) * PSW + col]);
            const float prev = (t0 + t == 0) ? 0.f : bf2f(PS[(row0 + t - 1) * PSW + col]);
            float z = cur + (prev - cur) * mix[1152 + j];
            if (j < 64) z = tanhf(z); else if (j >= 128) z = sigm(z);
            ZX[t * 256 + j] = z;
        }
        __syncthreads();
        {
            float accw[4], acca[4], accg[4];
#pragma unroll
            for (int i = 0; i < 4; ++i) { accw[i] = 0.f; acca[i] = 0.f; accg[i] = 0.f; }
#pragma unroll 2
            for (int j = 0; j < 64; ++j) { const float ww = w2[j * 384 + hc], aa = a2[j * 384 + hc];
#pragma unroll
                for (int i = 0; i < 4; ++i) { const int t = F.wave + 8 * i; accw[i] += ZX[t * 256 + j] * ww; acca[i] += ZX[t * 256 + 64 + j] * aa; } }
#pragma unroll 2
            for (int j = 0; j < 128; ++j) { const float gg = g2[j * 384 + hc];
#pragma unroll
                for (int i = 0; i < 4; ++i) { const int t = F.wave + 8 * i; accg[i] += ZX[t * 256 + 128 + j] * gg; } }
            const float w0c = w0[hc], a0c = a0[hc], kkc = k_k[hc], kac = k_a[hc], rkc = r_k[hc];
#pragma unroll
            for (int i = 0; i < 4; ++i) { const int t = F.wave + 8 * i; const int o = t * 64 + lane;
                const float x = -(w0c + accw[i]); const float sp = (x > 20.f) ? x : log1pf(__expf(x)); const float w = -sp - 0.5f;
                const float av = sigm(a0c + acca[i]);
                const float kraw = ZK[o]; float kk = kraw * kkc; const float nrm = sqrtf(wave_sum(kk * kk)); kk = kk / fmaxf(nrm, 1e-12f);
                const float knew = kraw * (1.0f + (av - 1.0f) * kac);
                const float bon = wave_sum(ZR[o] * knew * rkc);
                ZK[o] = knew; WD[o] = __expf(-__expf(w)); KA[o] = -kk; KB[o] = kk * av; GG[o] = accg[i]; if (lane == 0) BON[t] = bon; }
        }
        __syncthreads();
#pragma unroll 2
        for (int t = 0; t < CH; ++t) {
            const f32x4 a0v = *(const f32x4*)(KA + t * 64 + sj), a1v = *(const f32x4*)(KA + t * 64 + sj + 4);
            const f32x4 w0v = *(const f32x4*)(WD + t * 64 + sj), w1v = *(const f32x4*)(WD + t * 64 + sj + 4);
            const f32x4 b0v = *(const f32x4*)(KB + t * 64 + sj), b1v = *(const f32x4*)(KB + t * 64 + sj + 4);
            const f32x4 k0v = *(const f32x4*)(ZK + t * 64 + sj), k1v = *(const f32x4*)(ZK + t * 64 + sj + 4);
            const f32x4 r0v = *(const f32x4*)(ZR + t * 64 + sj), r1v = *(const f32x4*)(ZR + t * 64 + sj + 4);
            const float vi = ZV[t * 64 + si];
            float sa = 0.f;
#pragma unroll
            for (int j = 0; j < 4; ++j) sa += S[j] * a0v[j] + S[4 + j] * a1v[j];
            sa += shx<1>(sa); sa += shx<2>(sa); sa += shx<4>(sa);
            float y = 0.f;
#pragma unroll
            for (int j = 0; j < 4; ++j) { S[j] = S[j] * w0v[j] + sa * b0v[j] + vi * k0v[j]; S[4 + j] = S[4 + j] * w1v[j] + sa * b1v[j] + vi * k1v[j]; y += S[j] * r0v[j] + S[4 + j] * r1v[j]; }
            y += shx<1>(y); y += shx<2>(y); y += shx<4>(y);
            if ((tid & 7) == 0) YB[t * 64 + si] = y;
        }
        __syncthreads();
        const float lw = ln_w[hc], lb = ln_b[hc];
#pragma unroll
        for (int i = 0; i < 4; ++i) { const int t = F.wave + 8 * i; const int o = t * 64 + lane;
            const float y = YB[o]; const float mu = wave_sum(y) * (1.0f / 64.0f); const float dv = y - mu; const float var = wave_sum(dv * dv) * (1.0f / 64.0f);
            const float yn = dv * (1.0f / sqrtf(var + GN_EPS)) * lw + lb;
            const float out = (yn + BON[t] * ZV[o]) * GG[o];
            PS[(row0 + t) * PSW + C_RW + h * 64 + lane] = (bf16)f2bf(out); }
        __syncthreads();
    }
}

__device__ __forceinline__ float gelu_tanh(float x) { const float u = 0.7978845608028654f * (x + 0.044715f * x * x * x); const float th = 1.0f - 2.0f / (__expf(2.0f * u) + 1.0f); return 0.5f * x * (1.0f + th); }
__device__ __forceinline__ void ssm_v1(const KA& A, const Ctx& F, int l, int b, int g) {
    bf16* PS = (bf16*)(F.ws + WS_PS);
    float* L = (float*)F.lds;
    float* U = L, *XR = L + 1024, *XI = L + 1024 + 64 * 65, *CR = L + 1024 + 2 * 64 * 65, *CI = CR + 1024;
    const int tid = F.tid, lane = F.lane, p = lane;
    float are, aim, bre[16], bim[16];
    {
        const float step = __expf(A.in(16)[l * 16 + g]);
        const float lr = A.in(14)[(size_t)l * 1024 + g * 64 + p], li = A.in(15)[(size_t)l * 1024 + g * 64 + p];
        const float mag = __expf(lr * step), ang = li * step; float sn, cs; sincosf(ang, &sn, &cs);
        are = mag * cs; aim = mag * sn;
        const float inv = 1.0f / (lr * lr + li * li);
        const float fre = ((are - 1.0f) * lr + aim * li) * inv, fim = (aim * lr - (are - 1.0f) * li) * inv;
        const float* br = A.in(17) + (size_t)l * 16384 + (size_t)(g * 64 + p) * 16, *bi = A.in(18) + (size_t)l * 16384 + (size_t)(g * 64 + p) * 16;
#pragma unroll
        for (int c = 0; c < 16; ++c) { bre[c] = fre * br[c] - fim * bi[c]; bim[c] = fre * bi[c] + fim * br[c]; }
    }
    for (int e = tid; e < 1024; e += NTHREADS) { CR[e] = A.in(19)[(size_t)l * 16384 + g * 1024 + e]; CI[e] = A.in(20)[(size_t)l * 16384 + g * 1024 + e]; }
    const float* dsk = A.in(21) + l * 256 + g * 16;
    float xr = 0.f, xi = 0.f;
#pragma unroll 1
    for (int ch = 0; ch < SEQ / 64; ++ch) {
        const size_t row0 = (size_t)b * SEQ + ch * 64;
        for (int e = tid; e < 1024; e += NTHREADS) { const int t = e >> 4, c = e & 15; U[e] = bf2f(PS[(row0 + t) * PSW + C_SSM + g * 16 + c]); }
        __syncthreads();
#pragma unroll
        for (int i = 0; i < 8; ++i) { const int t = F.wave + 8 * i; float sr = 0.f, sii = 0.f;
#pragma unroll
            for (int c = 0; c < 16; ++c) { const float u = U[t * 16 + c]; sr += bre[c] * u; sii += bim[c] * u; }
            XR[t * 65 + p] = sr; XI[t * 65 + p] = sii; }
        __syncthreads();
        if (F.wave == 0) {
#pragma unroll 4
            for (int t = 0; t < 64; ++t) { const float nr = are * xr - aim * xi + XR[t * 65 + p], ni = are * xi + aim * xr + XI[t * 65 + p]; xr = nr; xi = ni; XR[t * 65 + p] = xr; XI[t * 65 + p] = xi; }
        }
        __syncthreads();
        { const int t = tid >> 3, c2 = (tid & 7) * 2;
#pragma unroll
          for (int q = 0; q < 2; ++q) { const int c = c2 + q; float y = 0.f;
#pragma unroll 4
              for (int pp = 0; pp < 64; ++pp) y += CR[c * 64 + pp] * XR[t * 65 + pp] - CI[c * 64 + pp] * XI[t * 65 + pp];
              y += dsk[c] * U[t * 16 + c];
              PS[(row0 + t) * PSW + C_SSM + g * 16 + c] = (bf16)f2bf(gelu_tanh(y)); } }
        __syncthreads();
    }
}
typedef short bf16x8_t __attribute__((ext_vector_type(8)));
typedef float f32x16 __attribute__((ext_vector_type(16)));
typedef short v4i16_t __attribute__((ext_vector_type(4)));
typedef __bf16 bf16x2_t __attribute__((ext_vector_type(2)));
typedef float f32x2_t __attribute__((ext_vector_type(2)));
__device__ __forceinline__ unsigned cvtpk(float lo, float hi) { f32x2_t v = {lo, hi}; bf16x2_t b = __builtin_convertvector(v, bf16x2_t); return __builtin_bit_cast(unsigned, b); }
__device__ __forceinline__ v4i16_t ds_tr16(const unsigned char* p) { return __builtin_amdgcn_ds_read_tr16_b64_v4i16((LAS v4i16_t*)p); }
__device__ __forceinline__ int crow16(int g, int hh) { return (g & 3) + 8 * (g >> 2) + 4 * hh; }

constexpr int ATT_VS = 96;
constexpr int ATT_ITEMS = BATCH * 6 * 16;

__device__ __forceinline__ void attn_v2(const KA& A, const Ctx& F, int l) {
    bf16* PS = (bf16*)(F.ws + WS_PS); float* LSE = (float*)(F.ws + WS_LSE);
    unsigned char* VI = F.lds;
    const int lane = F.lane, q = lane & 31, hh = lane >> 5, w = F.wave;
    unsigned* ctr = (unsigned*)(F.ws + WS_CTL) + CW_ATT + 64 * l + ((F.dry && (DRY_SEL & 2)) ? 32 : 0); volatile unsigned* slot = (volatile unsigned*)(F.lds + MISC_OFF + 64);
#pragma unroll 1
    for (;;) {
        if (F.tid == 0) *slot = __hip_atomic_fetch_add(ctr, 1u, __ATOMIC_RELAXED, __HIP_MEMORY_SCOPE_AGENT);
        __syncthreads();
        const int item = (int)*slot;
        if (item >= ATT_ITEMS) break;
        const int idx16 = item & 15, h = (item >> 4) % 6, b = item / 96;
        const int g = h >> 1, dsh = 2 * g, dil = 1 << dsh;
        const int bpr = 16 >> dsh, r = idx16 >> (4 - dsh), i0 = (idx16 & (bpr - 1)) * 256;
        const size_t tb = (size_t)b * SEQ + r;
        v4u vreg[6];
#pragma unroll
        for (int ps = 0; ps < 6; ++ps) { const int row = (F.tid >> 3) + 64 * ps, ch = F.tid & 7; int ki = i0 - 128 + row; ki = ki < 0 ? 0 : ki;
            vreg[ps] = *(const v4u*)(PS + (tb + (size_t)ki * dil) * PSW + C_V + h * 64 + ch * 8); }
        bf16x8_t qf[4], kf[5][4];
        { const bf16* qp = PS + (tb + (size_t)(i0 + 32 * w + q) * dil) * PSW + C_Q + h * 64 + 8 * hh;
#pragma unroll
          for (int s = 0; s < 4; ++s) qf[s] = *(const bf16x8_t*)(qp + 16 * s); }
#pragma unroll
        for (int kt = 0; kt < 5; ++kt) {
            int ki = i0 + 32 * w - 128 + 32 * kt + q; ki = ki < 0 ? 0 : ki;
            const bf16* kp = PS + (tb + (size_t)ki * dil) * PSW + C_K + h * 64 + 8 * hh;
#pragma unroll
            for (int s = 0; s < 4; ++s) kf[kt][s] = *(const bf16x8_t*)(kp + 16 * s); }
#pragma unroll
        for (int ps = 0; ps < 6; ++ps) { const int row = (F.tid >> 3) + 64 * ps, ch = F.tid & 7; *(v4u*)(VI + (row * ATT_VS + ch * 8) * 2) = vreg[ps]; }
        f32x16 p[5];
#pragma unroll
        for (int kt = 0; kt < 5; ++kt) {
            f32x16 acc = {};
#pragma unroll
            for (int s = 0; s < 4; ++s) acc = __builtin_amdgcn_mfma_f32_32x32x16_bf16(kf[kt][s], qf[s], acc, 0, 0, 0);
            p[kt] = acc;
        }
        const int kbase = i0 + 32 * w - 128;
        float mx = -3.0e38f;
#pragma unroll
        for (int kt = 0; kt < 5; ++kt)
#pragma unroll
            for (int gq = 0; gq < 16; ++gq) { const int kl = crow16(gq, hh); const int dist = q + 128 - 32 * kt - kl;
                const bool ok = (dist >= 0) && (dist <= 128) && (kbase + 32 * kt + kl >= 0);
                const float s = ok ? p[kt][gq] : -3.0e38f; p[kt][gq] = s; mx = fmaxf(mx, s); }
        mx = xmax32(mx);
        const float sc = 0.125f * 1.4426950408889634f;
        float l = 0.f;
#pragma unroll
        for (int kt = 0; kt < 5; ++kt)
#pragma unroll
            for (int gq = 0; gq < 16; ++gq) { const float e = __builtin_amdgcn_exp2f((p[kt][gq] - mx) * sc); p[kt][gq] = e; l += e; }
        l = xsum32(l);
        asm volatile("s_waitcnt lgkmcnt(0)" ::: "memory"); __builtin_amdgcn_s_barrier(); asm volatile("" ::: "memory");
        f32x16 o[2]; o[0] = f32x16{}; o[1] = f32x16{};
        const unsigned char* vb = VI + ((32 * w + 4 * hh + ((lane & 15) >> 2)) * ATT_VS + 16 * ((lane >> 4) & 1) + 4 * (lane & 3)) * 2;
#pragma unroll
        for (int kt = 0; kt < 5; ++kt)
#pragma unroll
            for (int s = 0; s < 2; ++s) {
                v4u pw; pw.x = cvtpk(p[kt][8 * s + 0], p[kt][8 * s + 1]); pw.y = cvtpk(p[kt][8 * s + 2], p[kt][8 * s + 3]); pw.z = cvtpk(p[kt][8 * s + 4], p[kt][8 * s + 5]); pw.w = cvtpk(p[kt][8 * s + 6], p[kt][8 * s + 7]);
                const bf16x8_t pb = __builtin_bit_cast(bf16x8_t, pw);
#pragma unroll
                for (int dt = 0; dt < 2; ++dt) {
                    const unsigned char* vp = vb + ((32 * kt + 16 * s) * ATT_VS + 32 * dt) * 2;
                    const v4i16_t lo = ds_tr16(vp), hi = ds_tr16(vp + 8 * ATT_VS * 2);
                    const bf16x8_t va = (bf16x8_t){lo[0], lo[1], lo[2], lo[3], hi[0], hi[1], hi[2], hi[3]};
                    o[dt] = __builtin_amdgcn_mfma_f32_32x32x16_bf16(va, pb, o[dt], 0, 0, 0);
                }
            }
        const float il = 1.0f / l;
        bf16* op = PS + (tb + (size_t)(i0 + 32 * w + q) * dil) * PSW + C_Q + h * 64 + 4 * hh;
#pragma unroll
        for (int dt = 0; dt < 2; ++dt)
#pragma unroll
            for (int g4 = 0; g4 < 4; ++g4) { v2u wv; wv.x = cvtpk(o[dt][4 * g4 + 0] * il, o[dt][4 * g4 + 1] * il); wv.y = cvtpk(o[dt][4 * g4 + 2] * il, o[dt][4 * g4 + 3] * il);
                if (!(F.dry && (DRY_SEL & 2))) *(v2u*)(op + 32 * dt + 8 * g4) = wv; }
        if (hh == 0 && !(F.dry && (DRY_SEL & 2))) LSE[(tb + (size_t)(i0 + 32 * w + q) * dil) * 6 + h] = mx * 0.125f + __logf(l);
        asm volatile("s_waitcnt lgkmcnt(0)" ::: "memory"); __builtin_amdgcn_s_barrier(); asm volatile("" ::: "memory");
    }
}
constexpr int TS = 72;
constexpr int TILE = 64 * TS * 2;
constexpr int RL_A = 0 * TILE, RL_B = 1 * TILE, RL_K = 2 * TILE, RL_R = 3 * TILE, RL_V = 4 * TILE, RL_BH = 5 * TILE, RL_KH = 6 * TILE,
              RL_AK = 7 * TILE, RL_RB = 8 * TILE, RL_RK = 9 * TILE, RL_AABF = 10 * TILE, RL_E1 = RL_AABF + 16384, RL_E2 = RL_E1 + TILE, RL_E3 = RL_E2 + TILE, RL_END = RL_E3 + TILE;
constexpr int RL_D = RL_B, RL_LP = RL_K, RL_X = RL_E1, RL_M = RL_E2, RL_M2 = RL_E3, RL_S = RL_AK, RL_T = RL_K, RL_W = RL_E2, RL_U = RL_E3;
constexpr int RL_WLF = RL_AK, RL_ALF = RL_WLF + 16384, RL_GF = RL_ALF + 16384, RL_TOT = RL_GF + 16384;
static_assert(RL_END <= MISC_OFF && RL_TOT + 2048 <= MISC_OFF, "rwkv LDS map");
constexpr int RW_ITEMS = BATCH * 6 * 64;
#ifndef SEC
#define SEC 0xFFFF
#endif

__device__ __forceinline__ bf16x8_t ldfrag(const unsigned char* tile, int row, int s, int hh) { return *(const bf16x8_t*)(tile + (row * TS + 16 * s + 8 * hh) * 2); }
__device__ __forceinline__ bf16x8_t ldfrag_tr(const unsigned char* tile, int n0, int s, int lane) {
    const int hh = lane >> 5;
    const unsigned char* p = tile + ((16 * s + 8 * hh + ((lane & 15) >> 2)) * TS + n0 + 16 * ((lane >> 4) & 1) + 4 * (lane & 3)) * 2;
    const v4i16_t lo = ds_tr16(p), hi = ds_tr16(p + 4 * TS * 2);
    return (bf16x8_t){lo[0], lo[1], lo[2], lo[3], hi[0], hi[1], hi[2], hi[3]};
}
template <bool AT, bool BT> __device__ __forceinline__ f32x16 mmx(f32x16 acc, const unsigned char* At, int m0, const unsigned char* Bt, int n0, int ks0, int ks1, int lane) {
    const int r = lane & 31, hh = lane >> 5;
#pragma unroll
    for (int s = 0; s < 4; ++s) if (s >= ks0 && s < ks1) {
        const bf16x8_t a = AT ? ldfrag_tr(At, m0, s, lane) : ldfrag(At, m0 + r, s, hh);
        const bf16x8_t b = BT ? ldfrag_tr(Bt, n0, s, lane) : ldfrag(Bt, n0 + r, s, hh);
        acc = __builtin_amdgcn_mfma_f32_32x32x16_bf16(a, b, acc, 0, 0, 0); }
    return acc;
}
__device__ __forceinline__ void st_tileT(unsigned char* tile, int ncol, int m0, const f32x16& acc, int hh) {
#pragma unroll
    for (int g4 = 0; g4 < 4; ++g4) { v2u wv; wv.x = cvtpk(acc[4 * g4 + 0], acc[4 * g4 + 1]); wv.y = cvtpk(acc[4 * g4 + 2], acc[4 * g4 + 3]);
        *(v2u*)(tile + (ncol * TS + m0 + 8 * g4 + 4 * hh) * 2) = wv; }
}
__device__ __forceinline__ bf16x8_t pack8(const float (&z)[8]) { v4u pw; pw.x = cvtpk(z[0], z[1]); pw.y = cvtpk(z[2], z[3]); pw.z = cvtpk(z[4], z[5]); pw.w = cvtpk(z[6], z[7]); return __builtin_bit_cast(bf16x8_t, pw); }
__device__ __forceinline__ void unpack8(const v4u w, float (&z)[8]) { z[0] = bflo(w.x); z[1] = bfhi(w.x); z[2] = bflo(w.y); z[3] = bfhi(w.y); z[4] = bflo(w.z); z[5] = bfhi(w.z); z[6] = bflo(w.w); z[7] = bfhi(w.w); }

template <int ACT> __device__ __forceinline__ bf16x8_t lora_frag(const bf16* PS, size_t grow, bool first, int jcol, const float* mix) {
    float c[8], p[8];
    unpack8(*(const v4u*)(PS + grow * PSW + C_LORA + jcol), c);
    unpack8(*(const v4u*)(PS + (grow - (first ? 0 : 1)) * PSW + C_LORA + jcol), p);
    const f32x4 m0 = *(const f32x4*)(mix + 1152 + jcol), m1 = *(const f32x4*)(mix + 1152 + jcol + 4);
    float z[8];
#pragma unroll
    for (int e = 0; e < 8; ++e) { const float mm = e < 4 ? m0[e] : m1[e - 4]; const float pe = first ? 0.f : p[e]; float v = c[e] + (pe - c[e]) * mm;
        if (ACT == 1) v = 1.0f - 2.0f / (__expf(2.0f * v) + 1.0f); else if (ACT == 2) v = sigm(v);
        z[e] = v; }
    return pack8(z);
}

__device__ __forceinline__ void rwkv_p1(const KA& A, const Ctx& F, int l) {
    bf16* PS = (bf16*)(F.ws + WS_PS); const bf16* BRB = (const bf16*)(F.ws + WS_BR);
    unsigned char* L = F.lds;
    unsigned char* wl = F.ws + WS_W + (size_t)l * W_LAYER;
    const bf16* W2T = (const bf16*)(wl + WO_W2); const bf16* A2T = (const bf16*)(wl + WO_A2); const bf16* G2T = (const bf16*)(wl + WO_G2);
    const float* mix = A.in(3) + (size_t)l * 1408;
    int tid = F.tid, lane = F.lane, r32 = lane & 31, hh = lane >> 5; const int w = F.wave;
#ifdef SECD
    const int sec_ = F.dry ? SECD : 0xFFFF;
#else
    constexpr int sec_ = 0xFFFF;
#endif
    const bool wr_ = !(F.dry && (DRY_SEL & 1));
#define RW_FENCE() do { asm volatile("s_waitcnt lgkmcnt(0)" ::: "memory"); __builtin_amdgcn_s_barrier(); asm volatile("" : "+v"(tid) :: "memory");     \
    lane = tid & 63; r32 = lane & 31; hh = lane >> 5; hc = h * 64 + lane; } while (0)
#pragma unroll 1
    for (int grp = F.bid; grp < RW_ITEMS / 6; grp += F.G) {
      const int j = grp & 63, b = grp >> 6;
      const size_t row0 = (size_t)b * SEQ + 64 * j;
      bf16x8_t xf[8];
      { const int tt = w & 1; const size_t grow = row0 + 32 * tt + r32; const bool first = (j == 0) && (tt == 0) && (r32 == 0);
        if (w < 4) {
#pragma unroll
            for (int s = 0; s < 8; ++s) xf[s] = lora_frag<2>(PS, grow, first, 128 + 16 * s + 8 * hh, mix);
        } else {
#pragma unroll
            for (int s = 0; s < 4; ++s) { xf[s] = lora_frag<1>(PS, grow, first, 16 * s + 8 * hh, mix); xf[4 + s] = lora_frag<0>(PS, grow, first, 64 + 16 * s + 8 * hh, mix); }
        } }
#pragma unroll 1
      for (int h = 0; h < 6; ++h) {
        const int item = (b * 6 + h) * 64 + j;
        int hc = h * 64 + lane;
        if (sec_ & 1) {
            const int tl = (w & 3), ct = tl >> 1, tt = tl & 1;
            if (w < 4) {
                f32x16 acc = {};
#pragma unroll
                for (int s = 0; s < 8; ++s) { const bf16x8_t af = *(const bf16x8_t*)(G2T + (size_t)(h * 64 + 32 * ct + r32) * 128 + 16 * s + 8 * hh);
                    acc = __builtin_amdgcn_mfma_f32_32x32x16_bf16(af, xf[s], acc, 0, 0, 0); }
                float* G = (float*)(L + RL_GF);
#pragma unroll
                for (int g4 = 0; g4 < 4; ++g4) *(f32x4*)(G + (32 * tt + r32) * 64 + 32 * ct + 8 * g4 + 4 * hh) = (f32x4){acc[4 * g4], acc[4 * g4 + 1], acc[4 * g4 + 2], acc[4 * g4 + 3]};
            } else {
                f32x16 accw = {}, acca = {};
#pragma unroll
                for (int s = 0; s < 4; ++s) {
                    const bf16x8_t wf = *(const bf16x8_t*)(W2T + (size_t)(h * 64 + 32 * ct + r32) * 64 + 16 * s + 8 * hh);
                    const bf16x8_t af = *(const bf16x8_t*)(A2T + (size_t)(h * 64 + 32 * ct + r32) * 64 + 16 * s + 8 * hh);
                    accw = __builtin_amdgcn_mfma_f32_32x32x16_bf16(wf, xf[s], accw, 0, 0, 0);
                    acca = __builtin_amdgcn_mfma_f32_32x32x16_bf16(af, xf[4 + s], acca, 0, 0, 0); }
                float* WLp = (float*)(L + RL_WLF); float* ALp = (float*)(L + RL_ALF);
#pragma unroll
                for (int g4 = 0; g4 < 4; ++g4) { const int o = (32 * tt + r32) * 64 + 32 * ct + 8 * g4 + 4 * hh;
                    *(f32x4*)(WLp + o) = (f32x4){accw[4 * g4], accw[4 * g4 + 1], accw[4 * g4 + 2], accw[4 * g4 + 3]};
                    *(f32x4*)(ALp + o) = (f32x4){acca[4 * g4], acca[4 * g4 + 1], acca[4 * g4 + 2], acca[4 * g4 + 3]}; }
            }
        }
        float rr[8], kn[8], vv[8], kk[8], bb[8], eadd[8], lp[8];
        {
            const float mr = mix[hc], mk = mix[384 + hc], mv = mix[768 + hc];
            float pr, pk, pv;
            if (w == 0) { if (j == 0) { pr = 0.f; pk = 0.f; pv = 0.f; } else { const bf16* bp = BRB + (size_t)(b * 64 + j - 1) * PSW + C_RW + hc; pr = bf2f(bp[0]); pk = bf2f(bp[384]); pv = bf2f(bp[768]); } }
            else { const bf16* pp = PS + (row0 + 8 * w - 1) * PSW + C_RW + hc; pr = bf2f(pp[0]); pk = bf2f(pp[384]); pv = bf2f(pp[768]); }
            float cr[8], ck[8], cv[8];
#pragma unroll
            for (int i = 0; i < 8; ++i) { const bf16* cp = PS + (row0 + 8 * w + i) * PSW + C_RW + hc; cr[i] = bf2f(cp[0]); ck[i] = bf2f(cp[384]); cv[i] = bf2f(cp[768]); }
#pragma unroll
            for (int i = 0; i < 8; ++i) { rr[i] = cr[i] + (pr - cr[i]) * mr; kn[i] = ck[i] + (pk - ck[i]) * mk; vv[i] = cv[i] + (pv - cv[i]) * mv; pr = cr[i]; pk = ck[i]; pv = cv[i]; }
        }
        RW_FENCE();
        if (sec_ & 2) {
            const float* WLp = (const float*)(L + RL_WLF); const float* ALp = (const float*)(L + RL_ALF); const float* G = (const float*)(L + RL_GF); float* TOT = (float*)(L + RL_TOT);
            const float w0c = A.in(4)[l * 384 + hc], a0c = A.in(6)[l * 384 + hc], kkc = A.in(9)[l * 384 + hc], kac = A.in(10)[l * 384 + hc], rkc = A.in(11)[l * 384 + hc];
            const float lnw = A.in(12)[l * 384 + hc], lnb = A.in(13)[l * 384 + hc];
            bf16* EM = (bf16*)(F.ws + WS_REM) + (size_t)item * 4096;
            float run = 0.f;
#pragma unroll
            for (int i = 0; i < 8; ++i) { const int t = 8 * w + i; const int o = t * 64 + lane;
                const float x = -(w0c + WLp[o]); const float sp = (x > 20.f) ? x : __logf(1.0f + __expf(x)); const float wv = -sp - 0.5f;
                run += -__expf(wv); lp[i] = run;
                const float av = sigm(a0c + ALp[o]); const float gv = G[o];
                float kq = kn[i] * kkc; const float nrm = __builtin_amdgcn_sqrtf(wave_sum(kq * kq)); kq = kq * __builtin_amdgcn_rcpf(fmaxf(nrm, 1e-12f));
                const float knew = kn[i] * (1.0f + (av - 1.0f) * kac);
                const float bon = wave_sum(rr[i] * knew * rkc);
                kk[i] = kq; bb[i] = kq * av; kn[i] = knew;
                if (wr_) EM[o] = (bf16)f2bf(lnw * gv); eadd[i] = (lnb + bon * vv[i]) * gv; }
            TOT[w * 64 + lane] = run;
        }
        RW_FENCE();
        if (sec_ & 8) {
            const float* TOT = (const float*)(L + RL_TOT);
            float off = 0.f, cl = 0.f;
#pragma unroll
            for (int q = 0; q < 8; ++q) { const float tq = TOT[q * 64 + lane]; cl += tq; if (q < w) off += tq; }
            if (w == 7 && wr_) ((float*)(F.ws + WS_RGL))[(size_t)item * 64 + lane] = __expf(cl);
            bf16* At = (bf16*)(L + RL_A), *Bt = (bf16*)(L + RL_B), *Kt = (bf16*)(L + RL_K), *Rt = (bf16*)(L + RL_R), *Vt = (bf16*)(L + RL_V), *BHt = (bf16*)(L + RL_BH), *KHt = (bf16*)(L + RL_KH);
            float cp = off;
#pragma unroll
            for (int i = 0; i < 8; ++i) { const int o = (8 * w + i) * TS + lane;
                const float ct = off + lp[i];
                const float ep = __expf(cp), et = __expf(ct), ei = __expf(-ct), eh = __expf(cl - ct);
                At[o] = (bf16)f2bf(-kk[i] * ep); Rt[o] = (bf16)f2bf(rr[i] * et);
                Bt[o] = (bf16)f2bf(bb[i] * ei); Kt[o] = (bf16)f2bf(kn[i] * ei);
                Vt[o] = (bf16)f2bf(vv[i]); BHt[o] = (bf16)f2bf(bb[i] * eh); KHt[o] = (bf16)f2bf(kn[i] * eh);
                cp = ct; }
        }
        RW_FENCE();
        if (sec_ & 16) {
#pragma unroll
        for (int rep = 0; rep < 2; ++rep) { const int job = w + 8 * rep, prod = job >> 2, tt = (job >> 1) & 1, st = job & 1;
            f32x16 acc = {};
            acc = mmx<false, false>(acc, L + ((prod & 1) ? RL_K : RL_B), 32 * st, L + ((prod & 2) ? RL_R : RL_A), 32 * tt, 0, 4, lane);
            const int t = 32 * tt + r32; const int incl = prod >> 1;
#pragma unroll
            for (int g = 0; g < 16; ++g) { const int s = 32 * st + crow16(g, hh); if (!(s < t + incl)) acc[g] = 0.f; }
            if (prod == 0) { float* AF = (float*)(L + RL_AABF);
#pragma unroll
                for (int g4 = 0; g4 < 4; ++g4) *(f32x4*)(AF + t * 64 + 32 * st + 8 * g4 + 4 * hh) = (f32x4){acc[4 * g4], acc[4 * g4 + 1], acc[4 * g4 + 2], acc[4 * g4 + 3]};
            } else st_tileT(L + (prod == 1 ? RL_AK : (prod == 2 ? RL_RB : RL_RK)), t, 32 * st, acc, hh);
        } }
        RW_FENCE();
        if (sec_ & 32) {
            const float* AF = (const float*)(L + RL_AABF); bf16* Dt = (bf16*)(L + RL_D); bf16* LPt = (bf16*)(L + RL_LP);
            if (w == 0) {
                const int I = lane >> 4, jc = lane & 15; float x[16];
#pragma unroll
                for (int r = 0; r < 16; ++r) { float s = (r == jc) ? 1.f : 0.f;
#pragma unroll
                    for (int q = 0; q < 16; ++q) if (q < r) s += AF[(16 * I + r) * 64 + 16 * I + q] * x[q];
                    x[r] = s; Dt[(16 * I + r) * TS + 16 * I + jc] = (bf16)f2bf(s); }
            } else if (w < 4) {
                for (int o = tid - 64; o < 4096; o += 192) { const int t = o >> 6, s = o & 63; const bool offd = (t >> 4) != (s >> 4);
                    LPt[t * TS + s] = ((t >> 4) > (s >> 4)) ? (bf16)f2bf(AF[o]) : (bf16)0; if (offd) Dt[t * TS + s] = (bf16)0; }
            } else { const int tl = w - 4, it = tl >> 1, tt = tl & 1;
                f32x16 acc = {};
                acc = mmx<true, false>(acc, L + RL_V, 32 * it, L + RL_AK, 32 * tt, 0, tt ? 4 : 2, lane);
                st_tileT(L + RL_X, 32 * tt + r32, 32 * it, acc, hh); }
        }
        RW_FENCE();
        if (sec_ & 32) {
#pragma unroll 1
            for (int stg = 0; stg < 4; ++stg) {
                const int pt = (stg == 0) ? RL_LP : (stg == 1 ? RL_M : (stg == 2 ? RL_M2 : RL_D));
                const int qt = (stg == 0) ? RL_D : (stg == 3 ? RL_S : RL_M);
                const int dt = (stg == 0) ? RL_M : (stg == 1 ? RL_M2 : (stg == 2 ? RL_S : RL_T));
                if (w < 3) { const int st = (w == 2) ? 1 : 0, tt = (w == 0) ? 0 : 1;
                    f32x16 acc = {};
                    acc = mmx<true, false>(acc, L + pt, 32 * st, L + qt, 32 * tt, 2 * st, 2 * tt + 2, lane);
                    const int t = 32 * tt + r32;
                    if (stg == 2) {
                        const bf16* Mt = (const bf16*)(L + RL_M); const bf16* M2t = (const bf16*)(L + RL_M2);
#pragma unroll
                        for (int g4 = 0; g4 < 4; ++g4) { const int s0 = 32 * st + 8 * g4 + 4 * hh; const v2u mv = *(const v2u*)(Mt + t * TS + s0), m2v = *(const v2u*)(M2t + t * TS + s0);
                            const bool lowt = (tt > st);
                            acc[4 * g4 + 0] += bflo(mv.x) + bflo(m2v.x) + ((s0 + 0 == t) ? 1.f : 0.f); acc[4 * g4 + 1] += bfhi(mv.x) + bfhi(m2v.x) + ((s0 + 1 == t) ? 1.f : 0.f);
                            acc[4 * g4 + 2] += bflo(mv.y) + bflo(m2v.y) + ((s0 + 2 == t) ? 1.f : 0.f); acc[4 * g4 + 3] += bfhi(mv.y) + bfhi(m2v.y) + ((s0 + 3 == t) ? 1.f : 0.f); (void)lowt; }
                    }
                    st_tileT(L + dt, t, 32 * st, acc, hh); }
                RW_FENCE();
            }
        }
        if (sec_ & 64) { const int mat = w >> 2, tl = w & 3, nt = tl >> 1, tt = tl & 1;
          f32x16 acc = {};
          acc = mmx<true, false>(acc, L + (mat ? RL_X : RL_A), 32 * nt, L + RL_T, 32 * tt, 0, tt ? 4 : 2, lane);
          st_tileT(L + (mat ? RL_U : RL_W), 32 * tt + r32, 32 * nt, acc, hh); }
        RW_FENCE();
        if (sec_ & 128) { const int tl = w & 3, ta = tl >> 1, tb2 = tl & 1;
          if (w < 4) {
              f32x16 acc = {};
              acc = mmx<true, true>(acc, L + RL_W, 32 * ta, L + RL_BH, 32 * tb2, 0, 4, lane);
              bf16* MC = (bf16*)(F.ws + WS_RMC) + (size_t)item * 4096;
#pragma unroll
              for (int g4 = 0; g4 < 4; ++g4) { v2u wv; wv.x = cvtpk(acc[4 * g4], acc[4 * g4 + 1]); wv.y = cvtpk(acc[4 * g4 + 2], acc[4 * g4 + 3]); if (wr_) *(v2u*)(MC + (32 * tb2 + r32) * 64 + 32 * ta + 8 * g4 + 4 * hh) = wv; }
              f32x16 an = {};
              an = mmx<true, true>(an, L + RL_BH, 32 * ta, L + RL_U, 32 * tb2, 0, 4, lane);
              an = mmx<true, true>(an, L + RL_KH, 32 * ta, L + RL_V, 32 * tb2, 0, 4, lane);
              bf16* NT = (bf16*)(F.ws + WS_RNT) + (size_t)item * 4096;
#pragma unroll
              for (int g4 = 0; g4 < 4; ++g4) { v2u wv; wv.x = cvtpk(an[4 * g4], an[4 * g4 + 1]); wv.y = cvtpk(an[4 * g4 + 2], an[4 * g4 + 3]); if (wr_) *(v2u*)(NT + (32 * tb2 + r32) * 64 + 32 * ta + 8 * g4 + 4 * hh) = wv; }
          } else {
              f32x16 acc = {};
              acc = mmx<true, false>(acc, L + RL_W, 32 * ta, L + RL_RB, 32 * tb2, 0, tb2 ? 4 : 2, lane);
              const int t = 32 * tb2 + r32; const bf16* Rt = (const bf16*)(L + RL_R);
              bf16* qd = PS + (row0 + t) * PSW + C_RW + h * 64;
#pragma unroll
              for (int g4 = 0; g4 < 4; ++g4) { const int c0 = 32 * ta + 8 * g4 + 4 * hh; const v2u rv = *(const v2u*)(Rt + t * TS + c0);
                  v2u wv; wv.x = cvtpk(acc[4 * g4] + bflo(rv.x), acc[4 * g4 + 1] + bfhi(rv.x)); wv.y = cvtpk(acc[4 * g4 + 2] + bflo(rv.y), acc[4 * g4 + 3] + bfhi(rv.y)); if (wr_) *(v2u*)(qd + c0) = wv; }
              f32x16 ay = {};
              ay = mmx<true, false>(ay, L + RL_U, 32 * ta, L + RL_RB, 32 * tb2, 0, tb2 ? 4 : 2, lane);
              ay = mmx<true, false>(ay, L + RL_V, 32 * ta, L + RL_RK, 32 * tb2, 0, tb2 ? 4 : 2, lane);
              bf16* yd = PS + (row0 + t) * PSW + C_RW + 384 + h * 64;
#pragma unroll
              for (int g4 = 0; g4 < 4; ++g4) { v2u wv; wv.x = cvtpk(ay[4 * g4], ay[4 * g4 + 1]); wv.y = cvtpk(ay[4 * g4 + 2], ay[4 * g4 + 3]); if (wr_) *(v2u*)(yd + 32 * ta + 8 * g4 + 4 * hh) = wv; }
          }
#pragma unroll
          for (int i = 0; i < 8; ++i) { if (wr_) PS[(row0 + 8 * w + i) * PSW + C_RW + 768 + hc] = (bf16)f2bf(eadd[i]); }
        }
        RW_FENCE();
      }
    }
#undef RW_FENCE
}

constexpr int RW_PF = 3;
constexpr size_t WS_RHS = WS_XN;
struct ScanOps { bf16x8_t mf[4]; f32x4 gl[4]; v2u nv[4]; };
__device__ __forceinline__ void scan_load(ScanOps& o, const bf16* __restrict__ MC, const bf16* __restrict__ NT, const float* __restrict__ GL, int ta, int tb2, int r32, int hh) {
#pragma unroll
    for (int s = 0; s < 4; ++s) o.mf[s] = *(const bf16x8_t*)(MC + (32 * ta + r32) * 64 + 16 * s + 8 * hh);
#pragma unroll
    for (int g4 = 0; g4 < 4; ++g4) { const int c0 = 32 * ta + 8 * g4 + 4 * hh; o.gl[g4] = *(const f32x4*)(GL + c0); o.nv[g4] = *(const v2u*)(NT + (32 * tb2 + r32) * 64 + c0); }
}
__device__ __forceinline__ void rwkv_scan_body(unsigned char* L, bf16* __restrict__ HS, const bf16* __restrict__ MC, const bf16* __restrict__ NT, const float* __restrict__ GL, bool act, bool wr, int ta, int tb2, int r32, int hh) {
#define SCAN_BAR() do { asm volatile("s_waitcnt lgkmcnt(0)" ::: "memory"); __builtin_amdgcn_s_barrier(); asm volatile("" ::: "memory"); } while (0)
    if (!act) {
#pragma unroll 1
        for (int j = 0; j < 64; ++j) SCAN_BAR();
        return;
    }
    f32x16 Hacc = {};
    ScanOps ops[RW_PF];
#pragma unroll
    for (int p = 0; p < RW_PF; ++p) scan_load(ops[p], MC + (size_t)p * 4096, NT + (size_t)p * 4096, GL + p * 64, ta, tb2, r32, hh);
#pragma unroll
    for (int j = 0; j < 64; ++j) { constexpr int dummy = 0; (void)dummy; const int p = j % RW_PF;
        const unsigned char* HBc = L + (j & 1) * 9216; unsigned char* HBn = L + ((j + 1) & 1) * 9216;
        if (wr) {
#pragma unroll
            for (int g4 = 0; g4 < 4; ++g4) { v2u wv; wv.x = cvtpk(Hacc[4 * g4], Hacc[4 * g4 + 1]); wv.y = cvtpk(Hacc[4 * g4 + 2], Hacc[4 * g4 + 3]); *(v2u*)(HS + (size_t)j * 4096 + (32 * tb2 + r32) * 64 + 32 * ta + 8 * g4 + 4 * hh) = wv; } }
#pragma unroll
        for (int g4 = 0; g4 < 4; ++g4) { Hacc[4 * g4 + 0] = Hacc[4 * g4 + 0] * ops[p].gl[g4][0] + bflo(ops[p].nv[g4].x); Hacc[4 * g4 + 1] = Hacc[4 * g4 + 1] * ops[p].gl[g4][1] + bfhi(ops[p].nv[g4].x);
            Hacc[4 * g4 + 2] = Hacc[4 * g4 + 2] * ops[p].gl[g4][2] + bflo(ops[p].nv[g4].y); Hacc[4 * g4 + 3] = Hacc[4 * g4 + 3] * ops[p].gl[g4][3] + bfhi(ops[p].nv[g4].y); }
#pragma unroll
        for (int s = 0; s < 4; ++s) Hacc = __builtin_amdgcn_mfma_f32_32x32x16_bf16(ops[p].mf[s], ldfrag(HBc, 32 * tb2 + r32, s, hh), Hacc, 0, 0, 0);
        if (j + RW_PF < 64) scan_load(ops[p], MC + (size_t)(j + RW_PF) * 4096, NT + (size_t)(j + RW_PF) * 4096, GL + (j + RW_PF) * 64, ta, tb2, r32, hh);
        st_tileT(HBn, 32 * tb2 + r32, 32 * ta, Hacc, hh);
        SCAN_BAR();
    }
#undef SCAN_BAR
}
__device__ __forceinline__ void rwkv_scan(const KA& A, const Ctx& F, int l, int b, int h) {
    unsigned char* L = F.lds;
    const int tid = F.tid, lane = F.lane, w = F.wave, r32 = lane & 31, hh = lane >> 5;
    for (int o = tid; o < 2 * 9216 / 4; o += NTHREADS) ((unsigned*)L)[o] = 0u;
    __syncthreads();
    const size_t item0 = (size_t)(b * 6 + h) * 64;
    rwkv_scan_body(L, (bf16*)(F.ws + WS_RHS) + item0 * 4096, (const bf16*)(F.ws + WS_RMC) + item0 * 4096, (const bf16*)(F.ws + WS_RNT) + item0 * 4096, (const float*)(F.ws + WS_RGL) + item0 * 64,
                   w < 4  , !(F.dry && (DRY_SEL & 2)), (w >> 1) & 1, w & 1, r32, hh);
}

__device__ __forceinline__ void rwkv_p3(const KA& A, const Ctx& F) {
    bf16* PS = (bf16*)(F.ws + WS_PS);
    const int lane = F.lane, w = F.wave, r32 = lane & 31, hh = lane >> 5, tb2 = w & 1;
#pragma unroll 1
    for (int it4 = F.bid; it4 < RW_ITEMS / 4; it4 += F.G) {
        const int item = it4 * 4 + (w >> 1); const int j = item & 63, h = (item >> 6) % 6, b = item / 384;
        const size_t row0 = (size_t)b * SEQ + 64 * j;
        const int t = 32 * tb2 + r32;
        const bf16* qd = PS + (row0 + t) * PSW + C_RW + h * 64; const bf16* yd = qd + 384; const bf16* ed = qd + 768; const bf16* EM = (const bf16*)(F.ws + WS_REM) + (size_t)item * 4096 + t * 64;
        const bf16* HS = (const bf16*)(F.ws + WS_RHS) + (size_t)item * 4096;
        bf16x8_t qf[4], hf[2][4];
#pragma unroll
        for (int s = 0; s < 4; ++s) { qf[s] = *(const bf16x8_t*)(qd + 16 * s + 8 * hh); hf[0][s] = *(const bf16x8_t*)(HS + r32 * 64 + 16 * s + 8 * hh); hf[1][s] = *(const bf16x8_t*)(HS + (32 + r32) * 64 + 16 * s + 8 * hh); }
        f32x16 y[2]; v2u em[2][4], ea[2][4];
#pragma unroll
        for (int it = 0; it < 2; ++it)
#pragma unroll
            for (int g4 = 0; g4 < 4; ++g4) { const int i0 = 32 * it + 8 * g4 + 4 * hh; const v2u yv = *(const v2u*)(yd + i0); em[it][g4] = *(const v2u*)(EM + i0); ea[it][g4] = *(const v2u*)(ed + i0);
                y[it][4 * g4] = bflo(yv.x); y[it][4 * g4 + 1] = bfhi(yv.x); y[it][4 * g4 + 2] = bflo(yv.y); y[it][4 * g4 + 3] = bfhi(yv.y); }
#pragma unroll
        for (int it = 0; it < 2; ++it)
#pragma unroll
            for (int s = 0; s < 4; ++s) y[it] = __builtin_amdgcn_mfma_f32_32x32x16_bf16(hf[it][s], qf[s], y[it], 0, 0, 0);
        float s1 = 0.f, s2 = 0.f;
#pragma unroll
        for (int it = 0; it < 2; ++it)
#pragma unroll
            for (int g = 0; g < 16; ++g) { s1 += y[it][g]; s2 += y[it][g] * y[it][g]; }
        s1 = xsum32(s1); s2 = xsum32(s2);
        const float mu = s1 * (1.0f / 64.0f); const float var = fmaxf(s2 * (1.0f / 64.0f) - mu * mu, 0.f); const float rs = 1.0f / sqrtf(var + GN_EPS);
        bf16* od = PS + (row0 + t) * PSW + C_RW + h * 64;
#pragma unroll
        for (int it = 0; it < 2; ++it)
#pragma unroll
            for (int g4 = 0; g4 < 4; ++g4) { const int i0 = 32 * it + 8 * g4 + 4 * hh; const v2u emv = em[it][g4], eav = ea[it][g4];
                v2u wv; wv.x = cvtpk((y[it][4 * g4] - mu) * rs * bflo(emv.x) + bflo(eav.x), (y[it][4 * g4 + 1] - mu) * rs * bfhi(emv.x) + bfhi(eav.x));
                wv.y = cvtpk((y[it][4 * g4 + 2] - mu) * rs * bflo(emv.y) + bflo(eav.y), (y[it][4 * g4 + 3] - mu) * rs * bfhi(emv.y) + bfhi(eav.y));
                if (!(F.dry && (DRY_SEL & 4))) *(v2u*)(od + i0) = wv; }
    }
}
constexpr size_t SSG_TM = 0, SSG_GM = 131072, SSG_HM = 196608, SSG_LAM = 262144, SSG_BYTES = 263168;
constexpr size_t WS_SSM = WS_RGL + 1 * MiB;
static_assert(WS_SSM + 32 * SSG_BYTES <= 512 * MiB, "ssm matrices fit the workspace");
constexpr int ZS = 132;

__device__ __forceinline__ void ssm_prep(const KA& A, const Ctx& F, int l, int g) {
    float* L = (float*)F.lds;
    float* PWr = L, *PWi = L + 17 * 64, *BBr = L + 2 * 17 * 64, *BBi = BBr + 1024, *CCr = BBi + 1024, *CCi = CCr + 1024, *KE = CCi + 1024;
    unsigned char* base = F.ws + WS_SSM + (size_t)(l * 16 + g) * SSG_BYTES;
    const int tid = F.tid;
    __syncthreads();
    if (tid < 64) { const int p = tid;
        const float step = __expf(A.in(16)[l * 16 + g]);
        const float lr = A.in(14)[(size_t)l * 1024 + g * 64 + p], li = A.in(15)[(size_t)l * 1024 + g * 64 + p];
        const float ang = li * step;
        for (int m = 0; m <= 16; ++m) { const float sn = __sinf(ang * (float)m), cs = __cosf(ang * (float)m); const float mg = __expf(lr * step * (float)m); PWr[m * 64 + p] = mg * cs; PWi[m * 64 + p] = mg * sn; }
        const float are = PWr[64 + p], aim = PWi[64 + p];
        const float inv = 1.0f / (lr * lr + li * li);
        const float fre = ((are - 1.0f) * lr + aim * li) * inv, fim = (aim * lr - (are - 1.0f) * li) * inv;
        const float* br = A.in(17) + (size_t)l * 16384 + (size_t)(g * 64 + p) * 16, *bi = A.in(18) + (size_t)l * 16384 + (size_t)(g * 64 + p) * 16;
        for (int c = 0; c < 16; ++c) { BBr[p * 16 + c] = fre * br[c] - fim * bi[c]; BBi[p * 16 + c] = fre * bi[c] + fim * br[c]; }
        float* lam = (float*)(base + SSG_LAM); lam[p] = PWr[16 * 64 + p]; lam[64 + p] = PWi[16 * 64 + p];
    }
    for (int e = tid; e < 1024; e += NTHREADS) { CCr[e] = A.in(19)[(size_t)l * 16384 + g * 1024 + e]; CCi[e] = A.in(20)[(size_t)l * 16384 + g * 1024 + e]; }
    __syncthreads();
    for (int e = tid; e < 4096; e += NTHREADS) { const int tau = e >> 8, c = (e >> 4) & 15, cp = e & 15; float s = 0.f;
        for (int p = 0; p < 64; ++p) { const float wr = CCr[c * 64 + p] * PWr[tau * 64 + p] - CCi[c * 64 + p] * PWi[tau * 64 + p], wi = CCr[c * 64 + p] * PWi[tau * 64 + p] + CCi[c * 64 + p] * PWr[tau * 64 + p];
            s += wr * BBr[p * 16 + cp] - wi * BBi[p * 16 + cp]; }
        KE[e] = s; }
    __syncthreads();
    const float* dsk = A.in(21) + l * 256 + g * 16;
    bf16* TM = (bf16*)(base + SSG_TM); bf16* GM = (bf16*)(base + SSG_GM); bf16* HM = (bf16*)(base + SSG_HM);
    for (int e = tid; e < 65536; e += NTHREADS) { const int n = e >> 8, k = e & 255, tp = n >> 4, c = n & 15, sp = k >> 4, cp = k & 15;
        float v = (sp <= tp) ? KE[((tp - sp) << 8) + (c << 4) + cp] : 0.f; if (sp == tp && c == cp) v += dsk[c];
        TM[e] = (bf16)f2bf(v); }
    for (int e = tid; e < 32768; e += NTHREADS) { const int n = e >> 8, k = e & 255, p = n & 63, im = n >> 6, sp = k >> 4, cp = k & 15, m = 15 - sp;
        const float wr = PWr[m * 64 + p] * BBr[p * 16 + cp] - PWi[m * 64 + p] * BBi[p * 16 + cp], wi = PWr[m * 64 + p] * BBi[p * 16 + cp] + PWi[m * 64 + p] * BBr[p * 16 + cp];
        GM[e] = (bf16)f2bf(im ? wi : wr); }
    for (int e = tid; e < 32768; e += NTHREADS) { const int n = e >> 7, k = e & 127, tp = n >> 4, c = n & 15, p = k & 63, im = k >> 6, m = tp + 1;
        const float wr = CCr[c * 64 + p] * PWr[m * 64 + p] - CCi[c * 64 + p] * PWi[m * 64 + p], wi = CCr[c * 64 + p] * PWi[m * 64 + p] + CCi[c * 64 + p] * PWr[m * 64 + p];
        HM[e] = (bf16)f2bf(im ? -wi : wr); }
    __syncthreads();
}

__device__ __forceinline__ void ssm_v2(const KA& A, const Ctx& F, int l, int b, int g) {
    bf16* PS = (bf16*)(F.ws + WS_PS);
    float* ZF = (float*)F.lds;
    const unsigned char* base = F.ws + WS_SSM + (size_t)(l * 16 + g) * SSG_BYTES;
    const bf16* TM = (const bf16*)(base + SSG_TM); const bf16* GM = (const bf16*)(base + SSG_GM); const bf16* HM = (const bf16*)(base + SSG_HM); const float* lam = (const float*)(base + SSG_LAM);
    const int lane = F.lane, w = F.wave, r32 = lane & 31, hh = lane >> 5;
    const size_t tok0 = (size_t)b * SEQ + 512 * w;
    bf16x8_t uf[16];
    { const bf16* up = PS + (tok0 + 16 * r32) * PSW + C_SSM + 16 * g + 8 * hh;
#pragma unroll
      for (int s = 0; s < 16; ++s) uf[s] = *(const bf16x8_t*)(up + (size_t)s * PSW); }
#pragma unroll 1
    for (int nt = 0; nt < 4; ++nt) {
        f32x16 acc = {};
        const bf16* gp = GM + (size_t)(32 * nt + r32) * 256 + 8 * hh;
#pragma unroll
        for (int s = 0; s < 16; ++s) acc = __builtin_amdgcn_mfma_f32_32x32x16_bf16(uf[s], *(const bf16x8_t*)(gp + 16 * s), acc, 0, 0, 0);
#pragma unroll
        for (int q = 0; q < 16; ++q) ZF[(32 * w + crow16(q, hh)) * ZS + 32 * nt + r32] = acc[q];
    }
    __syncthreads();
    if (w == 0) { const float lr = lam[lane], li = lam[64 + lane]; float xr = 0.f, xi = 0.f;
#pragma unroll 8
        for (int j = 0; j < 256; ++j) { const float zr = ZF[j * ZS + lane], zi = ZF[j * ZS + 64 + lane];
            ZF[j * ZS + lane] = xr; ZF[j * ZS + 64 + lane] = xi;
            const float nr = lr * xr - li * xi + zr, ni = lr * xi + li * xr + zi; xr = nr; xi = ni; } }
    __syncthreads();
    bf16x8_t xf[8];
    { const float* zp = ZF + (32 * w + r32) * ZS + 8 * hh;
#pragma unroll
      for (int s = 0; s < 8; ++s) { const f32x4 a0 = *(const f32x4*)(zp + 16 * s), a1 = *(const f32x4*)(zp + 16 * s + 4);
          v4u pw; pw.x = cvtpk(a0[0], a0[1]); pw.y = cvtpk(a0[2], a0[3]); pw.z = cvtpk(a1[0], a1[1]); pw.w = cvtpk(a1[2], a1[3]); xf[s] = __builtin_bit_cast(bf16x8_t, pw); } }
#pragma unroll
    for (int nt = 0; nt < 8; ++nt) {
        f32x16 acc = {};
        const bf16* tp = TM + (size_t)(32 * nt + r32) * 256 + 8 * hh; const bf16* hp = HM + (size_t)(32 * nt + r32) * 128 + 8 * hh;
#pragma unroll
        for (int s = 0; s < 16; ++s) if (s <= 2 * nt + 1) acc = __builtin_amdgcn_mfma_f32_32x32x16_bf16(uf[s], *(const bf16x8_t*)(tp + 16 * s), acc, 0, 0, 0);
#pragma unroll
        for (int s = 0; s < 8; ++s) acc = __builtin_amdgcn_mfma_f32_32x32x16_bf16(xf[s], *(const bf16x8_t*)(hp + 16 * s), acc, 0, 0, 0);
        bf16* op = PS + (tok0 + 2 * nt + (r32 >> 4)) * PSW + C_SSM + 16 * g + (r32 & 15);
#pragma unroll
        for (int q = 0; q < 16; ++q) { const bf16 gv_ = (bf16)f2bf(gelu_tanh(acc[q])); if (!(F.dry && (DRY_SEL & 2))) op[(size_t)(16 * crow16(q, hh)) * PSW] = gv_; }
    }
    __syncthreads();
}
typedef GAS unsigned gu32;
#define RLX_AGENT __ATOMIC_RELAXED, __HIP_MEMORY_SCOPE_AGENT
#define XB_TMO      128
#define XB_XCNT(j)  (256  + 64 * (j))
#define XB_XSUB(j)  (1280 + 64 * (j))
#define XB_XGEN(j)  (2304 + 64 * (j))
#define XB_TOP      3328
#define XB_TOPGEN   3392
#define XCD_BAR_WORDS 3456
#define XB_SPIN_CAP (1u << 18)

__device__ __forceinline__ unsigned xb_ld(unsigned* p)              { return __hip_atomic_load(p, __ATOMIC_RELAXED, __HIP_MEMORY_SCOPE_AGENT); }
__device__ __forceinline__ unsigned xb_add(unsigned* p, unsigned v) { return __hip_atomic_fetch_add(p, v, __ATOMIC_RELAXED, __HIP_MEMORY_SCOPE_AGENT); }
__device__ __forceinline__ unsigned xb_xcc_id() { return (unsigned)__builtin_amdgcn_s_getreg((3 << 11) | 20) & 0xFu; }
#define XB_SPIN(cond, bar) do { unsigned _sp = 0; while (cond) { __builtin_amdgcn_s_sleep(1); \
    if ((++_sp & 255u) == 0u) { if (xb_ld(&(bar)[XB_TMO])) break; if (_sp > XB_SPIN_CAP) { atomicAdd(&(bar)[XB_TMO], 1u); break; } } } } while (0)

struct XcdBarrier {
    unsigned* bar; unsigned x;
    volatile LAS unsigned* st;
};

__device__ __forceinline__ XcdBarrier xcd_barrier_post(unsigned* bar, volatile LAS unsigned* st) {
    XcdBarrier b; b.bar = bar; b.x = xb_xcc_id(); b.st = st;
    if (threadIdx.x == 0) (void)xb_add(&bar[XB_XCNT(b.x)], 1u);
    return b;
}
__device__ __forceinline__ void xcd_barrier_complete(unsigned* bar, unsigned x, unsigned& nloc, unsigned& nx) {
    const unsigned G = gridDim.x * gridDim.y * gridDim.z;
    unsigned sum, cnt, mine, sp = 0u;
    for (;;) {
        sum = 0u; cnt = 0u; mine = 0u;
#pragma unroll
        for (unsigned j = 0; j < 16; ++j) { const unsigned c = xb_ld(&bar[XB_XCNT(j)]); sum += c; cnt += (c > 0u) ? 1u : 0u; mine = (j == x) ? c : mine; }
        if (sum == G) break;
        __builtin_amdgcn_s_sleep(1);
        if ((++sp & 255u) == 0u) { if (xb_ld(&bar[XB_TMO])) break; if (sp > XB_SPIN_CAP) { atomicAdd(&bar[XB_TMO], 1u); break; } }
    }
    nloc = mine > 0u ? mine : 1u; nx = cnt > 0u ? cnt : 1u;
}

__device__ __forceinline__ void xcd_barrier(const XcdBarrier& b) {
    asm volatile("s_waitcnt vmcnt(0)" ::: "memory");
    __syncthreads();
    if (threadIdx.x == 0) {
        unsigned* bar = b.bar;
        __builtin_amdgcn_s_waitcnt(0);
        unsigned nloc = b.st[0], nx = b.st[1];
        if (nloc == 0u) { xcd_barrier_complete(bar, b.x, nloc, nx); b.st[0] = nloc; b.st[1] = nx; }
        const unsigned old = xb_add(&bar[XB_XSUB(b.x)], 1u);
        const unsigned gen = old / nloc;
        if (old + 1u == (gen + 1u) * nloc) {
            __builtin_amdgcn_fence(__ATOMIC_RELEASE, "agent");
            asm volatile("s_waitcnt vmcnt(0)" ::: "memory");
            const unsigned og = xb_add(&bar[XB_TOP], 1u);
            const unsigned tg = og / nx;
            if (og + 1u == (tg + 1u) * nx) xb_add(&bar[XB_TOPGEN], 1u);
            else XB_SPIN(xb_ld(&bar[XB_TOPGEN]) == tg, bar);
            __builtin_amdgcn_fence(__ATOMIC_ACQUIRE, "agent");
            xb_add(&bar[XB_XGEN(b.x)], 1u);
            asm volatile("s_waitcnt vmcnt(0)" ::: "memory");
        } else {
            XB_SPIN(xb_ld(&bar[XB_XGEN(b.x)]) == gen, bar);
            __builtin_amdgcn_fence(__ATOMIC_ACQUIRE, "agent");
            asm volatile("s_waitcnt vmcnt(0)" ::: "memory");
        }
    }
    __syncthreads();
}

constexpr int PPL = 10, NPH = 2 + DEPTH * PPL;

__device__ __forceinline__ void run_phase(const KA& A, const Ctx& F, int ph) {
    PG8_LAS unsigned char* lds3 = (PG8_LAS unsigned char*)F.lds;
    bf16* XN = (bf16*)(F.ws + WS_XN); bf16* PS = (bf16*)(F.ws + WS_PS); bf16* SO = (bf16*)(F.ws + WS_SO);
    const int l = (ph - 1) / PPL, k = (ph == 0) ? 20 : (ph == NPH - 1 ? 21 : (ph - 1) % PPL);
    unsigned char* wl = F.ws + WS_W + (size_t)l * W_LAYER;
    const float* hin = (l == 0) ? A.in(0) : F.out;
    int ngemm = 0;
    if (k == 20) { phase_prep(A, F); for (int it = F.bid; it < 32; it += F.G) ssm_prep(A, F, it >> 4, it & 15); }
    else if (k == 21) phase_rmsnorm<true>(A, F, F.out, A.in(31), F.out);
    else if (k == 0) phase_rmsnorm<false>(A, F, hin, A.in(1) + l * D, XN);
    else if (k == 7) phase_rmsnorm<false>(A, F, F.out, A.in(28) + l * D, XN);
    else if (k == 2) rwkv_p1(A, F, l);
    else if (k == 3) {
#ifdef P3D
        const int p3m = F.dry ? P3D : 7;
#else
        constexpr int p3m = 7;
#endif
        if (F.bid < 48) { if (p3m & 1) rwkv_scan(A, F, l, F.bid / 6, F.bid % 6); }
        else if (F.bid < 176) { if (p3m & 2) { const int it = F.bid - 48; ssm_v2(A, F, l, it / 16, it % 16); } }
        __syncthreads();
        if (p3m & 4) attn_v2(A, F, l);
    }
    else if (k == 4) { rwkv_p3(A, F); attn_finalize(A, F); ngemm = 1; }
    else if (k == 5) ngemm = 3;
    else ngemm = 1;
#pragma unroll 1
    for (int gi = 0; gi < ngemm; ++gi) {
        pg8::Gemm g; pg8::EpiAny E; E.kind = 0; E.gi = gi; E.ws = F.ws; E.base = hin; E.out = F.out;
        if (k == 1) { g = pg8::Gemm{XN, (const bf16*)(wl + WO_IN), NIN, D, D}; E.kind = 0; }
        else if (k == 4) { g = pg8::Gemm{PS + C_SSM, (const bf16*)(wl + WO_GLU), 512, 256, PSW}; E.kind = 4; }
        else if (k == 5) { E.kind = 1;
            if (gi == 0) g = pg8::Gemm{PS + C_Q, (const bf16*)(wl + WO_BA), D, 384, PSW};
            else if (gi == 1) g = pg8::Gemm{PS + C_RW, (const bf16*)(wl + WO_BR), D, 384, PSW};
            else g = pg8::Gemm{SO, (const bf16*)(wl + WO_BS), D, 256, 256}; }
        else if (k == 6) { g = pg8::Gemm{XN, (const bf16*)(wl + WO_OUT), D, D, D}; E.kind = 2; }
        else if (k == 8) { g = pg8::Gemm{XN, (const bf16*)(wl + WO_GU), 2 * FFH, D, D}; E.kind = 3; }
        else { g = pg8::Gemm{PS, (const bf16*)(wl + WO_DN), D, FFH, FFH}; E.kind = 2; E.base = F.out; }
        pg8::StaticOrder S; S.init(g.N, F.G, F.bid);
        pg8::gemm_phase<pg8::EpiAny, pg8::StaticOrder, true>(lds3, g, S, E);
    }
}

static_assert(pg8::EP_XN == WS_XN && pg8::EP_PS == WS_PS && pg8::EP_GT == WS_GT && pg8::EP_SO == WS_SO && pg8::EP_BR == WS_BR, "epilogue workspace offsets");

__global__ void __launch_bounds__(NTHREADS, 2) mega_fwd(Args args) {
    extern __shared__ __attribute__((aligned(16))) unsigned char lds[];
#if ONE_LAUNCH
    volatile LAS unsigned* misc = (volatile LAS unsigned*)((LAS unsigned char*)lds + MISC_OFF);
    if (threadIdx.x < 32) misc[threadIdx.x] = 0u;
    __syncthreads();
    XcdBarrier bar = xcd_barrier_post((unsigned*)(args.ws + WS_CTL) + CW_BAR, misc + 8);
#endif
#pragma unroll 1
    for (int ph = args.ph_lo; ph < args.ph_hi; ++ph) {
        int nrep_ = 1;
#ifdef REP_MASK
        { const int kk_ = (ph == 0 || ph == NPH - 1) ? 99 : (ph - 1) % PPL; const int ll_ = (ph - 1) / PPL;
          if ((kk_ < 16) && ((REP_MASK >> kk_) & 1) && !(kk_ == 6 && ll_ == 1)) nrep_ = 2;
          if (ph == 0 && ((REP_MASK >> 15) & 1)) nrep_ = 2; }
#endif
#pragma unroll 1
        for (int rp_ = 0; rp_ < nrep_; ++rp_) {
            KA A; A.p = (kptr_t)__builtin_amdgcn_kernarg_segment_ptr(); asm volatile("" : "+s"(A.p));
            int tid = threadIdx.x, bid = blockIdx.x, G = gridDim.x; asm volatile("" : "+v"(tid), "+s"(bid), "+s"(G));
            Ctx F;
            F.lds = lds; F.ws = A.ws(); F.out = A.out();
            F.tid = tid; F.lane = tid & 63; F.wave = __builtin_amdgcn_readfirstlane(tid >> 6); F.G = G; F.bid = bid; F.dry = (nrep_ == 2 && rp_ == 0) ? 1 : 0;
            run_phase(A, F, ph);
            __syncthreads();
        }
#if ONE_LAUNCH
        if (ph + 1 < args.ph_hi) {
#ifdef EXTRA_SYNCS
            for (int e_ = 0; e_ < EXTRA_SYNCS; ++e_) { XcdBarrier b2 = bar; asm volatile("" : "+s"(b2.bar)); xcd_barrier(b2); }
#endif
            if (ph == 0) { __threadfence(); cg::this_grid().sync(); }
            else { XcdBarrier b2 = bar; asm volatile("" : "+s"(b2.bar)); xcd_barrier(b2); } }
#endif
    }
}

extern "C" void kernel_launch(void* const* d_in, const int* in_sizes, int n_in, void* d_out, int out_size, void* d_ws, size_t ws_size, hipStream_t stream) {
    static int grid = 0;
    if (grid == 0) {
        if (n_in != 32 || in_sizes[0] != T * D || out_size != T * D || ws_size < WS_END) { fprintf(stderr, "kernel_launch: unexpected shapes (n_in %d, in0 %d, out %d, ws %zu); nothing launched\n", n_in, n_in > 0 ? in_sizes[0] : -1, out_size, ws_size); grid = -1; return; }
        int dev = 0, cus = 0, per_cu = 0;
        if (hipGetDevice(&dev) != hipSuccess || hipDeviceGetAttribute(&cus, hipDeviceAttributeMultiprocessorCount, dev) != hipSuccess) { grid = -1; return; }
        if (hipFuncSetAttribute((const void*)mega_fwd, hipFuncAttributeMaxDynamicSharedMemorySize, LDS_BYTES) != hipSuccess) { fprintf(stderr, "kernel_launch: hipFuncSetAttribute failed\n"); grid = -1; return; }
        if (hipOccupancyMaxActiveBlocksPerMultiprocessor(&per_cu, (const void*)mega_fwd, NTHREADS, LDS_BYTES) != hipSuccess || per_cu < 1) { fprintf(stderr, "kernel_launch: occupancy query says %d\n", per_cu); per_cu = 1; }
        (void)hipGetLastError();
        grid = cus;
        if (grid < 200) { fprintf(stderr, "kernel_launch: needs >= 200 CUs, got %d\n", grid); grid = -1; return; }
    }
    if (grid < 0) return;
    if (hipMemsetAsync((char*)d_ws + WS_CTL, 0, CTL_ZERO_BYTES, stream) != hipSuccess) { fprintf(stderr, "kernel_launch: hipMemsetAsync failed\n"); return; }
    Args a{};
    for (int i = 0; i < 32; ++i) a.in[i] = (const float*)d_in[i];
    a.out = (float*)d_out; a.ws = (unsigned char*)d_ws;
#if ONE_LAUNCH
    a.ph_lo = 0; a.ph_hi = NPH;
    void* kargs[] = {&a};
    hipError_t e = hipLaunchCooperativeKernel((const void*)mega_fwd, dim3(grid), dim3(NTHREADS), kargs, LDS_BYTES, stream);
    if (e != hipSuccess) fprintf(stderr, "kernel_launch: cooperative launch failed: %s (grid %d)\n", hipGetErrorString(e), grid);
#else
    for (int ph = 0; ph < NPH; ++ph) {
        a.ph_lo = ph; a.ph_hi = ph + 1;
        hipLaunchKernelGGL(mega_fwd, dim3(grid), dim3(NTHREADS), LDS_BYTES, stream, a);
    }
#endif
}
```
